# Optimizing an MI355X kernel written in HIP

```python
import jax, jax.numpy as jnp
from jax import lax
import numpy as np

D_MODEL = 1024
BATCH = 8
SEQ = 4096
DEPTH = 2

HEAD_DIM = 64
GRID_W = 64
NA_HEADS = D_MODEL // (4 * HEAD_DIM)
NA_WIN_H = 8
NA_WIN_W = 16
MLA_HEADS = 3 * D_MODEL // (8 * HEAD_DIM)
MLA_Q_LORA = D_MODEL // 4
MLA_KV_LORA = D_MODEL // 8
MLA_NOPE = 64
MLA_ROPE = 32
MLA_V = 64
MLA_BLOCK = 128
SWA_HEADS = 3 * D_MODEL // (8 * HEAD_DIM)
SWA_KV_HEADS = 2
SWA_WINDOW = 128
SWA_BLOCK = 128
ROPE_THETA = 10000.0
N_EXPERTS = 16
EC_CAPACITY = 2
D_EXPERT = D_MODEL
RMS_EPS = 1e-6
NEG_INF = -1e30

A_W = NA_HEADS * HEAD_DIM
B_W = MLA_HEADS * MLA_V
C_W = SWA_HEADS * HEAD_DIM
D_MIX = A_W + B_W + C_W
IN_WIDTHS = (A_W, A_W, A_W,
             MLA_Q_LORA, MLA_KV_LORA, MLA_ROPE,
             SWA_HEADS * HEAD_DIM, SWA_KV_HEADS * HEAD_DIM, SWA_KV_HEADS * HEAD_DIM)
IN_COLS = sum(IN_WIDTHS)
IN_OFFSETS = tuple(int(v) for v in np.cumsum(IN_WIDTHS)[:-1])

kernel_name = 'hybrid_na_mla_swa_ec_encoder'


def rms_norm(x, g):
    x32 = x.astype(jnp.float32)
    y = x32 * lax.rsqrt(jnp.mean(x32 * x32, axis=-1, keepdims=True) + RMS_EPS)
    return (y * g.astype(jnp.float32)).astype(x.dtype)


def rope_tables(seq, dim, dtype):
    inv = 1.0 / (ROPE_THETA ** (jnp.arange(0, dim, 2, dtype=jnp.float32) / dim))
    ang = jnp.arange(seq, dtype=jnp.float32)[:, None] * inv[None, :]
    return jnp.cos(ang).astype(dtype), jnp.sin(ang).astype(dtype)


def apply_rope(x, cos, sin):
    x1, x2 = jnp.split(x, 2, axis=-1)
    c = cos[None, :, None, :]
    s = sin[None, :, None, :]
    return jnp.concatenate([x1 * c - x2 * s, x2 * c + x1 * s], axis=-1)


def neighbourhood_attention(q, k, v, rpb):
    B, S, _ = q.shape
    rows = S // GRID_W
    wh = min(NA_WIN_H, rows)
    ww = NA_WIN_W
    shp = (B, rows, GRID_W, NA_HEADS, HEAD_DIM)
    qg, kg, vg = q.reshape(shp), k.reshape(shp), v.reshape(shp)
    cols = jnp.arange(GRID_W)
    col_start = jnp.clip(cols - ww // 2, 0, GRID_W - ww)
    col_idx = col_start[:, None] + jnp.arange(ww)[None, :]
    dc = col_idx - cols[:, None] + (NA_WIN_W - 1)
    scale = HEAD_DIM ** -0.5

    def one_row(args):
        r, q_row = args
        rs = jnp.clip(r - wh // 2, 0, rows - wh)
        k_rows = lax.dynamic_slice_in_dim(kg, rs, wh, axis=1)
        v_rows = lax.dynamic_slice_in_dim(vg, rs, wh, axis=1)
        k_win = k_rows[:, :, col_idx]
        v_win = v_rows[:, :, col_idx]
        dr = rs + jnp.arange(wh) - r + (NA_WIN_H - 1)
        bias = rpb[:, dr][:, :, dc].transpose(0, 2, 1, 3)
        s = jnp.einsum('bchd,brcjhd->bhcrj', q_row, k_win).astype(jnp.float32) * scale
        s = s + bias[None].astype(jnp.float32)
        p = jax.nn.softmax(s.reshape(B, NA_HEADS, GRID_W, wh * ww), axis=-1)
        p = p.reshape(s.shape).astype(v.dtype)
        return jnp.einsum('bhcrj,brcjhd->bchd', p, v_win)

    out = lax.map(one_row, (jnp.arange(rows), qg.swapaxes(0, 1)))
    return out.swapaxes(0, 1).reshape(B, S, NA_HEADS * HEAD_DIM)


def latent_attention(c_q, c_kv, k_rope, q_norm, w_uq, kv_norm, w_ukv, cos_r, sin_r):
    B, S, _ = c_q.shape
    q = (rms_norm(c_q, q_norm) @ w_uq).reshape(B, S, MLA_HEADS, MLA_NOPE + MLA_ROPE)
    q_nope = q[..., :MLA_NOPE]
    q_pe = apply_rope(q[..., MLA_NOPE:], cos_r, sin_r)
    kv = (rms_norm(c_kv, kv_norm) @ w_ukv).reshape(B, S, MLA_HEADS, MLA_NOPE + MLA_V)
    k_nope = kv[..., :MLA_NOPE]
    v = kv[..., MLA_NOPE:]
    k_pe = apply_rope(k_rope[:, :, None, :], cos_r, sin_r)[:, :, 0]
    nb = S // MLA_BLOCK
    scale = (MLA_NOPE + MLA_ROPE) ** -0.5

    def to_blocks(t):
        return t.reshape(B, nb, MLA_BLOCK, *t.shape[2:]).swapaxes(0, 1)

    def one_block(args):
        qn, qp = args
        s = (jnp.einsum('bqhd,bkhd->bhqk', qn, k_nope)
             + jnp.einsum('bqhd,bkd->bhqk', qp, k_pe)).astype(jnp.float32) * scale
        p = jax.nn.softmax(s, axis=-1).astype(v.dtype)
        return jnp.einsum('bhqk,bkhd->bqhd', p, v)

    o = lax.map(one_block, (to_blocks(q_nope), to_blocks(q_pe)))
    return o.swapaxes(0, 1).reshape(B, S, MLA_HEADS * MLA_V)


def window_gqa(q, k, v, sink, cos, sin):
    B, S, _ = q.shape
    G = SWA_HEADS // SWA_KV_HEADS
    q = apply_rope(q.reshape(B, S, SWA_HEADS, HEAD_DIM), cos, sin)
    k = apply_rope(k.reshape(B, S, SWA_KV_HEADS, HEAD_DIM), cos, sin)
    v = v.reshape(B, S, SWA_KV_HEADS, HEAD_DIM)
    nb = S // SWA_BLOCK
    n_side = -(-SWA_WINDOW // SWA_BLOCK)
    pad = n_side * SWA_BLOCK
    n_keys = (2 * n_side + 1) * SWA_BLOCK

    def band(t):
        tp = jnp.pad(t, ((0, 0), (pad, pad), (0, 0), (0, 0)))
        tp = tp.reshape(B, nb + 2 * n_side, SWA_BLOCK, SWA_KV_HEADS, HEAD_DIM)
        return jnp.concatenate([tp[:, i:i + nb] for i in range(2 * n_side + 1)], axis=2)

    kb, vb = band(k), band(v)
    qb = q.reshape(B, nb, SWA_BLOCK, SWA_KV_HEADS, G, HEAD_DIM)
    s = jnp.einsum('bnqkgd,bnjkd->bnkgqj', qb, kb).astype(jnp.float32) * (HEAD_DIM ** -0.5)
    blk = jnp.arange(nb)[:, None, None] * SWA_BLOCK
    qpos = blk + jnp.arange(SWA_BLOCK)[None, :, None]
    kpos = blk - pad + jnp.arange(n_keys)[None, None, :]
    valid = (jnp.abs(qpos - kpos) <= SWA_WINDOW) & (kpos >= 0) & (kpos < S)
    s = jnp.where(valid[None, :, None, None], s, NEG_INF)
    sink_logit = jnp.broadcast_to(sink.astype(jnp.float32).reshape(1, 1, SWA_KV_HEADS, G, 1, 1),
                                  s.shape[:-1] + (1,))
    p = jax.nn.softmax(jnp.concatenate([s, sink_logit], axis=-1), axis=-1)[..., :-1].astype(v.dtype)
    o = jnp.einsum('bnkgqj,bnjkd->bnqkgd', p, vb)
    return o.reshape(B, S, SWA_HEADS * HEAD_DIM)


def expert_choice_ffn(xn, w_router, w_gate, w_up, w_down):
    B, S, D = xn.shape
    cap = EC_CAPACITY * S // N_EXPERTS
    aff = jax.nn.softmax((xn @ w_router).astype(jnp.float32), axis=-1)
    g, idx = lax.top_k(aff.swapaxes(1, 2), cap)
    bidx = jnp.arange(B)[:, None, None]
    xs = xn[bidx, idx]
    hid = jax.nn.silu(jnp.einsum('becd,edf->becf', xs, w_gate)) * jnp.einsum('becd,edf->becf', xs, w_up)
    y = jnp.einsum('becf,efd->becd', hid, w_down) * g[..., None].astype(xn.dtype)
    return jnp.zeros_like(xn).at[bidx, idx].add(y)


def setup_inputs(seed: int = 0) -> dict:
    key = jax.random.key(seed)
    ks = jax.random.split(key, 17)
    f32 = jnp.float32

    def nrm(k, shape, scale):
        return jax.random.normal(k, shape, f32) * scale

    def gain(k, shape):
        return 1.0 + 0.05 * jax.random.normal(k, shape, f32)

    return {
        'x': nrm(ks[0], (BATCH, SEQ, D_MODEL), 1.0),
        'attn_norm': gain(ks[1], (DEPTH, D_MODEL)),
        'w_in': nrm(ks[2], (DEPTH, D_MODEL, IN_COLS), D_MODEL ** -0.5),
        'na_rpb': nrm(ks[3], (DEPTH, NA_HEADS, 2 * NA_WIN_H - 1, 2 * NA_WIN_W - 1), 0.1),
        'mla_q_norm': gain(ks[4], (DEPTH, MLA_Q_LORA)),
        'mla_w_uq': nrm(ks[5], (DEPTH, MLA_Q_LORA, MLA_HEADS * (MLA_NOPE + MLA_ROPE)), MLA_Q_LORA ** -0.5),
        'mla_kv_norm': gain(ks[6], (DEPTH, MLA_KV_LORA)),
        'mla_w_ukv': nrm(ks[7], (DEPTH, MLA_KV_LORA, MLA_HEADS * (MLA_NOPE + MLA_V)), MLA_KV_LORA ** -0.5),
        'swa_sink': nrm(ks[8], (DEPTH, SWA_HEADS), 1.0),
        'group_norm': gain(ks[9], (DEPTH, D_MIX)),
        'w_out': nrm(ks[10], (DEPTH, D_MIX, D_MODEL), D_MIX ** -0.5),
        'ffn_norm': gain(ks[11], (DEPTH, D_MODEL)),
        'w_router': nrm(ks[12], (DEPTH, D_MODEL, N_EXPERTS), D_MODEL ** -0.5),
        'w_gate': nrm(ks[13], (DEPTH, N_EXPERTS, D_MODEL, D_EXPERT), D_MODEL ** -0.5),
        'w_up': nrm(ks[14], (DEPTH, N_EXPERTS, D_MODEL, D_EXPERT), D_MODEL ** -0.5),
        'w_down': nrm(ks[15], (DEPTH, N_EXPERTS, D_EXPERT, D_MODEL), D_EXPERT ** -0.5),
        'final_norm': gain(ks[16], (D_MODEL,)),
    }


def reference(x, attn_norm, w_in, na_rpb, mla_q_norm, mla_w_uq, mla_kv_norm, mla_w_ukv, swa_sink,
              group_norm, w_out, ffn_norm, w_router, w_gate, w_up, w_down, final_norm):
    B, S, _ = x.shape
    cos, sin = rope_tables(S, HEAD_DIM, x.dtype)
    cos_r, sin_r = rope_tables(S, MLA_ROPE, x.dtype)
    h = x
    for l in range(DEPTH):
        xn = rms_norm(h, attn_norm[l])
        proj = xn @ w_in[l]
        a_q, a_k, a_v, b_cq, b_ckv, b_kr, c_q, c_k, c_v = jnp.split(proj, IN_OFFSETS, axis=-1)
        o_a = neighbourhood_attention(a_q, a_k, a_v, na_rpb[l])
        o_b = latent_attention(b_cq, b_ckv, b_kr, mla_q_norm[l], mla_w_uq[l],
                               mla_kv_norm[l], mla_w_ukv[l], cos_r, sin_r)
        o_c = window_gqa(c_q, c_k, c_v, swa_sink[l], cos, sin)
        gn = group_norm[l]
        o = jnp.concatenate([rms_norm(o_a, gn[:A_W]),
                             rms_norm(o_b, gn[A_W:A_W + B_W]),
                             rms_norm(o_c, gn[A_W + B_W:])], axis=-1)
        h = h + o @ w_out[l]
        h = h + expert_choice_ffn(rms_norm(h, ffn_norm[l]), w_router[l], w_gate[l], w_up[l], w_down[l])
    return rms_norm(h, final_norm)
```

```cpp
#include <hip/hip_runtime.h>
#include <cstdint>
#include <cstdio>

typedef unsigned short bf16;
constexpr int NB = 8, NS = 4096, DM = 1024, NT = NB * NS, NP = 2048, NE = 16, CAP = 512, DEPTH = 2;
constexpr int NSLOTS = NE * NB * CAP;
constexpr float LOG2E = 1.4426950408889634f;
constexpr float QS64 = 0.125f * LOG2E;
constexpr float QS96 = 0.10206207261596577f * LOG2E;
constexpr float EPS = 1e-6f;
constexpr int C_AQ = 0, C_AK = 256, C_AV = 512, C_CQ = 768, C_CKV = 1024, C_KR = 1152, C_SQ = 1184, C_SK = 1568, C_SV = 1696, C_END = 1824;

constexpr size_t MiB = 1u << 20;
constexpr size_t WS_CTL = 0;
constexpr size_t WS_COS64 = 1 * MiB, WS_SIN64 = WS_COS64 + 512 * 1024, WS_COS32 = 2 * MiB, WS_SIN32 = WS_COS32 + 256 * 1024;
constexpr size_t WS_WIN = 4 * MiB, WS_WUQ = 8 * MiB, WS_WUKV = 8 * MiB + 512 * 1024, WS_WOUT = 9 * MiB, WS_WGU = 12 * MiB, WS_WD = 76 * MiB;
constexpr size_t WS_CQSS = 108 * MiB, WS_CKVSS = WS_CQSS + 512 * 1024, WS_SS = 109 * MiB, WS_AFF = 111 * MiB, WS_INV = 113 * MiB, WS_IDX = 115 * MiB, WS_GATE = WS_IDX + 256 * 1024;
constexpr size_t WS_XN = 120 * MiB;
constexpr size_t WS_PROJ = 184 * MiB;
constexpr size_t WS_QB = 312 * MiB;
constexpr size_t WS_KV = 348 * MiB;
constexpr size_t WS_HID = 312 * MiB;
constexpr size_t WS_END = 440 * MiB;

__device__ __forceinline__ unsigned f2bf(float f) { unsigned u = __builtin_bit_cast(unsigned, f); return (u + 0x7fffu + ((u >> 16) & 1u)) >> 16; }
__device__ __forceinline__ float bf2f(unsigned short b) { return __builtin_bit_cast(float, (unsigned)b << 16); }
__device__ __forceinline__ float wave_sum(float v) {
#pragma unroll
    for (int o = 1; o < 64; o <<= 1) v += __shfl_xor(v, o);
    return v;
}

enum { PK_WIN = 0, PK_WUQ = 1, PK_WUKV = 2, PK_WOUT = 3, PK_WGU = 4, PK_WD = 5 };
__device__ __forceinline__ int prep_map(int kind, int n, float& sc, int& which) {
    sc = 1.f; which = 0;
    switch (kind) {
    case PK_WIN:
        if (n < 256) { sc = QS64; return n; }
        if (n < C_KR) return n;
        if (n < C_SQ) { const int p = n - C_KR, g = p >> 3, e = p & 7; return C_KR + 4 * g + (e & 3) + 16 * (e >> 2); }
        if (n < C_SK) { const int p = n - C_SQ, h = p >> 6, pp = p & 63, g = pp >> 3, e = pp & 7; sc = QS64; return C_SQ + h * 64 + 4 * g + (e & 3) + 32 * (e >> 2); }
        if (n < C_SV) { const int p = n - C_SK, h = p >> 6, pp = p & 63, g = pp >> 3, e = pp & 7; return C_SK + h * 64 + 4 * g + (e & 3) + 32 * (e >> 2); }
        if (n < C_END) return n;
        return -1;
    case PK_WUQ:
        if (n < 576) { const int h = n / 96, d = n % 96; sc = QS96; if (d < 64) return n; const int p = d - 64, g = p >> 3, e = p & 7; return h * 96 + 64 + 4 * g + (e & 3) + 16 * (e >> 2); }
        return -1;
    case PK_WUKV:
        if (n < 384) { const int h = n >> 6, d = n & 63; return h * 128 + d; }
        { const int m = n - 384, h = m >> 6, d = m & 63; return h * 128 + 64 + d; }
    case PK_WGU: { const int pn = n >> 8, half = (n >> 7) & 1, jj = n & 127; which = half; return 128 * pn + jj; }
    default: return n;
    }
}
struct PrepArgs { const float* W; const float* W2; const float* kgain; bf16* Wt; int K, Nsrc, Nout, kind; long sW, sWt; };
__global__ void __launch_bounds__(256) prep_wt(PrepArgs a) {
    __shared__ float tile[32][33];
    const int n0 = blockIdx.x * 32, k0 = blockIdx.y * 32, z = blockIdx.z, tx = threadIdx.x & 31, ty = threadIdx.x >> 5;
    float sc; int which; const int src = prep_map(a.kind, n0 + tx, sc, which);
    const float* W = (which ? a.W2 : a.W) + (size_t)z * a.sW;
#pragma unroll
    for (int i = 0; i < 4; ++i) { const int k = k0 + ty + 8 * i; float v = 0.f;
        if (src >= 0) { v = W[(size_t)k * a.Nsrc + src] * sc; if (a.kgain) v *= a.kgain[k]; }
        tile[ty + 8 * i][tx] = v; }
    __syncthreads();
    bf16* Wt = a.Wt + (size_t)z * a.sWt;
#pragma unroll
    for (int i = 0; i < 4; ++i) { const int n = n0 + ty + 8 * i; Wt[(size_t)n * a.K + k0 + tx] = (bf16)f2bf(tile[tx][ty + 8 * i]); }
}
__global__ void rope_tables(float* c64, float* s64, float* c32, float* s32) {
    const int i = blockIdx.x * blockDim.x + threadIdx.x;
    if (i < NS * 32) { const int s = i >> 5, j = i & 31; const float inv = 1.0f / powf(10000.f, (float)(2 * j) / 64.f); const float ang = (float)s * inv; c64[i] = (float)cos((double)ang); s64[i] = (float)sin((double)ang); }
    if (i < NS * 16) { const int s = i >> 4, j = i & 15; const float inv = 1.0f / powf(10000.f, (float)(2 * j) / 32.f); const float ang = (float)s * inv; c32[i] = (float)cos((double)ang); s32[i] = (float)sin((double)ang); }
}

__global__ void __launch_bounds__(256) norm_rows(const float* __restrict__ h, const float* __restrict__ g, bf16* __restrict__ xn) {
    const int row = blockIdx.x * 4 + (threadIdx.x >> 6), lane = threadIdx.x & 63;
    const float4* hr = (const float4*)(h + (size_t)row * DM) + lane; float4 v[4]; float s = 0.f;
#pragma unroll
    for (int j = 0; j < 4; ++j) { v[j] = hr[64 * j]; s += v[j].x * v[j].x + v[j].y * v[j].y + v[j].z * v[j].z + v[j].w * v[j].w; }
    const float rstd = rsqrtf(wave_sum(s) * (1.f / DM) + EPS);
    uint2* o = (uint2*)(xn + (size_t)row * DM) + lane;
#pragma unroll
    for (int j = 0; j < 4; ++j) { const float4 gg = ((const float4*)g)[lane + 64 * j];
        o[64 * j] = make_uint2(f2bf(v[j].x * rstd * gg.x) | (f2bf(v[j].y * rstd * gg.y) << 16), f2bf(v[j].z * rstd * gg.z) | (f2bf(v[j].w * rstd * gg.w) << 16)); }
}

enum { E_BF16 = 0, E_RESID = 1, E_SWIGLU = 2, E_GATE = 3 };
struct GArgs { const bf16* A; const bf16* Bt; void* C; int M, N, K, lda, ldb, ldc; long sA, sB, sC; const float* ss; float ssinv; const float* gate; long sG; };
template <int EPI> __global__ void __launch_bounds__(256) gemm_bt_naive(GArgs g) {
    __shared__ float As[16][68], Bs[16][68], Bs2[EPI == E_SWIGLU ? 16 : 1][68];
    const int tid = threadIdx.x, tx = tid & 15, ty = tid >> 4, z = blockIdx.z;
    const int m0 = blockIdx.y * 64, nt0 = blockIdx.x * 64;
    const int nb0 = (EPI == E_SWIGLU) ? (256 * (nt0 >> 7) + (nt0 & 127)) : nt0;
    const bf16* A = g.A + (size_t)z * g.sA; const bf16* Bt = g.Bt + (size_t)z * g.sB;
    float acc[4][4] = {}, acc2[4][4] = {};
    const int lr = tid >> 2, lk = (tid & 3) * 4;
    for (int k0 = 0; k0 < g.K; k0 += 16) {
        { const uint2 a = *(const uint2*)(A + (size_t)(m0 + lr) * g.lda + k0 + lk); As[lk][lr] = bf2f(a.x & 0xffff); As[lk + 1][lr] = bf2f(a.x >> 16); As[lk + 2][lr] = bf2f(a.y & 0xffff); As[lk + 3][lr] = bf2f(a.y >> 16); }
        { const uint2 b = *(const uint2*)(Bt + (size_t)(nb0 + lr) * g.ldb + k0 + lk); Bs[lk][lr] = bf2f(b.x & 0xffff); Bs[lk + 1][lr] = bf2f(b.x >> 16); Bs[lk + 2][lr] = bf2f(b.y & 0xffff); Bs[lk + 3][lr] = bf2f(b.y >> 16); }
        if (EPI == E_SWIGLU) { const uint2 b = *(const uint2*)(Bt + (size_t)(nb0 + 128 + lr) * g.ldb + k0 + lk); Bs2[lk][lr] = bf2f(b.x & 0xffff); Bs2[lk + 1][lr] = bf2f(b.x >> 16); Bs2[lk + 2][lr] = bf2f(b.y & 0xffff); Bs2[lk + 3][lr] = bf2f(b.y >> 16); }
        __syncthreads();
#pragma unroll
        for (int kk = 0; kk < 16; ++kk) {
            const float4 a = *(const float4*)&As[kk][ty * 4], b = *(const float4*)&Bs[kk][tx * 4];
            const float av[4] = {a.x, a.y, a.z, a.w}, bv[4] = {b.x, b.y, b.z, b.w};
#pragma unroll
            for (int i = 0; i < 4; ++i)
#pragma unroll
                for (int j = 0; j < 4; ++j) acc[i][j] += av[i] * bv[j];
            if (EPI == E_SWIGLU) { const float4 b2 = *(const float4*)&Bs2[kk][tx * 4]; const float b2v[4] = {b2.x, b2.y, b2.z, b2.w};
#pragma unroll
                for (int i = 0; i < 4; ++i)
#pragma unroll
                    for (int j = 0; j < 4; ++j) acc2[i][j] += av[i] * b2v[j]; }
        }
        __syncthreads();
    }
#pragma unroll
    for (int i = 0; i < 4; ++i) { const int m = m0 + ty * 4 + i; const int n = nt0 + tx * 4;
        if (EPI == E_RESID) { float4* c = (float4*)((float*)g.C + (size_t)z * g.sC + (size_t)m * g.ldc + n); float4 o = *c; o.x += acc[i][0]; o.y += acc[i][1]; o.z += acc[i][2]; o.w += acc[i][3]; *c = o; }
        else { float v[4];
            if (EPI == E_BF16) { float rs = 1.f; if (g.ss) { const float4 p = *(const float4*)(g.ss + (size_t)m * 4); rs = rsqrtf((p.x + p.y + p.z + p.w) * g.ssinv + EPS); }
#pragma unroll
                for (int j = 0; j < 4; ++j) v[j] = acc[i][j] * rs; }
            if (EPI == E_SWIGLU) {
#pragma unroll
                for (int j = 0; j < 4; ++j) { const float gt = acc[i][j]; v[j] = gt / (1.f + __expf(-gt)) * acc2[i][j]; } }
            if (EPI == E_GATE) { const float gt = g.gate[(size_t)z * g.sG + m];
#pragma unroll
                for (int j = 0; j < 4; ++j) v[j] = acc[i][j] * gt; }
            *(uint2*)((bf16*)g.C + (size_t)z * g.sC + (size_t)m * g.ldc + n) = make_uint2(f2bf(v[0]) | (f2bf(v[1]) << 16), f2bf(v[2]) | (f2bf(v[3]) << 16)); }
    }
}

__global__ void rope_naive(bf16* buf, int pitch, int col0, int hstride, int nheads, int hd, const float* ct, const float* st) {
    const int ng = hd / 8; const long i = (long)blockIdx.x * blockDim.x + threadIdx.x; const long tot = (long)NT * nheads * ng;
    if (i >= tot) return;
    const int g = (int)(i % ng), h = (int)((i / ng) % nheads); const int row = (int)(i / ((long)ng * nheads)); const int pos = row % NS;
    bf16* p = buf + (size_t)row * pitch + col0 + h * hstride + 8 * g;
    uint4 w = *(uint4*)p; unsigned u[4] = {w.x, w.y, w.z, w.w}; float x[8];
#pragma unroll
    for (int e = 0; e < 4; ++e) { x[2 * e] = bf2f(u[e] & 0xffff); x[2 * e + 1] = bf2f(u[e] >> 16); }
    float o[8];
#pragma unroll
    for (int e = 0; e < 4; ++e) { const float c = ct[pos * (hd / 2) + 4 * g + e], s = st[pos * (hd / 2) + 4 * g + e]; o[e] = x[e] * c - x[4 + e] * s; o[4 + e] = x[4 + e] * c + x[e] * s; }
    w.x = f2bf(o[0]) | (f2bf(o[1]) << 16); w.y = f2bf(o[2]) | (f2bf(o[3]) << 16); w.z = f2bf(o[4]) | (f2bf(o[5]) << 16); w.w = f2bf(o[6]) | (f2bf(o[7]) << 16);
    *(uint4*)p = w;
}
__global__ void sumsq_naive(const bf16* proj, float* cqss, float* ckvss) {
    const int row = blockIdx.x * blockDim.x + threadIdx.x; if (row >= NT) return;
    float s = 0.f; for (int c = 0; c < 256; ++c) { const float v = bf2f(proj[(size_t)row * NP + C_CQ + c]); s += v * v; }
    float s2 = 0.f; for (int c = 0; c < 128; ++c) { const float v = bf2f(proj[(size_t)row * NP + C_CKV + c]); s2 += v * v; }
    cqss[row * 4] = s; cqss[row * 4 + 1] = 0.f; cqss[row * 4 + 2] = 0.f; cqss[row * 4 + 3] = 0.f;
    ckvss[row * 4] = s2; ckvss[row * 4 + 1] = 0.f; ckvss[row * 4 + 2] = 0.f; ckvss[row * 4 + 3] = 0.f;
}

__global__ void __launch_bounds__(256) na_naive(const bf16* __restrict__ proj, const float* __restrict__ rpb, bf16* __restrict__ O, float* __restrict__ SS) {
    const int gid = blockIdx.x * 256 + threadIdx.x; const int h = gid / NT, tok = gid % NT; const int b = tok / NS, s = tok % NS, r = s >> 6, c = s & 63;
    const int rs = min(max(r - 4, 0), 56), cs = min(max(c - 8, 0), 48);
    float q[64], o[64];
    { const bf16* qp = proj + (size_t)tok * NP + C_AQ + h * 64;
#pragma unroll
      for (int d = 0; d < 64; ++d) { q[d] = bf2f(qp[d]); o[d] = 0.f; } }
    float m = -1e30f, l = 0.f;
    for (int i = 0; i < 8; ++i) for (int j = 0; j < 16; ++j) {
        const int kr = rs + i, kc = cs + j; const size_t kt = (size_t)b * NS + kr * 64 + kc;
        const bf16* kp = proj + kt * NP + C_AK + h * 64; const bf16* vp = proj + kt * NP + C_AV + h * 64;
        float sc = 0.f;
#pragma unroll
        for (int d = 0; d < 64; ++d) sc += q[d] * bf2f(kp[d]);
        sc += rpb[(h * 15 + (kr - r + 7)) * 31 + (kc - c + 15)] * LOG2E;
        const float mn = fmaxf(m, sc), f = exp2f(m - mn), p = exp2f(sc - mn); l = l * f + p; m = mn;
#pragma unroll
        for (int d = 0; d < 64; ++d) o[d] = o[d] * f + p * bf2f(vp[d]);
    }
    const float il = 1.f / l; float ss = 0.f; bf16* op = O + (size_t)tok * DM + h * 64;
#pragma unroll
    for (int d = 0; d < 64; ++d) { const float v = o[d] * il; ss += v * v; op[d] = (bf16)f2bf(v); }
    SS[(size_t)tok * 16 + h] = ss;
}
__global__ void __launch_bounds__(256) mla_naive(const bf16* __restrict__ QB, const bf16* __restrict__ KV, const bf16* __restrict__ proj, bf16* __restrict__ O, float* __restrict__ SS) {
    __shared__ float Ks[16][96], Vs[16][64];
    const int b = blockIdx.z, h = blockIdx.y, q0 = blockIdx.x * 256, tid = threadIdx.x; const size_t tok = (size_t)b * NS + q0 + tid;
    float q[96], o[64];
    { const bf16* qp = QB + tok * 576 + h * 96;
#pragma unroll
      for (int d = 0; d < 96; ++d) q[d] = bf2f(qp[d]);
#pragma unroll
      for (int d = 0; d < 64; ++d) o[d] = 0.f; }
    float m = -1e30f, l = 0.f;
    for (int k0 = 0; k0 < NS; k0 += 16) {
        __syncthreads();
        for (int i = tid; i < 16 * 160; i += 256) { const int kk = i / 160, d = i % 160; const size_t kt = (size_t)b * NS + k0 + kk;
            if (d < 64) Ks[kk][d] = bf2f(KV[kt * 768 + h * 64 + d]); else if (d < 96) Ks[kk][d] = bf2f(proj[kt * NP + C_KR + d - 64]); else Vs[kk][d - 96] = bf2f(KV[kt * 768 + 384 + h * 64 + d - 96]); }
        __syncthreads();
        float sc[16]; float tm = -1e30f;
#pragma unroll
        for (int kk = 0; kk < 16; ++kk) { float a = 0.f;
#pragma unroll
            for (int d = 0; d < 96; ++d) a += q[d] * Ks[kk][d];
            sc[kk] = a; tm = fmaxf(tm, a); }
        const float mn = fmaxf(m, tm), f = exp2f(m - mn); m = mn; l *= f;
#pragma unroll
        for (int d = 0; d < 64; ++d) o[d] *= f;
#pragma unroll
        for (int kk = 0; kk < 16; ++kk) { const float p = exp2f(sc[kk] - mn); l += p;
#pragma unroll
            for (int d = 0; d < 64; ++d) o[d] += p * Vs[kk][d]; }
    }
    const float il = 1.f / l; float ss = 0.f; bf16* op = O + tok * DM + 256 + h * 64;
#pragma unroll
    for (int d = 0; d < 64; ++d) { const float v = o[d] * il; ss += v * v; op[d] = (bf16)f2bf(v); }
    SS[tok * 16 + 4 + h] = ss;
}
__global__ void __launch_bounds__(256) swa_naive(const bf16* __restrict__ proj, const float* __restrict__ sink, bf16* __restrict__ O, float* __restrict__ SS) {
    __shared__ float Ks[16][64], Vs[16][64];
    const int b = blockIdx.z, hq = blockIdx.y, kvh = hq / 3, q0 = blockIdx.x * 256, tid = threadIdx.x; const int qpos = q0 + tid; const size_t tok = (size_t)b * NS + qpos;
    float q[64], o[64];
    { const bf16* qp = proj + tok * NP + C_SQ + hq * 64;
#pragma unroll
      for (int d = 0; d < 64; ++d) { q[d] = bf2f(qp[d]); o[d] = 0.f; } }
    float m = sink[hq] * LOG2E, l = 1.f;
    const int kbeg = max(q0 - 128, 0), kend = min(q0 + 256 + 128, NS);
    for (int k0 = kbeg; k0 < kend; k0 += 16) {
        __syncthreads();
        for (int i = tid; i < 16 * 128; i += 256) { const int kk = i >> 7, d = i & 127; const size_t kt = (size_t)b * NS + k0 + kk;
            if (d < 64) Ks[kk][d] = bf2f(proj[kt * NP + C_SK + kvh * 64 + d]); else Vs[kk][d - 64] = bf2f(proj[kt * NP + C_SV + kvh * 64 + d - 64]); }
        __syncthreads();
        float sc[16]; float tm = -1e30f;
#pragma unroll
        for (int kk = 0; kk < 16; ++kk) { float a = 0.f;
#pragma unroll
            for (int d = 0; d < 64; ++d) a += q[d] * Ks[kk][d];
            const int dist = qpos - (k0 + kk); const bool ok = dist <= 128 && dist >= -128;
            sc[kk] = ok ? a : -1e30f; tm = fmaxf(tm, sc[kk]); }
        const float mn = fmaxf(m, tm), f = exp2f(m - mn); m = mn; l *= f;
#pragma unroll
        for (int d = 0; d < 64; ++d) o[d] *= f;
#pragma unroll
        for (int kk = 0; kk < 16; ++kk) { const float p = sc[kk] > -1e29f ? exp2f(sc[kk] - mn) : 0.f; l += p;
#pragma unroll
            for (int d = 0; d < 64; ++d) o[d] += p * Vs[kk][d]; }
    }
    const float il = 1.f / l; float ss = 0.f; bf16* op = O + tok * DM + 640 + hq * 64;
#pragma unroll
    for (int d = 0; d < 64; ++d) { const float v = o[d] * il; ss += v * v; op[d] = (bf16)f2bf(v); }
    SS[tok * 16 + 10 + hq] = ss;
}
__global__ void __launch_bounds__(256) gnorm_rows(bf16* O, const float* __restrict__ SS) {
    const int row = blockIdx.x * 4 + (threadIdx.x >> 6), lane = threadIdx.x & 63;
    const float* ss = SS + (size_t)row * 16;
    const float ra = rsqrtf((ss[0] + ss[1] + ss[2] + ss[3]) * (1.f / 256.f) + EPS);
    const float rb = rsqrtf((ss[4] + ss[5] + ss[6] + ss[7] + ss[8] + ss[9]) * (1.f / 384.f) + EPS);
    const float rc = rsqrtf((ss[10] + ss[11] + ss[12] + ss[13] + ss[14] + ss[15]) * (1.f / 384.f) + EPS);
    uint2* o = (uint2*)(O + (size_t)row * DM) + lane;
#pragma unroll
    for (int j = 0; j < 4; ++j) { const int col = 4 * lane + 256 * j; const float r = col < 256 ? ra : (col < 640 ? rb : rc); uint2 w = o[64 * j];
        w.x = f2bf(bf2f(w.x & 0xffff) * r) | (f2bf(bf2f(w.x >> 16) * r) << 16); w.y = f2bf(bf2f(w.y & 0xffff) * r) | (f2bf(bf2f(w.y >> 16) * r) << 16); o[64 * j] = w; }
}

__global__ void __launch_bounds__(256) router_rows(const float* __restrict__ h, const float* __restrict__ g, const float* __restrict__ wr, bf16* __restrict__ xn, float* __restrict__ aff) {
    const int row = blockIdx.x * 4 + (threadIdx.x >> 6), lane = threadIdx.x & 63;
    const float4* hr = (const float4*)(h + (size_t)row * DM) + lane; float4 v[4]; float s = 0.f;
#pragma unroll
    for (int j = 0; j < 4; ++j) { v[j] = hr[64 * j]; s += v[j].x * v[j].x + v[j].y * v[j].y + v[j].z * v[j].z + v[j].w * v[j].w; }
    const float rstd = rsqrtf(wave_sum(s) * (1.f / DM) + EPS);
    uint2* o = (uint2*)(xn + (size_t)row * DM) + lane; float lg[16];
#pragma unroll
    for (int e = 0; e < 16; ++e) lg[e] = 0.f;
#pragma unroll
    for (int j = 0; j < 4; ++j) { const float4 gg = ((const float4*)g)[lane + 64 * j];
        const float x[4] = {v[j].x * rstd * gg.x, v[j].y * rstd * gg.y, v[j].z * rstd * gg.z, v[j].w * rstd * gg.w};
        o[64 * j] = make_uint2(f2bf(x[0]) | (f2bf(x[1]) << 16), f2bf(x[2]) | (f2bf(x[3]) << 16));
#pragma unroll
        for (int c = 0; c < 4; ++c) { const float4* w = (const float4*)(wr + (size_t)(4 * lane + 256 * j + c) * 16);
#pragma unroll
            for (int e4 = 0; e4 < 4; ++e4) { const float4 ww = w[e4]; lg[4 * e4] += x[c] * ww.x; lg[4 * e4 + 1] += x[c] * ww.y; lg[4 * e4 + 2] += x[c] * ww.z; lg[4 * e4 + 3] += x[c] * ww.w; } } }
    float mx = -1e30f;
#pragma unroll
    for (int e = 0; e < 16; ++e) { lg[e] = wave_sum(lg[e]); mx = fmaxf(mx, lg[e]); }
    float den = 0.f;
#pragma unroll
    for (int e = 0; e < 16; ++e) { lg[e] = __expf(lg[e] - mx); den += lg[e]; }
    const int b = row / NS, sidx = row % NS;
    if (lane < 16) { float val = 0.f;
#pragma unroll
        for (int e = 0; e < 16; ++e) if (lane == e) val = lg[e];
        aff[((size_t)b * NE + lane) * NS + sidx] = val / den; }
}
__global__ void __launch_bounds__(1024) topk_rank(const float* __restrict__ aff, int* __restrict__ inv, int* __restrict__ idx, float* __restrict__ gatef) {
    __shared__ float a[NS];
    const int be = blockIdx.x, b = be / NE, e = be % NE, tid = threadIdx.x;
    const float* src = aff + (size_t)be * NS;
    for (int i = tid; i < NS; i += 1024) a[i] = src[i];
    __syncthreads();
    float mine[4]; int rank[4] = {0, 0, 0, 0};
#pragma unroll
    for (int u = 0; u < 4; ++u) mine[u] = a[tid + 1024 * u];
    for (int j = 0; j < NS; ++j) { const float x = a[j];
#pragma unroll
        for (int u = 0; u < 4; ++u) { const int i = tid + 1024 * u; rank[u] += (x > mine[u] || (x == mine[u] && j < i)) ? 1 : 0; } }
#pragma unroll
    for (int u = 0; u < 4; ++u) { const int i = tid + 1024 * u;
        if (rank[u] < CAP) { inv[(size_t)be * NS + i] = rank[u]; idx[be * CAP + rank[u]] = i; gatef[(size_t)e * (NB * CAP) + b * CAP + rank[u]] = mine[u]; }
        else inv[(size_t)be * NS + i] = -1; }
}
__global__ void __launch_bounds__(256) gather_rows(const bf16* __restrict__ xn, const int* __restrict__ idx, bf16* __restrict__ xs) {
    const int r = blockIdx.x * 4 + (threadIdx.x >> 6), lane = threadIdx.x & 63;
    const int e = r >> 12, b = (r >> 9) & 7, slot = r & 511; const int tokn = idx[(b * NE + e) * CAP + slot];
    const uint4* s = (const uint4*)(xn + ((size_t)b * NS + tokn) * DM) + lane; uint4* d = (uint4*)(xs + (size_t)r * DM) + lane;
    d[0] = s[0]; d[64] = s[64];
}
__global__ void __launch_bounds__(256) combine_rows(float* h, const bf16* __restrict__ Y, const int* __restrict__ inv, const float* __restrict__ g, bf16* __restrict__ xn, int final_mode) {
    const int row = blockIdx.x * 4 + (threadIdx.x >> 6), lane = threadIdx.x & 63; const int b = row / NS, s = row % NS;
    float4* hr = (float4*)(h + (size_t)row * DM) + lane; float4 v[4];
#pragma unroll
    for (int j = 0; j < 4; ++j) v[j] = hr[64 * j];
    for (int e = 0; e < NE; ++e) { const int slot = inv[((size_t)b * NE + e) * NS + s];
        if (slot >= 0) { const uint2* y = (const uint2*)(Y + ((size_t)e * (NB * CAP) + b * CAP + slot) * DM) + lane;
#pragma unroll
            for (int j = 0; j < 4; ++j) { const uint2 w = y[64 * j]; v[j].x += bf2f(w.x & 0xffff); v[j].y += bf2f(w.x >> 16); v[j].z += bf2f(w.y & 0xffff); v[j].w += bf2f(w.y >> 16); } } }
    float ssum = 0.f;
#pragma unroll
    for (int j = 0; j < 4; ++j) ssum += v[j].x * v[j].x + v[j].y * v[j].y + v[j].z * v[j].z + v[j].w * v[j].w;
    const float rstd = rsqrtf(wave_sum(ssum) * (1.f / DM) + EPS);
    if (final_mode) {
#pragma unroll
        for (int j = 0; j < 4; ++j) { const float4 gg = ((const float4*)g)[lane + 64 * j]; hr[64 * j] = make_float4(v[j].x * rstd * gg.x, v[j].y * rstd * gg.y, v[j].z * rstd * gg.z, v[j].w * rstd * gg.w); }
    } else {
        uint2* o = (uint2*)(xn + (size_t)row * DM) + lane;
#pragma unroll
        for (int j = 0; j < 4; ++j) { const float4 gg = ((const float4*)g)[lane + 64 * j]; hr[64 * j] = v[j];
            o[64 * j] = make_uint2(f2bf(v[j].x * rstd * gg.x) | (f2bf(v[j].y * rstd * gg.y) << 16), f2bf(v[j].z * rstd * gg.z) | (f2bf(v[j].w * rstd * gg.w) << 16)); }
    }
}

extern "C" void kernel_launch(void* const* d_in, const int* in_sizes, int n_in, void* d_out, int out_size, void* d_ws, size_t ws_size, hipStream_t stream) {
    if (n_in != 17 || out_size != NT * DM || ws_size < WS_END) { fprintf(stderr, "kernel_launch: unexpected shapes (n_in %d out %d ws %zu)\n", n_in, out_size, ws_size); return; }
    const float* x = (const float*)d_in[0]; const float* attn_norm = (const float*)d_in[1]; const float* w_in = (const float*)d_in[2]; const float* na_rpb = (const float*)d_in[3];
    const float* q_norm = (const float*)d_in[4]; const float* w_uq = (const float*)d_in[5]; const float* kv_norm = (const float*)d_in[6]; const float* w_ukv = (const float*)d_in[7];
    const float* swa_sink = (const float*)d_in[8]; const float* group_norm = (const float*)d_in[9]; const float* w_out = (const float*)d_in[10]; const float* ffn_norm = (const float*)d_in[11];
    const float* w_router = (const float*)d_in[12]; const float* w_gate = (const float*)d_in[13]; const float* w_up = (const float*)d_in[14]; const float* w_down = (const float*)d_in[15]; const float* final_norm = (const float*)d_in[16];
    unsigned char* ws = (unsigned char*)d_ws; float* H = (float*)d_out;
    float *c64 = (float*)(ws + WS_COS64), *s64 = (float*)(ws + WS_SIN64), *c32 = (float*)(ws + WS_COS32), *s32 = (float*)(ws + WS_SIN32);
    bf16 *WIN = (bf16*)(ws + WS_WIN), *WUQ = (bf16*)(ws + WS_WUQ), *WUKV = (bf16*)(ws + WS_WUKV), *WOUT = (bf16*)(ws + WS_WOUT), *WGU = (bf16*)(ws + WS_WGU), *WD = (bf16*)(ws + WS_WD);
    float *CQSS = (float*)(ws + WS_CQSS), *CKVSS = (float*)(ws + WS_CKVSS), *SS = (float*)(ws + WS_SS), *AFF = (float*)(ws + WS_AFF), *GATE = (float*)(ws + WS_GATE);
    int *INV = (int*)(ws + WS_INV), *IDX = (int*)(ws + WS_IDX);
    bf16 *XN = (bf16*)(ws + WS_XN), *PROJ = (bf16*)(ws + WS_PROJ), *QB = (bf16*)(ws + WS_QB), *KV = (bf16*)(ws + WS_KV), *HID = (bf16*)(ws + WS_HID), *XS = PROJ, *Y = PROJ, *O = XN, *XN2 = XN;

    hipLaunchKernelGGL(rope_tables, dim3(NS * 32 / 256), dim3(256), 0, stream, c64, s64, c32, s32);
    hipMemcpyAsync(H, x, (size_t)NT * DM * 4, hipMemcpyDeviceToDevice, stream);
    hipLaunchKernelGGL(norm_rows, dim3(NT / 4), dim3(256), 0, stream, (const float*)H, attn_norm, XN);
    for (int l = 0; l < DEPTH; ++l) {
        { PrepArgs a{w_in + (size_t)l * DM * C_END, nullptr, nullptr, WIN, DM, C_END, NP, PK_WIN, 0, 0}; hipLaunchKernelGGL(prep_wt, dim3(NP / 32, DM / 32, 1), dim3(256), 0, stream, a); }
        { PrepArgs a{w_uq + (size_t)l * 256 * 576, nullptr, q_norm + l * 256, WUQ, 256, 576, 768, PK_WUQ, 0, 0}; hipLaunchKernelGGL(prep_wt, dim3(768 / 32, 256 / 32, 1), dim3(256), 0, stream, a); }
        { PrepArgs a{w_ukv + (size_t)l * 128 * 768, nullptr, kv_norm + l * 128, WUKV, 128, 768, 768, PK_WUKV, 0, 0}; hipLaunchKernelGGL(prep_wt, dim3(768 / 32, 128 / 32, 1), dim3(256), 0, stream, a); }
        { PrepArgs a{w_out + (size_t)l * DM * DM, nullptr, group_norm + l * DM, WOUT, DM, DM, DM, PK_WOUT, 0, 0}; hipLaunchKernelGGL(prep_wt, dim3(DM / 32, DM / 32, 1), dim3(256), 0, stream, a); }
        { PrepArgs a{w_gate + (size_t)l * NE * DM * DM, w_up + (size_t)l * NE * DM * DM, nullptr, WGU, DM, DM, 2048, PK_WGU, (long)DM * DM, (long)2048 * DM}; hipLaunchKernelGGL(prep_wt, dim3(2048 / 32, DM / 32, NE), dim3(256), 0, stream, a); }
        { PrepArgs a{w_down + (size_t)l * NE * DM * DM, nullptr, nullptr, WD, DM, DM, DM, PK_WD, (long)DM * DM, (long)DM * DM}; hipLaunchKernelGGL(prep_wt, dim3(DM / 32, DM / 32, NE), dim3(256), 0, stream, a); }
        { GArgs g{XN, WIN, PROJ, NT, NP, DM, DM, DM, NP, 0, 0, 0, nullptr, 0.f, nullptr, 0}; hipLaunchKernelGGL(gemm_bt_naive<E_BF16>, dim3(NP / 64, NT / 64, 1), dim3(256), 0, stream, g); }
        hipLaunchKernelGGL(sumsq_naive, dim3(NT / 256), dim3(256), 0, stream, (const bf16*)PROJ, CQSS, CKVSS);
        hipLaunchKernelGGL(rope_naive, dim3((NT * 4 + 255) / 256), dim3(256), 0, stream, PROJ, NP, C_KR, 32, 1, 32, (const float*)c32, (const float*)s32);
        hipLaunchKernelGGL(rope_naive, dim3((NT * 8 * 8 + 255) / 256), dim3(256), 0, stream, PROJ, NP, C_SQ, 64, 8, 64, (const float*)c64, (const float*)s64);
        { GArgs g{PROJ + C_CQ, WUQ, QB, NT, 576, 256, NP, 256, 576, 0, 0, 0, CQSS, 1.f / 256.f, nullptr, 0}; hipLaunchKernelGGL(gemm_bt_naive<E_BF16>, dim3(576 / 64, NT / 64, 1), dim3(256), 0, stream, g); }
        hipLaunchKernelGGL(rope_naive, dim3((NT * 6 * 4 + 255) / 256), dim3(256), 0, stream, QB, 576, 64, 96, 6, 32, (const float*)c32, (const float*)s32);
        { GArgs g{PROJ + C_CKV, WUKV, KV, NT, 768, 128, NP, 128, 768, 0, 0, 0, CKVSS, 1.f / 128.f, nullptr, 0}; hipLaunchKernelGGL(gemm_bt_naive<E_BF16>, dim3(768 / 64, NT / 64, 1), dim3(256), 0, stream, g); }
        hipLaunchKernelGGL(na_naive, dim3(NT * 4 / 256), dim3(256), 0, stream, (const bf16*)PROJ, na_rpb + (size_t)l * 4 * 15 * 31, O, SS);
        hipLaunchKernelGGL(mla_naive, dim3(NS / 256, 6, NB), dim3(256), 0, stream, (const bf16*)QB, (const bf16*)KV, (const bf16*)PROJ, O, SS);
        hipLaunchKernelGGL(swa_naive, dim3(NS / 256, 6, NB), dim3(256), 0, stream, (const bf16*)PROJ, swa_sink + l * 6, O, SS);
        hipLaunchKernelGGL(gnorm_rows, dim3(NT / 4), dim3(256), 0, stream, O, (const float*)SS);
        { GArgs g{O, WOUT, H, NT, DM, DM, DM, DM, DM, 0, 0, 0, nullptr, 0.f, nullptr, 0}; hipLaunchKernelGGL(gemm_bt_naive<E_RESID>, dim3(DM / 64, NT / 64, 1), dim3(256), 0, stream, g); }
        hipLaunchKernelGGL(router_rows, dim3(NT / 4), dim3(256), 0, stream, (const float*)H, ffn_norm + l * DM, w_router + (size_t)l * DM * NE, XN2, AFF);
        hipLaunchKernelGGL(topk_rank, dim3(NB * NE), dim3(1024), 0, stream, (const float*)AFF, INV, IDX, GATE);
        hipLaunchKernelGGL(gather_rows, dim3(NSLOTS / 4), dim3(256), 0, stream, (const bf16*)XN2, (const int*)IDX, XS);
        { GArgs g{XS, WGU, HID, NB * CAP, DM, DM, DM, DM, DM, (long)NB * CAP * DM, (long)2048 * DM, (long)NB * CAP * DM, nullptr, 0.f, nullptr, 0}; hipLaunchKernelGGL(gemm_bt_naive<E_SWIGLU>, dim3(DM / 64, NB * CAP / 64, NE), dim3(256), 0, stream, g); }
        { GArgs g{HID, WD, Y, NB * CAP, DM, DM, DM, DM, DM, (long)NB * CAP * DM, (long)DM * DM, (long)NB * CAP * DM, nullptr, 0.f, GATE, (long)NB * CAP}; hipLaunchKernelGGL(gemm_bt_naive<E_GATE>, dim3(DM / 64, NB * CAP / 64, NE), dim3(256), 0, stream, g); }
        const bool last = (l == DEPTH - 1);
        hipLaunchKernelGGL(combine_rows, dim3(NT / 4), dim3(256), 0, stream, H, (const bf16*)Y, (const int*)INV, last ? final_norm : attn_norm + (l + 1) * DM, XN, last ? 1 : 0);
    }
}
```

```cpp
#include <hip/hip_runtime.h>
#include <cstdint>
#include <cstdio>

typedef unsigned short bf16;
constexpr int NB = 8, NS = 4096, DM = 1024, NT = NB * NS, NP = 2048, NE = 16, CAP = 512, DEPTH = 2;
constexpr int NSLOTS = NE * NB * CAP;
constexpr float LOG2E = 1.4426950408889634f;
constexpr float QS64 = 0.125f * LOG2E;
constexpr float QS96 = 0.10206207261596577f * LOG2E;
constexpr float EPS = 1e-6f;
constexpr int C_AQ = 0, C_AK = 256, C_AV = 512, C_CQ = 768, C_CKV = 1024, C_KR = 1152, C_SQ = 1184, C_SK = 1568, C_SV = 1696, C_END = 1824;

constexpr size_t MiB = 1u << 20;
constexpr size_t WS_CTL = 0;
constexpr size_t WS_COS64 = 1 * MiB, WS_SIN64 = WS_COS64 + 512 * 1024, WS_COS32 = 2 * MiB, WS_SIN32 = WS_COS32 + 256 * 1024;
constexpr size_t WS_WIN = 4 * MiB, WS_WUQ = 8 * MiB, WS_WUKV = 8 * MiB + 512 * 1024, WS_WOUT = 9 * MiB, WS_WGU = 12 * MiB, WS_WD = 76 * MiB;
constexpr size_t WS_CQSS = 108 * MiB, WS_CKVSS = WS_CQSS + 512 * 1024, WS_SS = 109 * MiB, WS_AFF = 111 * MiB, WS_INV = 113 * MiB, WS_IDX = 115 * MiB, WS_GATE = WS_IDX + 256 * 1024;
constexpr size_t WS_XN = 120 * MiB;
constexpr size_t WS_PROJ = 184 * MiB;
constexpr size_t WS_QB = 312 * MiB;
constexpr size_t WS_KV = 348 * MiB;
constexpr size_t WS_HID = 312 * MiB;
constexpr size_t WS_END = 440 * MiB;

__device__ __forceinline__ unsigned f2bf(float f) { unsigned u = __builtin_bit_cast(unsigned, f); return (u + 0x7fffu + ((u >> 16) & 1u)) >> 16; }
__device__ __forceinline__ float bf2f(unsigned short b) { return __builtin_bit_cast(float, (unsigned)b << 16); }
__device__ __forceinline__ float wave_sum(float v) {
#pragma unroll
    for (int o = 1; o < 64; o <<= 1) v += __shfl_xor(v, o);
    return v;
}

enum { PK_WIN = 0, PK_WUQ = 1, PK_WUKV = 2, PK_WOUT = 3, PK_WGU = 4, PK_WD = 5 };
__device__ __forceinline__ int prep_map(int kind, int n, float& sc, int& which) {
    sc = 1.f; which = 0;
    switch (kind) {
    case PK_WIN:
        if (n < 256) { sc = QS64; return n; }
        if (n < C_KR) return n;
        if (n < C_SQ) { const int p = n - C_KR, g = p >> 3, e = p & 7; return C_KR + 4 * g + (e & 3) + 16 * (e >> 2); }
        if (n < C_SK) { const int p = n - C_SQ, h = p >> 6, pp = p & 63, g = pp >> 3, e = pp & 7; sc = QS64; return C_SQ + h * 64 + 4 * g + (e & 3) + 32 * (e >> 2); }
        if (n < C_SV) { const int p = n - C_SK, h = p >> 6, pp = p & 63, g = pp >> 3, e = pp & 7; return C_SK + h * 64 + 4 * g + (e & 3) + 32 * (e >> 2); }
        if (n < C_END) return n;
        return -1;
    case PK_WUQ:
        if (n < 576) { const int h = n / 96, d = n % 96; sc = QS96; if (d < 64) return n; const int p = d - 64, g = p >> 3, e = p & 7; return h * 96 + 64 + 4 * g + (e & 3) + 16 * (e >> 2); }
        return -1;
    case PK_WUKV:
        if (n < 384) { const int h = n >> 6, d = n & 63; return h * 128 + d; }
        { const int m = n - 384, h = m >> 6, d = m & 63; return h * 128 + 64 + d; }
    case PK_WGU: { const int pn = n >> 8, half = (n >> 7) & 1, jj = n & 127; which = half; return 128 * pn + jj; }
    default: return n;
    }
}
struct PrepArgs { const float* W; const float* W2; const float* kgain; bf16* Wt; int K, Nsrc, Nout, kind; long sW, sWt; };
__global__ void __launch_bounds__(256) prep_wt(PrepArgs a) {
    __shared__ float tile[32][33];
    const int n0 = blockIdx.x * 32, k0 = blockIdx.y * 32, z = blockIdx.z, tx = threadIdx.x & 31, ty = threadIdx.x >> 5;
    float sc; int which; const int src = prep_map(a.kind, n0 + tx, sc, which);
    const float* W = (which ? a.W2 : a.W) + (size_t)z * a.sW;
#pragma unroll
    for (int i = 0; i < 4; ++i) { const int k = k0 + ty + 8 * i; float v = 0.f;
        if (src >= 0) { v = W[(size_t)k * a.Nsrc + src] * sc; if (a.kgain) v *= a.kgain[k]; }
        tile[ty + 8 * i][tx] = v; }
    __syncthreads();
    bf16* Wt = a.Wt + (size_t)z * a.sWt;
#pragma unroll
    for (int i = 0; i < 4; ++i) { const int n = n0 + ty + 8 * i; Wt[(size_t)n * a.K + k0 + tx] = (bf16)f2bf(tile[tx][ty + 8 * i]); }
}
__global__ void rope_tables(float* c64, float* s64, float* c32, float* s32) {
    const int i = blockIdx.x * blockDim.x + threadIdx.x;
    if (i < NS * 32) { const int s = i >> 5, j = i & 31; const float inv = 1.0f / powf(10000.f, (float)(2 * j) / 64.f); const float ang = (float)s * inv; c64[i] = (float)cos((double)ang); s64[i] = (float)sin((double)ang); }
    if (i < NS * 16) { const int s = i >> 4, j = i & 15; const float inv = 1.0f / powf(10000.f, (float)(2 * j) / 32.f); const float ang = (float)s * inv; c32[i] = (float)cos((double)ang); s32[i] = (float)sin((double)ang); }
}

__global__ void __launch_bounds__(256) norm_rows(const float* __restrict__ h, const float* __restrict__ g, bf16* __restrict__ xn) {
    const int row = blockIdx.x * 4 + (threadIdx.x >> 6), lane = threadIdx.x & 63;
    const float4* hr = (const float4*)(h + (size_t)row * DM) + lane; float4 v[4]; float s = 0.f;
#pragma unroll
    for (int j = 0; j < 4; ++j) { v[j] = hr[64 * j]; s += v[j].x * v[j].x + v[j].y * v[j].y + v[j].z * v[j].z + v[j].w * v[j].w; }
    const float rstd = rsqrtf(wave_sum(s) * (1.f / DM) + EPS);
    uint2* o = (uint2*)(xn + (size_t)row * DM) + lane;
#pragma unroll
    for (int j = 0; j < 4; ++j) { const float4 gg = ((const float4*)g)[lane + 64 * j];
        o[64 * j] = make_uint2(f2bf(v[j].x * rstd * gg.x) | (f2bf(v[j].y * rstd * gg.y) << 16), f2bf(v[j].z * rstd * gg.z) | (f2bf(v[j].w * rstd * gg.w) << 16)); }
}

enum { E_BF16 = 0, E_RESID = 1, E_SWIGLU = 2, E_GATE = 3 };
struct GArgs { const bf16* A; const bf16* Bt; void* C; int M, N, K, lda, ldb, ldc; long sA, sB, sC; const float* ss; float ssinv; const float* gate; long sG; };
template <int EPI> __global__ void __launch_bounds__(256) gemm_bt_naive(GArgs g) {
    __shared__ float As[16][68], Bs[16][68], Bs2[EPI == E_SWIGLU ? 16 : 1][68];
    const int tid = threadIdx.x, tx = tid & 15, ty = tid >> 4, z = blockIdx.z;
    const int m0 = blockIdx.y * 64, nt0 = blockIdx.x * 64;
    const int nb0 = (EPI == E_SWIGLU) ? (256 * (nt0 >> 7) + (nt0 & 127)) : nt0;
    const bf16* A = g.A + (size_t)z * g.sA; const bf16* Bt = g.Bt + (size_t)z * g.sB;
    float acc[4][4] = {}, acc2[4][4] = {};
    const int lr = tid >> 2, lk = (tid & 3) * 4;
    for (int k0 = 0; k0 < g.K; k0 += 16) {
        { const uint2 a = *(const uint2*)(A + (size_t)(m0 + lr) * g.lda + k0 + lk); As[lk][lr] = bf2f(a.x & 0xffff); As[lk + 1][lr] = bf2f(a.x >> 16); As[lk + 2][lr] = bf2f(a.y & 0xffff); As[lk + 3][lr] = bf2f(a.y >> 16); }
        { const uint2 b = *(const uint2*)(Bt + (size_t)(nb0 + lr) * g.ldb + k0 + lk); Bs[lk][lr] = bf2f(b.x & 0xffff); Bs[lk + 1][lr] = bf2f(b.x >> 16); Bs[lk + 2][lr] = bf2f(b.y & 0xffff); Bs[lk + 3][lr] = bf2f(b.y >> 16); }
        if (EPI == E_SWIGLU) { const uint2 b = *(const uint2*)(Bt + (size_t)(nb0 + 128 + lr) * g.ldb + k0 + lk); Bs2[lk][lr] = bf2f(b.x & 0xffff); Bs2[lk + 1][lr] = bf2f(b.x >> 16); Bs2[lk + 2][lr] = bf2f(b.y & 0xffff); Bs2[lk + 3][lr] = bf2f(b.y >> 16); }
        __syncthreads();
#pragma unroll
        for (int kk = 0; kk < 16; ++kk) {
            const float4 a = *(const float4*)&As[kk][ty * 4], b = *(const float4*)&Bs[kk][tx * 4];
            const float av[4] = {a.x, a.y, a.z, a.w}, bv[4] = {b.x, b.y, b.z, b.w};
#pragma unroll
            for (int i = 0; i < 4; ++i)
#pragma unroll
                for (int j = 0; j < 4; ++j) acc[i][j] += av[i] * bv[j];
            if (EPI == E_SWIGLU) { const float4 b2 = *(const float4*)&Bs2[kk][tx * 4]; const float b2v[4] = {b2.x, b2.y, b2.z, b2.w};
#pragma unroll
                for (int i = 0; i < 4; ++i)
#pragma unroll
                    for (int j = 0; j < 4; ++j) acc2[i][j] += av[i] * b2v[j]; }
        }
        __syncthreads();
    }
#pragma unroll
    for (int i = 0; i < 4; ++i) { const int m = m0 + ty * 4 + i; const int n = nt0 + tx * 4;
        if (EPI == E_RESID) { float4* c = (float4*)((float*)g.C + (size_t)z * g.sC + (size_t)m * g.ldc + n); float4 o = *c; o.x += acc[i][0]; o.y += acc[i][1]; o.z += acc[i][2]; o.w += acc[i][3]; *c = o; }
        else { float v[4];
            if (EPI == E_BF16) { float rs = 1.f; if (g.ss) { const float4 p = *(const float4*)(g.ss + (size_t)m * 4); rs = rsqrtf((p.x + p.y + p.z + p.w) * g.ssinv + EPS); }
#pragma unroll
                for (int j = 0; j < 4; ++j) v[j] = acc[i][j] * rs; }
            if (EPI == E_SWIGLU) {
#pragma unroll
                for (int j = 0; j < 4; ++j) { const float gt = acc[i][j]; v[j] = gt / (1.f + __expf(-gt)) * acc2[i][j]; } }
            if (EPI == E_GATE) { const float gt = g.gate[(size_t)z * g.sG + m];
#pragma unroll
                for (int j = 0; j < 4; ++j) v[j] = acc[i][j] * gt; }
            *(uint2*)((bf16*)g.C + (size_t)z * g.sC + (size_t)m * g.ldc + n) = make_uint2(f2bf(v[0]) | (f2bf(v[1]) << 16), f2bf(v[2]) | (f2bf(v[3]) << 16)); }
    }
}

__global__ void rope_naive(bf16* buf, int pitch, int col0, int hstride, int nheads, int hd, const float* ct, const float* st) {
    const int ng = hd / 8; const long i = (long)blockIdx.x * blockDim.x + threadIdx.x; const long tot = (long)NT * nheads * ng;
    if (i >= tot) return;
    const int g = (int)(i % ng), h = (int)((i / ng) % nheads); const int row = (int)(i / ((long)ng * nheads)); const int pos = row % NS;
    bf16* p = buf + (size_t)row * pitch + col0 + h * hstride + 8 * g;
    uint4 w = *(uint4*)p; unsigned u[4] = {w.x, w.y, w.z, w.w}; float x[8];
#pragma unroll
    for (int e = 0; e < 4; ++e) { x[2 * e] = bf2f(u[e] & 0xffff); x[2 * e + 1] = bf2f(u[e] >> 16); }
    float o[8];
#pragma unroll
    for (int e = 0; e < 4; ++e) { const float c = ct[pos * (hd / 2) + 4 * g + e], s = st[pos * (hd / 2) + 4 * g + e]; o[e] = x[e] * c - x[4 + e] * s; o[4 + e] = x[4 + e] * c + x[e] * s; }
    w.x = f2bf(o[0]) | (f2bf(o[1]) << 16); w.y = f2bf(o[2]) | (f2bf(o[3]) << 16); w.z = f2bf(o[4]) | (f2bf(o[5]) << 16); w.w = f2bf(o[6]) | (f2bf(o[7]) << 16);
    *(uint4*)p = w;
}
__global__ void sumsq_naive(const bf16* proj, float* cqss, float* ckvss) {
    const int row = blockIdx.x * blockDim.x + threadIdx.x; if (row >= NT) return;
    float s = 0.f; for (int c = 0; c < 256; ++c) { const float v = bf2f(proj[(size_t)row * NP + C_CQ + c]); s += v * v; }
    float s2 = 0.f; for (int c = 0; c < 128; ++c) { const float v = bf2f(proj[(size_t)row * NP + C_CKV + c]); s2 += v * v; }
    cqss[row * 4] = s; cqss[row * 4 + 1] = 0.f; cqss[row * 4 + 2] = 0.f; cqss[row * 4 + 3] = 0.f;
    ckvss[row * 4] = s2; ckvss[row * 4 + 1] = 0.f; ckvss[row * 4 + 2] = 0.f; ckvss[row * 4 + 3] = 0.f;
}

__global__ void __launch_bounds__(256) na_naive(const bf16* __restrict__ proj, const float* __restrict__ rpb, bf16* __restrict__ O, float* __restrict__ SS) {
    const int gid = blockIdx.x * 256 + threadIdx.x; const int h = gid / NT, tok = gid % NT; const int b = tok / NS, s = tok % NS, r = s >> 6, c = s & 63;
    const int rs = min(max(r - 4, 0), 56), cs = min(max(c - 8, 0), 48);
    float q[64], o[64];
    { const bf16* qp = proj + (size_t)tok * NP + C_AQ + h * 64;
#pragma unroll
      for (int d = 0; d < 64; ++d) { q[d] = bf2f(qp[d]); o[d] = 0.f; } }
    float m = -1e30f, l = 0.f;
    for (int i = 0; i < 8; ++i) for (int j = 0; j < 16; ++j) {
        const int kr = rs + i, kc = cs + j; const size_t kt = (size_t)b * NS + kr * 64 + kc;
        const bf16* kp = proj + kt * NP + C_AK + h * 64; const bf16* vp = proj + kt * NP + C_AV + h * 64;
        float sc = 0.f;
#pragma unroll
        for (int d = 0; d < 64; ++d) sc += q[d] * bf2f(kp[d]);
        sc += rpb[(h * 15 + (kr - r + 7)) * 31 + (kc - c + 15)] * LOG2E;
        const float mn = fmaxf(m, sc), f = exp2f(m - mn), p = exp2f(sc - mn); l = l * f + p; m = mn;
#pragma unroll
        for (int d = 0; d < 64; ++d) o[d] = o[d] * f + p * bf2f(vp[d]);
    }
    const float il = 1.f / l; float ss = 0.f; bf16* op = O + (size_t)tok * DM + h * 64;
#pragma unroll
    for (int d = 0; d < 64; ++d) { const float v = o[d] * il; ss += v * v; op[d] = (bf16)f2bf(v); }
    SS[(size_t)tok * 16 + h] = ss;
}
__global__ void __launch_bounds__(256) mla_naive(const bf16* __restrict__ QB, const bf16* __restrict__ KV, const bf16* __restrict__ proj, bf16* __restrict__ O, float* __restrict__ SS) {
    __shared__ float Ks[16][96], Vs[16][64];
    const int b = blockIdx.z, h = blockIdx.y, q0 = blockIdx.x * 256, tid = threadIdx.x; const size_t tok = (size_t)b * NS + q0 + tid;
    float q[96], o[64];
    { const bf16* qp = QB + tok * 576 + h * 96;
#pragma unroll
      for (int d = 0; d < 96; ++d) q[d] = bf2f(qp[d]);
#pragma unroll
      for (int d = 0; d < 64; ++d) o[d] = 0.f; }
    float m = -1e30f, l = 0.f;
    for (int k0 = 0; k0 < NS; k0 += 16) {
        __syncthreads();
        for (int i = tid; i < 16 * 160; i += 256) { const int kk = i / 160, d = i % 160; const size_t kt = (size_t)b * NS + k0 + kk;
            if (d < 64) Ks[kk][d] = bf2f(KV[kt * 768 + h * 64 + d]); else if (d < 96) Ks[kk][d] = bf2f(proj[kt * NP + C_KR + d - 64]); else Vs[kk][d - 96] = bf2f(KV[kt * 768 + 384 + h * 64 + d - 96]); }
        __syncthreads();
        float sc[16]; float tm = -1e30f;
#pragma unroll
        for (int kk = 0; kk < 16; ++kk) { float a = 0.f;
#pragma unroll
            for (int d = 0; d < 96; ++d) a += q[d] * Ks[kk][d];
            sc[kk] = a; tm = fmaxf(tm, a); }
        const float mn = fmaxf(m, tm), f = exp2f(m - mn); m = mn; l *= f;
#pragma unroll
        for (int d = 0; d < 64; ++d) o[d] *= f;
#pragma unroll
        for (int kk = 0; kk < 16; ++kk) { const float p = exp2f(sc[kk] - mn); l += p;
#pragma unroll
            for (int d = 0; d < 64; ++d) o[d] += p * Vs[kk][d]; }
    }
    const float il = 1.f / l; float ss = 0.f; bf16* op = O + tok * DM + 256 + h * 64;
#pragma unroll
    for (int d = 0; d < 64; ++d) { const float v = o[d] * il; ss += v * v; op[d] = (bf16)f2bf(v); }
    SS[tok * 16 + 4 + h] = ss;
}
__global__ void __launch_bounds__(256) swa_naive(const bf16* __restrict__ proj, const float* __restrict__ sink, bf16* __restrict__ O, float* __restrict__ SS) {
    __shared__ float Ks[16][64], Vs[16][64];
    const int b = blockIdx.z, hq = blockIdx.y, kvh = hq / 3, q0 = blockIdx.x * 256, tid = threadIdx.x; const int qpos = q0 + tid; const size_t tok = (size_t)b * NS + qpos;
    float q[64], o[64];
    { const bf16* qp = proj + tok * NP + C_SQ + hq * 64;
#pragma unroll
      for (int d = 0; d < 64; ++d) { q[d] = bf2f(qp[d]); o[d] = 0.f; } }
    float m = sink[hq] * LOG2E, l = 1.f;
    const int kbeg = max(q0 - 128, 0), kend = min(q0 + 256 + 128, NS);
    for (int k0 = kbeg; k0 < kend; k0 += 16) {
        __syncthreads();
        for (int i = tid; i < 16 * 128; i += 256) { const int kk = i >> 7, d = i & 127; const size_t kt = (size_t)b * NS + k0 + kk;
            if (d < 64) Ks[kk][d] = bf2f(proj[kt * NP + C_SK + kvh * 64 + d]); else Vs[kk][d - 64] = bf2f(proj[kt * NP + C_SV + kvh * 64 + d - 64]); }
        __syncthreads();
        float sc[16]; float tm = -1e30f;
#pragma unroll
        for (int kk = 0; kk < 16; ++kk) { float a = 0.f;
#pragma unroll
            for (int d = 0; d < 64; ++d) a += q[d] * Ks[kk][d];
            const int dist = qpos - (k0 + kk); const bool ok = dist <= 128 && dist >= -128;
            sc[kk] = ok ? a : -1e30f; tm = fmaxf(tm, sc[kk]); }
        const float mn = fmaxf(m, tm), f = exp2f(m - mn); m = mn; l *= f;
#pragma unroll
        for (int d = 0; d < 64; ++d) o[d] *= f;
#pragma unroll
        for (int kk = 0; kk < 16; ++kk) { const float p = sc[kk] > -1e29f ? exp2f(sc[kk] - mn) : 0.f; l += p;
#pragma unroll
            for (int d = 0; d < 64; ++d) o[d] += p * Vs[kk][d]; }
    }
    const float il = 1.f / l; float ss = 0.f; bf16* op = O + tok * DM + 640 + hq * 64;
#pragma unroll
    for (int d = 0; d < 64; ++d) { const float v = o[d] * il; ss += v * v; op[d] = (bf16)f2bf(v); }
    SS[tok * 16 + 10 + hq] = ss;
}
__global__ void __launch_bounds__(256) gnorm_rows(bf16* O, const float* __restrict__ SS) {
    const int row = blockIdx.x * 4 + (threadIdx.x >> 6), lane = threadIdx.x & 63;
    const float* ss = SS + (size_t)row * 16;
    const float ra = rsqrtf((ss[0] + ss[1] + ss[2] + ss[3]) * (1.f / 256.f) + EPS);
    const float rb = rsqrtf((ss[4] + ss[5] + ss[6] + ss[7] + ss[8] + ss[9]) * (1.f / 384.f) + EPS);
    const float rc = rsqrtf((ss[10] + ss[11] + ss[12] + ss[13] + ss[14] + ss[15]) * (1.f / 384.f) + EPS);
    uint2* o = (uint2*)(O + (size_t)row * DM) + lane;
#pragma unroll
    for (int j = 0; j < 4; ++j) { const int col = 4 * lane + 256 * j; const float r = col < 256 ? ra : (col < 640 ? rb : rc); uint2 w = o[64 * j];
        w.x = f2bf(bf2f(w.x & 0xffff) * r) | (f2bf(bf2f(w.x >> 16) * r) << 16); w.y = f2bf(bf2f(w.y & 0xffff) * r) | (f2bf(bf2f(w.y >> 16) * r) << 16); o[64 * j] = w; }
}

__global__ void __launch_bounds__(256) router_rows(const float* __restrict__ h, const float* __restrict__ g, const float* __restrict__ wr, bf16* __restrict__ xn, float* __restrict__ aff) {
    const int row = blockIdx.x * 4 + (threadIdx.x >> 6), lane = threadIdx.x & 63;
    const float4* hr = (const float4*)(h + (size_t)row * DM) + lane; float4 v[4]; float s = 0.f;
#pragma unroll
    for (int j = 0; j < 4; ++j) { v[j] = hr[64 * j]; s += v[j].x * v[j].x + v[j].y * v[j].y + v[j].z * v[j].z + v[j].w * v[j].w; }
    const float rstd = rsqrtf(wave_sum(s) * (1.f / DM) + EPS);
    uint2* o = (uint2*)(xn + (size_t)row * DM) + lane; float lg[16];
#pragma unroll
    for (int e = 0; e < 16; ++e) lg[e] = 0.f;
#pragma unroll
    for (int j = 0; j < 4; ++j) { const float4 gg = ((const float4*)g)[lane + 64 * j];
        const float x[4] = {v[j].x * rstd * gg.x, v[j].y * rstd * gg.y, v[j].z * rstd * gg.z, v[j].w * rstd * gg.w};
        o[64 * j] = make_uint2(f2bf(x[0]) | (f2bf(x[1]) << 16), f2bf(x[2]) | (f2bf(x[3]) << 16));
#pragma unroll
        for (int c = 0; c < 4; ++c) { const float4* w = (const float4*)(wr + (size_t)(4 * lane + 256 * j + c) * 16);
#pragma unroll
            for (int e4 = 0; e4 < 4; ++e4) { const float4 ww = w[e4]; lg[4 * e4] += x[c] * ww.x; lg[4 * e4 + 1] += x[c] * ww.y; lg[4 * e4 + 2] += x[c] * ww.z; lg[4 * e4 + 3] += x[c] * ww.w; } } }
    float mx = -1e30f;
#pragma unroll
    for (int e = 0; e < 16; ++e) { lg[e] = wave_sum(lg[e]); mx = fmaxf(mx, lg[e]); }
    float den = 0.f;
#pragma unroll
    for (int e = 0; e < 16; ++e) { lg[e] = __expf(lg[e] - mx); den += lg[e]; }
    const int b = row / NS, sidx = row % NS;
    if (lane < 16) { float val = 0.f;
#pragma unroll
        for (int e = 0; e < 16; ++e) if (lane == e) val = lg[e];
        aff[((size_t)b * NE + lane) * NS + sidx] = val / den; }
}
__global__ void __launch_bounds__(1024) topk_rank(const float* __restrict__ aff, int* __restrict__ inv, int* __restrict__ idx, float* __restrict__ gatef) {
    __shared__ float a[NS];
    const int be = blockIdx.x, b = be / NE, e = be % NE, tid = threadIdx.x;
    const float* src = aff + (size_t)be * NS;
    for (int i = tid; i < NS; i += 1024) a[i] = src[i];
    __syncthreads();
    float mine[4]; int rank[4] = {0, 0, 0, 0};
#pragma unroll
    for (int u = 0; u < 4; ++u) mine[u] = a[tid + 1024 * u];
    for (int j = 0; j < NS; ++j) { const float x = a[j];
#pragma unroll
        for (int u = 0; u < 4; ++u) { const int i = tid + 1024 * u; rank[u] += (x > mine[u] || (x == mine[u] && j < i)) ? 1 : 0; } }
#pragma unroll
    for (int u = 0; u < 4; ++u) { const int i = tid + 1024 * u;
        if (rank[u] < CAP) { inv[(size_t)be * NS + i] = rank[u]; idx[be * CAP + rank[u]] = i; gatef[(size_t)e * (NB * CAP) + b * CAP + rank[u]] = mine[u]; }
        else inv[(size_t)be * NS + i] = -1; }
}
__global__ void __launch_bounds__(256) gather_rows(const bf16* __restrict__ xn, const int* __restrict__ idx, bf16* __restrict__ xs) {
    const int r = blockIdx.x * 4 + (threadIdx.x >> 6), lane = threadIdx.x & 63;
    const int e = r >> 12, b = (r >> 9) & 7, slot = r & 511; const int tokn = idx[(b * NE + e) * CAP + slot];
    const uint4* s = (const uint4*)(xn + ((size_t)b * NS + tokn) * DM) + lane; uint4* d = (uint4*)(xs + (size_t)r * DM) + lane;
    d[0] = s[0]; d[64] = s[64];
}
__global__ void __launch_bounds__(256) combine_rows(float* h, const bf16* __restrict__ Y, const int* __restrict__ inv, const float* __restrict__ g, bf16* __restrict__ xn, int final_mode) {
    const int row = blockIdx.x * 4 + (threadIdx.x >> 6), lane = threadIdx.x & 63; const int b = row / NS, s = row % NS;
    float4* hr = (float4*)(h + (size_t)row * DM) + lane; float4 v[4];
#pragma unroll
    for (int j = 0; j < 4; ++j) v[j] = hr[64 * j];
    for (int e = 0; e < NE; ++e) { const int slot = inv[((size_t)b * NE + e) * NS + s];
        if (slot >= 0) { const uint2* y = (const uint2*)(Y + ((size_t)e * (NB * CAP) + b * CAP + slot) * DM) + lane;
#pragma unroll
            for (int j = 0; j < 4; ++j) { const uint2 w = y[64 * j]; v[j].x += bf2f(w.x & 0xffff); v[j].y += bf2f(w.x >> 16); v[j].z += bf2f(w.y & 0xffff); v[j].w += bf2f(w.y >> 16); } } }
    float ssum = 0.f;
#pragma unroll
    for (int j = 0; j < 4; ++j) ssum += v[j].x * v[j].x + v[j].y * v[j].y + v[j].z * v[j].z + v[j].w * v[j].w;
    const float rstd = rsqrtf(wave_sum(ssum) * (1.f / DM) + EPS);
    if (final_mode) {
#pragma unroll
        for (int j = 0; j < 4; ++j) { const float4 gg = ((const float4*)g)[lane + 64 * j]; hr[64 * j] = make_float4(v[j].x * rstd * gg.x, v[j].y * rstd * gg.y, v[j].z * rstd * gg.z, v[j].w * rstd * gg.w); }
    } else {
        uint2* o = (uint2*)(xn + (size_t)row * DM) + lane;
#pragma unroll
        for (int j = 0; j < 4; ++j) { const float4 gg = ((const float4*)g)[lane + 64 * j]; hr[64 * j] = v[j];
            o[64 * j] = make_uint2(f2bf(v[j].x * rstd * gg.x) | (f2bf(v[j].y * rstd * gg.y) << 16), f2bf(v[j].z * rstd * gg.z) | (f2bf(v[j].w * rstd * gg.w) << 16)); }
    }
}


#define LAS __attribute__((address_space(3)))
#define GAS __attribute__((address_space(1)))
namespace pg8 {
typedef short bf16x8 __attribute__((ext_vector_type(8)));
typedef float f32x4 __attribute__((ext_vector_type(4)));
typedef unsigned u32x4 __attribute__((ext_vector_type(4)));
constexpr int BM = 256, BK = 64, HALF = 128, HTB = HALF * BK * 2, STAGE_BYTES = 8 * HTB, NXCD = 8, WGM = 8;
__host__ __device__ __forceinline__ int lds_byte(int r, int c) { const int st = (r >> 4) * 2 + (c >> 5), rr = r & 15, cc = c & 31, ob = rr * 64 + cc * 2; return st * 1024 + (ob ^ (((ob >> 9) & 1) << 5)); }
__host__ __device__ __forceinline__ void stage_rc(int b, int& R, int& C) { const int st = b / 1024, sb = b % 1024, swz = sb ^ (((sb >> 9) & 1) << 5); R = (st >> 1) * 16 + swz / 64; C = (st & 1) * 32 + (swz % 64) / 2; }
__host__ __device__ __forceinline__ int perm32(int rho) { const int n = rho >> 4, i = rho & 15; return 8 * (i >> 2) + 4 * n + (i & 3); }
struct Unit { int pm, pn, pb; };
struct Gemm { const bf16* A; const bf16* Bt; int K, lda, ldb; };
struct StaticOrder {
    int nM, nN, nwg, G, c, gm;
    __device__ void init(int nM_, int nN_, int G_, int c_, int gm_) { nM = nM_; nN = nN_; nwg = nM * nN; G = G_; c = c_; gm = gm_; }
    __device__ bool next(int i, Unit& u) const {
        const long L = (long)i * G + c; if (L >= nwg) return false;
        int wgid = (int)L; { const int q = nwg / NXCD, r = nwg % NXCD, xcd = wgid % NXCD, off = wgid / NXCD; wgid = (xcd < r ? xcd * (q + 1) : r * (q + 1) + (xcd - r) * q) + off; }
        const int nig = WGM * nN, gid = wgid / nig, fm = gid * WGM, gsz = (nM - fm) < WGM ? (nM - fm) : WGM;
        u.pm = fm + ((wgid % nig) % gsz); u.pn = (wgid % nig) / gsz; u.pb = gm ? (u.pm / gm) * nN + u.pn : u.pn; return true;
    }
};
__device__ __forceinline__ unsigned cvt_pk_bf16(float lo, float hi) { unsigned r; asm volatile("v_cvt_pk_bf16_f32 %0, %1, %2" : "=v"(r) : "v"(lo), "v"(hi)); return r; }

template <class Epi, class Sched, bool ALIGN_EPI>
__device__ __forceinline__ void gemm_phase(LAS unsigned char* lds, const Gemm g, const Sched& S, const Epi& E) {
    int tid = threadIdx.x; asm volatile("" : "+v"(tid));
    const int wid = __builtin_amdgcn_readfirstlane(tid >> 6), lane = tid & 63, wr = wid >> 2, wc = wid & 3, fr = lane & 15, fq = lane >> 4;
    const int K = g.K, nt = K / BK;
    unsigned voffA[2], voffB[2];
#pragma unroll
    for (int i = 0; i < 2; ++i) { int R, C; stage_rc(tid * 16 + i * 8192, R, C); const int Rb = Epi::PERM ? ((R & ~31) + perm32(R & 31)) : R;
        voffA[i] = (unsigned)(R * g.lda + C) * 2u; voffB[i] = (unsigned)(Rb * g.ldb + C) * 2u; }
    const size_t kstep = (size_t)(BK * 2);
    const size_t hstepA = (size_t)HALF * g.lda * 2, hstepB = (size_t)HALF * g.ldb * 2, tstepA = 2 * hstepA, tstepB = 2 * hstepB;
    const unsigned ldsw = (unsigned)wid * 1024u;
    const int aoff = lds_byte(wr * 64 + fr, fq * 8), boff = lds_byte(wc * 32 + fr, fq * 8);
#define PG8_SA(b, h) (((b) * 2 + (h)) * HTB)
#define PG8_SB(b, h) ((4 + (b) * 2 + (h)) * HTB)
#define PG8_STAGE(bufoff, gbase, voff) do { _Pragma("unroll") for (int _i = 0; _i < 2; ++_i) \
        __builtin_amdgcn_global_load_lds((const unsigned*)((const char*)(gbase) + (voff)[_i]), (LAS unsigned*)(lds + (bufoff) + ldsw + _i * 8192), 16, 0, 0); } while (0)
#define PG8_LDA(dst, b, h) do { _Pragma("unroll") for (int m = 0; m < 4; ++m) _Pragma("unroll") for (int k = 0; k < 2; ++k) dst[m][k] = *(const LAS bf16x8*)(lds + PG8_SA(b, h) + aoff + m * 2048 + k * 1024); } while (0)
#define PG8_LDB(dst, b, h) do { _Pragma("unroll") for (int n = 0; n < 2; ++n) _Pragma("unroll") for (int k = 0; k < 2; ++k) dst[n][k] = *(const LAS bf16x8*)(lds + PG8_SB(b, h) + boff + n * 2048 + k * 1024); } while (0)
#define PG8_MMA(ai, bj, At, Bt) do { __builtin_amdgcn_s_setprio(1); _Pragma("unroll") for (int m = 0; m < 4; ++m) _Pragma("unroll") for (int n = 0; n < 2; ++n) _Pragma("unroll") for (int k = 0; k < 2; ++k) \
        acc[ai][bj][m][n] = __builtin_amdgcn_mfma_f32_16x16x32_bf16(Bt[n][k], At[m][k], acc[ai][bj][m][n], 0, 0, 0); __builtin_amdgcn_s_setprio(0); } while (0)
#define PG8_WAIT_V(n) asm volatile("s_waitcnt vmcnt(" #n ")" ::: "memory")
#define PG8_WAIT_L(n) asm volatile("s_waitcnt lgkmcnt(" #n ")" ::: "memory")
#define PG8_BAR __builtin_amdgcn_s_barrier()
#define PG8_SCHED __builtin_amdgcn_sched_barrier(0)
    Unit cur, nxt; int ui = 0;
    if (!S.next(0, cur)) return;
    f32x4 acc[2][2][4][2];
#pragma unroll
    for (int a = 0; a < 2; ++a)
#pragma unroll
        for (int b = 0; b < 2; ++b)
#pragma unroll
            for (int m = 0; m < 4; ++m)
#pragma unroll
                for (int n = 0; n < 2; ++n) acc[a][b][m][n] = (f32x4){0.f, 0.f, 0.f, 0.f};
    bf16x8 At[4][2], B0[2][2], B1[2][2];
    const char* cA = (const char*)g.A + (size_t)cur.pm * tstepA; const char* cB = (const char*)g.Bt + (size_t)cur.pb * tstepB;
    PG8_STAGE(PG8_SB(0, 0), cB, voffB); PG8_STAGE(PG8_SB(0, 1), cB + hstepB, voffB); PG8_STAGE(PG8_SA(0, 0), cA, voffA); PG8_STAGE(PG8_SA(0, 1), cA + hstepA, voffA);
    if (wr == 1) PG8_BAR;
    PG8_WAIT_V(2); PG8_BAR;
    PG8_STAGE(PG8_SB(1, 0), cB + kstep, voffB); PG8_STAGE(PG8_SA(1, 0), cA + kstep, voffA); PG8_STAGE(PG8_SB(1, 1), cB + hstepB + kstep, voffB);
    PG8_WAIT_V(6); PG8_BAR;
    for (;;) {
        const bool has_next = S.next(ui + 1, nxt);
        const char* nA = has_next ? (const char*)g.A + (size_t)nxt.pm * tstepA : cA; const char* nB = has_next ? (const char*)g.Bt + (size_t)nxt.pb * tstepB : cB;
        for (int t = 0; t < nt; t += 2) {
            const bool last = (t == nt - 2);
            const char* a1 = cA + (size_t)(t + 1) * kstep;
            const char* a2 = last ? nA : cA + (size_t)(t + 2) * kstep; const char* b2 = last ? nB : cB + (size_t)(t + 2) * kstep;
            const char* a3 = a2 + kstep; const char* b3 = b2 + kstep;
            PG8_LDB(B0, 0, 0); PG8_LDB(B1, 0, 1); PG8_SCHED; PG8_LDA(At, 0, 0); PG8_STAGE(PG8_SA(1, 1), a1 + hstepA, voffA);
            PG8_WAIT_V(8); PG8_WAIT_L(0); PG8_BAR; PG8_MMA(0, 0, At, B0); PG8_MMA(0, 1, At, B1); PG8_BAR; PG8_SCHED;
            PG8_LDA(At, 0, 1); PG8_STAGE(PG8_SB(0, 0), b2, voffB); PG8_STAGE(PG8_SB(0, 1), b2 + hstepB, voffB); PG8_STAGE(PG8_SA(0, 0), a2, voffA);
            PG8_WAIT_V(8); PG8_WAIT_L(0); PG8_BAR; PG8_MMA(1, 0, At, B0); PG8_MMA(1, 1, At, B1); PG8_BAR; PG8_SCHED;
            PG8_LDB(B0, 1, 0); PG8_LDB(B1, 1, 1); PG8_SCHED; PG8_LDA(At, 1, 0); PG8_STAGE(PG8_SA(0, 1), a2 + hstepA, voffA);
            PG8_WAIT_V(8); PG8_WAIT_L(0); PG8_BAR; PG8_MMA(0, 0, At, B0); PG8_MMA(0, 1, At, B1); PG8_BAR; PG8_SCHED;
            PG8_LDA(At, 1, 1); PG8_STAGE(PG8_SB(1, 0), b3, voffB); PG8_STAGE(PG8_SB(1, 1), b3 + hstepB, voffB); PG8_STAGE(PG8_SA(1, 0), a3, voffA);
            PG8_WAIT_V(8); PG8_WAIT_L(0); PG8_BAR; PG8_MMA(1, 0, At, B0); PG8_MMA(1, 1, At, B1); PG8_BAR; PG8_SCHED;
        }
        if constexpr (ALIGN_EPI) { if (wr == 0) PG8_BAR; }
        { int t2 = threadIdx.x; asm volatile("" : "+v"(t2)); E(acc, cur, wr, wc, t2 & 15, (t2 >> 4) & 3); }
        if (!has_next) break;
#pragma unroll
        for (int a = 0; a < 2; ++a)
#pragma unroll
            for (int b = 0; b < 2; ++b)
#pragma unroll
                for (int m = 0; m < 4; ++m)
#pragma unroll
                    for (int n = 0; n < 2; ++n) acc[a][b][m][n] = (f32x4){0.f, 0.f, 0.f, 0.f};
        cur = nxt; cA = nA; cB = nB; ++ui;
        if constexpr (ALIGN_EPI) { if (wr == 1) PG8_BAR; }
    }
    PG8_WAIT_V(0);
    if constexpr (!ALIGN_EPI) { if (wr == 0) PG8_BAR; }
    PG8_BAR;
#undef PG8_SA
#undef PG8_SB
#undef PG8_STAGE
#undef PG8_LDA
#undef PG8_LDB
#undef PG8_MMA
#undef PG8_WAIT_V
#undef PG8_WAIT_L
#undef PG8_BAR
#undef PG8_SCHED
}

typedef const f32x4 (&AccRef)[2][2][4][2];
__device__ __forceinline__ void st_bf16x8(bf16* p, f32x4 v0, f32x4 v1) { u32x4 w; w.x = cvt_pk_bf16(v0[0], v0[1]); w.y = cvt_pk_bf16(v0[2], v0[3]); w.z = cvt_pk_bf16(v1[0], v1[1]); w.w = cvt_pk_bf16(v1[2], v1[3]); *(u32x4*)p = w; }
struct EpiProj {
    static constexpr bool PERM = true;
    bf16* P; const float *c64, *s64, *c32, *s32; float *cqss, *ckvss;
    __device__ __forceinline__ void operator()(AccRef acc, const Unit& u, int wr, int wc, int fr, int fq) const {
#pragma unroll
        for (int ai = 0; ai < 2; ++ai)
#pragma unroll
            for (int m = 0; m < 4; ++m) { const int row = u.pm * BM + ai * HALF + wr * 64 + m * 16 + fr; const int pos = row & (NS - 1); float ssq = 0.f;
#pragma unroll
                for (int bj = 0; bj < 2; ++bj) { const int cw = u.pn * BM + bj * HALF + wc * 32, col0 = cw + 8 * fq; f32x4 v0 = acc[ai][bj][m][0], v1 = acc[ai][bj][m][1];
                    if (cw >= C_SQ && cw < C_SV) { const int g = ((col0 - C_SQ) & 63) >> 3; const f32x4 c = *(const f32x4*)(c64 + pos * 32 + 4 * g), s = *(const f32x4*)(s64 + pos * 32 + 4 * g);
                        const f32x4 o0 = v0 * c - v1 * s, o1 = v1 * c + v0 * s; v0 = o0; v1 = o1; }
                    else if (cw == C_KR) { const f32x4 c = *(const f32x4*)(c32 + pos * 16 + 4 * fq), s = *(const f32x4*)(s32 + pos * 16 + 4 * fq);
                        const f32x4 o0 = v0 * c - v1 * s, o1 = v1 * c + v0 * s; v0 = o0; v1 = o1; }
                    if (u.pn == 3 || (u.pn == 4 && bj == 0)) ssq += (v0[0] * v0[0] + v0[1] * v0[1]) + (v0[2] * v0[2] + v0[3] * v0[3]) + (v1[0] * v1[0] + v1[1] * v1[1]) + (v1[2] * v1[2] + v1[3] * v1[3]);
                    st_bf16x8(P + (size_t)row * NP + col0, v0, v1); }
                if (u.pn == 3 || u.pn == 4) { ssq += __shfl_xor(ssq, 16); ssq += __shfl_xor(ssq, 32); if (fq == 0) (u.pn == 3 ? cqss : ckvss)[(size_t)row * 4 + wc] = ssq; }
            }
    }
};
template <bool QMODE, int ldc, int ncols> struct EpiMla {
    static constexpr bool PERM = true;
    bf16* O; const float* ss; float ssinv; const float *c32, *s32;
    __device__ __forceinline__ void operator()(AccRef acc, const Unit& u, int wr, int wc, int fr, int fq) const {
#pragma unroll
        for (int ai = 0; ai < 2; ++ai)
#pragma unroll
            for (int m = 0; m < 4; ++m) { const int row = u.pm * BM + ai * HALF + wr * 64 + m * 16 + fr; const int pos = row & (NS - 1);
                const f32x4 p = *(const f32x4*)(ss + (size_t)row * 4); const float rs = rsqrtf(((p[0] + p[1]) + (p[2] + p[3])) * ssinv + EPS);
#pragma unroll
                for (int bj = 0; bj < 2; ++bj) { const int cw = u.pn * BM + bj * HALF + wc * 32, col0 = cw + 8 * fq; if (cw >= ncols) continue;
                    f32x4 v0 = acc[ai][bj][m][0] * rs, v1 = acc[ai][bj][m][1] * rs;
                    if (QMODE && (cw % 96) == 64) { const f32x4 c = *(const f32x4*)(c32 + pos * 16 + 4 * fq), s = *(const f32x4*)(s32 + pos * 16 + 4 * fq);
                        const f32x4 o0 = v0 * c - v1 * s, o1 = v1 * c + v0 * s; v0 = o0; v1 = o1; }
                    st_bf16x8(O + (size_t)row * ldc + col0, v0, v1); }
                asm volatile("" ::: "memory"); }
    }
};
struct EpiResid {
    static constexpr bool PERM = false;
    const float* Hin; float* Hout;
    __device__ __forceinline__ void operator()(AccRef acc, const Unit& u, int wr, int wc, int fr, int fq) const {
#pragma unroll
        for (int ai = 0; ai < 2; ++ai)
#pragma unroll
            for (int m = 0; m < 4; ++m) { const size_t off = (size_t)(u.pm * BM + ai * HALF + wr * 64 + m * 16 + fr) * DM + u.pn * BM + wc * 32 + 4 * fq;
#pragma unroll
                for (int bj = 0; bj < 2; ++bj)
#pragma unroll
                    for (int n = 0; n < 2; ++n) { const f32x4 b = *(const f32x4*)(Hin + off + bj * HALF + n * 16); *(f32x4*)(Hout + off + bj * HALF + n * 16) = b + acc[ai][bj][m][n]; } }
    }
};
struct EpiSwiglu {
    static constexpr bool PERM = true;
    bf16* Hd;
    __device__ __forceinline__ void operator()(AccRef acc, const Unit& u, int wr, int wc, int fr, int fq) const {
#pragma unroll
        for (int ai = 0; ai < 2; ++ai)
#pragma unroll
            for (int m = 0; m < 4; ++m) { const size_t row = (size_t)(u.pm * BM + ai * HALF + wr * 64 + m * 16 + fr); f32x4 o[2];
#pragma unroll
                for (int n = 0; n < 2; ++n) { const f32x4 gt = acc[ai][0][m][n], up = acc[ai][1][m][n];
#pragma unroll
                    for (int e = 0; e < 4; ++e) o[n][e] = gt[e] * __builtin_amdgcn_rcpf(1.f + __builtin_amdgcn_exp2f(-gt[e] * LOG2E)) * up[e]; }
                st_bf16x8(Hd + row * DM + u.pn * HALF + wc * 32 + 8 * fq, o[0], o[1]); }
    }
};
struct EpiGate {
    static constexpr bool PERM = true;
    bf16* Y; const float* gate;
    __device__ __forceinline__ void operator()(AccRef acc, const Unit& u, int wr, int wc, int fr, int fq) const {
#pragma unroll
        for (int ai = 0; ai < 2; ++ai)
#pragma unroll
            for (int m = 0; m < 4; ++m) { const size_t row = (size_t)(u.pm * BM + ai * HALF + wr * 64 + m * 16 + fr); const float gt = gate[row];
#pragma unroll
                for (int bj = 0; bj < 2; ++bj) st_bf16x8(Y + row * DM + u.pn * BM + bj * HALF + wc * 32 + 8 * fq, acc[ai][bj][m][0] * gt, acc[ai][bj][m][1] * gt); }
    }
};
}

constexpr int NWAVES = 8, LDS_BYTES = 147456, RING_BYTES = 131072;
enum { PH_PROJ = 0, PH_MLAUP, PH_OUT, PH_MOE1, PH_MOE2, PH_COUNT };
struct MegaArgs {
    const float* x; float* H; unsigned char* ws;
    const float *rpb, *sink;
    int layer, ph_lo, ph_hi, pad;
};
__global__ void __launch_bounds__(NWAVES * 64, 2) mega(MegaArgs a) {
    extern __shared__ __attribute__((aligned(16))) unsigned char lds_raw[];
    LAS unsigned char* lds = (LAS unsigned char*)lds_raw;
    unsigned char* ws = a.ws;
    const int G = gridDim.x, bx = blockIdx.x;
    float *c64 = (float*)(ws + WS_COS64), *s64 = (float*)(ws + WS_SIN64), *c32 = (float*)(ws + WS_COS32), *s32 = (float*)(ws + WS_SIN32);
    bf16 *WIN = (bf16*)(ws + WS_WIN), *WUQ = (bf16*)(ws + WS_WUQ), *WUKV = (bf16*)(ws + WS_WUKV), *WOUT = (bf16*)(ws + WS_WOUT), *WGU = (bf16*)(ws + WS_WGU), *WD = (bf16*)(ws + WS_WD);
    float *CQSS = (float*)(ws + WS_CQSS), *CKVSS = (float*)(ws + WS_CKVSS), *GATE = (float*)(ws + WS_GATE);
    bf16 *XN = (bf16*)(ws + WS_XN), *PROJ = (bf16*)(ws + WS_PROJ), *QB = (bf16*)(ws + WS_QB), *KV = (bf16*)(ws + WS_KV), *HID = (bf16*)(ws + WS_HID), *XS = PROJ, *Y = PROJ, *O = XN;
    const int lo = a.ph_lo, hi = a.ph_hi;
#define IN(k) (lo <= (k) && (k) < hi)
    if (IN(PH_PROJ)) {
        pg8::Gemm g{XN, WIN, DM, DM, DM}; pg8::StaticOrder S; S.init(NT / 256, NP / 256, G, bx, 0);
        pg8::EpiProj E{PROJ, c64, s64, c32, s32, CQSS, CKVSS};
        pg8::gemm_phase<pg8::EpiProj, pg8::StaticOrder, true>(lds, g, S, E);
    }
    if (IN(PH_MLAUP)) {
        { pg8::Gemm g{PROJ + C_CQ, WUQ, 256, NP, 256}; pg8::StaticOrder S; S.init(NT / 256, 3, G, bx, 0);
          typedef pg8::EpiMla<true, 576, 576> EQ; EQ E{QB, CQSS, 1.f / 256.f, c32, s32};
          pg8::gemm_phase<EQ, pg8::StaticOrder, true>(lds, g, S, E); }
        { pg8::Gemm g{PROJ + C_CKV, WUKV, 128, NP, 128}; pg8::StaticOrder S; S.init(NT / 256, 3, G, bx, 0);
          typedef pg8::EpiMla<false, 768, 768> EK; EK E{KV, CKVSS, 1.f / 128.f, c32, s32};
          pg8::gemm_phase<EK, pg8::StaticOrder, true>(lds, g, S, E); }
    }
    if (IN(PH_OUT)) {
        pg8::Gemm g{O, WOUT, DM, DM, DM}; pg8::StaticOrder S; S.init(NT / 256, DM / 256, G, bx, 0);
        pg8::EpiResid E{a.layer == 0 ? a.x : a.H, a.H};
        pg8::gemm_phase<pg8::EpiResid, pg8::StaticOrder, true>(lds, g, S, E);
    }
    if (IN(PH_MOE1)) {
        pg8::Gemm g{XS, WGU, DM, DM, DM}; pg8::StaticOrder S; S.init(NSLOTS / 256, 8, G, bx, 16);
        pg8::EpiSwiglu E{HID};
        pg8::gemm_phase<pg8::EpiSwiglu, pg8::StaticOrder, true>(lds, g, S, E);
    }
    if (IN(PH_MOE2)) {
        pg8::Gemm g{HID, WD, DM, DM, DM}; pg8::StaticOrder S; S.init(NSLOTS / 256, 4, G, bx, 16);
        pg8::EpiGate E{Y, GATE};
        pg8::gemm_phase<pg8::EpiGate, pg8::StaticOrder, true>(lds, g, S, E);
    }
#undef IN
}
extern "C" void kernel_launch(void* const* d_in, const int* in_sizes, int n_in, void* d_out, int out_size, void* d_ws, size_t ws_size, hipStream_t stream) {
    if (n_in != 17 || out_size != NT * DM || ws_size < WS_END) { fprintf(stderr, "kernel_launch: unexpected shapes (n_in %d out %d ws %zu)\n", n_in, out_size, ws_size); return; }
    const float* x = (const float*)d_in[0]; const float* attn_norm = (const float*)d_in[1]; const float* w_in = (const float*)d_in[2]; const float* na_rpb = (const float*)d_in[3];
    const float* q_norm = (const float*)d_in[4]; const float* w_uq = (const float*)d_in[5]; const float* kv_norm = (const float*)d_in[6]; const float* w_ukv = (const float*)d_in[7];
    const float* swa_sink = (const float*)d_in[8]; const float* group_norm = (const float*)d_in[9]; const float* w_out = (const float*)d_in[10]; const float* ffn_norm = (const float*)d_in[11];
    const float* w_router = (const float*)d_in[12]; const float* w_gate = (const float*)d_in[13]; const float* w_up = (const float*)d_in[14]; const float* w_down = (const float*)d_in[15]; const float* final_norm = (const float*)d_in[16];
    unsigned char* ws = (unsigned char*)d_ws; float* H = (float*)d_out;
    float *c64 = (float*)(ws + WS_COS64), *s64 = (float*)(ws + WS_SIN64), *c32 = (float*)(ws + WS_COS32), *s32 = (float*)(ws + WS_SIN32);
    bf16 *WIN = (bf16*)(ws + WS_WIN), *WUQ = (bf16*)(ws + WS_WUQ), *WUKV = (bf16*)(ws + WS_WUKV), *WOUT = (bf16*)(ws + WS_WOUT), *WGU = (bf16*)(ws + WS_WGU), *WD = (bf16*)(ws + WS_WD);
    float *CQSS = (float*)(ws + WS_CQSS), *CKVSS = (float*)(ws + WS_CKVSS), *SS = (float*)(ws + WS_SS), *AFF = (float*)(ws + WS_AFF), *GATE = (float*)(ws + WS_GATE);
    int *INV = (int*)(ws + WS_INV), *IDX = (int*)(ws + WS_IDX);
    bf16 *XN = (bf16*)(ws + WS_XN), *PROJ = (bf16*)(ws + WS_PROJ), *QB = (bf16*)(ws + WS_QB), *KV = (bf16*)(ws + WS_KV), *HID = (bf16*)(ws + WS_HID), *XS = PROJ, *Y = PROJ, *O = XN, *XN2 = XN;

    static int grid = 0;
    if (grid == 0) { int dev = 0, cus = 0; hipGetDevice(&dev); hipDeviceGetAttribute(&cus, hipDeviceAttributeMultiprocessorCount, dev);
        if (hipFuncSetAttribute((const void*)mega, hipFuncAttributeMaxDynamicSharedMemorySize, LDS_BYTES) != hipSuccess) fprintf(stderr, "hipFuncSetAttribute failed\n");
        grid = cus > 0 ? cus : 256; }
    MegaArgs ma{}; ma.x = x; ma.H = H; ma.ws = ws;
#define MEGA(ph) do { ma.layer = l; ma.ph_lo = (ph); ma.ph_hi = (ph) + 1; ma.rpb = na_rpb + (size_t)l * 4 * 15 * 31; ma.sink = swa_sink + l * 6; hipLaunchKernelGGL(mega, dim3(grid), dim3(NWAVES * 64), LDS_BYTES, stream, ma); } while (0)
    hipLaunchKernelGGL(rope_tables, dim3(NS * 32 / 256), dim3(256), 0, stream, c64, s64, c32, s32);
    hipLaunchKernelGGL(norm_rows, dim3(NT / 4), dim3(256), 0, stream, x, attn_norm, XN);
    for (int l = 0; l < DEPTH; ++l) {
        { PrepArgs a{w_in + (size_t)l * DM * C_END, nullptr, nullptr, WIN, DM, C_END, NP, PK_WIN, 0, 0}; hipLaunchKernelGGL(prep_wt, dim3(NP / 32, DM / 32, 1), dim3(256), 0, stream, a); }
        { PrepArgs a{w_uq + (size_t)l * 256 * 576, nullptr, q_norm + l * 256, WUQ, 256, 576, 768, PK_WUQ, 0, 0}; hipLaunchKernelGGL(prep_wt, dim3(768 / 32, 256 / 32, 1), dim3(256), 0, stream, a); }
        { PrepArgs a{w_ukv + (size_t)l * 128 * 768, nullptr, kv_norm + l * 128, WUKV, 128, 768, 768, PK_WUKV, 0, 0}; hipLaunchKernelGGL(prep_wt, dim3(768 / 32, 128 / 32, 1), dim3(256), 0, stream, a); }
        { PrepArgs a{w_out + (size_t)l * DM * DM, nullptr, group_norm + l * DM, WOUT, DM, DM, DM, PK_WOUT, 0, 0}; hipLaunchKernelGGL(prep_wt, dim3(DM / 32, DM / 32, 1), dim3(256), 0, stream, a); }
        { PrepArgs a{w_gate + (size_t)l * NE * DM * DM, w_up + (size_t)l * NE * DM * DM, nullptr, WGU, DM, DM, 2048, PK_WGU, (long)DM * DM, (long)2048 * DM}; hipLaunchKernelGGL(prep_wt, dim3(2048 / 32, DM / 32, NE), dim3(256), 0, stream, a); }
        { PrepArgs a{w_down + (size_t)l * NE * DM * DM, nullptr, nullptr, WD, DM, DM, DM, PK_WD, (long)DM * DM, (long)DM * DM}; hipLaunchKernelGGL(prep_wt, dim3(DM / 32, DM / 32, NE), dim3(256), 0, stream, a); }
        MEGA(PH_PROJ);
        MEGA(PH_MLAUP);
        hipLaunchKernelGGL(na_naive, dim3(NT * 4 / 256), dim3(256), 0, stream, (const bf16*)PROJ, na_rpb + (size_t)l * 4 * 15 * 31, O, SS);
        hipLaunchKernelGGL(mla_naive, dim3(NS / 256, 6, NB), dim3(256), 0, stream, (const bf16*)QB, (const bf16*)KV, (const bf16*)PROJ, O, SS);
        hipLaunchKernelGGL(swa_naive, dim3(NS / 256, 6, NB), dim3(256), 0, stream, (const bf16*)PROJ, swa_sink + l * 6, O, SS);
        hipLaunchKernelGGL(gnorm_rows, dim3(NT / 4), dim3(256), 0, stream, O, (const float*)SS);
        MEGA(PH_OUT);
        hipLaunchKernelGGL(router_rows, dim3(NT / 4), dim3(256), 0, stream, (const float*)H, ffn_norm + l * DM, w_router + (size_t)l * DM * NE, XN2, AFF);
        hipLaunchKernelGGL(topk_rank, dim3(NB * NE), dim3(1024), 0, stream, (const float*)AFF, INV, IDX, GATE);
        hipLaunchKernelGGL(gather_rows, dim3(NSLOTS / 4), dim3(256), 0, stream, (const bf16*)XN2, (const int*)IDX, XS);
        MEGA(PH_MOE1);
        MEGA(PH_MOE2);
        const bool last = (l == DEPTH - 1);
        hipLaunchKernelGGL(combine_rows, dim3(NT / 4), dim3(256), 0, stream, H, (const bf16*)Y, (const int*)INV, last ? final_norm : attn_norm + (l + 1) * DM, XN, last ? 1 : 0);
    }
}
```

```cpp
#include <hip/hip_runtime.h>
#include <cstdint>
#include <cstdio>

typedef unsigned short bf16;
constexpr int NB = 8, NS = 4096, DM = 1024, NT = NB * NS, NP = 2048, NE = 16, CAP = 512, DEPTH = 2;
constexpr int NSLOTS = NE * NB * CAP;
constexpr float LOG2E = 1.4426950408889634f;
constexpr float QS64 = 0.125f * LOG2E;
constexpr float QS96 = 0.10206207261596577f * LOG2E;
constexpr float EPS = 1e-6f;
constexpr int C_AQ = 0, C_AK = 256, C_AV = 512, C_CQ = 768, C_CKV = 1024, C_KR = 1152, C_SQ = 1184, C_SK = 1568, C_SV = 1696, C_END = 1824;

constexpr size_t MiB = 1u << 20;
constexpr size_t WS_CTL = 0;
constexpr size_t WS_COS64 = 1 * MiB, WS_SIN64 = WS_COS64 + 512 * 1024, WS_COS32 = 2 * MiB, WS_SIN32 = WS_COS32 + 256 * 1024;
constexpr size_t WS_WIN = 4 * MiB, WS_WUQ = 8 * MiB, WS_WUKV = 8 * MiB + 512 * 1024, WS_WOUT = 9 * MiB, WS_WGU = 12 * MiB, WS_WD = 76 * MiB;
constexpr size_t WS_CQSS = 108 * MiB, WS_CKVSS = WS_CQSS + 512 * 1024, WS_SS = 109 * MiB, WS_AFF = 111 * MiB, WS_INV = 113 * MiB, WS_IDX = 115 * MiB, WS_GATE = WS_IDX + 256 * 1024;
constexpr size_t WS_XN = 120 * MiB;
constexpr size_t WS_PROJ = 184 * MiB;
constexpr size_t WS_QB = 312 * MiB;
constexpr size_t WS_KV = 348 * MiB;
constexpr size_t WS_HID = 312 * MiB;
constexpr size_t WS_END = 440 * MiB;

__device__ __forceinline__ unsigned f2bf(float f) { unsigned u = __builtin_bit_cast(unsigned, f); return (u + 0x7fffu + ((u >> 16) & 1u)) >> 16; }
__device__ __forceinline__ float bf2f(unsigned short b) { return __builtin_bit_cast(float, (unsigned)b << 16); }
__device__ __forceinline__ float wave_sum(float v) {
#pragma unroll
    for (int o = 1; o < 64; o <<= 1) v += __shfl_xor(v, o);
    return v;
}

enum { PK_WIN = 0, PK_WUQ = 1, PK_WUKV = 2, PK_WOUT = 3, PK_WGU = 4, PK_WD = 5 };
__device__ __forceinline__ int prep_map(int kind, int n, float& sc, int& which) {
    sc = 1.f; which = 0;
    switch (kind) {
    case PK_WIN:
        if (n < 256) { sc = QS64; return n; }
        if (n < C_KR) return n;
        if (n < C_SQ) { const int p = n - C_KR, g = p >> 3, e = p & 7; return C_KR + 4 * g + (e & 3) + 16 * (e >> 2); }
        if (n < C_SK) { const int p = n - C_SQ, h = p >> 6, pp = p & 63, g = pp >> 3, e = pp & 7; sc = QS64; return C_SQ + h * 64 + 4 * g + (e & 3) + 32 * (e >> 2); }
        if (n < C_SV) { const int p = n - C_SK, h = p >> 6, pp = p & 63, g = pp >> 3, e = pp & 7; return C_SK + h * 64 + 4 * g + (e & 3) + 32 * (e >> 2); }
        if (n < C_END) return n;
        return -1;
    case PK_WUQ:
        if (n < 576) { const int h = n / 96, d = n % 96; sc = QS96; if (d < 64) return n; const int p = d - 64, g = p >> 3, e = p & 7; return h * 96 + 64 + 4 * g + (e & 3) + 16 * (e >> 2); }
        return -1;
    case PK_WUKV:
        if (n < 384) { const int h = n >> 6, d = n & 63; return h * 128 + d; }
        { const int m = n - 384, h = m >> 6, d = m & 63; return h * 128 + 64 + d; }
    case PK_WGU: { const int pn = n >> 8, half = (n >> 7) & 1, jj = n & 127; which = half; return 128 * pn + jj; }
    default: return n;
    }
}
struct PrepArgs { const float* W; const float* W2; const float* kgain; bf16* Wt; int K, Nsrc, Nout, kind; long sW, sWt; };
__global__ void __launch_bounds__(256) prep_wt(PrepArgs a) {
    __shared__ float tile[32][33];
    const int n0 = blockIdx.x * 32, k0 = blockIdx.y * 32, z = blockIdx.z, tx = threadIdx.x & 31, ty = threadIdx.x >> 5;
    float sc; int which; const int src = prep_map(a.kind, n0 + tx, sc, which);
    const float* W = (which ? a.W2 : a.W) + (size_t)z * a.sW;
#pragma unroll
    for (int i = 0; i < 4; ++i) { const int k = k0 + ty + 8 * i; float v = 0.f;
        if (src >= 0) { v = W[(size_t)k * a.Nsrc + src] * sc; if (a.kgain) v *= a.kgain[k]; }
        tile[ty + 8 * i][tx] = v; }
    __syncthreads();
    bf16* Wt = a.Wt + (size_t)z * a.sWt;
#pragma unroll
    for (int i = 0; i < 4; ++i) { const int n = n0 + ty + 8 * i; Wt[(size_t)n * a.K + k0 + tx] = (bf16)f2bf(tile[tx][ty + 8 * i]); }
}
__global__ void rope_tables(float* c64, float* s64, float* c32, float* s32) {
    const int i = blockIdx.x * blockDim.x + threadIdx.x;
    if (i < NS * 32) { const int s = i >> 5, j = i & 31; const float inv = 1.0f / powf(10000.f, (float)(2 * j) / 64.f); const float ang = (float)s * inv; c64[i] = (float)cos((double)ang); s64[i] = (float)sin((double)ang); }
    if (i < NS * 16) { const int s = i >> 4, j = i & 15; const float inv = 1.0f / powf(10000.f, (float)(2 * j) / 32.f); const float ang = (float)s * inv; c32[i] = (float)cos((double)ang); s32[i] = (float)sin((double)ang); }
}

__global__ void __launch_bounds__(256) norm_rows(const float* __restrict__ h, const float* __restrict__ g, bf16* __restrict__ xn) {
    const int row = blockIdx.x * 4 + (threadIdx.x >> 6), lane = threadIdx.x & 63;
    const float4* hr = (const float4*)(h + (size_t)row * DM) + lane; float4 v[4]; float s = 0.f;
#pragma unroll
    for (int j = 0; j < 4; ++j) { v[j] = hr[64 * j]; s += v[j].x * v[j].x + v[j].y * v[j].y + v[j].z * v[j].z + v[j].w * v[j].w; }
    const float rstd = rsqrtf(wave_sum(s) * (1.f / DM) + EPS);
    uint2* o = (uint2*)(xn + (size_t)row * DM) + lane;
#pragma unroll
    for (int j = 0; j < 4; ++j) { const float4 gg = ((const float4*)g)[lane + 64 * j];
        o[64 * j] = make_uint2(f2bf(v[j].x * rstd * gg.x) | (f2bf(v[j].y * rstd * gg.y) << 16), f2bf(v[j].z * rstd * gg.z) | (f2bf(v[j].w * rstd * gg.w) << 16)); }
}

enum { E_BF16 = 0, E_RESID = 1, E_SWIGLU = 2, E_GATE = 3 };
struct GArgs { const bf16* A; const bf16* Bt; void* C; int M, N, K, lda, ldb, ldc; long sA, sB, sC; const float* ss; float ssinv; const float* gate; long sG; };
template <int EPI> __global__ void __launch_bounds__(256) gemm_bt_naive(GArgs g) {
    __shared__ float As[16][68], Bs[16][68], Bs2[EPI == E_SWIGLU ? 16 : 1][68];
    const int tid = threadIdx.x, tx = tid & 15, ty = tid >> 4, z = blockIdx.z;
    const int m0 = blockIdx.y * 64, nt0 = blockIdx.x * 64;
    const int nb0 = (EPI == E_SWIGLU) ? (256 * (nt0 >> 7) + (nt0 & 127)) : nt0;
    const bf16* A = g.A + (size_t)z * g.sA; const bf16* Bt = g.Bt + (size_t)z * g.sB;
    float acc[4][4] = {}, acc2[4][4] = {};
    const int lr = tid >> 2, lk = (tid & 3) * 4;
    for (int k0 = 0; k0 < g.K; k0 += 16) {
        { const uint2 a = *(const uint2*)(A + (size_t)(m0 + lr) * g.lda + k0 + lk); As[lk][lr] = bf2f(a.x & 0xffff); As[lk + 1][lr] = bf2f(a.x >> 16); As[lk + 2][lr] = bf2f(a.y & 0xffff); As[lk + 3][lr] = bf2f(a.y >> 16); }
        { const uint2 b = *(const uint2*)(Bt + (size_t)(nb0 + lr) * g.ldb + k0 + lk); Bs[lk][lr] = bf2f(b.x & 0xffff); Bs[lk + 1][lr] = bf2f(b.x >> 16); Bs[lk + 2][lr] = bf2f(b.y & 0xffff); Bs[lk + 3][lr] = bf2f(b.y >> 16); }
        if (EPI == E_SWIGLU) { const uint2 b = *(const uint2*)(Bt + (size_t)(nb0 + 128 + lr) * g.ldb + k0 + lk); Bs2[lk][lr] = bf2f(b.x & 0xffff); Bs2[lk + 1][lr] = bf2f(b.x >> 16); Bs2[lk + 2][lr] = bf2f(b.y & 0xffff); Bs2[lk + 3][lr] = bf2f(b.y >> 16); }
        __syncthreads();
#pragma unroll
        for (int kk = 0; kk < 16; ++kk) {
            const float4 a = *(const float4*)&As[kk][ty * 4], b = *(const float4*)&Bs[kk][tx * 4];
            const float av[4] = {a.x, a.y, a.z, a.w}, bv[4] = {b.x, b.y, b.z, b.w};
#pragma unroll
            for (int i = 0; i < 4; ++i)
#pragma unroll
                for (int j = 0; j < 4; ++j) acc[i][j] += av[i] * bv[j];
            if (EPI == E_SWIGLU) { const float4 b2 = *(const float4*)&Bs2[kk][tx * 4]; const float b2v[4] = {b2.x, b2.y, b2.z, b2.w};
#pragma unroll
                for (int i = 0; i < 4; ++i)
#pragma unroll
                    for (int j = 0; j < 4; ++j) acc2[i][j] += av[i] * b2v[j]; }
        }
        __syncthreads();
    }
#pragma unroll
    for (int i = 0; i < 4; ++i) { const int m = m0 + ty * 4 + i; const int n = nt0 + tx * 4;
        if (EPI == E_RESID) { float4* c = (float4*)((float*)g.C + (size_t)z * g.sC + (size_t)m * g.ldc + n); float4 o = *c; o.x += acc[i][0]; o.y += acc[i][1]; o.z += acc[i][2]; o.w += acc[i][3]; *c = o; }
        else { float v[4];
            if (EPI == E_BF16) { float rs = 1.f; if (g.ss) { const float4 p = *(const float4*)(g.ss + (size_t)m * 4); rs = rsqrtf((p.x + p.y + p.z + p.w) * g.ssinv + EPS); }
#pragma unroll
                for (int j = 0; j < 4; ++j) v[j] = acc[i][j] * rs; }
            if (EPI == E_SWIGLU) {
#pragma unroll
                for (int j = 0; j < 4; ++j) { const float gt = acc[i][j]; v[j] = gt / (1.f + __expf(-gt)) * acc2[i][j]; } }
            if (EPI == E_GATE) { const float gt = g.gate[(size_t)z * g.sG + m];
#pragma unroll
                for (int j = 0; j < 4; ++j) v[j] = acc[i][j] * gt; }
            *(uint2*)((bf16*)g.C + (size_t)z * g.sC + (size_t)m * g.ldc + n) = make_uint2(f2bf(v[0]) | (f2bf(v[1]) << 16), f2bf(v[2]) | (f2bf(v[3]) << 16)); }
    }
}

__global__ void rope_naive(bf16* buf, int pitch, int col0, int hstride, int nheads, int hd, const float* ct, const float* st) {
    const int ng = hd / 8; const long i = (long)blockIdx.x * blockDim.x + threadIdx.x; const long tot = (long)NT * nheads * ng;
    if (i >= tot) return;
    const int g = (int)(i % ng), h = (int)((i / ng) % nheads); const int row = (int)(i / ((long)ng * nheads)); const int pos = row % NS;
    bf16* p = buf + (size_t)row * pitch + col0 + h * hstride + 8 * g;
    uint4 w = *(uint4*)p; unsigned u[4] = {w.x, w.y, w.z, w.w}; float x[8];
#pragma unroll
    for (int e = 0; e < 4; ++e) { x[2 * e] = bf2f(u[e] & 0xffff); x[2 * e + 1] = bf2f(u[e] >> 16); }
    float o[8];
#pragma unroll
    for (int e = 0; e < 4; ++e) { const float c = ct[pos * (hd / 2) + 4 * g + e], s = st[pos * (hd / 2) + 4 * g + e]; o[e] = x[e] * c - x[4 + e] * s; o[4 + e] = x[4 + e] * c + x[e] * s; }
    w.x = f2bf(o[0]) | (f2bf(o[1]) << 16); w.y = f2bf(o[2]) | (f2bf(o[3]) << 16); w.z = f2bf(o[4]) | (f2bf(o[5]) << 16); w.w = f2bf(o[6]) | (f2bf(o[7]) << 16);
    *(uint4*)p = w;
}
__global__ void sumsq_naive(const bf16* proj, float* cqss, float* ckvss) {
    const int row = blockIdx.x * blockDim.x + threadIdx.x; if (row >= NT) return;
    float s = 0.f; for (int c = 0; c < 256; ++c) { const float v = bf2f(proj[(size_t)row * NP + C_CQ + c]); s += v * v; }
    float s2 = 0.f; for (int c = 0; c < 128; ++c) { const float v = bf2f(proj[(size_t)row * NP + C_CKV + c]); s2 += v * v; }
    cqss[row * 4] = s; cqss[row * 4 + 1] = 0.f; cqss[row * 4 + 2] = 0.f; cqss[row * 4 + 3] = 0.f;
    ckvss[row * 4] = s2; ckvss[row * 4 + 1] = 0.f; ckvss[row * 4 + 2] = 0.f; ckvss[row * 4 + 3] = 0.f;
}

__global__ void __launch_bounds__(256) na_naive(const bf16* __restrict__ proj, const float* __restrict__ rpb, bf16* __restrict__ O, float* __restrict__ SS) {
    const int gid = blockIdx.x * 256 + threadIdx.x; const int h = gid / NT, tok = gid % NT; const int b = tok / NS, s = tok % NS, r = s >> 6, c = s & 63;
    const int rs = min(max(r - 4, 0), 56), cs = min(max(c - 8, 0), 48);
    float q[64], o[64];
    { const bf16* qp = proj + (size_t)tok * NP + C_AQ + h * 64;
#pragma unroll
      for (int d = 0; d < 64; ++d) { q[d] = bf2f(qp[d]); o[d] = 0.f; } }
    float m = -1e30f, l = 0.f;
    for (int i = 0; i < 8; ++i) for (int j = 0; j < 16; ++j) {
        const int kr = rs + i, kc = cs + j; const size_t kt = (size_t)b * NS + kr * 64 + kc;
        const bf16* kp = proj + kt * NP + C_AK + h * 64; const bf16* vp = proj + kt * NP + C_AV + h * 64;
        float sc = 0.f;
#pragma unroll
        for (int d = 0; d < 64; ++d) sc += q[d] * bf2f(kp[d]);
        sc += rpb[(h * 15 + (kr - r + 7)) * 31 + (kc - c + 15)] * LOG2E;
        const float mn = fmaxf(m, sc), f = exp2f(m - mn), p = exp2f(sc - mn); l = l * f + p; m = mn;
#pragma unroll
        for (int d = 0; d < 64; ++d) o[d] = o[d] * f + p * bf2f(vp[d]);
    }
    const float il = 1.f / l; float ss = 0.f; bf16* op = O + (size_t)tok * DM + h * 64;
#pragma unroll
    for (int d = 0; d < 64; ++d) { const float v = o[d] * il; ss += v * v; op[d] = (bf16)f2bf(v); }
    SS[(size_t)tok * 16 + h] = ss;
}
__global__ void __launch_bounds__(256) mla_naive(const bf16* __restrict__ QB, const bf16* __restrict__ KV, const bf16* __restrict__ proj, bf16* __restrict__ O, float* __restrict__ SS) {
    __shared__ float Ks[16][96], Vs[16][64];
    const int b = blockIdx.z, h = blockIdx.y, q0 = blockIdx.x * 256, tid = threadIdx.x; const size_t tok = (size_t)b * NS + q0 + tid;
    float q[96], o[64];
    { const bf16* qp = QB + tok * 576 + h * 96;
#pragma unroll
      for (int d = 0; d < 96; ++d) q[d] = bf2f(qp[d]);
#pragma unroll
      for (int d = 0; d < 64; ++d) o[d] = 0.f; }
    float m = -1e30f, l = 0.f;
    for (int k0 = 0; k0 < NS; k0 += 16) {
        __syncthreads();
        for (int i = tid; i < 16 * 160; i += 256) { const int kk = i / 160, d = i % 160; const size_t kt = (size_t)b * NS + k0 + kk;
            if (d < 64) Ks[kk][d] = bf2f(KV[kt * 768 + h * 64 + d]); else if (d < 96) Ks[kk][d] = bf2f(proj[kt * NP + C_KR + d - 64]); else Vs[kk][d - 96] = bf2f(KV[kt * 768 + 384 + h * 64 + d - 96]); }
        __syncthreads();
        float sc[16]; float tm = -1e30f;
#pragma unroll
        for (int kk = 0; kk < 16; ++kk) { float a = 0.f;
#pragma unroll
            for (int d = 0; d < 96; ++d) a += q[d] * Ks[kk][d];
            sc[kk] = a; tm = fmaxf(tm, a); }
        const float mn = fmaxf(m, tm), f = exp2f(m - mn); m = mn; l *= f;
#pragma unroll
        for (int d = 0; d < 64; ++d) o[d] *= f;
#pragma unroll
        for (int kk = 0; kk < 16; ++kk) { const float p = exp2f(sc[kk] - mn); l += p;
#pragma unroll
            for (int d = 0; d < 64; ++d) o[d] += p * Vs[kk][d]; }
    }
    const float il = 1.f / l; float ss = 0.f; bf16* op = O + tok * DM + 256 + h * 64;
#pragma unroll
    for (int d = 0; d < 64; ++d) { const float v = o[d] * il; ss += v * v; op[d] = (bf16)f2bf(v); }
    SS[tok * 16 + 4 + h] = ss;
}
__global__ void __launch_bounds__(256) swa_naive(const bf16* __restrict__ proj, const float* __restrict__ sink, bf16* __restrict__ O, float* __restrict__ SS) {
    __shared__ float Ks[16][64], Vs[16][64];
    const int b = blockIdx.z, hq = blockIdx.y, kvh = hq / 3, q0 = blockIdx.x * 256, tid = threadIdx.x; const int qpos = q0 + tid; const size_t tok = (size_t)b * NS + qpos;
    float q[64], o[64];
    { const bf16* qp = proj + tok * NP + C_SQ + hq * 64;
#pragma unroll
      for (int d = 0; d < 64; ++d) { q[d] = bf2f(qp[d]); o[d] = 0.f; } }
    float m = sink[hq] * LOG2E, l = 1.f;
    const int kbeg = max(q0 - 128, 0), kend = min(q0 + 256 + 128, NS);
    for (int k0 = kbeg; k0 < kend; k0 += 16) {
        __syncthreads();
        for (int i = tid; i < 16 * 128; i += 256) { const int kk = i >> 7, d = i & 127; const size_t kt = (size_t)b * NS + k0 + kk;
            if (d < 64) Ks[kk][d] = bf2f(proj[kt * NP + C_SK + kvh * 64 + d]); else Vs[kk][d - 64] = bf2f(proj[kt * NP + C_SV + kvh * 64 + d - 64]); }
        __syncthreads();
        float sc[16]; float tm = -1e30f;
#pragma unroll
        for (int kk = 0; kk < 16; ++kk) { float a = 0.f;
#pragma unroll
            for (int d = 0; d < 64; ++d) a += q[d] * Ks[kk][d];
            const int dist = qpos - (k0 + kk); const bool ok = dist <= 128 && dist >= -128;
            sc[kk] = ok ? a : -1e30f; tm = fmaxf(tm, sc[kk]); }
        const float mn = fmaxf(m, tm), f = exp2f(m - mn); m = mn; l *= f;
#pragma unroll
        for (int d = 0; d < 64; ++d) o[d] *= f;
#pragma unroll
        for (int kk = 0; kk < 16; ++kk) { const float p = sc[kk] > -1e29f ? exp2f(sc[kk] - mn) : 0.f; l += p;
#pragma unroll
            for (int d = 0; d < 64; ++d) o[d] += p * Vs[kk][d]; }
    }
    const float il = 1.f / l; float ss = 0.f; bf16* op = O + tok * DM + 640 + hq * 64;
#pragma unroll
    for (int d = 0; d < 64; ++d) { const float v = o[d] * il; ss += v * v; op[d] = (bf16)f2bf(v); }
    SS[tok * 16 + 10 + hq] = ss;
}
__global__ void __launch_bounds__(256) gnorm_rows(bf16* O, const float* __restrict__ SS) {
    const int row = blockIdx.x * 4 + (threadIdx.x >> 6), lane = threadIdx.x & 63;
    const float* ss = SS + (size_t)row * 16;
    const float ra = rsqrtf((ss[0] + ss[1] + ss[2] + ss[3]) * (1.f / 256.f) + EPS);
    const float rb = rsqrtf((ss[4] + ss[5] + ss[6] + ss[7] + ss[8] + ss[9]) * (1.f / 384.f) + EPS);
    const float rc = rsqrtf((ss[10] + ss[11] + ss[12] + ss[13] + ss[14] + ss[15]) * (1.f / 384.f) + EPS);
    uint2* o = (uint2*)(O + (size_t)row * DM) + lane;
#pragma unroll
    for (int j = 0; j < 4; ++j) { const int col = 4 * lane + 256 * j; const float r = col < 256 ? ra : (col < 640 ? rb : rc); uint2 w = o[64 * j];
        w.x = f2bf(bf2f(w.x & 0xffff) * r) | (f2bf(bf2f(w.x >> 16) * r) << 16); w.y = f2bf(bf2f(w.y & 0xffff) * r) | (f2bf(bf2f(w.y >> 16) * r) << 16); o[64 * j] = w; }
}

__global__ void __launch_bounds__(256) router_rows(const float* __restrict__ h, const float* __restrict__ g, const float* __restrict__ wr, bf16* __restrict__ xn, float* __restrict__ aff) {
    const int row = blockIdx.x * 4 + (threadIdx.x >> 6), lane = threadIdx.x & 63;
    const float4* hr = (const float4*)(h + (size_t)row * DM) + lane; float4 v[4]; float s = 0.f;
#pragma unroll
    for (int j = 0; j < 4; ++j) { v[j] = hr[64 * j]; s += v[j].x * v[j].x + v[j].y * v[j].y + v[j].z * v[j].z + v[j].w * v[j].w; }
    const float rstd = rsqrtf(wave_sum(s) * (1.f / DM) + EPS);
    uint2* o = (uint2*)(xn + (size_t)row * DM) + lane; float lg[16];
#pragma unroll
    for (int e = 0; e < 16; ++e) lg[e] = 0.f;
#pragma unroll
    for (int j = 0; j < 4; ++j) { const float4 gg = ((const float4*)g)[lane + 64 * j];
        const float x[4] = {v[j].x * rstd * gg.x, v[j].y * rstd * gg.y, v[j].z * rstd * gg.z, v[j].w * rstd * gg.w};
        o[64 * j] = make_uint2(f2bf(x[0]) | (f2bf(x[1]) << 16), f2bf(x[2]) | (f2bf(x[3]) << 16));
#pragma unroll
        for (int c = 0; c < 4; ++c) { const float4* w = (const float4*)(wr + (size_t)(4 * lane + 256 * j + c) * 16);
#pragma unroll
            for (int e4 = 0; e4 < 4; ++e4) { const float4 ww = w[e4]; lg[4 * e4] += x[c] * ww.x; lg[4 * e4 + 1] += x[c] * ww.y; lg[4 * e4 + 2] += x[c] * ww.z; lg[4 * e4 + 3] += x[c] * ww.w; } } }
    float mx = -1e30f;
#pragma unroll
    for (int e = 0; e < 16; ++e) { lg[e] = wave_sum(lg[e]); mx = fmaxf(mx, lg[e]); }
    float den = 0.f;
#pragma unroll
    for (int e = 0; e < 16; ++e) { lg[e] = __expf(lg[e] - mx); den += lg[e]; }
    const int b = row / NS, sidx = row % NS;
    if (lane < 16) { float val = 0.f;
#pragma unroll
        for (int e = 0; e < 16; ++e) if (lane == e) val = lg[e];
        aff[((size_t)b * NE + lane) * NS + sidx] = val / den; }
}
__global__ void __launch_bounds__(1024) topk_rank(const float* __restrict__ aff, int* __restrict__ inv, int* __restrict__ idx, float* __restrict__ gatef) {
    __shared__ float a[NS];
    const int be = blockIdx.x, b = be / NE, e = be % NE, tid = threadIdx.x;
    const float* src = aff + (size_t)be * NS;
    for (int i = tid; i < NS; i += 1024) a[i] = src[i];
    __syncthreads();
    float mine[4]; int rank[4] = {0, 0, 0, 0};
#pragma unroll
    for (int u = 0; u < 4; ++u) mine[u] = a[tid + 1024 * u];
    for (int j = 0; j < NS; ++j) { const float x = a[j];
#pragma unroll
        for (int u = 0; u < 4; ++u) { const int i = tid + 1024 * u; rank[u] += (x > mine[u] || (x == mine[u] && j < i)) ? 1 : 0; } }
#pragma unroll
    for (int u = 0; u < 4; ++u) { const int i = tid + 1024 * u;
        if (rank[u] < CAP) { inv[(size_t)be * NS + i] = rank[u]; idx[be * CAP + rank[u]] = i; gatef[(size_t)e * (NB * CAP) + b * CAP + rank[u]] = mine[u]; }
        else inv[(size_t)be * NS + i] = -1; }
}
__global__ void __launch_bounds__(256) gather_rows(const bf16* __restrict__ xn, const int* __restrict__ idx, bf16* __restrict__ xs) {
    const int r = blockIdx.x * 4 + (threadIdx.x >> 6), lane = threadIdx.x & 63;
    const int e = r >> 12, b = (r >> 9) & 7, slot = r & 511; const int tokn = idx[(b * NE + e) * CAP + slot];
    const uint4* s = (const uint4*)(xn + ((size_t)b * NS + tokn) * DM) + lane; uint4* d = (uint4*)(xs + (size_t)r * DM) + lane;
    d[0] = s[0]; d[64] = s[64];
}
__global__ void __launch_bounds__(256) combine_rows(float* h, const bf16* __restrict__ Y, const int* __restrict__ inv, const float* __restrict__ g, bf16* __restrict__ xn, int final_mode) {
    const int row = blockIdx.x * 4 + (threadIdx.x >> 6), lane = threadIdx.x & 63; const int b = row / NS, s = row % NS;
    float4* hr = (float4*)(h + (size_t)row * DM) + lane; float4 v[4];
#pragma unroll
    for (int j = 0; j < 4; ++j) v[j] = hr[64 * j];
    for (int e = 0; e < NE; ++e) { const int slot = inv[((size_t)b * NE + e) * NS + s];
        if (slot >= 0) { const uint2* y = (const uint2*)(Y + ((size_t)e * (NB * CAP) + b * CAP + slot) * DM) + lane;
#pragma unroll
            for (int j = 0; j < 4; ++j) { const uint2 w = y[64 * j]; v[j].x += bf2f(w.x & 0xffff); v[j].y += bf2f(w.x >> 16); v[j].z += bf2f(w.y & 0xffff); v[j].w += bf2f(w.y >> 16); } } }
    float ssum = 0.f;
#pragma unroll
    for (int j = 0; j < 4; ++j) ssum += v[j].x * v[j].x + v[j].y * v[j].y + v[j].z * v[j].z + v[j].w * v[j].w;
    const float rstd = rsqrtf(wave_sum(ssum) * (1.f / DM) + EPS);
    if (final_mode) {
#pragma unroll
        for (int j = 0; j < 4; ++j) { const float4 gg = ((const float4*)g)[lane + 64 * j]; hr[64 * j] = make_float4(v[j].x * rstd * gg.x, v[j].y * rstd * gg.y, v[j].z * rstd * gg.z, v[j].w * rstd * gg.w); }
    } else {
        uint2* o = (uint2*)(xn + (size_t)row * DM) + lane;
#pragma unroll
        for (int j = 0; j < 4; ++j) { const float4 gg = ((const float4*)g)[lane + 64 * j]; hr[64 * j] = v[j];
            o[64 * j] = make_uint2(f2bf(v[j].x * rstd * gg.x) | (f2bf(v[j].y * rstd * gg.y) << 16), f2bf(v[j].z * rstd * gg.z) | (f2bf(v[j].w * rstd * gg.w) << 16)); }
    }
}


#define LAS __attribute__((address_space(3)))
#define GAS __attribute__((address_space(1)))
namespace pg8 {
typedef short bf16x8 __attribute__((ext_vector_type(8)));
typedef float f32x4 __attribute__((ext_vector_type(4)));
typedef unsigned u32x4 __attribute__((ext_vector_type(4)));
constexpr int BM = 256, BK = 64, HALF = 128, HTB = HALF * BK * 2, STAGE_BYTES = 8 * HTB, NXCD = 8, WGM = 8;
__host__ __device__ __forceinline__ int lds_byte(int r, int c) { const int st = (r >> 4) * 2 + (c >> 5), rr = r & 15, cc = c & 31, ob = rr * 64 + cc * 2; return st * 1024 + (ob ^ (((ob >> 9) & 1) << 5)); }
__host__ __device__ __forceinline__ void stage_rc(int b, int& R, int& C) { const int st = b / 1024, sb = b % 1024, swz = sb ^ (((sb >> 9) & 1) << 5); R = (st >> 1) * 16 + swz / 64; C = (st & 1) * 32 + (swz % 64) / 2; }
__host__ __device__ __forceinline__ int perm32(int rho) { const int n = rho >> 4, i = rho & 15; return 8 * (i >> 2) + 4 * n + (i & 3); }
struct Unit { int pm, pn, pb; };
struct Gemm { const bf16* A; const bf16* Bt; int K, lda, ldb; };
struct StaticOrder {
    int nM, nN, nwg, G, c, gm;
    __device__ void init(int nM_, int nN_, int G_, int c_, int gm_) { nM = nM_; nN = nN_; nwg = nM * nN; G = G_; c = c_; gm = gm_; }
    __device__ bool next(int i, Unit& u) const {
        const long L = (long)i * G + c; if (L >= nwg) return false;
        int wgid = (int)L; { const int q = nwg / NXCD, r = nwg % NXCD, xcd = wgid % NXCD, off = wgid / NXCD; wgid = (xcd < r ? xcd * (q + 1) : r * (q + 1) + (xcd - r) * q) + off; }
        const int nig = WGM * nN, gid = wgid / nig, fm = gid * WGM, gsz = (nM - fm) < WGM ? (nM - fm) : WGM;
        u.pm = fm + ((wgid % nig) % gsz); u.pn = (wgid % nig) / gsz; u.pb = gm ? (u.pm / gm) * nN + u.pn : u.pn; return true;
    }
};
__device__ __forceinline__ unsigned cvt_pk_bf16(float lo, float hi) { unsigned r; asm volatile("v_cvt_pk_bf16_f32 %0, %1, %2" : "=v"(r) : "v"(lo), "v"(hi)); return r; }

template <class Epi, class Sched, bool ALIGN_EPI>
__device__ __forceinline__ void gemm_phase(LAS unsigned char* lds, const Gemm g, const Sched& S, const Epi& E) {
    int tid = threadIdx.x; asm volatile("" : "+v"(tid));
    const int wid = __builtin_amdgcn_readfirstlane(tid >> 6), lane = tid & 63, wr = wid >> 2, wc = wid & 3, fr = lane & 15, fq = lane >> 4;
    const int K = g.K, nt = K / BK;
    unsigned voffA[2], voffB[2];
#pragma unroll
    for (int i = 0; i < 2; ++i) { int R, C; stage_rc(tid * 16 + i * 8192, R, C); const int Rb = Epi::PERM ? ((R & ~31) + perm32(R & 31)) : R;
        voffA[i] = (unsigned)(R * g.lda + C) * 2u; voffB[i] = (unsigned)(Rb * g.ldb + C) * 2u; }
    const size_t kstep = (size_t)(BK * 2);
    const size_t hstepA = (size_t)HALF * g.lda * 2, hstepB = (size_t)HALF * g.ldb * 2, tstepA = 2 * hstepA, tstepB = 2 * hstepB;
    const unsigned ldsw = (unsigned)wid * 1024u;
    const int aoff = lds_byte(wr * 64 + fr, fq * 8), boff = lds_byte(wc * 32 + fr, fq * 8);
#define PG8_SA(b, h) (((b) * 2 + (h)) * HTB)
#define PG8_SB(b, h) ((4 + (b) * 2 + (h)) * HTB)
#define PG8_STAGE(bufoff, gbase, voff) do { _Pragma("unroll") for (int _i = 0; _i < 2; ++_i) \
        __builtin_amdgcn_global_load_lds((const unsigned*)((const char*)(gbase) + (voff)[_i]), (LAS unsigned*)(lds + (bufoff) + ldsw + _i * 8192), 16, 0, 0); } while (0)
#define PG8_LDA(dst, b, h) do { _Pragma("unroll") for (int m = 0; m < 4; ++m) _Pragma("unroll") for (int k = 0; k < 2; ++k) dst[m][k] = *(const LAS bf16x8*)(lds + PG8_SA(b, h) + aoff + m * 2048 + k * 1024); } while (0)
#define PG8_LDB(dst, b, h) do { _Pragma("unroll") for (int n = 0; n < 2; ++n) _Pragma("unroll") for (int k = 0; k < 2; ++k) dst[n][k] = *(const LAS bf16x8*)(lds + PG8_SB(b, h) + boff + n * 2048 + k * 1024); } while (0)
#define PG8_MMA(ai, bj, At, Bt) do { __builtin_amdgcn_s_setprio(1); _Pragma("unroll") for (int m = 0; m < 4; ++m) _Pragma("unroll") for (int n = 0; n < 2; ++n) _Pragma("unroll") for (int k = 0; k < 2; ++k) \
        acc[ai][bj][m][n] = __builtin_amdgcn_mfma_f32_16x16x32_bf16(Bt[n][k], At[m][k], acc[ai][bj][m][n], 0, 0, 0); __builtin_amdgcn_s_setprio(0); } while (0)
#define PG8_WAIT_V(n) asm volatile("s_waitcnt vmcnt(" #n ")" ::: "memory")
#define PG8_WAIT_L(n) asm volatile("s_waitcnt lgkmcnt(" #n ")" ::: "memory")
#define PG8_BAR __builtin_amdgcn_s_barrier()
#define PG8_SCHED __builtin_amdgcn_sched_barrier(0)
    Unit cur, nxt; int ui = 0;
    if (!S.next(0, cur)) return;
    f32x4 acc[2][2][4][2];
#pragma unroll
    for (int a = 0; a < 2; ++a)
#pragma unroll
        for (int b = 0; b < 2; ++b)
#pragma unroll
            for (int m = 0; m < 4; ++m)
#pragma unroll
                for (int n = 0; n < 2; ++n) acc[a][b][m][n] = (f32x4){0.f, 0.f, 0.f, 0.f};
    bf16x8 At[4][2], B0[2][2], B1[2][2];
    const char* cA = (const char*)g.A + (size_t)cur.pm * tstepA; const char* cB = (const char*)g.Bt + (size_t)cur.pb * tstepB;
    PG8_STAGE(PG8_SB(0, 0), cB, voffB); PG8_STAGE(PG8_SB(0, 1), cB + hstepB, voffB); PG8_STAGE(PG8_SA(0, 0), cA, voffA); PG8_STAGE(PG8_SA(0, 1), cA + hstepA, voffA);
    if (wr == 1) PG8_BAR;
    PG8_WAIT_V(2); PG8_BAR;
    PG8_STAGE(PG8_SB(1, 0), cB + kstep, voffB); PG8_STAGE(PG8_SA(1, 0), cA + kstep, voffA); PG8_STAGE(PG8_SB(1, 1), cB + hstepB + kstep, voffB);
    PG8_WAIT_V(6); PG8_BAR;
    for (;;) {
        const bool has_next = S.next(ui + 1, nxt);
        const char* nA = has_next ? (const char*)g.A + (size_t)nxt.pm * tstepA : cA; const char* nB = has_next ? (const char*)g.Bt + (size_t)nxt.pb * tstepB : cB;
        for (int t = 0; t < nt; t += 2) {
            const bool last = (t == nt - 2);
            const char* a1 = cA + (size_t)(t + 1) * kstep;
            const char* a2 = last ? nA : cA + (size_t)(t + 2) * kstep; const char* b2 = last ? nB : cB + (size_t)(t + 2) * kstep;
            const char* a3 = a2 + kstep; const char* b3 = b2 + kstep;
            PG8_LDB(B0, 0, 0); PG8_LDB(B1, 0, 1); PG8_SCHED; PG8_LDA(At, 0, 0); PG8_STAGE(PG8_SA(1, 1), a1 + hstepA, voffA);
            PG8_WAIT_V(8); PG8_WAIT_L(0); PG8_BAR; PG8_MMA(0, 0, At, B0); PG8_MMA(0, 1, At, B1); PG8_BAR; PG8_SCHED;
            PG8_LDA(At, 0, 1); PG8_STAGE(PG8_SB(0, 0), b2, voffB); PG8_STAGE(PG8_SB(0, 1), b2 + hstepB, voffB); PG8_STAGE(PG8_SA(0, 0), a2, voffA);
            PG8_WAIT_V(8); PG8_WAIT_L(0); PG8_BAR; PG8_MMA(1, 0, At, B0); PG8_MMA(1, 1, At, B1); PG8_BAR; PG8_SCHED;
            PG8_LDB(B0, 1, 0); PG8_LDB(B1, 1, 1); PG8_SCHED; PG8_LDA(At, 1, 0); PG8_STAGE(PG8_SA(0, 1), a2 + hstepA, voffA);
            PG8_WAIT_V(8); PG8_WAIT_L(0); PG8_BAR; PG8_MMA(0, 0, At, B0); PG8_MMA(0, 1, At, B1); PG8_BAR; PG8_SCHED;
            PG8_LDA(At, 1, 1); PG8_STAGE(PG8_SB(1, 0), b3, voffB); PG8_STAGE(PG8_SB(1, 1), b3 + hstepB, voffB); PG8_STAGE(PG8_SA(1, 0), a3, voffA);
            PG8_WAIT_V(8); PG8_WAIT_L(0); PG8_BAR; PG8_MMA(1, 0, At, B0); PG8_MMA(1, 1, At, B1); PG8_BAR; PG8_SCHED;
        }
        if constexpr (ALIGN_EPI) { if (wr == 0) PG8_BAR; }
        { int t2 = threadIdx.x; asm volatile("" : "+v"(t2)); E(acc, cur, wr, wc, t2 & 15, (t2 >> 4) & 3); }
        if (!has_next) break;
#pragma unroll
        for (int a = 0; a < 2; ++a)
#pragma unroll
            for (int b = 0; b < 2; ++b)
#pragma unroll
                for (int m = 0; m < 4; ++m)
#pragma unroll
                    for (int n = 0; n < 2; ++n) acc[a][b][m][n] = (f32x4){0.f, 0.f, 0.f, 0.f};
        cur = nxt; cA = nA; cB = nB; ++ui;
        if constexpr (ALIGN_EPI) { if (wr == 1) PG8_BAR; }
    }
    PG8_WAIT_V(0);
    if constexpr (!ALIGN_EPI) { if (wr == 0) PG8_BAR; }
    PG8_BAR;
#undef PG8_SA
#undef PG8_SB
#undef PG8_STAGE
#undef PG8_LDA
#undef PG8_LDB
#undef PG8_MMA
#undef PG8_WAIT_V
#undef PG8_WAIT_L
#undef PG8_BAR
#undef PG8_SCHED
}

typedef const f32x4 (&AccRef)[2][2][4][2];
__device__ __forceinline__ void st_bf16x8(bf16* p, f32x4 v0, f32x4 v1) { u32x4 w; w.x = cvt_pk_bf16(v0[0], v0[1]); w.y = cvt_pk_bf16(v0[2], v0[3]); w.z = cvt_pk_bf16(v1[0], v1[1]); w.w = cvt_pk_bf16(v1[2], v1[3]); *(u32x4*)p = w; }
struct EpiProj {
    static constexpr bool PERM = true;
    bf16* P; const float *c64, *s64, *c32, *s32; float *cqss, *ckvss;
    __device__ __forceinline__ void operator()(AccRef acc, const Unit& u, int wr, int wc, int fr, int fq) const {
#pragma unroll
        for (int ai = 0; ai < 2; ++ai)
#pragma unroll
            for (int m = 0; m < 4; ++m) { const int row = u.pm * BM + ai * HALF + wr * 64 + m * 16 + fr; const int pos = row & (NS - 1); float ssq = 0.f;
#pragma unroll
                for (int bj = 0; bj < 2; ++bj) { const int cw = u.pn * BM + bj * HALF + wc * 32, col0 = cw + 8 * fq; f32x4 v0 = acc[ai][bj][m][0], v1 = acc[ai][bj][m][1];
                    if (cw >= C_SQ && cw < C_SV) { const int g = ((col0 - C_SQ) & 63) >> 3; const f32x4 c = *(const f32x4*)(c64 + pos * 32 + 4 * g), s = *(const f32x4*)(s64 + pos * 32 + 4 * g);
                        const f32x4 o0 = v0 * c - v1 * s, o1 = v1 * c + v0 * s; v0 = o0; v1 = o1; }
                    else if (cw == C_KR) { const f32x4 c = *(const f32x4*)(c32 + pos * 16 + 4 * fq), s = *(const f32x4*)(s32 + pos * 16 + 4 * fq);
                        const f32x4 o0 = v0 * c - v1 * s, o1 = v1 * c + v0 * s; v0 = o0; v1 = o1; }
                    if (u.pn == 3 || (u.pn == 4 && bj == 0)) ssq += (v0[0] * v0[0] + v0[1] * v0[1]) + (v0[2] * v0[2] + v0[3] * v0[3]) + (v1[0] * v1[0] + v1[1] * v1[1]) + (v1[2] * v1[2] + v1[3] * v1[3]);
                    st_bf16x8(P + (size_t)row * NP + col0, v0, v1); }
                if (u.pn == 3 || u.pn == 4) { ssq += __shfl_xor(ssq, 16); ssq += __shfl_xor(ssq, 32); if (fq == 0) (u.pn == 3 ? cqss : ckvss)[(size_t)row * 4 + wc] = ssq; }
            }
    }
};
template <bool QMODE, int ldc, int ncols> struct EpiMla {
    static constexpr bool PERM = true;
    bf16* O; const float* ss; float ssinv; const float *c32, *s32;
    __device__ __forceinline__ void operator()(AccRef acc, const Unit& u, int wr, int wc, int fr, int fq) const {
#pragma unroll
        for (int ai = 0; ai < 2; ++ai)
#pragma unroll
            for (int m = 0; m < 4; ++m) { const int row = u.pm * BM + ai * HALF + wr * 64 + m * 16 + fr; const int pos = row & (NS - 1);
                const f32x4 p = *(const f32x4*)(ss + (size_t)row * 4); const float rs = rsqrtf(((p[0] + p[1]) + (p[2] + p[3])) * ssinv + EPS);
#pragma unroll
                for (int bj = 0; bj < 2; ++bj) { const int cw = u.pn * BM + bj * HALF + wc * 32, col0 = cw + 8 * fq; if (cw >= ncols) continue;
                    f32x4 v0 = acc[ai][bj][m][0] * rs, v1 = acc[ai][bj][m][1] * rs;
                    if (QMODE && (cw % 96) == 64) { const f32x4 c = *(const f32x4*)(c32 + pos * 16 + 4 * fq), s = *(const f32x4*)(s32 + pos * 16 + 4 * fq);
                        const f32x4 o0 = v0 * c - v1 * s, o1 = v1 * c + v0 * s; v0 = o0; v1 = o1; }
                    st_bf16x8(O + (size_t)row * ldc + col0, v0, v1); }
                asm volatile("" ::: "memory"); }
    }
};
struct EpiResid {
    static constexpr bool PERM = false;
    const float* Hin; float* Hout;
    __device__ __forceinline__ void operator()(AccRef acc, const Unit& u, int wr, int wc, int fr, int fq) const {
#pragma unroll
        for (int ai = 0; ai < 2; ++ai)
#pragma unroll
            for (int m = 0; m < 4; ++m) { const size_t off = (size_t)(u.pm * BM + ai * HALF + wr * 64 + m * 16 + fr) * DM + u.pn * BM + wc * 32 + 4 * fq;
#pragma unroll
                for (int bj = 0; bj < 2; ++bj)
#pragma unroll
                    for (int n = 0; n < 2; ++n) { const f32x4 b = *(const f32x4*)(Hin + off + bj * HALF + n * 16); *(f32x4*)(Hout + off + bj * HALF + n * 16) = b + acc[ai][bj][m][n]; } }
    }
};
struct EpiSwiglu {
    static constexpr bool PERM = true;
    bf16* Hd;
    __device__ __forceinline__ void operator()(AccRef acc, const Unit& u, int wr, int wc, int fr, int fq) const {
#pragma unroll
        for (int ai = 0; ai < 2; ++ai)
#pragma unroll
            for (int m = 0; m < 4; ++m) { const size_t row = (size_t)(u.pm * BM + ai * HALF + wr * 64 + m * 16 + fr); f32x4 o[2];
#pragma unroll
                for (int n = 0; n < 2; ++n) { const f32x4 gt = acc[ai][0][m][n], up = acc[ai][1][m][n];
#pragma unroll
                    for (int e = 0; e < 4; ++e) o[n][e] = gt[e] * __builtin_amdgcn_rcpf(1.f + __builtin_amdgcn_exp2f(-gt[e] * LOG2E)) * up[e]; }
                st_bf16x8(Hd + row * DM + u.pn * HALF + wc * 32 + 8 * fq, o[0], o[1]); }
    }
};
struct EpiGate {
    static constexpr bool PERM = true;
    bf16* Y; const float* gate;
    __device__ __forceinline__ void operator()(AccRef acc, const Unit& u, int wr, int wc, int fr, int fq) const {
#pragma unroll
        for (int ai = 0; ai < 2; ++ai)
#pragma unroll
            for (int m = 0; m < 4; ++m) { const size_t row = (size_t)(u.pm * BM + ai * HALF + wr * 64 + m * 16 + fr); const float gt = gate[row];
#pragma unroll
                for (int bj = 0; bj < 2; ++bj) st_bf16x8(Y + row * DM + u.pn * BM + bj * HALF + wc * 32 + 8 * fq, acc[ai][bj][m][0] * gt, acc[ai][bj][m][1] * gt); }
    }
};
}


namespace att {
typedef short bf16x8 __attribute__((ext_vector_type(8)));
typedef short s16x4 __attribute__((ext_vector_type(4)));
typedef float f32x16 __attribute__((ext_vector_type(16)));
typedef float f32x4 __attribute__((ext_vector_type(4)));
typedef unsigned u32x4 __attribute__((ext_vector_type(4)));
typedef float f32x2_t __attribute__((ext_vector_type(2))); typedef __bf16 bf16x2_t __attribute__((ext_vector_type(2)));
typedef short v4i16_t __attribute__((ext_vector_type(4)));
constexpr int KSLOT = 12288, VSLOT = 8192;
constexpr int L_K = 0, L_V = 2 * KSLOT, L_WS = L_V + 2 * VSLOT, L_OST = L_WS + 8 * 256, L_BIAS = L_OST + 8 * 4096, L_END = L_BIAS + 2048;
constexpr float THR = 8.f;
__device__ __forceinline__ int crow(int r, int hi) { return (r & 3) + 8 * (r >> 2) + 4 * hi; }
__device__ __forceinline__ unsigned cvtpk(float lo, float hi) { f32x2_t v = {lo, hi}; bf16x2_t b = __builtin_convertvector(v, bf16x2_t); return __builtin_bit_cast(unsigned, b); }
__device__ __forceinline__ s16x4 vtr(const LAS unsigned char* p) { return __builtin_bit_cast(s16x4, __builtin_amdgcn_ds_read_tr16_b64_v4i16((LAS v4i16_t*)p)); }
__device__ __forceinline__ void glds(const bf16* src, LAS unsigned char* dst) { __builtin_amdgcn_global_load_lds((const unsigned*)src, (LAS unsigned*)dst, 16, 0, 0); }
struct AttnP { const bf16 *PROJ, *QB, *KV; bf16* O; float* SS; const float* rpb; const float* sink; };

template <int TYPE> __device__ __forceinline__ void attn_unit(const AttnP& P, int b, int h, int qb, LAS unsigned char* lds) {
    constexpr int ND0 = (TYPE == 1) ? 6 : 4;
    int tid = threadIdx.x; asm volatile("" : "+v"(tid));
    const int lane = tid & 63, r32 = lane & 31, hi = lane >> 5, wid = __builtin_amdgcn_readfirstlane(tid >> 6);
    const int q0 = qb * 256, qw0 = q0 + wid * 32; const size_t tokb = (size_t)b * NS;
    int ntile, kbase, ta, tb;
    if (TYPE == 1) { ntile = NS / 64; kbase = 0; ta = 0; tb = ntile - 1; }
    else if (TYPE == 2) { kbase = max(q0 - 128, 0); const int ke = min(q0 + 384, NS); ntile = (ke - kbase) >> 6; ta = max(qw0 - 128 - kbase, 0) >> 6; tb = min(ntile - 1, (qw0 + 159 - kbase) >> 6); }
    else { const int r0 = qb * 4; kbase = min(max(r0 - 4, 0), 56); ntile = min(max(r0 - 1, 0), 56) + 7 - kbase + 1; const int r = r0 + (wid >> 1); ta = min(max(r - 4, 0), 56) - kbase; tb = ta + 7; }
    const int kvh = (TYPE == 2) ? h / 3 : h;
    const bf16 *ksrc, *ksrc2 = nullptr, *vsrc; size_t kpitch, vpitch, tstep;
    { const size_t key0 = tokb + (TYPE == 0 ? (size_t)kbase * 64 : (size_t)kbase); const int vrow = 16 * (wid & 3) + (lane >> 2), vcol = (wid >> 2) * 32 + (lane & 3) * 8;
      if (TYPE == 0) { ksrc = P.PROJ + (key0 + lane) * NP + C_AK + h * 64 + wid * 8; vsrc = P.PROJ + (key0 + vrow) * NP + C_AV + h * 64 + vcol; kpitch = vpitch = NP; }
      else if (TYPE == 1) { ksrc = P.KV + (key0 + lane) * 768 + h * 64 + wid * 8; ksrc2 = P.PROJ + (key0 + lane) * NP + C_KR + (wid & 3) * 8; vsrc = P.KV + (key0 + vrow) * 768 + 384 + h * 64 + vcol; kpitch = vpitch = 768; }
      else { ksrc = P.PROJ + (key0 + lane) * NP + C_SK + kvh * 64 + wid * 8; vsrc = P.PROJ + (key0 + vrow) * NP + C_SV + kvh * 64 + vcol; kpitch = vpitch = NP; } }
    LAS unsigned char* kdst = lds + L_K + wid * 1024; LAS unsigned char* vdst = lds + L_V + wid * 1024;
#define ATT_DMA(t, slot) do { glds(ksrc + (size_t)(t) * 64 * kpitch, kdst + (slot) * KSLOT); if (TYPE == 1 && wid < 4) glds(ksrc2 + (size_t)(t) * 64 * NP, kdst + (slot) * KSLOT + 8192); \
        glds(vsrc + (size_t)(t) * 64 * vpitch, vdst + (slot) * VSLOT); } while (0)
    LAS float* biasL = (LAS float*)(lds + L_BIAS);
    if (TYPE == 0) { for (int i = tid; i < 15 * 31; i += 512) biasL[i] = P.rpb[h * 465 + i] * LOG2E; }
    bf16x8 qr[ND0];
    { const bf16* qp = (TYPE == 1) ? P.QB + (tokb + qw0 + r32) * 576 + h * 96 : P.PROJ + (tokb + qw0 + r32) * NP + (TYPE == 0 ? C_AQ : C_SQ) + h * 64;
#pragma unroll
      for (int d0 = 0; d0 < ND0; ++d0) qr[d0] = *(const bf16x8*)(qp + d0 * 16 + hi * 8); }
    LAS float* wsf = (LAS float*)(lds + L_WS) + wid * 64;
    float m = (TYPE == 2) ? P.sink[h] * LOG2E : -1e30f, l = (TYPE == 2 && hi == 0) ? 1.f : 0.f;
    f32x16 o[2]; o[0] = f32x16{}; o[1] = f32x16{};
    ATT_DMA(0, 0);
    for (int t = 0; t < ntile; ++t) {
        const int slot = t & 1;
        asm volatile("s_waitcnt vmcnt(0)" ::: "memory"); __syncthreads();
        if (t + 1 < ntile) ATT_DMA(t + 1, slot ^ 1);
        if (t < ta || t > tb) continue;
        const LAS unsigned char* Kp = lds + L_K + slot * KSLOT + hi * 1024 + r32 * 16;
        f32x16 p0 = f32x16{}, p1 = f32x16{};
#pragma unroll
        for (int d0 = 0; d0 < ND0; ++d0) { const bf16x8 k0 = *(const LAS bf16x8*)(Kp + d0 * 2048), k1 = *(const LAS bf16x8*)(Kp + d0 * 2048 + 512);
            p0 = __builtin_amdgcn_mfma_f32_32x32x16_bf16(k0, qr[d0], p0, 0, 0, 0); p1 = __builtin_amdgcn_mfma_f32_32x32x16_bf16(k1, qr[d0], p1, 0, 0, 0); }
        if (TYPE == 2) { const int dq = qw0 + r32 - (kbase + t * 64) - 4 * hi;
#pragma unroll
            for (int r = 0; r < 16; ++r) { const int d0_ = dq - ((r & 3) + 8 * (r >> 2)), d1_ = d0_ - 32;
                if (d0_ > 128 || d0_ < -128) p0[r] = -INFINITY; if (d1_ > 128 || d1_ < -128) p1[r] = -INFINITY; } }
        if (TYPE == 0) { const int c = (wid & 1) * 32 + r32, cs = min(max(c - 8, 0), 48); const int r = qb * 4 + (wid >> 1), kr = kbase + t; const LAS float* brow = biasL + (kr - r + 7) * 31 + 15 - c;
#pragma unroll
            for (int rr = 0; rr < 16; ++rr) { const int kc0 = crow(rr, hi), kc1 = kc0 + 32;
                const bool v0 = kc0 >= cs && kc0 < cs + 16, v1 = kc1 >= cs && kc1 < cs + 16;
                p0[rr] = v0 ? p0[rr] + brow[v0 ? kc0 : c] : -INFINITY; p1[rr] = v1 ? p1[rr] + brow[v1 ? kc1 : c] : -INFINITY; } }
        float rm = fmaxf(p0[0], p1[0]);
#pragma unroll
        for (int r = 1; r < 16; ++r) rm = fmaxf(rm, fmaxf(p0[r], p1[r]));
        { auto rr = __builtin_amdgcn_permlane32_swap(__float_as_uint(rm), __float_as_uint(rm), false, false); rm = fmaxf(__uint_as_float(rr[0]), __uint_as_float(rr[1])); }
        if (__any(rm > m + THR)) { const float mn = fmaxf(m, rm), f = __builtin_amdgcn_exp2f(m - mn); m = mn; l *= f;
            if (hi == 0) wsf[r32] = f;
#pragma unroll
            for (int g = 0; g < 4; ++g) { const f32x4 fv = *(const LAS f32x4*)(wsf + 8 * g + 4 * hi);
#pragma unroll
                for (int e = 0; e < 4; ++e) { o[0][4 * g + e] *= fv[e]; o[1][4 * g + e] *= fv[e]; } } }
        float sacc = 0.f;
#pragma unroll
        for (int r = 0; r < 16; ++r) { p0[r] = __builtin_amdgcn_exp2f(p0[r] - m); p1[r] = __builtin_amdgcn_exp2f(p1[r] - m); sacc += p0[r] + p1[r]; }
        l += sacc;
        u32x4 pw[4];
#pragma unroll
        for (int e = 0; e < 4; ++e) { pw[0][e] = cvtpk(p0[2 * e], p0[2 * e + 1]); pw[1][e] = cvtpk(p0[8 + 2 * e], p0[9 + 2 * e]); pw[2][e] = cvtpk(p1[2 * e], p1[2 * e + 1]); pw[3][e] = cvtpk(p1[8 + 2 * e], p1[9 + 2 * e]); }
        const LAS unsigned char* Vp = lds + L_V + slot * VSLOT + ((lane >> 4) & 1) * 32 + (lane & 3) * 8 + (4 * hi + ((lane & 15) >> 2)) * 64;
#pragma unroll
        for (int d0 = 0; d0 < 2; ++d0)
#pragma unroll
            for (int ks = 0; ks < 4; ++ks) { const s16x4 lo = vtr(Vp + d0 * 4096 + ks * 1024), hh = vtr(Vp + d0 * 4096 + ks * 1024 + 512);
                const bf16x8 vf = (bf16x8){lo[0], lo[1], lo[2], lo[3], hh[0], hh[1], hh[2], hh[3]};
                o[d0] = __builtin_amdgcn_mfma_f32_32x32x16_bf16(__builtin_bit_cast(bf16x8, pw[ks]), vf, o[d0], 0, 0, 0); }
    }
    { auto rr = __builtin_amdgcn_permlane32_swap(__float_as_uint(l), __float_as_uint(l), false, false); l = __uint_as_float(rr[0]) + __uint_as_float(rr[1]); }
    if (hi == 0) wsf[32 + r32] = 1.f / l;
    LAS bf16* stg = (LAS bf16*)(lds + L_OST) + wid * 2048;
#pragma unroll
    for (int g = 0; g < 4; ++g) { const f32x4 iv = *(const LAS f32x4*)(wsf + 32 + 8 * g + 4 * hi);
#pragma unroll
        for (int e = 0; e < 4; ++e) { const int orow = 8 * g + 4 * hi + e; stg[orow * 64 + r32] = (bf16)(cvtpk(o[0][4 * g + e] * iv[e], 0.f) & 0xffff); stg[orow * 64 + 32 + r32] = (bf16)(cvtpk(o[1][4 * g + e] * iv[e], 0.f) & 0xffff); } }
    const int ocol = (TYPE == 0 ? 0 : (TYPE == 1 ? 256 : 640)) + h * 64, sidx = (TYPE == 0 ? 0 : (TYPE == 1 ? 4 : 10)) + h;
#pragma unroll
    for (int i = 0; i < 4; ++i) { const int row = i * 8 + (lane >> 3), ch = lane & 7; const u32x4 v = *(const LAS u32x4*)(stg + row * 64 + ch * 8);
        const size_t tokn = tokb + qw0 + row; *(u32x4*)(P.O + tokn * DM + ocol + ch * 8) = v;
        float sq = 0.f;
#pragma unroll
        for (int e = 0; e < 4; ++e) { const float a = __builtin_bit_cast(float, v[e] << 16), c2 = __builtin_bit_cast(float, v[e] & 0xffff0000u); sq += a * a + c2 * c2; }
        sq += __shfl_xor(sq, 1); sq += __shfl_xor(sq, 2); sq += __shfl_xor(sq, 4);
        if (ch == 0) P.SS[tokn * 16 + sidx] = sq; }
    __syncthreads();
#undef ATT_DMA
}
__device__ __forceinline__ void attn_phase(const AttnP& P, LAS unsigned char* lds, int vcu) {
    const int x = vcu >> 5, cx = vcu & 31;
    for (int i = 0; i < 3; ++i) { const int j = cx * 3 + i, bh = 6 * x + (j >> 4), qb = j & 15; attn_unit<1>(P, bh / 6, bh % 6, qb, lds); }
    for (int i = 0; i < 3; ++i) { const int j = cx * 3 + i, bh = 6 * x + (j >> 4), qb = j & 15; attn_unit<2>(P, bh / 6, bh % 6, qb, lds); }
    for (int i = 0; i < 2; ++i) { const int j = cx * 2 + i, bh = 4 * x + (j >> 4), qb = j & 15; attn_unit<0>(P, bh >> 2, bh & 3, qb, lds); }
}
}

constexpr int NWAVES = 8, LDS_BYTES = 147456, RING_BYTES = 131072;
enum { PH_PROJ = 0, PH_MLAUP, PH_ATTN, PH_OUT, PH_MOE1, PH_MOE2, PH_COUNT };
struct MegaArgs {
    const float* x; float* H; unsigned char* ws;
    const float *rpb, *sink;
    int layer, ph_lo, ph_hi, pad;
};
__global__ void __launch_bounds__(NWAVES * 64, 2) mega(MegaArgs a) {
    extern __shared__ __attribute__((aligned(16))) unsigned char lds_raw[];
    LAS unsigned char* lds = (LAS unsigned char*)lds_raw;
    unsigned char* ws = a.ws;
    const int G = gridDim.x, bx = blockIdx.x;
    float *c64 = (float*)(ws + WS_COS64), *s64 = (float*)(ws + WS_SIN64), *c32 = (float*)(ws + WS_COS32), *s32 = (float*)(ws + WS_SIN32);
    bf16 *WIN = (bf16*)(ws + WS_WIN), *WUQ = (bf16*)(ws + WS_WUQ), *WUKV = (bf16*)(ws + WS_WUKV), *WOUT = (bf16*)(ws + WS_WOUT), *WGU = (bf16*)(ws + WS_WGU), *WD = (bf16*)(ws + WS_WD);
    float *CQSS = (float*)(ws + WS_CQSS), *CKVSS = (float*)(ws + WS_CKVSS), *GATE = (float*)(ws + WS_GATE);
    bf16 *XN = (bf16*)(ws + WS_XN), *PROJ = (bf16*)(ws + WS_PROJ), *QB = (bf16*)(ws + WS_QB), *KV = (bf16*)(ws + WS_KV), *HID = (bf16*)(ws + WS_HID), *XS = PROJ, *Y = PROJ, *O = XN;
    const int lo = a.ph_lo, hi = a.ph_hi;
#define IN(k) (lo <= (k) && (k) < hi)
    if (IN(PH_PROJ)) {
        pg8::Gemm g{XN, WIN, DM, DM, DM}; pg8::StaticOrder S; S.init(NT / 256, NP / 256, G, bx, 0);
        pg8::EpiProj E{PROJ, c64, s64, c32, s32, CQSS, CKVSS};
        pg8::gemm_phase<pg8::EpiProj, pg8::StaticOrder, true>(lds, g, S, E);
    }
    if (IN(PH_MLAUP)) {
        { pg8::Gemm g{PROJ + C_CQ, WUQ, 256, NP, 256}; pg8::StaticOrder S; S.init(NT / 256, 3, G, bx, 0);
          typedef pg8::EpiMla<true, 576, 576> EQ; EQ E{QB, CQSS, 1.f / 256.f, c32, s32};
          pg8::gemm_phase<EQ, pg8::StaticOrder, true>(lds, g, S, E); }
        { pg8::Gemm g{PROJ + C_CKV, WUKV, 128, NP, 128}; pg8::StaticOrder S; S.init(NT / 256, 3, G, bx, 0);
          typedef pg8::EpiMla<false, 768, 768> EK; EK E{KV, CKVSS, 1.f / 128.f, c32, s32};
          pg8::gemm_phase<EK, pg8::StaticOrder, true>(lds, g, S, E); }
    }
    if (IN(PH_ATTN)) {
        if (G == 256) { const att::AttnP P{PROJ, QB, KV, O, (float*)(ws + WS_SS), a.rpb, a.sink}; att::attn_phase(P, lds, (bx % 8) * (G / 8) + bx / 8); }
    }
    if (IN(PH_OUT)) {
        pg8::Gemm g{O, WOUT, DM, DM, DM}; pg8::StaticOrder S; S.init(NT / 256, DM / 256, G, bx, 0);
        pg8::EpiResid E{a.layer == 0 ? a.x : a.H, a.H};
        pg8::gemm_phase<pg8::EpiResid, pg8::StaticOrder, true>(lds, g, S, E);
    }
    if (IN(PH_MOE1)) {
        pg8::Gemm g{XS, WGU, DM, DM, DM}; pg8::StaticOrder S; S.init(NSLOTS / 256, 8, G, bx, 16);
        pg8::EpiSwiglu E{HID};
        pg8::gemm_phase<pg8::EpiSwiglu, pg8::StaticOrder, true>(lds, g, S, E);
    }
    if (IN(PH_MOE2)) {
        pg8::Gemm g{HID, WD, DM, DM, DM}; pg8::StaticOrder S; S.init(NSLOTS / 256, 4, G, bx, 16);
        pg8::EpiGate E{Y, GATE};
        pg8::gemm_phase<pg8::EpiGate, pg8::StaticOrder, true>(lds, g, S, E);
    }
#undef IN
}
extern "C" void kernel_launch(void* const* d_in, const int* in_sizes, int n_in, void* d_out, int out_size, void* d_ws, size_t ws_size, hipStream_t stream) {
    if (n_in != 17 || out_size != NT * DM || ws_size < WS_END) { fprintf(stderr, "kernel_launch: unexpected shapes (n_in %d out %d ws %zu)\n", n_in, out_size, ws_size); return; }
    const float* x = (const float*)d_in[0]; const float* attn_norm = (const float*)d_in[1]; const float* w_in = (const float*)d_in[2]; const float* na_rpb = (const float*)d_in[3];
    const float* q_norm = (const float*)d_in[4]; const float* w_uq = (const float*)d_in[5]; const float* kv_norm = (const float*)d_in[6]; const float* w_ukv = (const float*)d_in[7];
    const float* swa_sink = (const float*)d_in[8]; const float* group_norm = (const float*)d_in[9]; const float* w_out = (const float*)d_in[10]; const float* ffn_norm = (const float*)d_in[11];
    const float* w_router = (const float*)d_in[12]; const float* w_gate = (const float*)d_in[13]; const float* w_up = (const float*)d_in[14]; const float* w_down = (const float*)d_in[15]; const float* final_norm = (const float*)d_in[16];
    unsigned char* ws = (unsigned char*)d_ws; float* H = (float*)d_out;
    float *c64 = (float*)(ws + WS_COS64), *s64 = (float*)(ws + WS_SIN64), *c32 = (float*)(ws + WS_COS32), *s32 = (float*)(ws + WS_SIN32);
    bf16 *WIN = (bf16*)(ws + WS_WIN), *WUQ = (bf16*)(ws + WS_WUQ), *WUKV = (bf16*)(ws + WS_WUKV), *WOUT = (bf16*)(ws + WS_WOUT), *WGU = (bf16*)(ws + WS_WGU), *WD = (bf16*)(ws + WS_WD);
    float *CQSS = (float*)(ws + WS_CQSS), *CKVSS = (float*)(ws + WS_CKVSS), *SS = (float*)(ws + WS_SS), *AFF = (float*)(ws + WS_AFF), *GATE = (float*)(ws + WS_GATE);
    int *INV = (int*)(ws + WS_INV), *IDX = (int*)(ws + WS_IDX);
    bf16 *XN = (bf16*)(ws + WS_XN), *PROJ = (bf16*)(ws + WS_PROJ), *QB = (bf16*)(ws + WS_QB), *KV = (bf16*)(ws + WS_KV), *HID = (bf16*)(ws + WS_HID), *XS = PROJ, *Y = PROJ, *O = XN, *XN2 = XN;

    static int grid = 0;
    if (grid == 0) { int dev = 0, cus = 0; hipGetDevice(&dev); hipDeviceGetAttribute(&cus, hipDeviceAttributeMultiprocessorCount, dev);
        if (hipFuncSetAttribute((const void*)mega, hipFuncAttributeMaxDynamicSharedMemorySize, LDS_BYTES) != hipSuccess) fprintf(stderr, "hipFuncSetAttribute failed\n");
        grid = cus > 0 ? cus : 256; }
    MegaArgs ma{}; ma.x = x; ma.H = H; ma.ws = ws;
#define MEGA(ph) do { ma.layer = l; ma.ph_lo = (ph); ma.ph_hi = (ph) + 1; ma.rpb = na_rpb + (size_t)l * 4 * 15 * 31; ma.sink = swa_sink + l * 6; hipLaunchKernelGGL(mega, dim3(grid), dim3(NWAVES * 64), LDS_BYTES, stream, ma); } while (0)
    hipLaunchKernelGGL(rope_tables, dim3(NS * 32 / 256), dim3(256), 0, stream, c64, s64, c32, s32);
    hipLaunchKernelGGL(norm_rows, dim3(NT / 4), dim3(256), 0, stream, x, attn_norm, XN);
    for (int l = 0; l < DEPTH; ++l) {
        { PrepArgs a{w_in + (size_t)l * DM * C_END, nullptr, nullptr, WIN, DM, C_END, NP, PK_WIN, 0, 0}; hipLaunchKernelGGL(prep_wt, dim3(NP / 32, DM / 32, 1), dim3(256), 0, stream, a); }
        { PrepArgs a{w_uq + (size_t)l * 256 * 576, nullptr, q_norm + l * 256, WUQ, 256, 576, 768, PK_WUQ, 0, 0}; hipLaunchKernelGGL(prep_wt, dim3(768 / 32, 256 / 32, 1), dim3(256), 0, stream, a); }
        { PrepArgs a{w_ukv + (size_t)l * 128 * 768, nullptr, kv_norm + l * 128, WUKV, 128, 768, 768, PK_WUKV, 0, 0}; hipLaunchKernelGGL(prep_wt, dim3(768 / 32, 128 / 32, 1), dim3(256), 0, stream, a); }
        { PrepArgs a{w_out + (size_t)l * DM * DM, nullptr, group_norm + l * DM, WOUT, DM, DM, DM, PK_WOUT, 0, 0}; hipLaunchKernelGGL(prep_wt, dim3(DM / 32, DM / 32, 1), dim3(256), 0, stream, a); }
        { PrepArgs a{w_gate + (size_t)l * NE * DM * DM, w_up + (size_t)l * NE * DM * DM, nullptr, WGU, DM, DM, 2048, PK_WGU, (long)DM * DM, (long)2048 * DM}; hipLaunchKernelGGL(prep_wt, dim3(2048 / 32, DM / 32, NE), dim3(256), 0, stream, a); }
        { PrepArgs a{w_down + (size_t)l * NE * DM * DM, nullptr, nullptr, WD, DM, DM, DM, PK_WD, (long)DM * DM, (long)DM * DM}; hipLaunchKernelGGL(prep_wt, dim3(DM / 32, DM / 32, NE), dim3(256), 0, stream, a); }
        MEGA(PH_PROJ);
        MEGA(PH_MLAUP);
        MEGA(PH_ATTN);
        hipLaunchKernelGGL(gnorm_rows, dim3(NT / 4), dim3(256), 0, stream, O, (const float*)SS);
        MEGA(PH_OUT);
        hipLaunchKernelGGL(router_rows, dim3(NT / 4), dim3(256), 0, stream, (const float*)H, ffn_norm + l * DM, w_router + (size_t)l * DM * NE, XN2, AFF);
        hipLaunchKernelGGL(topk_rank, dim3(NB * NE), dim3(1024), 0, stream, (const float*)AFF, INV, IDX, GATE);
        hipLaunchKernelGGL(gather_rows, dim3(NSLOTS / 4), dim3(256), 0, stream, (const bf16*)XN2, (const int*)IDX, XS);
        MEGA(PH_MOE1);
        MEGA(PH_MOE2);
        const bool last = (l == DEPTH - 1);
        hipLaunchKernelGGL(combine_rows, dim3(NT / 4), dim3(256), 0, stream, H, (const bf16*)Y, (const int*)INV, last ? final_norm : attn_norm + (l + 1) * DM, XN, last ? 1 : 0);
    }
}
```

```cpp
#include <hip/hip_runtime.h>
#include <cstdint>
#include <cstdio>

typedef unsigned short bf16;
constexpr int NB = 8, NS = 4096, DM = 1024, NT = NB * NS, NP = 2048, NE = 16, CAP = 512, DEPTH = 2;
constexpr int NSLOTS = NE * NB * CAP;
constexpr float LOG2E = 1.4426950408889634f;
constexpr float QS64 = 0.125f * LOG2E;
constexpr float QS96 = 0.10206207261596577f * LOG2E;
constexpr float EPS = 1e-6f;
constexpr int C_AQ = 0, C_AK = 256, C_AV = 512, C_CQ = 768, C_CKV = 1024, C_KR = 1152, C_SQ = 1184, C_SK = 1568, C_SV = 1696, C_END = 1824;

constexpr size_t MiB = 1u << 20;
constexpr size_t WS_CTL = 0;
constexpr size_t WS_COS64 = 1 * MiB, WS_SIN64 = WS_COS64 + 512 * 1024, WS_COS32 = 2 * MiB, WS_SIN32 = WS_COS32 + 256 * 1024;
constexpr size_t WS_WIN = 4 * MiB, WS_WUQ = 8 * MiB, WS_WUKV = 8 * MiB + 512 * 1024, WS_WOUT = 9 * MiB, WS_WGU = 12 * MiB, WS_WD = 76 * MiB;
constexpr size_t WS_CQSS = 108 * MiB, WS_CKVSS = WS_CQSS + 512 * 1024, WS_SS = 109 * MiB, WS_AFF = 111 * MiB, WS_INV = 113 * MiB, WS_IDX = 115 * MiB, WS_GATE = WS_IDX + 256 * 1024;
constexpr size_t WS_XN = 120 * MiB;
constexpr size_t WS_PROJ = 184 * MiB;
constexpr size_t WS_QB = 312 * MiB;
constexpr size_t WS_KV = 348 * MiB;
constexpr size_t WS_HID = 312 * MiB;
constexpr size_t WS_END = 440 * MiB;

__device__ __forceinline__ unsigned f2bf(float f) { unsigned u = __builtin_bit_cast(unsigned, f); return (u + 0x7fffu + ((u >> 16) & 1u)) >> 16; }
__device__ __forceinline__ float bf2f(unsigned short b) { return __builtin_bit_cast(float, (unsigned)b << 16); }
__device__ __forceinline__ float wave_sum(float v) {
#pragma unroll
    for (int o = 1; o < 64; o <<= 1) v += __shfl_xor(v, o);
    return v;
}

enum { PK_WIN = 0, PK_WUQ = 1, PK_WUKV = 2, PK_WOUT = 3, PK_WGU = 4, PK_WD = 5 };
__device__ __forceinline__ int prep_map(int kind, int n, float& sc, int& which) {
    sc = 1.f; which = 0;
    switch (kind) {
    case PK_WIN:
        if (n < 256) { sc = QS64; return n; }
        if (n < C_KR) return n;
        if (n < C_SQ) { const int p = n - C_KR, g = p >> 3, e = p & 7; return C_KR + 4 * g + (e & 3) + 16 * (e >> 2); }
        if (n < C_SK) { const int p = n - C_SQ, h = p >> 6, pp = p & 63, g = pp >> 3, e = pp & 7; sc = QS64; return C_SQ + h * 64 + 4 * g + (e & 3) + 32 * (e >> 2); }
        if (n < C_SV) { const int p = n - C_SK, h = p >> 6, pp = p & 63, g = pp >> 3, e = pp & 7; return C_SK + h * 64 + 4 * g + (e & 3) + 32 * (e >> 2); }
        if (n < C_END) return n;
        return -1;
    case PK_WUQ:
        if (n < 576) { const int h = n / 96, d = n % 96; sc = QS96; if (d < 64) return n; const int p = d - 64, g = p >> 3, e = p & 7; return h * 96 + 64 + 4 * g + (e & 3) + 16 * (e >> 2); }
        return -1;
    case PK_WUKV:
        if (n < 384) { const int h = n >> 6, d = n & 63; return h * 128 + d; }
        { const int m = n - 384, h = m >> 6, d = m & 63; return h * 128 + 64 + d; }
    case PK_WGU: { const int pn = n >> 8, half = (n >> 7) & 1, jj = n & 127; which = half; return 128 * pn + jj; }
    default: return n;
    }
}
#define LAS __attribute__((address_space(3)))
#define GAS __attribute__((address_space(1)))
namespace pg8 {
typedef short bf16x8 __attribute__((ext_vector_type(8)));
typedef float f32x4 __attribute__((ext_vector_type(4)));
typedef unsigned u32x4 __attribute__((ext_vector_type(4)));
constexpr int BM = 256, BK = 64, HALF = 128, HTB = HALF * BK * 2, STAGE_BYTES = 8 * HTB, NXCD = 8, WGM = 8;
__host__ __device__ __forceinline__ int lds_byte(int r, int c) { const int st = (r >> 4) * 2 + (c >> 5), rr = r & 15, cc = c & 31, ob = rr * 64 + cc * 2; return st * 1024 + (ob ^ (((ob >> 9) & 1) << 5)); }
__host__ __device__ __forceinline__ void stage_rc(int b, int& R, int& C) { const int st = b / 1024, sb = b % 1024, swz = sb ^ (((sb >> 9) & 1) << 5); R = (st >> 1) * 16 + swz / 64; C = (st & 1) * 32 + (swz % 64) / 2; }
__host__ __device__ __forceinline__ int perm32(int rho) { const int n = rho >> 4, i = rho & 15; return 8 * (i >> 2) + 4 * n + (i & 3); }
struct Unit { int pm, pn, pb; };
struct Gemm { const bf16* A; const bf16* Bt; int K, lda, ldb; };
struct StaticOrder {
    int nM, nN, nwg, G, c, gm;
    __device__ void init(int nM_, int nN_, int G_, int c_, int gm_) { nM = nM_; nN = nN_; nwg = nM * nN; G = G_; c = c_; gm = gm_; }
    __device__ bool next(int i, Unit& u) const {
        const long L = (long)i * G + c; if (L >= nwg) return false;
        int wgid = (int)L; { const int q = nwg / NXCD, r = nwg % NXCD, xcd = wgid % NXCD, off = wgid / NXCD; wgid = (xcd < r ? xcd * (q + 1) : r * (q + 1) + (xcd - r) * q) + off; }
        const int nig = WGM * nN, gid = wgid / nig, fm = gid * WGM, gsz = (nM - fm) < WGM ? (nM - fm) : WGM;
        u.pm = fm + ((wgid % nig) % gsz); u.pn = (wgid % nig) / gsz; u.pb = gm ? (u.pm / gm) * nN + u.pn : u.pn; return true;
    }
};
__device__ __forceinline__ unsigned cvt_pk_bf16(float lo, float hi) { unsigned r; asm volatile("v_cvt_pk_bf16_f32 %0, %1, %2" : "=v"(r) : "v"(lo), "v"(hi)); return r; }

template <class Epi, class Sched, bool ALIGN_EPI>
__device__ __forceinline__ void gemm_phase(LAS unsigned char* lds, const Gemm g, const Sched& S, const Epi& E) {
    int tid = threadIdx.x; asm volatile("" : "+v"(tid));
    const int wid = __builtin_amdgcn_readfirstlane(tid >> 6), lane = tid & 63, wr = wid >> 2, wc = wid & 3, fr = lane & 15, fq = lane >> 4;
    const int K = g.K, nt = K / BK;
    unsigned voffA[2], voffB[2];
#pragma unroll
    for (int i = 0; i < 2; ++i) { int R, C; stage_rc(tid * 16 + i * 8192, R, C); const int Rb = Epi::PERM ? ((R & ~31) + perm32(R & 31)) : R;
        voffA[i] = (unsigned)(R * g.lda + C) * 2u; voffB[i] = (unsigned)(Rb * g.ldb + C) * 2u; }
    const size_t kstep = (size_t)(BK * 2);
    const size_t hstepA = (size_t)HALF * g.lda * 2, hstepB = (size_t)HALF * g.ldb * 2, tstepA = 2 * hstepA, tstepB = 2 * hstepB;
    const unsigned ldsw = (unsigned)wid * 1024u;
    const int aoff = lds_byte(wr * 64 + fr, fq * 8), boff = lds_byte(wc * 32 + fr, fq * 8);
#define PG8_SA(b, h) (((b) * 2 + (h)) * HTB)
#define PG8_SB(b, h) ((4 + (b) * 2 + (h)) * HTB)
#define PG8_STAGE(bufoff, gbase, voff) do { _Pragma("unroll") for (int _i = 0; _i < 2; ++_i) \
        __builtin_amdgcn_global_load_lds((const unsigned*)((const char*)(gbase) + (voff)[_i]), (LAS unsigned*)(lds + (bufoff) + ldsw + _i * 8192), 16, 0, 0); } while (0)
#define PG8_LDA(dst, b, h) do { _Pragma("unroll") for (int m = 0; m < 4; ++m) _Pragma("unroll") for (int k = 0; k < 2; ++k) dst[m][k] = *(const LAS bf16x8*)(lds + PG8_SA(b, h) + aoff + m * 2048 + k * 1024); } while (0)
#define PG8_LDB(dst, b, h) do { _Pragma("unroll") for (int n = 0; n < 2; ++n) _Pragma("unroll") for (int k = 0; k < 2; ++k) dst[n][k] = *(const LAS bf16x8*)(lds + PG8_SB(b, h) + boff + n * 2048 + k * 1024); } while (0)
#define PG8_MMA(ai, bj, At, Bt) do { __builtin_amdgcn_s_setprio(1); _Pragma("unroll") for (int m = 0; m < 4; ++m) _Pragma("unroll") for (int n = 0; n < 2; ++n) _Pragma("unroll") for (int k = 0; k < 2; ++k) \
        acc[ai][bj][m][n] = __builtin_amdgcn_mfma_f32_16x16x32_bf16(Bt[n][k], At[m][k], acc[ai][bj][m][n], 0, 0, 0); __builtin_amdgcn_s_setprio(0); } while (0)
#define PG8_WAIT_V(n) asm volatile("s_waitcnt vmcnt(" #n ")" ::: "memory")
#define PG8_WAIT_L(n) asm volatile("s_waitcnt lgkmcnt(" #n ")" ::: "memory")
#define PG8_BAR __builtin_amdgcn_s_barrier()
#define PG8_SCHED __builtin_amdgcn_sched_barrier(0)
    Unit cur, nxt; int ui = 0;
    if (!S.next(0, cur)) return;
    f32x4 acc[2][2][4][2];
#pragma unroll
    for (int a = 0; a < 2; ++a)
#pragma unroll
        for (int b = 0; b < 2; ++b)
#pragma unroll
            for (int m = 0; m < 4; ++m)
#pragma unroll
                for (int n = 0; n < 2; ++n) acc[a][b][m][n] = (f32x4){0.f, 0.f, 0.f, 0.f};
    bf16x8 At[4][2], B0[2][2], B1[2][2];
    const char* cA = (const char*)g.A + (size_t)cur.pm * tstepA; const char* cB = (const char*)g.Bt + (size_t)cur.pb * tstepB;
    PG8_STAGE(PG8_SB(0, 0), cB, voffB); PG8_STAGE(PG8_SB(0, 1), cB + hstepB, voffB); PG8_STAGE(PG8_SA(0, 0), cA, voffA); PG8_STAGE(PG8_SA(0, 1), cA + hstepA, voffA);
    if (wr == 1) PG8_BAR;
    PG8_WAIT_V(2); PG8_BAR;
    PG8_STAGE(PG8_SB(1, 0), cB + kstep, voffB); PG8_STAGE(PG8_SA(1, 0), cA + kstep, voffA); PG8_STAGE(PG8_SB(1, 1), cB + hstepB + kstep, voffB);
    PG8_WAIT_V(6); PG8_BAR;
    for (;;) {
        const bool has_next = S.next(ui + 1, nxt);
        const char* nA = has_next ? (const char*)g.A + (size_t)nxt.pm * tstepA : cA; const char* nB = has_next ? (const char*)g.Bt + (size_t)nxt.pb * tstepB : cB;
        for (int t = 0; t < nt; t += 2) {
            const bool last = (t == nt - 2);
            const char* a1 = cA + (size_t)(t + 1) * kstep;
            const char* a2 = last ? nA : cA + (size_t)(t + 2) * kstep; const char* b2 = last ? nB : cB + (size_t)(t + 2) * kstep;
            const char* a3 = a2 + kstep; const char* b3 = b2 + kstep;
            PG8_LDB(B0, 0, 0); PG8_LDB(B1, 0, 1); PG8_SCHED; PG8_LDA(At, 0, 0); PG8_STAGE(PG8_SA(1, 1), a1 + hstepA, voffA);
            PG8_WAIT_V(8); PG8_WAIT_L(0); PG8_BAR; PG8_MMA(0, 0, At, B0); PG8_MMA(0, 1, At, B1); PG8_BAR; PG8_SCHED;
            PG8_LDA(At, 0, 1); PG8_STAGE(PG8_SB(0, 0), b2, voffB); PG8_STAGE(PG8_SB(0, 1), b2 + hstepB, voffB); PG8_STAGE(PG8_SA(0, 0), a2, voffA);
            PG8_WAIT_V(8); PG8_WAIT_L(0); PG8_BAR; PG8_MMA(1, 0, At, B0); PG8_MMA(1, 1, At, B1); PG8_BAR; PG8_SCHED;
            PG8_LDB(B0, 1, 0); PG8_LDB(B1, 1, 1); PG8_SCHED; PG8_LDA(At, 1, 0); PG8_STAGE(PG8_SA(0, 1), a2 + hstepA, voffA);
            PG8_WAIT_V(8); PG8_WAIT_L(0); PG8_BAR; PG8_MMA(0, 0, At, B0); PG8_MMA(0, 1, At, B1); PG8_BAR; PG8_SCHED;
            PG8_LDA(At, 1, 1); PG8_STAGE(PG8_SB(1, 0), b3, voffB); PG8_STAGE(PG8_SB(1, 1), b3 + hstepB, voffB); PG8_STAGE(PG8_SA(1, 0), a3, voffA);
            PG8_WAIT_V(8); PG8_WAIT_L(0); PG8_BAR; PG8_MMA(1, 0, At, B0); PG8_MMA(1, 1, At, B1); PG8_BAR; PG8_SCHED;
        }
        if constexpr (ALIGN_EPI) { if (wr == 0) PG8_BAR; }
        { int t2 = threadIdx.x; asm volatile("" : "+v"(t2)); E(acc, cur, wr, wc, t2 & 15, (t2 >> 4) & 3); }
        if (!has_next) break;
#pragma unroll
        for (int a = 0; a < 2; ++a)
#pragma unroll
            for (int b = 0; b < 2; ++b)
#pragma unroll
                for (int m = 0; m < 4; ++m)
#pragma unroll
                    for (int n = 0; n < 2; ++n) acc[a][b][m][n] = (f32x4){0.f, 0.f, 0.f, 0.f};
        cur = nxt; cA = nA; cB = nB; ++ui;
        if constexpr (ALIGN_EPI) { if (wr == 1) PG8_BAR; }
    }
    PG8_WAIT_V(0);
    if constexpr (!ALIGN_EPI) { if (wr == 0) PG8_BAR; }
    PG8_BAR;
#undef PG8_SA
#undef PG8_SB
#undef PG8_STAGE
#undef PG8_LDA
#undef PG8_LDB
#undef PG8_MMA
#undef PG8_WAIT_V
#undef PG8_WAIT_L
#undef PG8_BAR
#undef PG8_SCHED
}

typedef const f32x4 (&AccRef)[2][2][4][2];
__device__ __forceinline__ void st_bf16x8(bf16* p, f32x4 v0, f32x4 v1) { u32x4 w; w.x = cvt_pk_bf16(v0[0], v0[1]); w.y = cvt_pk_bf16(v0[2], v0[3]); w.z = cvt_pk_bf16(v1[0], v1[1]); w.w = cvt_pk_bf16(v1[2], v1[3]); *(u32x4*)p = w; }
struct EpiProj {
    static constexpr bool PERM = true;
    bf16* P; const float *c64, *s64, *c32, *s32; float *cqss, *ckvss;
    __device__ __forceinline__ void operator()(AccRef acc, const Unit& u, int wr, int wc, int fr, int fq) const {
#pragma unroll
        for (int ai = 0; ai < 2; ++ai)
#pragma unroll
            for (int m = 0; m < 4; ++m) { const int row = u.pm * BM + ai * HALF + wr * 64 + m * 16 + fr; const int pos = row & (NS - 1); float ssq = 0.f;
#pragma unroll
                for (int bj = 0; bj < 2; ++bj) { const int cw = u.pn * BM + bj * HALF + wc * 32, col0 = cw + 8 * fq; f32x4 v0 = acc[ai][bj][m][0], v1 = acc[ai][bj][m][1];
                    if (cw >= C_SQ && cw < C_SV) { const int g = ((col0 - C_SQ) & 63) >> 3; const f32x4 c = *(const f32x4*)(c64 + pos * 32 + 4 * g), s = *(const f32x4*)(s64 + pos * 32 + 4 * g);
                        const f32x4 o0 = v0 * c - v1 * s, o1 = v1 * c + v0 * s; v0 = o0; v1 = o1; }
                    else if (cw == C_KR) { const f32x4 c = *(const f32x4*)(c32 + pos * 16 + 4 * fq), s = *(const f32x4*)(s32 + pos * 16 + 4 * fq);
                        const f32x4 o0 = v0 * c - v1 * s, o1 = v1 * c + v0 * s; v0 = o0; v1 = o1; }
                    if (u.pn == 3 || (u.pn == 4 && bj == 0)) ssq += (v0[0] * v0[0] + v0[1] * v0[1]) + (v0[2] * v0[2] + v0[3] * v0[3]) + (v1[0] * v1[0] + v1[1] * v1[1]) + (v1[2] * v1[2] + v1[3] * v1[3]);
                    st_bf16x8(P + (size_t)row * NP + col0, v0, v1); }
                if (u.pn == 3 || u.pn == 4) { ssq += __shfl_xor(ssq, 16); ssq += __shfl_xor(ssq, 32); if (fq == 0) (u.pn == 3 ? cqss : ckvss)[(size_t)row * 4 + wc] = ssq; }
            }
    }
};
template <bool QMODE, int ldc, int ncols> struct EpiMla {
    static constexpr bool PERM = true;
    bf16* O; const float* ss; float ssinv; const float *c32, *s32;
    __device__ __forceinline__ void operator()(AccRef acc, const Unit& u, int wr, int wc, int fr, int fq) const {
#pragma unroll
        for (int ai = 0; ai < 2; ++ai)
#pragma unroll
            for (int m = 0; m < 4; ++m) { const int row = u.pm * BM + ai * HALF + wr * 64 + m * 16 + fr; const int pos = row & (NS - 1);
                const f32x4 p = *(const f32x4*)(ss + (size_t)row * 4); const float rs = rsqrtf(((p[0] + p[1]) + (p[2] + p[3])) * ssinv + EPS);
#pragma unroll
                for (int bj = 0; bj < 2; ++bj) { const int cw = u.pn * BM + bj * HALF + wc * 32, col0 = cw + 8 * fq; if (cw >= ncols) continue;
                    f32x4 v0 = acc[ai][bj][m][0] * rs, v1 = acc[ai][bj][m][1] * rs;
                    if (QMODE && (cw % 96) == 64) { const f32x4 c = *(const f32x4*)(c32 + pos * 16 + 4 * fq), s = *(const f32x4*)(s32 + pos * 16 + 4 * fq);
                        const f32x4 o0 = v0 * c - v1 * s, o1 = v1 * c + v0 * s; v0 = o0; v1 = o1; }
                    st_bf16x8(O + (size_t)row * ldc + col0, v0, v1); }
                asm volatile("" ::: "memory"); }
    }
};
struct EpiResid {
    static constexpr bool PERM = false;
    const float* Hin; float* Hout;
    __device__ __forceinline__ void operator()(AccRef acc, const Unit& u, int wr, int wc, int fr, int fq) const {
#pragma unroll
        for (int ai = 0; ai < 2; ++ai)
#pragma unroll
            for (int m = 0; m < 4; ++m) { const size_t off = (size_t)(u.pm * BM + ai * HALF + wr * 64 + m * 16 + fr) * DM + u.pn * BM + wc * 32 + 4 * fq;
#pragma unroll
                for (int bj = 0; bj < 2; ++bj)
#pragma unroll
                    for (int n = 0; n < 2; ++n) { const f32x4 b = *(const f32x4*)(Hin + off + bj * HALF + n * 16); *(f32x4*)(Hout + off + bj * HALF + n * 16) = b + acc[ai][bj][m][n]; } }
    }
};
struct EpiSwiglu {
    static constexpr bool PERM = true;
    bf16* Hd;
    __device__ __forceinline__ void operator()(AccRef acc, const Unit& u, int wr, int wc, int fr, int fq) const {
#pragma unroll
        for (int ai = 0; ai < 2; ++ai)
#pragma unroll
            for (int m = 0; m < 4; ++m) { const size_t row = (size_t)(u.pm * BM + ai * HALF + wr * 64 + m * 16 + fr); f32x4 o[2];
#pragma unroll
                for (int n = 0; n < 2; ++n) { const f32x4 gt = acc[ai][0][m][n], up = acc[ai][1][m][n];
#pragma unroll
                    for (int e = 0; e < 4; ++e) o[n][e] = gt[e] * __builtin_amdgcn_rcpf(1.f + __builtin_amdgcn_exp2f(-gt[e] * LOG2E)) * up[e]; }
                st_bf16x8(Hd + row * DM + u.pn * HALF + wc * 32 + 8 * fq, o[0], o[1]); }
    }
};
struct EpiGate {
    static constexpr bool PERM = true;
    bf16* Y; const float* gate;
    __device__ __forceinline__ void operator()(AccRef acc, const Unit& u, int wr, int wc, int fr, int fq) const {
#pragma unroll
        for (int ai = 0; ai < 2; ++ai)
#pragma unroll
            for (int m = 0; m < 4; ++m) { const size_t row = (size_t)(u.pm * BM + ai * HALF + wr * 64 + m * 16 + fr); const float gt = gate[row];
#pragma unroll
                for (int bj = 0; bj < 2; ++bj) st_bf16x8(Y + row * DM + u.pn * BM + bj * HALF + wc * 32 + 8 * fq, acc[ai][bj][m][0] * gt, acc[ai][bj][m][1] * gt); }
    }
};
}


namespace att {
typedef short bf16x8 __attribute__((ext_vector_type(8)));
typedef short s16x4 __attribute__((ext_vector_type(4)));
typedef float f32x16 __attribute__((ext_vector_type(16)));
typedef float f32x4 __attribute__((ext_vector_type(4)));
typedef unsigned u32x4 __attribute__((ext_vector_type(4)));
typedef float f32x2_t __attribute__((ext_vector_type(2))); typedef __bf16 bf16x2_t __attribute__((ext_vector_type(2)));
typedef short v4i16_t __attribute__((ext_vector_type(4)));
constexpr int KSLOT = 12288, VSLOT = 8192;
constexpr int L_K = 0, L_V = 2 * KSLOT, L_WS = L_V + 2 * VSLOT, L_OST = L_WS + 8 * 256, L_BIAS = L_OST + 8 * 4096, L_END = L_BIAS + 2048;
constexpr float THR = 8.f;
__device__ __forceinline__ int crow(int r, int hi) { return (r & 3) + 8 * (r >> 2) + 4 * hi; }
__device__ __forceinline__ unsigned cvtpk(float lo, float hi) { f32x2_t v = {lo, hi}; bf16x2_t b = __builtin_convertvector(v, bf16x2_t); return __builtin_bit_cast(unsigned, b); }
__device__ __forceinline__ s16x4 vtr(const LAS unsigned char* p) { return __builtin_bit_cast(s16x4, __builtin_amdgcn_ds_read_tr16_b64_v4i16((LAS v4i16_t*)p)); }
__device__ __forceinline__ void glds(const bf16* src, LAS unsigned char* dst) { __builtin_amdgcn_global_load_lds((const unsigned*)src, (LAS unsigned*)dst, 16, 0, 0); }
struct AttnP { const bf16 *PROJ, *QB, *KV; bf16* O; float* SS; const float* rpb; const float* sink; };

template <int TYPE> __device__ __forceinline__ void attn_unit(const AttnP& P, int b, int h, int qb, LAS unsigned char* lds) {
    constexpr int ND0 = (TYPE == 1) ? 6 : 4;
    int tid = threadIdx.x; asm volatile("" : "+v"(tid));
    const int lane = tid & 63, r32 = lane & 31, hi = lane >> 5, wid = __builtin_amdgcn_readfirstlane(tid >> 6);
    const int q0 = qb * 256, qw0 = q0 + wid * 32; const size_t tokb = (size_t)b * NS;
    int ntile, kbase, ta, tb;
    if (TYPE == 1) { ntile = NS / 64; kbase = 0; ta = 0; tb = ntile - 1; }
    else if (TYPE == 2) { kbase = max(q0 - 128, 0); const int ke = min(q0 + 384, NS); ntile = (ke - kbase) >> 6; ta = max(qw0 - 128 - kbase, 0) >> 6; tb = min(ntile - 1, (qw0 + 159 - kbase) >> 6); }
    else { const int r0 = qb * 4; kbase = min(max(r0 - 4, 0), 56); ntile = min(max(r0 - 1, 0), 56) + 7 - kbase + 1; const int r = r0 + (wid >> 1); ta = min(max(r - 4, 0), 56) - kbase; tb = ta + 7; }
    const int kvh = (TYPE == 2) ? h / 3 : h;
    const bf16 *ksrc, *ksrc2 = nullptr, *vsrc; size_t kpitch, vpitch, tstep;
    { const size_t key0 = tokb + (TYPE == 0 ? (size_t)kbase * 64 : (size_t)kbase); const int vrow = 16 * (wid & 3) + (lane >> 2), vcol = (wid >> 2) * 32 + (lane & 3) * 8;
      if (TYPE == 0) { ksrc = P.PROJ + (key0 + lane) * NP + C_AK + h * 64 + wid * 8; vsrc = P.PROJ + (key0 + vrow) * NP + C_AV + h * 64 + vcol; kpitch = vpitch = NP; }
      else if (TYPE == 1) { ksrc = P.KV + (key0 + lane) * 768 + h * 64 + wid * 8; ksrc2 = P.PROJ + (key0 + lane) * NP + C_KR + (wid & 3) * 8; vsrc = P.KV + (key0 + vrow) * 768 + 384 + h * 64 + vcol; kpitch = vpitch = 768; }
      else { ksrc = P.PROJ + (key0 + lane) * NP + C_SK + kvh * 64 + wid * 8; vsrc = P.PROJ + (key0 + vrow) * NP + C_SV + kvh * 64 + vcol; kpitch = vpitch = NP; } }
    LAS unsigned char* kdst = lds + L_K + wid * 1024; LAS unsigned char* vdst = lds + L_V + wid * 1024;
#define ATT_DMA(t, slot) do { glds(ksrc + (size_t)(t) * 64 * kpitch, kdst + (slot) * KSLOT); if (TYPE == 1 && wid < 4) glds(ksrc2 + (size_t)(t) * 64 * NP, kdst + (slot) * KSLOT + 8192); \
        glds(vsrc + (size_t)(t) * 64 * vpitch, vdst + (slot) * VSLOT); } while (0)
    LAS float* biasL = (LAS float*)(lds + L_BIAS);
    if (TYPE == 0) { for (int i = tid; i < 15 * 31; i += 512) biasL[i] = P.rpb[h * 465 + i] * LOG2E; }
    bf16x8 qr[ND0];
    { const bf16* qp = (TYPE == 1) ? P.QB + (tokb + qw0 + r32) * 576 + h * 96 : P.PROJ + (tokb + qw0 + r32) * NP + (TYPE == 0 ? C_AQ : C_SQ) + h * 64;
#pragma unroll
      for (int d0 = 0; d0 < ND0; ++d0) qr[d0] = *(const bf16x8*)(qp + d0 * 16 + hi * 8); }
    LAS float* wsf = (LAS float*)(lds + L_WS) + wid * 64;
    float m = (TYPE == 2) ? P.sink[h] * LOG2E : -1e30f, l = (TYPE == 2 && hi == 0) ? 1.f : 0.f;
    f32x16 o[2]; o[0] = f32x16{}; o[1] = f32x16{};
    ATT_DMA(0, 0);
    for (int t = 0; t < ntile; ++t) {
        const int slot = t & 1;
        asm volatile("s_waitcnt vmcnt(0)" ::: "memory"); __syncthreads();
        if (t + 1 < ntile) ATT_DMA(t + 1, slot ^ 1);
        if (t < ta || t > tb) continue;
        const LAS unsigned char* Kp = lds + L_K + slot * KSLOT + hi * 1024 + r32 * 16;
        f32x16 p0 = f32x16{}, p1 = f32x16{};
#pragma unroll
        for (int d0 = 0; d0 < ND0; ++d0) { const bf16x8 k0 = *(const LAS bf16x8*)(Kp + d0 * 2048), k1 = *(const LAS bf16x8*)(Kp + d0 * 2048 + 512);
            p0 = __builtin_amdgcn_mfma_f32_32x32x16_bf16(k0, qr[d0], p0, 0, 0, 0); p1 = __builtin_amdgcn_mfma_f32_32x32x16_bf16(k1, qr[d0], p1, 0, 0, 0); }
        if (TYPE == 2) { const int dq = qw0 + r32 - (kbase + t * 64) - 4 * hi;
#pragma unroll
            for (int r = 0; r < 16; ++r) { const int d0_ = dq - ((r & 3) + 8 * (r >> 2)), d1_ = d0_ - 32;
                if (d0_ > 128 || d0_ < -128) p0[r] = -INFINITY; if (d1_ > 128 || d1_ < -128) p1[r] = -INFINITY; } }
        if (TYPE == 0) { const int c = (wid & 1) * 32 + r32, cs = min(max(c - 8, 0), 48); const int r = qb * 4 + (wid >> 1), kr = kbase + t; const LAS float* brow = biasL + (kr - r + 7) * 31 + 15 - c;
#pragma unroll
            for (int rr = 0; rr < 16; ++rr) { const int kc0 = crow(rr, hi), kc1 = kc0 + 32;
                const bool v0 = kc0 >= cs && kc0 < cs + 16, v1 = kc1 >= cs && kc1 < cs + 16;
                p0[rr] = v0 ? p0[rr] + brow[v0 ? kc0 : c] : -INFINITY; p1[rr] = v1 ? p1[rr] + brow[v1 ? kc1 : c] : -INFINITY; } }
        float rm = fmaxf(p0[0], p1[0]);
#pragma unroll
        for (int r = 1; r < 16; ++r) rm = fmaxf(rm, fmaxf(p0[r], p1[r]));
        { auto rr = __builtin_amdgcn_permlane32_swap(__float_as_uint(rm), __float_as_uint(rm), false, false); rm = fmaxf(__uint_as_float(rr[0]), __uint_as_float(rr[1])); }
        if (__any(rm > m + THR)) { const float mn = fmaxf(m, rm), f = __builtin_amdgcn_exp2f(m - mn); m = mn; l *= f;
            if (hi == 0) wsf[r32] = f;
#pragma unroll
            for (int g = 0; g < 4; ++g) { const f32x4 fv = *(const LAS f32x4*)(wsf + 8 * g + 4 * hi);
#pragma unroll
                for (int e = 0; e < 4; ++e) { o[0][4 * g + e] *= fv[e]; o[1][4 * g + e] *= fv[e]; } } }
        float sacc = 0.f;
#pragma unroll
        for (int r = 0; r < 16; ++r) { p0[r] = __builtin_amdgcn_exp2f(p0[r] - m); p1[r] = __builtin_amdgcn_exp2f(p1[r] - m); sacc += p0[r] + p1[r]; }
        l += sacc;
        u32x4 pw[4];
#pragma unroll
        for (int e = 0; e < 4; ++e) { pw[0][e] = cvtpk(p0[2 * e], p0[2 * e + 1]); pw[1][e] = cvtpk(p0[8 + 2 * e], p0[9 + 2 * e]); pw[2][e] = cvtpk(p1[2 * e], p1[2 * e + 1]); pw[3][e] = cvtpk(p1[8 + 2 * e], p1[9 + 2 * e]); }
        const LAS unsigned char* Vp = lds + L_V + slot * VSLOT + ((lane >> 4) & 1) * 32 + (lane & 3) * 8 + (4 * hi + ((lane & 15) >> 2)) * 64;
#pragma unroll
        for (int d0 = 0; d0 < 2; ++d0)
#pragma unroll
            for (int ks = 0; ks < 4; ++ks) { const s16x4 lo = vtr(Vp + d0 * 4096 + ks * 1024), hh = vtr(Vp + d0 * 4096 + ks * 1024 + 512);
                const bf16x8 vf = (bf16x8){lo[0], lo[1], lo[2], lo[3], hh[0], hh[1], hh[2], hh[3]};
                o[d0] = __builtin_amdgcn_mfma_f32_32x32x16_bf16(__builtin_bit_cast(bf16x8, pw[ks]), vf, o[d0], 0, 0, 0); }
    }
    { auto rr = __builtin_amdgcn_permlane32_swap(__float_as_uint(l), __float_as_uint(l), false, false); l = __uint_as_float(rr[0]) + __uint_as_float(rr[1]); }
    if (hi == 0) wsf[32 + r32] = 1.f / l;
    LAS bf16* stg = (LAS bf16*)(lds + L_OST) + wid * 2048;
#pragma unroll
    for (int g = 0; g < 4; ++g) { const f32x4 iv = *(const LAS f32x4*)(wsf + 32 + 8 * g + 4 * hi);
#pragma unroll
        for (int e = 0; e < 4; ++e) { const int orow = 8 * g + 4 * hi + e; stg[orow * 64 + r32] = (bf16)(cvtpk(o[0][4 * g + e] * iv[e], 0.f) & 0xffff); stg[orow * 64 + 32 + r32] = (bf16)(cvtpk(o[1][4 * g + e] * iv[e], 0.f) & 0xffff); } }
    const int ocol = (TYPE == 0 ? 0 : (TYPE == 1 ? 256 : 640)) + h * 64, sidx = (TYPE == 0 ? 0 : (TYPE == 1 ? 4 : 10)) + h;
#pragma unroll
    for (int i = 0; i < 4; ++i) { const int row = i * 8 + (lane >> 3), ch = lane & 7; const u32x4 v = *(const LAS u32x4*)(stg + row * 64 + ch * 8);
        const size_t tokn = tokb + qw0 + row; *(u32x4*)(P.O + tokn * DM + ocol + ch * 8) = v;
        float sq = 0.f;
#pragma unroll
        for (int e = 0; e < 4; ++e) { const float a = __builtin_bit_cast(float, v[e] << 16), c2 = __builtin_bit_cast(float, v[e] & 0xffff0000u); sq += a * a + c2 * c2; }
        sq += __shfl_xor(sq, 1); sq += __shfl_xor(sq, 2); sq += __shfl_xor(sq, 4);
        if (ch == 0) P.SS[tokn * 16 + sidx] = sq; }
    __syncthreads();
#undef ATT_DMA
}
__device__ __forceinline__ void attn_phase(const AttnP& P, LAS unsigned char* lds, int vcu) {
    const int x = vcu >> 5, cx = vcu & 31;
    for (int i = 0; i < 3; ++i) { const int j = cx * 3 + i, bh = 6 * x + (j >> 4), qb = j & 15; attn_unit<1>(P, bh / 6, bh % 6, qb, lds); }
    for (int i = 0; i < 3; ++i) { const int j = cx * 3 + i, bh = 6 * x + (j >> 4), qb = j & 15; attn_unit<2>(P, bh / 6, bh % 6, qb, lds); }
    for (int i = 0; i < 2; ++i) { const int j = cx * 2 + i, bh = 4 * x + (j >> 4), qb = j & 15; attn_unit<0>(P, bh >> 2, bh & 3, qb, lds); }
}
}


constexpr int NWAVES = 8, LDS_BYTES = 147456, RING_BYTES = 131072, MISC_OFF = RING_BYTES + 320;
#define XB_TMO      128
#define XB_XCNT(j)  (256  + 64 * (j))
#define XB_XSUB(j)  (1280 + 64 * (j))
#define XB_XGEN(j)  (2304 + 64 * (j))
#define XB_TOP      3328
#define XB_TOPGEN   3392
#define XCD_BAR_WORDS 3456
#define XB_SPIN_CAP (1u << 18)
constexpr int CW_BAR = 4096;
__device__ __forceinline__ unsigned xb_ld(unsigned* p)              { return __hip_atomic_load(p, __ATOMIC_RELAXED, __HIP_MEMORY_SCOPE_AGENT); }
__device__ __forceinline__ unsigned xb_add(unsigned* p, unsigned v) { return __hip_atomic_fetch_add(p, v, __ATOMIC_RELAXED, __HIP_MEMORY_SCOPE_AGENT); }
__device__ __forceinline__ unsigned xb_xcc_id() { return (unsigned)__builtin_amdgcn_s_getreg((3 << 11) | 20) & 0xFu; }
#define XB_SPIN(cond, bar) do { unsigned _sp = 0; while (cond) { __builtin_amdgcn_s_sleep(1); \
    if ((++_sp & 255u) == 0u) { if (xb_ld(&(bar)[XB_TMO])) break; if (_sp > XB_SPIN_CAP) { atomicAdd(&(bar)[XB_TMO], 1u); break; } } } } while (0)
struct XcdBarrier { unsigned* bar; unsigned x; volatile LAS unsigned* st; };
__device__ __forceinline__ XcdBarrier xcd_barrier_post(unsigned* bar, volatile LAS unsigned* st) {
    XcdBarrier b; b.bar = bar; b.x = xb_xcc_id(); b.st = st;
    if (threadIdx.x == 0) (void)xb_add(&bar[XB_XCNT(b.x)], 1u);
    return b;
}
__device__ __forceinline__ void xcd_barrier_complete(unsigned* bar, unsigned x, unsigned& nloc, unsigned& nx) {
    const unsigned G = gridDim.x * gridDim.y * gridDim.z;
    unsigned sum, cnt, mine, sp = 0u;
    for (;;) {
        sum = 0u; cnt = 0u; mine = 0u;
#pragma unroll
        for (unsigned j = 0; j < 16; ++j) { const unsigned c = xb_ld(&bar[XB_XCNT(j)]); sum += c; cnt += (c > 0u) ? 1u : 0u; mine = (j == x) ? c : mine; }
        if (sum == G) break;
        __builtin_amdgcn_s_sleep(1);
        if ((++sp & 255u) == 0u) { if (xb_ld(&bar[XB_TMO])) break; if (sp > XB_SPIN_CAP) { atomicAdd(&bar[XB_TMO], 1u); break; } }
    }
    nloc = mine > 0u ? mine : 1u; nx = cnt > 0u ? cnt : 1u;
}
__device__ __forceinline__ void xcd_barrier(const XcdBarrier& b) {
    asm volatile("s_waitcnt vmcnt(0)" ::: "memory");
    __syncthreads();
    if (threadIdx.x == 0) {
        unsigned* bar = b.bar; asm volatile("" : "+s"(bar));
        __builtin_amdgcn_s_waitcnt(0);
        unsigned nloc = b.st[0], nx = b.st[1];
        if (nloc == 0u) { xcd_barrier_complete(bar, b.x, nloc, nx); b.st[0] = nloc; b.st[1] = nx; }
        const unsigned old = xb_add(&bar[XB_XSUB(b.x)], 1u);
        const unsigned gen = old / nloc;
        if (old + 1u == (gen + 1u) * nloc) {
            __builtin_amdgcn_fence(__ATOMIC_RELEASE, "agent");
            asm volatile("s_waitcnt vmcnt(0)" ::: "memory");
            const unsigned og = xb_add(&bar[XB_TOP], 1u);
            const unsigned tg = og / nx;
            if (og + 1u == (tg + 1u) * nx) xb_add(&bar[XB_TOPGEN], 1u);
            else XB_SPIN(xb_ld(&bar[XB_TOPGEN]) == tg, bar);
            __builtin_amdgcn_fence(__ATOMIC_ACQUIRE, "agent");
            xb_add(&bar[XB_XGEN(b.x)], 1u);
            asm volatile("s_waitcnt vmcnt(0)" ::: "memory");
        } else {
            XB_SPIN(xb_ld(&bar[XB_XGEN(b.x)]) == gen, bar);
            __builtin_amdgcn_fence(__ATOMIC_ACQUIRE, "agent");
            asm volatile("s_waitcnt vmcnt(0)" ::: "memory");
        }
    }
    __syncthreads();
}

struct MegaArgs {
    const float *x, *attn_norm, *w_in, *na_rpb, *q_norm, *w_uq, *kv_norm, *w_ukv, *swa_sink, *group_norm, *w_out, *ffn_norm, *w_router, *w_gate, *w_up, *w_down, *final_norm;
    float* H; unsigned char* ws;
    int ph_lo, ph_hi;
};

__device__ __forceinline__ void prep_item(int kind, const float* W, const float* W2, const float* kgain, bf16* Wt, int K, int Nsrc, int nblk, int item, LAS float* scr, int lane) {
    const int kb = item / nblk, nb = item % nblk, k0 = 64 * kb, n0 = 32 * nb, r = lane >> 3, q = lane & 7;
    float sc; int which; const int src4 = prep_map(kind, n0 + 4 * q, sc, which); const float* Wb = which ? W2 : W;
    float4 v[8];
#pragma unroll
    for (int i = 0; i < 8; ++i) v[i] = (src4 >= 0) ? *(const float4*)(Wb + (size_t)(k0 + 8 * i + r) * Nsrc + src4) : make_float4(0.f, 0.f, 0.f, 0.f);
#pragma unroll
    for (int i = 0; i < 8; ++i) { const float g = (kgain ? kgain[k0 + 8 * i + r] : 1.f) * sc; LAS float* d = scr + (8 * i + r) * 33 + 4 * q; d[0] = v[i].x * g; d[1] = v[i].y * g; d[2] = v[i].z * g; d[3] = v[i].w * g; }
    asm volatile("s_waitcnt lgkmcnt(0)" ::: "memory");
    const int c = lane & 7;
#pragma unroll
    for (int j = 0; j < 4; ++j) { const int n = (lane >> 3) + 8 * j; const LAS float* s = scr + (8 * c) * 33 + n;
        uint4 o; o.x = f2bf(s[0]) | (f2bf(s[33]) << 16); o.y = f2bf(s[2 * 33]) | (f2bf(s[3 * 33]) << 16); o.z = f2bf(s[4 * 33]) | (f2bf(s[5 * 33]) << 16); o.w = f2bf(s[6 * 33]) | (f2bf(s[7 * 33]) << 16);
        *(uint4*)(Wt + (size_t)(n0 + n) * K + k0 + 8 * c) = o; }
    asm volatile("s_waitcnt lgkmcnt(0)" ::: "memory");
}
__device__ __forceinline__ void ph_prep(const MegaArgs& a, int l, LAS unsigned char* lds, int gw, int ngw, int wave, int lane) {
    unsigned char* ws = a.ws; LAS float* scr = (LAS float*)(lds + wave * 8448);
    constexpr int I_WIN = 16 * 64, I_WUQ = 4 * 24, I_WUKV = 2 * 24, I_WOUT = 16 * 32, I_WGU1 = 16 * 64, I_WGU = NE * I_WGU1, I_WD1 = 16 * 32, I_WD = NE * I_WD1;
    constexpr int NITEMS = I_WIN + I_WUQ + I_WUKV + I_WOUT + I_WGU + I_WD;
    for (int it = gw; it < NITEMS; it += ngw) { int r = it;
        if (r < I_WGU) { const int e = r / I_WGU1; prep_item(PK_WGU, a.w_gate + ((size_t)l * NE + e) * DM * DM, a.w_up + ((size_t)l * NE + e) * DM * DM, nullptr, (bf16*)(ws + WS_WGU) + (size_t)e * 2048 * DM, DM, DM, 64, r % I_WGU1, scr, lane); continue; } r -= I_WGU;
        if (r < I_WD) { const int e = r / I_WD1; prep_item(PK_WD, a.w_down + ((size_t)l * NE + e) * DM * DM, nullptr, nullptr, (bf16*)(ws + WS_WD) + (size_t)e * DM * DM, DM, DM, 32, r % I_WD1, scr, lane); continue; } r -= I_WD;
        if (r < I_WIN) { prep_item(PK_WIN, a.w_in + (size_t)l * DM * C_END, nullptr, nullptr, (bf16*)(ws + WS_WIN), DM, C_END, 64, r, scr, lane); continue; } r -= I_WIN;
        if (r < I_WOUT) { prep_item(PK_WOUT, a.w_out + (size_t)l * DM * DM, nullptr, a.group_norm + l * DM, (bf16*)(ws + WS_WOUT), DM, DM, 32, r, scr, lane); continue; } r -= I_WOUT;
        if (r < I_WUQ) { prep_item(PK_WUQ, a.w_uq + (size_t)l * 256 * 576, nullptr, a.q_norm + l * 256, (bf16*)(ws + WS_WUQ), 256, 576, 24, r, scr, lane); continue; } r -= I_WUQ;
        prep_item(PK_WUKV, a.w_ukv + (size_t)l * 128 * 768, nullptr, a.kv_norm + l * 128, (bf16*)(ws + WS_WUKV), 128, 768, 24, r, scr, lane);
    }
}
__device__ __forceinline__ void ph_rope_tables(unsigned char* ws, int gtid, int ngt) {
    float *c64 = (float*)(ws + WS_COS64), *s64 = (float*)(ws + WS_SIN64), *c32 = (float*)(ws + WS_COS32), *s32 = (float*)(ws + WS_SIN32);
    for (int i = gtid; i < NS * 32; i += ngt) {
        { const int s = i >> 5, j = i & 31; const float inv = 1.0f / powf(10000.f, (float)(2 * j) / 64.f); const float ang = (float)s * inv;
          const double rev = (double)ang * 0.15915494309189535; const float fr = (float)(rev - floor(rev)); c64[i] = __builtin_amdgcn_cosf(fr); s64[i] = __builtin_amdgcn_sinf(fr); }
        if (i < NS * 16) { const int s = i >> 4, j = i & 15; const float inv = 1.0f / powf(10000.f, (float)(2 * j) / 32.f); const float ang = (float)s * inv;
          const double rev = (double)ang * 0.15915494309189535; const float fr = (float)(rev - floor(rev)); c32[i] = __builtin_amdgcn_cosf(fr); s32[i] = __builtin_amdgcn_sinf(fr); }
    }
}
__device__ __forceinline__ void row_norm_store(const float4 (&v)[4], const float* g, bf16* orow, int lane) {
    float s = 0.f;
#pragma unroll
    for (int j = 0; j < 4; ++j) s += v[j].x * v[j].x + v[j].y * v[j].y + v[j].z * v[j].z + v[j].w * v[j].w;
    const float rstd = rsqrtf(wave_sum(s) * (1.f / DM) + EPS);
    uint2* o = (uint2*)orow + lane;
#pragma unroll
    for (int j = 0; j < 4; ++j) { const float4 gg = ((const float4*)g)[lane + 64 * j];
        o[64 * j] = make_uint2(f2bf(v[j].x * rstd * gg.x) | (f2bf(v[j].y * rstd * gg.y) << 16), f2bf(v[j].z * rstd * gg.z) | (f2bf(v[j].w * rstd * gg.w) << 16)); }
}
__device__ __forceinline__ void ph_norm_x(const MegaArgs& a, int gw, int ngw, int lane) {
    bf16* XN = (bf16*)(a.ws + WS_XN);
    for (int row = gw; row < NT; row += ngw) { const float4* hr = (const float4*)(a.x + (size_t)row * DM) + lane; float4 v[4];
#pragma unroll
        for (int j = 0; j < 4; ++j) v[j] = hr[64 * j];
        row_norm_store(v, a.attn_norm, XN + (size_t)row * DM, lane); }
}
__device__ __forceinline__ void ph_gnorm(unsigned char* ws, int gw, int ngw, int lane) {
    bf16* O = (bf16*)(ws + WS_XN); const float* SS = (const float*)(ws + WS_SS);
    for (int row = gw; row < NT; row += ngw) {
        const float4* ss4 = (const float4*)(SS + (size_t)row * 16); const float4 s0 = ss4[0], s1 = ss4[1], s2 = ss4[2], s3 = ss4[3];
        const float ra = rsqrtf((s0.x + s0.y + s0.z + s0.w) * (1.f / 256.f) + EPS);
        const float rb = rsqrtf((s1.x + s1.y + s1.z + s1.w + s2.x + s2.y) * (1.f / 384.f) + EPS);
        const float rc = rsqrtf((s2.z + s2.w + s3.x + s3.y + s3.z + s3.w) * (1.f / 384.f) + EPS);
        uint2* o = (uint2*)(O + (size_t)row * DM) + lane;
#pragma unroll
        for (int j = 0; j < 4; ++j) { const int col = 4 * lane + 256 * j; const float r = col < 256 ? ra : (col < 640 ? rb : rc); uint2 w = o[64 * j];
            w.x = f2bf(bf2f(w.x & 0xffff) * r) | (f2bf(bf2f(w.x >> 16) * r) << 16); w.y = f2bf(bf2f(w.y & 0xffff) * r) | (f2bf(bf2f(w.y >> 16) * r) << 16); o[64 * j] = w; }
    }
}
__device__ __forceinline__ void ph_router(const MegaArgs& a, int l, LAS unsigned char* lds, int gw, int ngw, int lane) {
    LAS float* wl = (LAS float*)lds; const float* wr = a.w_router + (size_t)l * DM * NE; const float* g = a.ffn_norm + l * DM;
    for (int i = threadIdx.x; i < DM * NE; i += NWAVES * 64) wl[(i & 15) * DM + (i >> 4)] = wr[i];
    __syncthreads();
    bf16* XN2 = (bf16*)(a.ws + WS_XN); float* AFF = (float*)(a.ws + WS_AFF);
    for (int row = gw; row < NT; row += ngw) {
        asm volatile("" ::: "memory");
        const float4* hr = (const float4*)(a.H + (size_t)row * DM) + lane; float4 v[4]; float s = 0.f;
#pragma unroll
        for (int j = 0; j < 4; ++j) { v[j] = hr[64 * j]; s += v[j].x * v[j].x + v[j].y * v[j].y + v[j].z * v[j].z + v[j].w * v[j].w; }
        const float rstd = rsqrtf(wave_sum(s) * (1.f / DM) + EPS);
        uint2* o = (uint2*)(XN2 + (size_t)row * DM) + lane; float lg[16];
#pragma unroll
        for (int e = 0; e < 16; ++e) lg[e] = 0.f;
#pragma unroll
        for (int j = 0; j < 4; ++j) { const float4 gg = ((const float4*)g)[lane + 64 * j];
            const float4 xv = make_float4(v[j].x * rstd * gg.x, v[j].y * rstd * gg.y, v[j].z * rstd * gg.z, v[j].w * rstd * gg.w);
            o[64 * j] = make_uint2(f2bf(xv.x) | (f2bf(xv.y) << 16), f2bf(xv.z) | (f2bf(xv.w) << 16));
#pragma unroll
            for (int e = 0; e < 16; ++e) { const pg8::f32x4 w = *(const LAS pg8::f32x4*)(wl + e * DM + 4 * lane + 256 * j); lg[e] += xv.x * w[0] + xv.y * w[1] + xv.z * w[2] + xv.w * w[3]; } }
        float mx = -1e30f;
#pragma unroll
        for (int e = 0; e < 16; ++e) { lg[e] = wave_sum(lg[e]); mx = fmaxf(mx, lg[e]); }
        float den = 0.f;
#pragma unroll
        for (int e = 0; e < 16; ++e) { lg[e] = __expf(lg[e] - mx); den += lg[e]; }
        const int b = row / NS, sidx = row % NS;
        if (lane < 16) { float val = 0.f;
#pragma unroll
            for (int e = 0; e < 16; ++e) if (lane == e) val = lg[e];
            AFF[((size_t)b * NE + lane) * NS + sidx] = val / den; }
    }
    __syncthreads();
}
__device__ __forceinline__ void ph_topk(unsigned char* ws, LAS unsigned char* lds, int bx, int G) {
    LAS unsigned* hist = (LAS unsigned*)lds;
    LAS unsigned* sh = hist + 256;
    LAS unsigned* wcnt = hist + 512;
    const int tid = threadIdx.x, lane = tid & 63, wave = tid >> 6;
    const float* AFF = (const float*)(ws + WS_AFF); int* INV = (int*)(ws + WS_INV); int* IDX = (int*)(ws + WS_IDX); float* GATE = (float*)(ws + WS_GATE);
    for (int be = bx; be < NB * NE; be += G) {
        const int b = be / NE, e = be % NE; const float* src = AFF + (size_t)be * NS;
        unsigned u[8];
#pragma unroll
        for (int i = 0; i < 8; ++i) u[i] = __float_as_uint(src[tid * 8 + i]);
        unsigned prefix = 0u, krem = CAP;
#pragma unroll 1
        for (int pass = 0; pass < 4; ++pass) { const int shift = 24 - 8 * pass; const unsigned pmask = pass == 0 ? 0u : (0xffffffffu << (shift + 8));
            if (tid < 256) hist[tid] = 0u;
            __syncthreads();
#pragma unroll
            for (int i = 0; i < 8; ++i) if ((u[i] & pmask) == prefix) __hip_atomic_fetch_add(&hist[(u[i] >> shift) & 255u], 1u, __ATOMIC_RELAXED, __HIP_MEMORY_SCOPE_WORKGROUP);
            __syncthreads();
            if (wave == 0) {
                unsigned c4[4]; unsigned tot = 0u;
#pragma unroll
                for (int i = 0; i < 4; ++i) { c4[i] = hist[255 - (lane * 4 + i)]; tot += c4[i]; }
                unsigned inc = tot;
#pragma unroll
                for (int o = 1; o < 64; o <<= 1) { const unsigned t = __shfl_up(inc, o); if (lane >= o) inc += t; }
                const unsigned before = inc - tot;
                if (before < krem && inc >= krem) { unsigned acc = before;
#pragma unroll
                    for (int i = 0; i < 4; ++i) { if (acc < krem && acc + c4[i] >= krem) { sh[0] = prefix | ((unsigned)(255 - (lane * 4 + i)) << shift); sh[1] = krem - acc; } acc += c4[i]; } }
            }
            __syncthreads();
            prefix = sh[0]; krem = sh[1];
            __syncthreads();
        }
        unsigned ngt = 0u, neq = 0u;
#pragma unroll
        for (int i = 0; i < 8; ++i) { ngt += (u[i] > prefix) ? 1u : 0u; neq += (u[i] == prefix) ? 1u : 0u; }
        unsigned ig = ngt, iq = neq;
#pragma unroll
        for (int o = 1; o < 64; o <<= 1) { const unsigned tg = __shfl_up(ig, o), tq = __shfl_up(iq, o); if (lane >= o) { ig += tg; iq += tq; } }
        if (lane == 63) { wcnt[wave * 2] = ig; wcnt[wave * 2 + 1] = iq; }
        __syncthreads();
        unsigned bg = 0u, bq = 0u;
        for (int w = 0; w < wave; ++w) { bg += wcnt[w * 2]; bq += wcnt[w * 2 + 1]; }
        unsigned pg = bg + ig - ngt, pq = bq + iq - neq;
#pragma unroll
        for (int i = 0; i < 8; ++i) { const int idx = tid * 8 + i; int slot = -1;
            if (u[i] > prefix) { slot = (int)(pg + min(pq, krem)); ++pg; }
            else if (u[i] == prefix) { if (pq < krem) slot = (int)(pg + pq); ++pq; }
            INV[(size_t)be * NS + idx] = slot;
            if (slot >= 0) { IDX[be * CAP + slot] = idx; GATE[(size_t)e * (NB * CAP) + b * CAP + slot] = __uint_as_float(u[i]); } }
        __syncthreads();
    }
}
__device__ __forceinline__ void ph_gather(unsigned char* ws, int gw, int ngw, int lane) {
    const bf16* XN2 = (const bf16*)(ws + WS_XN); const int* IDX = (const int*)(ws + WS_IDX); bf16* XS = (bf16*)(ws + WS_PROJ);
    for (int r = gw; r < NSLOTS; r += ngw) { const int e = r >> 12, b = (r >> 9) & 7, slot = r & 511; const int tokn = IDX[(b * NE + e) * CAP + slot];
        const uint4* s = (const uint4*)(XN2 + ((size_t)b * NS + tokn) * DM) + lane; uint4* d = (uint4*)(XS + (size_t)r * DM) + lane; const uint4 a0 = s[0], a1 = s[64]; d[0] = a0; d[64] = a1; }
}
__device__ __forceinline__ void ph_combine(const MegaArgs& a, int l, int gw, int ngw, int lane) {
    const bf16* Y = (const bf16*)(a.ws + WS_PROJ); const int* INV = (const int*)(a.ws + WS_INV); bf16* XN = (bf16*)(a.ws + WS_XN); const bool last = (l == DEPTH - 1);
    for (int row = gw; row < NT; row += ngw) { const int b = row / NS, s = row % NS;
        float4* hr = (float4*)(a.H + (size_t)row * DM) + lane; float4 v[4];
#pragma unroll
        for (int j = 0; j < 4; ++j) v[j] = hr[64 * j];
        int slot_l = -1; if (lane < NE) slot_l = INV[((size_t)b * NE + lane) * NS + s];
        unsigned long long msk = __ballot(slot_l >= 0);
        while (msk) { const int e = __builtin_ctzll(msk); msk &= msk - 1; const int slot = __shfl(slot_l, e);
            const uint2* y = (const uint2*)(Y + ((size_t)e * (NB * CAP) + b * CAP + slot) * DM) + lane;
#pragma unroll
            for (int j = 0; j < 4; ++j) { const uint2 w = y[64 * j]; v[j].x += bf2f(w.x & 0xffff); v[j].y += bf2f(w.x >> 16); v[j].z += bf2f(w.y & 0xffff); v[j].w += bf2f(w.y >> 16); } }
        if (last) { float ssum = 0.f;
#pragma unroll
            for (int j = 0; j < 4; ++j) ssum += v[j].x * v[j].x + v[j].y * v[j].y + v[j].z * v[j].z + v[j].w * v[j].w;
            const float rstd = rsqrtf(wave_sum(ssum) * (1.f / DM) + EPS);
#pragma unroll
            for (int j = 0; j < 4; ++j) { const float4 gg = ((const float4*)a.final_norm)[lane + 64 * j]; hr[64 * j] = make_float4(v[j].x * rstd * gg.x, v[j].y * rstd * gg.y, v[j].z * rstd * gg.z, v[j].w * rstd * gg.w); } }
        else {
#pragma unroll
            for (int j = 0; j < 4; ++j) hr[64 * j] = v[j];
            row_norm_store(v, a.attn_norm + (l + 1) * DM, XN + (size_t)row * DM, lane); }
    }
}

enum { PL_PROJ = 0, PL_MLAUP, PL_ATTN, PL_GNORM, PL_OUT, PL_ROUTER, PL_TOPK, PL_GATHER, PL_MOE1, PL_MOE2, PL_COMBINE, PL_COUNT };
constexpr int N_PHASES = 1 + DEPTH * PL_COUNT;
#define IN(k) (lo <= (k) && (k) < hi)
#define SEAM(k) do { if (IN((k) + 1)) xcd_barrier(bar); } while (0)
#define PH_LOCALS unsigned char* ws = a.ws; asm volatile("" : "+s"(ws)); int t_ = threadIdx.x; asm volatile("" : "+v"(t_)); int bx = blockIdx.x; asm volatile("" : "+s"(bx)); \
    const int vcu = (bx % 8) * (G / 8) + bx / 8; const int lane = t_ & 63, wave = __builtin_amdgcn_readfirstlane(t_ >> 6), gw = vcu * NWAVES + wave; (void)lane; (void)gw; (void)ws; (void)vcu;
template <int l> __device__ __forceinline__ void layer_phases(const MegaArgs& a, LAS unsigned char* lds, const XcdBarrier& bar, const int lo, const int hi) {
    constexpr int G = 256, ngw = G * NWAVES, pb = 1 + l * PL_COUNT;
        if (IN(pb + PL_PROJ)) { PH_LOCALS
            pg8::Gemm g{(bf16*)(ws + WS_XN), (bf16*)(ws + WS_WIN), DM, DM, DM}; pg8::StaticOrder S; S.init(NT / 256, NP / 256, G, bx, 0);
            pg8::EpiProj E{(bf16*)(ws + WS_PROJ), (float*)(ws + WS_COS64), (float*)(ws + WS_SIN64), (float*)(ws + WS_COS32), (float*)(ws + WS_SIN32), (float*)(ws + WS_CQSS), (float*)(ws + WS_CKVSS)};
            pg8::gemm_phase<pg8::EpiProj, pg8::StaticOrder, true>(lds, g, S, E);
            SEAM(pb + PL_PROJ);
        }
        if (IN(pb + PL_MLAUP)) { PH_LOCALS
            { pg8::Gemm g{(bf16*)(ws + WS_PROJ) + C_CQ, (bf16*)(ws + WS_WUQ), 256, NP, 256}; pg8::StaticOrder S; S.init(NT / 256, 3, G, bx, 0);
              typedef pg8::EpiMla<true, 576, 576> EQ; EQ E{(bf16*)(ws + WS_QB), (float*)(ws + WS_CQSS), 1.f / 256.f, (float*)(ws + WS_COS32), (float*)(ws + WS_SIN32)};
              pg8::gemm_phase<EQ, pg8::StaticOrder, true>(lds, g, S, E); }
            { pg8::Gemm g{(bf16*)(ws + WS_PROJ) + C_CKV, (bf16*)(ws + WS_WUKV), 128, NP, 128}; pg8::StaticOrder S; S.init(NT / 256, 3, G, bx, 0);
              typedef pg8::EpiMla<false, 768, 768> EK; EK E{(bf16*)(ws + WS_KV), (float*)(ws + WS_CKVSS), 1.f / 128.f, (float*)(ws + WS_COS32), (float*)(ws + WS_SIN32)};
              pg8::gemm_phase<EK, pg8::StaticOrder, true>(lds, g, S, E); }
            SEAM(pb + PL_MLAUP);
        }
        if (IN(pb + PL_ATTN)) { PH_LOCALS
            if (G == 256) { const att::AttnP P{(bf16*)(ws + WS_PROJ), (bf16*)(ws + WS_QB), (bf16*)(ws + WS_KV), (bf16*)(ws + WS_XN), (float*)(ws + WS_SS), a.na_rpb + (size_t)l * 4 * 15 * 31, a.swa_sink + l * 6}; att::attn_phase(P, lds, vcu); }
            SEAM(pb + PL_ATTN);
        }
        if (IN(pb + PL_GNORM)) { PH_LOCALS ph_gnorm(ws, gw, ngw, lane); SEAM(pb + PL_GNORM); }
        if (IN(pb + PL_OUT)) { PH_LOCALS
            pg8::Gemm g{(bf16*)(ws + WS_XN), (bf16*)(ws + WS_WOUT), DM, DM, DM}; pg8::StaticOrder S; S.init(NT / 256, DM / 256, G, bx, 0);
            pg8::EpiResid E{l == 0 ? a.x : a.H, a.H};
            pg8::gemm_phase<pg8::EpiResid, pg8::StaticOrder, true>(lds, g, S, E);
            SEAM(pb + PL_OUT);
        }
        if (IN(pb + PL_ROUTER)) { PH_LOCALS ph_router(a, l, lds, gw, ngw, lane); SEAM(pb + PL_ROUTER); }
        if (IN(pb + PL_TOPK)) { PH_LOCALS ph_topk(ws, lds, bx, G); SEAM(pb + PL_TOPK); }
        if (IN(pb + PL_GATHER)) { PH_LOCALS ph_gather(ws, gw, ngw, lane); SEAM(pb + PL_GATHER); }
        if (IN(pb + PL_MOE1)) { PH_LOCALS
            pg8::Gemm g{(bf16*)(ws + WS_PROJ), (bf16*)(ws + WS_WGU), DM, DM, DM}; pg8::StaticOrder S; S.init(NSLOTS / 256, 8, G, bx, 16);
            pg8::EpiSwiglu E{(bf16*)(ws + WS_HID)};
            pg8::gemm_phase<pg8::EpiSwiglu, pg8::StaticOrder, true>(lds, g, S, E);
            SEAM(pb + PL_MOE1);
        }
        if (IN(pb + PL_MOE2)) { PH_LOCALS
            pg8::Gemm g{(bf16*)(ws + WS_HID), (bf16*)(ws + WS_WD), DM, DM, DM}; pg8::StaticOrder S; S.init(NSLOTS / 256, 4, G, bx, 16);
            pg8::EpiGate E{(bf16*)(ws + WS_PROJ), (float*)(ws + WS_GATE)};
            pg8::gemm_phase<pg8::EpiGate, pg8::StaticOrder, true>(lds, g, S, E);
            SEAM(pb + PL_MOE2);
        }
        if (IN(pb + PL_COMBINE)) { PH_LOCALS
            ph_combine(a, l, gw, ngw, lane);
            if (l + 1 < DEPTH) { __syncthreads(); ph_prep(a, l + 1, lds, gw, ngw, wave, lane); }
            SEAM(pb + PL_COMBINE);
        }
}
__global__ void __launch_bounds__(NWAVES * 64, 2) mega(MegaArgs a) {
    extern __shared__ __attribute__((aligned(16))) unsigned char lds_raw[];
    LAS unsigned char* lds = (LAS unsigned char*)lds_raw;
    constexpr int G = 256;
    constexpr int ngw = G * NWAVES;
    for (int u = threadIdx.x; u < (LDS_BYTES - RING_BYTES) / 4; u += NWAVES * 64) ((LAS unsigned*)(lds + RING_BYTES))[u] = 0u;
    __syncthreads();
    XcdBarrier bar = xcd_barrier_post((unsigned*)(a.ws + WS_CTL) + CW_BAR, (volatile LAS unsigned*)(lds + MISC_OFF) + 8);
    const int lo = a.ph_lo, hi = a.ph_hi;
    if (IN(0)) { PH_LOCALS ph_prep(a, 0, lds, gw, ngw, wave, lane); ph_rope_tables(ws, bx * NWAVES * 64 + t_, G * NWAVES * 64); ph_norm_x(a, gw, ngw, lane); SEAM(0); }
    layer_phases<0>(a, lds, bar, lo, hi);
    layer_phases<1>(a, lds, bar, lo, hi);
    static_assert(DEPTH == 2, "two layers are written out");
}


#ifndef MK_PER_PHASE
#define MK_PER_PHASE 0
#endif
extern "C" void kernel_launch(void* const* d_in, const int* in_sizes, int n_in, void* d_out, int out_size, void* d_ws, size_t ws_size, hipStream_t stream) {
    if (n_in != 17 || out_size != NT * DM || ws_size < WS_END) { fprintf(stderr, "kernel_launch: unexpected shapes (n_in %d out %d ws %zu)\n", n_in, out_size, ws_size); return; }
    static int grid = 0;
    if (grid == 0) { int dev = 0, cus = 0; (void)hipGetDevice(&dev); (void)hipDeviceGetAttribute(&cus, hipDeviceAttributeMultiprocessorCount, dev);
        if (hipFuncSetAttribute((const void*)mega, hipFuncAttributeMaxDynamicSharedMemorySize, LDS_BYTES) != hipSuccess) fprintf(stderr, "hipFuncSetAttribute failed\n");
        if (cus != 256) fprintf(stderr, "kernel_launch: built for a 256-CU device (got %d CUs)\n", cus);
        grid = 256; }
    (void)hipMemsetAsync((char*)d_ws + WS_CTL, 0, 1 * MiB, stream);
    MegaArgs ma{};
    ma.x = (const float*)d_in[0]; ma.attn_norm = (const float*)d_in[1]; ma.w_in = (const float*)d_in[2]; ma.na_rpb = (const float*)d_in[3]; ma.q_norm = (const float*)d_in[4]; ma.w_uq = (const float*)d_in[5];
    ma.kv_norm = (const float*)d_in[6]; ma.w_ukv = (const float*)d_in[7]; ma.swa_sink = (const float*)d_in[8]; ma.group_norm = (const float*)d_in[9]; ma.w_out = (const float*)d_in[10]; ma.ffn_norm = (const float*)d_in[11];
    ma.w_router = (const float*)d_in[12]; ma.w_gate = (const float*)d_in[13]; ma.w_up = (const float*)d_in[14]; ma.w_down = (const float*)d_in[15]; ma.final_norm = (const float*)d_in[16];
    ma.H = (float*)d_out; ma.ws = (unsigned char*)d_ws;
#if MK_PER_PHASE
    for (int p = 0; p < N_PHASES; ++p) { ma.ph_lo = p; ma.ph_hi = p + 1; hipLaunchKernelGGL(mega, dim3(grid), dim3(NWAVES * 64), LDS_BYTES, stream, ma); }
#else
    ma.ph_lo = 0; ma.ph_hi = N_PHASES; hipLaunchKernelGGL(mega, dim3(grid), dim3(NWAVES * 64), LDS_BYTES, stream, ma);
#endif
}
```

```cpp
#include <hip/hip_runtime.h>
#include <cstdint>
#include <cstdio>

typedef unsigned short bf16;
constexpr int NB = 8, NS = 4096, DM = 1024, NT = NB * NS, NP = 2048, NE = 16, CAP = 512, DEPTH = 2;
constexpr int NSLOTS = NE * NB * CAP;
constexpr float LOG2E = 1.4426950408889634f;
constexpr float QS64 = 0.125f * LOG2E;
constexpr float QS96 = 0.10206207261596577f * LOG2E;
constexpr float EPS = 1e-6f;
constexpr int C_AQ = 0, C_AK = 256, C_AV = 512, C_CQ = 768, C_CKV = 1024, C_KR = 1152, C_SQ = 1184, C_SK = 1568, C_SV = 1696, C_END = 1824;

constexpr size_t MiB = 1u << 20;
constexpr size_t WS_CTL = 0;
constexpr size_t WS_COS64 = 1 * MiB, WS_SIN64 = WS_COS64 + 512 * 1024, WS_COS32 = 2 * MiB, WS_SIN32 = WS_COS32 + 256 * 1024;
constexpr size_t WS_WIN = 4 * MiB, WS_WUQ = 8 * MiB, WS_WUKV = 8 * MiB + 512 * 1024, WS_WOUT = 9 * MiB, WS_WGU = 12 * MiB, WS_WD = 76 * MiB;
constexpr size_t WS_CQSS = 108 * MiB, WS_CKVSS = WS_CQSS + 512 * 1024, WS_SS = 109 * MiB, WS_AFF = 111 * MiB, WS_INV = 113 * MiB, WS_IDX = 115 * MiB, WS_GATE = WS_IDX + 256 * 1024;
constexpr size_t WS_XN = 120 * MiB;
constexpr size_t WS_PROJ = 184 * MiB;
constexpr size_t WS_QB = 312 * MiB;
constexpr size_t WS_KV = 348 * MiB;
constexpr size_t WS_HID = 312 * MiB;
constexpr size_t WS_END = 440 * MiB;

__device__ __forceinline__ unsigned f2bf(float f) { unsigned u = __builtin_bit_cast(unsigned, f); return (u + 0x7fffu + ((u >> 16) & 1u)) >> 16; }
__device__ __forceinline__ float bf2f(unsigned short b) { return __builtin_bit_cast(float, (unsigned)b << 16); }
__device__ __forceinline__ float wave_sum(float v) {
#pragma unroll
    for (int o = 1; o < 64; o <<= 1) v += __shfl_xor(v, o);
    return v;
}

enum { PK_WIN = 0, PK_WUQ = 1, PK_WUKV = 2, PK_WOUT = 3, PK_WGU = 4, PK_WD = 5 };
__device__ __forceinline__ int prep_map(int kind, int n, float& sc, int& which) {
    sc = 1.f; which = 0;
    switch (kind) {
    case PK_WIN:
        if (n < 256) { sc = QS64; return n; }
        if (n < C_KR) return n;
        if (n < C_SQ) { const int p = n - C_KR, g = p >> 3, e = p & 7; return C_KR + 4 * g + (e & 3) + 16 * (e >> 2); }
        if (n < C_SK) { const int p = n - C_SQ, h = p >> 6, pp = p & 63, g = pp >> 3, e = pp & 7; sc = QS64; return C_SQ + h * 64 + 4 * g + (e & 3) + 32 * (e >> 2); }
        if (n < C_SV) { const int p = n - C_SK, h = p >> 6, pp = p & 63, g = pp >> 3, e = pp & 7; return C_SK + h * 64 + 4 * g + (e & 3) + 32 * (e >> 2); }
        if (n < C_END) return n;
        return -1;
    case PK_WUQ:
        if (n < 576) { const int h = n / 96, d = n % 96; sc = QS96; if (d < 64) return n; const int p = d - 64, g = p >> 3, e = p & 7; return h * 96 + 64 + 4 * g + (e & 3) + 16 * (e >> 2); }
        return -1;
    case PK_WUKV:
        if (n < 384) { const int h = n >> 6, d = n & 63; return h * 128 + d; }
        { const int m = n - 384, h = m >> 6, d = m & 63; return h * 128 + 64 + d; }
    case PK_WGU: { const int pn = n >> 8, half = (n >> 7) & 1, jj = n & 127; which = half; return 128 * pn + jj; }
    default: return n;
    }
}
#define LAS __attribute__((address_space(3)))
#define GAS __attribute__((address_space(1)))
namespace pg8 {
typedef short bf16x8 __attribute__((ext_vector_type(8)));
typedef float f32x4 __attribute__((ext_vector_type(4)));
typedef unsigned u32x4 __attribute__((ext_vector_type(4)));
constexpr int BM = 256, BK = 64, HALF = 128, HTB = HALF * BK * 2, STAGE_BYTES = 8 * HTB, NXCD = 8, WGM = 8;
__host__ __device__ __forceinline__ int lds_byte(int r, int c) { const int st = (r >> 4) * 2 + (c >> 5), rr = r & 15, cc = c & 31, ob = rr * 64 + cc * 2; return st * 1024 + (ob ^ (((ob >> 9) & 1) << 5)); }
__host__ __device__ __forceinline__ void stage_rc(int b, int& R, int& C) { const int st = b / 1024, sb = b % 1024, swz = sb ^ (((sb >> 9) & 1) << 5); R = (st >> 1) * 16 + swz / 64; C = (st & 1) * 32 + (swz % 64) / 2; }
__host__ __device__ __forceinline__ int perm32(int rho) { const int n = rho >> 4, i = rho & 15; return 8 * (i >> 2) + 4 * n + (i & 3); }
struct Unit { int pm, pn, pb; };
struct Gemm { const bf16* A; const bf16* Bt; int K, lda, ldb; };
struct StaticOrder {
    int nM, nN, nwg, G, c, gm;
    __device__ void init(int nM_, int nN_, int G_, int c_, int gm_) { nM = nM_; nN = nN_; nwg = nM * nN; G = G_; c = c_; gm = gm_; }
    __device__ bool next(int i, Unit& u) const {
        const long L = (long)i * G + c; if (L >= nwg) return false;
        int wgid = (int)L; { const int q = nwg / NXCD, r = nwg % NXCD, xcd = wgid % NXCD, off = wgid / NXCD; wgid = (xcd < r ? xcd * (q + 1) : r * (q + 1) + (xcd - r) * q) + off; }
        const int nig = WGM * nN, gid = wgid / nig, fm = gid * WGM, gsz = (nM - fm) < WGM ? (nM - fm) : WGM;
        u.pm = fm + ((wgid % nig) % gsz); u.pn = (wgid % nig) / gsz; u.pb = gm ? (u.pm / gm) * nN + u.pn : u.pn; return true;
    }
};
__device__ __forceinline__ unsigned cvt_pk_bf16(float lo, float hi) { unsigned r; asm volatile("v_cvt_pk_bf16_f32 %0, %1, %2" : "=v"(r) : "v"(lo), "v"(hi)); return r; }

template <class Epi, class Sched, bool ALIGN_EPI>
__device__ __forceinline__ void gemm_phase(LAS unsigned char* lds, const Gemm g, const Sched& S, const Epi& E) {
    int tid = threadIdx.x; asm volatile("" : "+v"(tid));
    const int wid = __builtin_amdgcn_readfirstlane(tid >> 6), lane = tid & 63, wr = wid >> 2, wc = wid & 3, fr = lane & 15, fq = lane >> 4;
    const int K = g.K, nt = K / BK;
    unsigned voffA[2], voffB[2];
#pragma unroll
    for (int i = 0; i < 2; ++i) { int R, C; stage_rc(tid * 16 + i * 8192, R, C); const int Rb = Epi::PERM ? ((R & ~31) + perm32(R & 31)) : R;
        voffA[i] = (unsigned)(R * g.lda + C) * 2u; voffB[i] = (unsigned)(Rb * g.ldb + C) * 2u; }
    const size_t kstep = (size_t)(BK * 2);
    const size_t hstepA = (size_t)HALF * g.lda * 2, hstepB = (size_t)HALF * g.ldb * 2, tstepA = 2 * hstepA, tstepB = 2 * hstepB;
    const unsigned ldsw = (unsigned)wid * 1024u;
    const int aoff = lds_byte(wr * 64 + fr, fq * 8), boff = lds_byte(wc * 32 + fr, fq * 8);
#define PG8_SA(b, h) (((b) * 2 + (h)) * HTB)
#define PG8_SB(b, h) ((4 + (b) * 2 + (h)) * HTB)
#define PG8_STAGE(bufoff, gbase, voff) do { _Pragma("unroll") for (int _i = 0; _i < 2; ++_i) \
        __builtin_amdgcn_global_load_lds((const unsigned*)((const char*)(gbase) + (voff)[_i]), (LAS unsigned*)(lds + (bufoff) + ldsw + _i * 8192), 16, 0, 0); } while (0)
#define PG8_LDA(dst, b, h) do { _Pragma("unroll") for (int m = 0; m < 4; ++m) _Pragma("unroll") for (int k = 0; k < 2; ++k) dst[m][k] = *(const LAS bf16x8*)(lds + PG8_SA(b, h) + aoff + m * 2048 + k * 1024); } while (0)
#define PG8_LDB(dst, b, h) do { _Pragma("unroll") for (int n = 0; n < 2; ++n) _Pragma("unroll") for (int k = 0; k < 2; ++k) dst[n][k] = *(const LAS bf16x8*)(lds + PG8_SB(b, h) + boff + n * 2048 + k * 1024); } while (0)
#define PG8_MMA(ai, bj, At, Bt) do { __builtin_amdgcn_s_setprio(1); _Pragma("unroll") for (int m = 0; m < 4; ++m) _Pragma("unroll") for (int n = 0; n < 2; ++n) _Pragma("unroll") for (int k = 0; k < 2; ++k) \
        acc[ai][bj][m][n] = __builtin_amdgcn_mfma_f32_16x16x32_bf16(Bt[n][k], At[m][k], acc[ai][bj][m][n], 0, 0, 0); __builtin_amdgcn_s_setprio(0); } while (0)
#define PG8_WAIT_V(n) asm volatile("s_waitcnt vmcnt(" #n ")" ::: "memory")
#define PG8_WAIT_L(n) asm volatile("s_waitcnt lgkmcnt(" #n ")" ::: "memory")
#define PG8_BAR __builtin_amdgcn_s_barrier()
#define PG8_SCHED __builtin_amdgcn_sched_barrier(0)
    Unit cur, nxt; int ui = 0;
    if (!S.next(0, cur)) return;
    f32x4 acc[2][2][4][2];
#pragma unroll
    for (int a = 0; a < 2; ++a)
#pragma unroll
        for (int b = 0; b < 2; ++b)
#pragma unroll
            for (int m = 0; m < 4; ++m)
#pragma unroll
                for (int n = 0; n < 2; ++n) acc[a][b][m][n] = (f32x4){0.f, 0.f, 0.f, 0.f};
    bf16x8 At[4][2], B0[2][2], B1[2][2];
    const char* cA = (const char*)g.A + (size_t)cur.pm * tstepA; const char* cB = (const char*)g.Bt + (size_t)cur.pb * tstepB;
    PG8_STAGE(PG8_SB(0, 0), cB, voffB); PG8_STAGE(PG8_SB(0, 1), cB + hstepB, voffB); PG8_STAGE(PG8_SA(0, 0), cA, voffA); PG8_STAGE(PG8_SA(0, 1), cA + hstepA, voffA);
    if (wr == 1) PG8_BAR;
    PG8_WAIT_V(2); PG8_BAR;
    PG8_STAGE(PG8_SB(1, 0), cB + kstep, voffB); PG8_STAGE(PG8_SA(1, 0), cA + kstep, voffA); PG8_STAGE(PG8_SB(1, 1), cB + hstepB + kstep, voffB);
    PG8_WAIT_V(6); PG8_BAR;
    for (;;) {
        const bool has_next = S.next(ui + 1, nxt);
        const char* nA = has_next ? (const char*)g.A + (size_t)nxt.pm * tstepA : cA; const char* nB = has_next ? (const char*)g.Bt + (size_t)nxt.pb * tstepB : cB;
        for (int t = 0; t < nt; t += 2) {
            const bool last = (t == nt - 2);
            const char* a1 = cA + (size_t)(t + 1) * kstep;
            const char* a2 = last ? nA : cA + (size_t)(t + 2) * kstep; const char* b2 = last ? nB : cB + (size_t)(t + 2) * kstep;
            const char* a3 = a2 + kstep; const char* b3 = b2 + kstep;
            PG8_LDB(B0, 0, 0); PG8_LDB(B1, 0, 1); PG8_SCHED; PG8_LDA(At, 0, 0); PG8_STAGE(PG8_SA(1, 1), a1 + hstepA, voffA);
            PG8_WAIT_V(8); PG8_WAIT_L(0); PG8_BAR; PG8_MMA(0, 0, At, B0); PG8_MMA(0, 1, At, B1); PG8_BAR; PG8_SCHED;
            PG8_LDA(At, 0, 1); PG8_STAGE(PG8_SB(0, 0), b2, voffB); PG8_STAGE(PG8_SB(0, 1), b2 + hstepB, voffB); PG8_STAGE(PG8_SA(0, 0), a2, voffA);
            PG8_WAIT_V(8); PG8_WAIT_L(0); PG8_BAR; PG8_MMA(1, 0, At, B0); PG8_MMA(1, 1, At, B1); PG8_BAR; PG8_SCHED;
            PG8_LDB(B0, 1, 0); PG8_LDB(B1, 1, 1); PG8_SCHED; PG8_LDA(At, 1, 0); PG8_STAGE(PG8_SA(0, 1), a2 + hstepA, voffA);
            PG8_WAIT_V(8); PG8_WAIT_L(0); PG8_BAR; PG8_MMA(0, 0, At, B0); PG8_MMA(0, 1, At, B1); PG8_BAR; PG8_SCHED;
            PG8_LDA(At, 1, 1); PG8_STAGE(PG8_SB(1, 0), b3, voffB); PG8_STAGE(PG8_SB(1, 1), b3 + hstepB, voffB); PG8_STAGE(PG8_SA(1, 0), a3, voffA);
            PG8_WAIT_V(8); PG8_WAIT_L(0); PG8_BAR; PG8_MMA(1, 0, At, B0); PG8_MMA(1, 1, At, B1); PG8_BAR; PG8_SCHED;
        }
        if constexpr (ALIGN_EPI) { if (wr == 0) PG8_BAR; }
        { int t2 = threadIdx.x; asm volatile("" : "+v"(t2)); E(acc, cur, wr, wc, t2 & 15, (t2 >> 4) & 3); }
        if (!has_next) break;
#pragma unroll
        for (int a = 0; a < 2; ++a)
#pragma unroll
            for (int b = 0; b < 2; ++b)
#pragma unroll
                for (int m = 0; m < 4; ++m)
#pragma unroll
                    for (int n = 0; n < 2; ++n) acc[a][b][m][n] = (f32x4){0.f, 0.f, 0.f, 0.f};
        cur = nxt; cA = nA; cB = nB; ++ui;
        if constexpr (ALIGN_EPI) { if (wr == 1) PG8_BAR; }
    }
    PG8_WAIT_V(0);
    if constexpr (!ALIGN_EPI) { if (wr == 0) PG8_BAR; }
    PG8_BAR;
#undef PG8_SA
#undef PG8_SB
#undef PG8_STAGE
#undef PG8_LDA
#undef PG8_LDB
#undef PG8_MMA
#undef PG8_WAIT_V
#undef PG8_WAIT_L
#undef PG8_BAR
#undef PG8_SCHED
}

typedef const f32x4 (&AccRef)[2][2][4][2];
__device__ __forceinline__ void st_bf16x8(bf16* p, f32x4 v0, f32x4 v1) { u32x4 w; w.x = cvt_pk_bf16(v0[0], v0[1]); w.y = cvt_pk_bf16(v0[2], v0[3]); w.z = cvt_pk_bf16(v1[0], v1[1]); w.w = cvt_pk_bf16(v1[2], v1[3]); *(u32x4*)p = w; }
struct EpiProj {
    static constexpr bool PERM = true;
    bf16* P; const float *c64, *s64, *c32, *s32; float *cqss, *ckvss;
    __device__ __forceinline__ void operator()(AccRef acc, const Unit& u, int wr, int wc, int fr, int fq) const {
#pragma unroll
        for (int ai = 0; ai < 2; ++ai)
#pragma unroll
            for (int m = 0; m < 4; ++m) { const int row = u.pm * BM + ai * HALF + wr * 64 + m * 16 + fr; const int pos = row & (NS - 1); float ssq = 0.f;
#pragma unroll
                for (int bj = 0; bj < 2; ++bj) { const int cw = u.pn * BM + bj * HALF + wc * 32, col0 = cw + 8 * fq; f32x4 v0 = acc[ai][bj][m][0], v1 = acc[ai][bj][m][1];
                    if (cw >= C_SQ && cw < C_SV) { const int g = ((col0 - C_SQ) & 63) >> 3; const f32x4 c = *(const f32x4*)(c64 + pos * 32 + 4 * g), s = *(const f32x4*)(s64 + pos * 32 + 4 * g);
                        const f32x4 o0 = v0 * c - v1 * s, o1 = v1 * c + v0 * s; v0 = o0; v1 = o1; }
                    else if (cw == C_KR) { const f32x4 c = *(const f32x4*)(c32 + pos * 16 + 4 * fq), s = *(const f32x4*)(s32 + pos * 16 + 4 * fq);
                        const f32x4 o0 = v0 * c - v1 * s, o1 = v1 * c + v0 * s; v0 = o0; v1 = o1; }
                    if (u.pn == 3 || (u.pn == 4 && bj == 0)) ssq += (v0[0] * v0[0] + v0[1] * v0[1]) + (v0[2] * v0[2] + v0[3] * v0[3]) + (v1[0] * v1[0] + v1[1] * v1[1]) + (v1[2] * v1[2] + v1[3] * v1[3]);
                    st_bf16x8(P + (size_t)row * NP + col0, v0, v1); }
                if (u.pn == 3 || u.pn == 4) { ssq += __shfl_xor(ssq, 16); ssq += __shfl_xor(ssq, 32); if (fq == 0) (u.pn == 3 ? cqss : ckvss)[(size_t)row * 4 + wc] = ssq; }
            }
    }
};
template <bool QMODE, int ldc, int ncols> struct EpiMla {
    static constexpr bool PERM = true;
    bf16* O; const float* ss; float ssinv; const float *c32, *s32;
    __device__ __forceinline__ void operator()(AccRef acc, const Unit& u, int wr, int wc, int fr, int fq) const {
#pragma unroll
        for (int ai = 0; ai < 2; ++ai)
#pragma unroll
            for (int m = 0; m < 4; ++m) { const int row = u.pm * BM + ai * HALF + wr * 64 + m * 16 + fr; const int pos = row & (NS - 1);
                const f32x4 p = *(const f32x4*)(ss + (size_t)row * 4); const float rs = rsqrtf(((p[0] + p[1]) + (p[2] + p[3])) * ssinv + EPS);
#pragma unroll
                for (int bj = 0; bj < 2; ++bj) { const int cw = u.pn * BM + bj * HALF + wc * 32, col0 = cw + 8 * fq; if (cw >= ncols) continue;
                    f32x4 v0 = acc[ai][bj][m][0] * rs, v1 = acc[ai][bj][m][1] * rs;
                    if (QMODE && (cw % 96) == 64) { const f32x4 c = *(const f32x4*)(c32 + pos * 16 + 4 * fq), s = *(const f32x4*)(s32 + pos * 16 + 4 * fq);
                        const f32x4 o0 = v0 * c - v1 * s, o1 = v1 * c + v0 * s; v0 = o0; v1 = o1; }
                    st_bf16x8(O + (size_t)row * ldc + col0, v0, v1); }
                asm volatile("" ::: "memory"); }
    }
};
struct EpiResid {
    static constexpr bool PERM = false;
    const float* Hin; float* Hout;
    __device__ __forceinline__ void operator()(AccRef acc, const Unit& u, int wr, int wc, int fr, int fq) const {
#pragma unroll
        for (int ai = 0; ai < 2; ++ai)
#pragma unroll
            for (int m = 0; m < 4; ++m) { const size_t off = (size_t)(u.pm * BM + ai * HALF + wr * 64 + m * 16 + fr) * DM + u.pn * BM + wc * 32 + 4 * fq;
#pragma unroll
                for (int bj = 0; bj < 2; ++bj)
#pragma unroll
                    for (int n = 0; n < 2; ++n) { const f32x4 b = *(const f32x4*)(Hin + off + bj * HALF + n * 16); *(f32x4*)(Hout + off + bj * HALF + n * 16) = b + acc[ai][bj][m][n]; } }
    }
};
struct EpiSwiglu {
    static constexpr bool PERM = true;
    bf16* Hd;
    __device__ __forceinline__ void operator()(AccRef acc, const Unit& u, int wr, int wc, int fr, int fq) const {
#pragma unroll
        for (int ai = 0; ai < 2; ++ai)
#pragma unroll
            for (int m = 0; m < 4; ++m) { const size_t row = (size_t)(u.pm * BM + ai * HALF + wr * 64 + m * 16 + fr); f32x4 o[2];
#pragma unroll
                for (int n = 0; n < 2; ++n) { const f32x4 gt = acc[ai][0][m][n], up = acc[ai][1][m][n];
#pragma unroll
                    for (int e = 0; e < 4; ++e) o[n][e] = gt[e] * __builtin_amdgcn_rcpf(1.f + __builtin_amdgcn_exp2f(-gt[e] * LOG2E)) * up[e]; }
                st_bf16x8(Hd + row * DM + u.pn * HALF + wc * 32 + 8 * fq, o[0], o[1]); }
    }
};
struct EpiGate {
    static constexpr bool PERM = true;
    bf16* Y; const float* gate;
    __device__ __forceinline__ void operator()(AccRef acc, const Unit& u, int wr, int wc, int fr, int fq) const {
#pragma unroll
        for (int ai = 0; ai < 2; ++ai)
#pragma unroll
            for (int m = 0; m < 4; ++m) { const size_t row = (size_t)(u.pm * BM + ai * HALF + wr * 64 + m * 16 + fr); const float gt = gate[row];
#pragma unroll
                for (int bj = 0; bj < 2; ++bj) st_bf16x8(Y + row * DM + u.pn * BM + bj * HALF + wc * 32 + 8 * fq, acc[ai][bj][m][0] * gt, acc[ai][bj][m][1] * gt); }
    }
};
}


namespace att {
typedef short bf16x8 __attribute__((ext_vector_type(8)));
typedef short s16x4 __attribute__((ext_vector_type(4)));
typedef float f32x16 __attribute__((ext_vector_type(16)));
typedef float f32x4 __attribute__((ext_vector_type(4)));
typedef unsigned u32x4 __attribute__((ext_vector_type(4)));
typedef float f32x2_t __attribute__((ext_vector_type(2))); typedef __bf16 bf16x2_t __attribute__((ext_vector_type(2)));
typedef short v4i16_t __attribute__((ext_vector_type(4)));
constexpr int KSLOT = 12288, VSLOT = 8192, NSL = 3;
constexpr int L_K = 0, L_V = NSL * KSLOT, L_WS = L_V + NSL * VSLOT, L_OST = L_WS + 8 * 256, L_BIAS = L_OST + 8 * 4096, L_END = L_BIAS + 2048;
constexpr float THR = 8.f;
constexpr int ATT_PROBE = 0;
constexpr bool LSUM_MFMA = true;
__device__ __forceinline__ int crow(int r, int hi) { return (r & 3) + 8 * (r >> 2) + 4 * hi; }
__device__ __forceinline__ unsigned cvtpk(float lo, float hi) { f32x2_t v = {lo, hi}; bf16x2_t b = __builtin_convertvector(v, bf16x2_t); return __builtin_bit_cast(unsigned, b); }
__device__ __forceinline__ s16x4 vtr(const LAS unsigned char* p) { return __builtin_bit_cast(s16x4, __builtin_amdgcn_ds_read_tr16_b64_v4i16((LAS v4i16_t*)p)); }
__device__ __forceinline__ void glds(const bf16* src, unsigned lds_dst) { unsigned keep;
    asm volatile("s_mov_b32 %0, m0\n\ts_mov_b32 m0, %2\n\ts_nop 0\n\tglobal_load_lds_dwordx4 %1, off\n\ts_mov_b32 m0, %0" : "=&s"(keep) : "v"(src), "s"(lds_dst) : "memory"); }
struct AttnP { const bf16 *PROJ, *QB, *KV; bf16* O; float* SS; const float* rpb; const float* sink; };
#define ATT_WAIT_BAR() do { if (PROBE != 3) asm volatile("s_waitcnt vmcnt(0) lgkmcnt(0)\n\ts_barrier" ::: "memory"); } while (0)

template <int TYPE, int PROBE = 0> __device__ __forceinline__ void attn_unit(const AttnP& P, int b, int h, int qb, LAS unsigned char* lds) {
    constexpr int ND0 = (TYPE == 1) ? 6 : 4;
    int tid = threadIdx.x; asm volatile("" : "+v"(tid));
    const int lane = tid & 63, r32 = lane & 31, hi = lane >> 5, wid = __builtin_amdgcn_readfirstlane(tid >> 6);
    const bool ordA = wid < 4;
    const int q0 = qb * 256, qw0 = q0 + wid * 32; const size_t tokb = (size_t)b * NS;
    int ntile, kbase, ta, tb;
    if (TYPE == 1) { ntile = NS / 64; kbase = 0; ta = 0; tb = ntile - 1; }
    else if (TYPE == 2) { kbase = max(q0 - 128, 0); const int ke = min(q0 + 384, NS); ntile = (ke - kbase) >> 6; ta = max(qw0 - 128 - kbase, 0) >> 6; tb = min(ntile - 1, (qw0 + 159 - kbase) >> 6); }
    else { const int r0 = qb * 4; kbase = min(max(r0 - 4, 0), 56); ntile = min(max(r0 - 1, 0), 56) + 7 - kbase + 1; const int r = r0 + (wid >> 1); ta = min(max(r - 4, 0), 56) - kbase; tb = ta + 7; }
    const int kvh = (TYPE == 2) ? h / 3 : h;
    const bf16 *ksrc, *ksrc2 = nullptr, *vsrc; size_t kpitch, vpitch;
    { const size_t key0 = tokb + (TYPE == 0 ? (size_t)kbase * 64 : (size_t)kbase); const int vrow = 16 * (wid & 3) + (lane >> 2), vcol = (wid >> 2) * 32 + (lane & 3) * 8;
      if (TYPE == 0) { ksrc = P.PROJ + (key0 + lane) * NP + C_AK + h * 64 + wid * 8; vsrc = P.PROJ + (key0 + vrow) * NP + C_AV + h * 64 + vcol; kpitch = vpitch = NP; }
      else if (TYPE == 1) { ksrc = P.KV + (key0 + lane) * 768 + h * 64 + wid * 8; ksrc2 = P.PROJ + (key0 + lane) * NP + C_KR + (wid & 3) * 8; vsrc = P.KV + (key0 + vrow) * 768 + 384 + h * 64 + vcol; kpitch = vpitch = 768; }
      else { ksrc = P.PROJ + (key0 + lane) * NP + C_SK + kvh * 64 + wid * 8; vsrc = P.PROJ + (key0 + vrow) * NP + C_SV + kvh * 64 + vcol; kpitch = vpitch = NP; } }
    const unsigned kdst = (unsigned)(uintptr_t)(lds + L_K) + wid * 1024, vdst = (unsigned)(uintptr_t)(lds + L_V) + wid * 1024;
#define ATT_DMA(t, slot) do { if (PROBE == 2 || PROBE == 3) break; glds(ksrc + (size_t)(t) * 64 * kpitch, (unsigned)__builtin_amdgcn_readfirstlane(kdst + (slot) * KSLOT)); if (TYPE == 1 && wid < 4) glds(ksrc2 + (size_t)(t) * 64 * NP, (unsigned)__builtin_amdgcn_readfirstlane(kdst + (slot) * KSLOT + 8192)); \
        glds(vsrc + (size_t)(t) * 64 * vpitch, (unsigned)__builtin_amdgcn_readfirstlane(vdst + (slot) * VSLOT)); } while (0)
    LAS float* biasL = (LAS float*)(lds + L_BIAS);
    if (TYPE == 0) { for (int i = tid; i < 15 * 31; i += 512) biasL[i] = P.rpb[h * 465 + i] * LOG2E; }
    bf16x8 qr[ND0];
    { const bf16* qp = (TYPE == 1) ? P.QB + (tokb + qw0 + r32) * 576 + h * 96 : P.PROJ + (tokb + qw0 + r32) * NP + (TYPE == 0 ? C_AQ : C_SQ) + h * 64;
#pragma unroll
      for (int d0 = 0; d0 < ND0; ++d0) qr[d0] = *(const bf16x8*)(qp + d0 * 16 + hi * 8); }
    LAS float* wsf = (LAS float*)(lds + L_WS) + wid * 64;
    float m = (TYPE == 2) ? P.sink[h] * LOG2E : 0.f;
    f32x16 negm; { const float nm = -m;
#pragma unroll
      for (int r = 0; r < 16; ++r) negm[r] = nm; }
    f32x16 o[2]; o[0] = f32x16{}; o[1] = f32x16{};
    f32x16 lacc;
    { const float l0 = (TYPE == 2) ? 1.f : 0.f;
#pragma unroll
      for (int r = 0; r < 16; ++r) lacc[r] = l0; }
    float lsum = (TYPE == 2 && hi == 0) ? 1.f : 0.f;
    const bf16x8 ones = (bf16x8){0x3F80, 0x3F80, 0x3F80, 0x3F80, 0x3F80, 0x3F80, 0x3F80, 0x3F80};
    f32x16 sA0, sA1, sB0, sB1;
#define ATT_QK(X0, X1, tt, sl) do { const LAS unsigned char* Kp = lds + L_K + (sl) * KSLOT + hi * 1024 + r32 * 16; X0 = negm; X1 = negm; \
        bf16x8 ka0 = *(const LAS bf16x8*)(Kp), ka1 = *(const LAS bf16x8*)(Kp + 512); \
        _Pragma("unroll") for (int d0 = 0; d0 < ND0; ++d0) { bf16x8 kb0 = ka0, kb1 = ka1; \
            if (d0 + 1 < ND0) { kb0 = *(const LAS bf16x8*)(Kp + (d0 + 1) * 2048); kb1 = *(const LAS bf16x8*)(Kp + (d0 + 1) * 2048 + 512); }     \
            X0 = __builtin_amdgcn_mfma_f32_32x32x16_bf16(ka0, qr[d0], X0, 0, 0, 0); X1 = __builtin_amdgcn_mfma_f32_32x32x16_bf16(ka1, qr[d0], X1, 0, 0, 0); ka0 = kb0; ka1 = kb1; } \
        __builtin_amdgcn_sched_group_barrier(0x100, 2, 0); __builtin_amdgcn_sched_group_barrier(0x100, 2, 0);        \
        _Pragma("unroll") for (int d0 = 0; d0 + 2 < ND0; ++d0) { __builtin_amdgcn_sched_group_barrier(0x8, 2, 0); __builtin_amdgcn_sched_group_barrier(0x100, 2, 0); } \
        __builtin_amdgcn_sched_group_barrier(0x8, 2, 0); __builtin_amdgcn_sched_group_barrier(0x8, 2, 0); \
        if (TYPE == 2) { const int dq = qw0 + r32 - (kbase + (tt) * 64) - 4 * hi; \
            _Pragma("unroll") for (int r = 0; r < 16; ++r) { const int d0_ = dq - ((r & 3) + 8 * (r >> 2)), d1_ = d0_ - 32; \
                if (d0_ > 128 || d0_ < -128) X0[r] = -INFINITY; if (d1_ > 128 || d1_ < -128) X1[r] = -INFINITY; } } \
        if (TYPE == 0) { const int c = (wid & 1) * 32 + r32, cs = min(max(c - 8, 0), 48); const int rq = qb * 4 + (wid >> 1), kr = kbase + (tt); const LAS float* brow = biasL + (kr - rq + 7) * 31 + 15 - c; \
            _Pragma("unroll") for (int rr = 0; rr < 16; ++rr) { const int kc0 = crow(rr, hi), kc1 = kc0 + 32; \
                const bool v0 = kc0 >= cs && kc0 < cs + 16, v1 = kc1 >= cs && kc1 < cs + 16; \
                X0[rr] = v0 ? X0[rr] + brow[v0 ? kc0 : c] : -INFINITY; X1[rr] = v1 ? X1[rr] + brow[v1 ? kc1 : c] : -INFINITY; } } \
        asm volatile("s_nop 15\n\ts_nop 7" : "+v"(X0), "+v"(X1)); } while (0)
#define ATT_MAX3(a, b, c) ({ float r_; asm("v_max3_f32 %0, %1, %2, %3" : "=v"(r_) : "v"(a), "v"(b), "v"(c)); r_; })
#define ATT_STEP(ORDA, C0, C1, N0, N1, t) do { \
        if ((t) + 1 < ntile) ATT_WAIT_BAR(); \
        if ((t) + 2 < ntile) ATT_DMA((t) + 2, sl_nn); \
        const bool act = ((t) >= ta && (t) <= tb), nact = ((t) + 1 >= ta && (t) + 1 <= tb); \
        if (ORDA && nact) ATT_QK(N0, N1, (t) + 1, sl_nxt); \
        if (act) { \
            float ma = 0.f, mb = 0.f; if (PROBE != 4) { ma = ATT_MAX3(C0[0], C0[1], C1[0]); mb = ATT_MAX3(C0[2], C0[3], C1[1]); ma = ATT_MAX3(ma, C1[2], C1[3]); \
            _Pragma("unroll") for (int r = 4; r < 16; r += 4) { ma = ATT_MAX3(ma, C0[r], C0[r + 1]); mb = ATT_MAX3(mb, C0[r + 2], C0[r + 3]); ma = ATT_MAX3(ma, C1[r], C1[r + 1]); mb = ATT_MAX3(mb, C1[r + 2], C1[r + 3]); } } \
            float rm = fmaxf(ma, mb); \
            { auto rr = __builtin_amdgcn_permlane32_swap(__float_as_uint(rm), __float_as_uint(rm), false, false); rm = fmaxf(__uint_as_float(rr[0]), __uint_as_float(rr[1])); } \
            const bool first = (TYPE != 2) && ((t) == ta); \
            if (first || __any(rm > THR)) { const float dl = first ? rm : fmaxf(rm, 0.f), f = first ? 1.f : __builtin_amdgcn_exp2f(-dl); m += dl; lsum *= f; \
                _Pragma("unroll") for (int r = 0; r < 16; ++r) { C0[r] -= dl; C1[r] -= dl; negm[r] = -m; } \
                if (ORDA && nact) { _Pragma("unroll") for (int r = 0; r < 16; ++r) { N0[r] -= dl; N1[r] -= dl; } } \
                if (hi == 0) wsf[r32] = f; \
                _Pragma("unroll") for (int g = 0; g < 4; ++g) { const f32x4 fv = *(const LAS f32x4*)(wsf + 8 * g + 4 * hi); \
                    _Pragma("unroll") for (int e = 0; e < 4; ++e) { o[0][4 * g + e] *= fv[e]; o[1][4 * g + e] *= fv[e]; lacc[4 * g + e] *= fv[e]; } } } \
            const LAS unsigned char* Vp = lds + L_V + sl_cur * VSLOT + ((lane >> 4) & 1) * 32 + (lane & 3) * 8 + (4 * hi + ((lane & 15) >> 2)) * 64; \
            s16x4 va[4], vb[4]; \
            va[0] = vtr(Vp); va[1] = vtr(Vp + 512); va[2] = vtr(Vp + 4096); va[3] = vtr(Vp + 4096 + 512);        \
            if (PROBE != 4) { _Pragma("unroll") for (int r = 0; r < 16; ++r) { C0[r] = __builtin_amdgcn_exp2f(C0[r]); C1[r] = __builtin_amdgcn_exp2f(C1[r]); } } \
            if (!LSUM_MFMA) { float sa = 0.f, sb = 0.f; _Pragma("unroll") for (int r = 0; r < 16; ++r) { sa += C0[r]; sb += C1[r]; } lsum += sa + sb; } \
            u32x4 pw[4]; \
            _Pragma("unroll") for (int e = 0; e < 4; ++e) { pw[0][e] = cvtpk(C0[2 * e], C0[2 * e + 1]); pw[1][e] = cvtpk(C0[8 + 2 * e], C0[9 + 2 * e]); pw[2][e] = cvtpk(C1[2 * e], C1[2 * e + 1]); pw[3][e] = cvtpk(C1[8 + 2 * e], C1[9 + 2 * e]); } \
            _Pragma("unroll") for (int ks = 0; ks < 4; ++ks) { const bf16x8 pa = __builtin_bit_cast(bf16x8, pw[ks]); \
                if (ks + 1 < 4) { vb[0] = vtr(Vp + (ks + 1) * 1024); vb[1] = vtr(Vp + (ks + 1) * 1024 + 512); vb[2] = vtr(Vp + 4096 + (ks + 1) * 1024); vb[3] = vtr(Vp + 4096 + (ks + 1) * 1024 + 512); }     \
                o[0] = __builtin_amdgcn_mfma_f32_32x32x16_bf16(pa, ((bf16x8){va[0][0], va[0][1], va[0][2], va[0][3], va[1][0], va[1][1], va[1][2], va[1][3]}), o[0], 0, 0, 0); \
                o[1] = __builtin_amdgcn_mfma_f32_32x32x16_bf16(pa, ((bf16x8){va[2][0], va[2][1], va[2][2], va[2][3], va[3][0], va[3][1], va[3][2], va[3][3]}), o[1], 0, 0, 0); \
                if (LSUM_MFMA) lacc = __builtin_amdgcn_mfma_f32_32x32x16_bf16(pa, ones, lacc, 0, 0, 0); \
                _Pragma("unroll") for (int q_ = 0; q_ < 4; ++q_) va[q_] = vb[q_]; } \
            __builtin_amdgcn_sched_group_barrier(0x100, 4, 1); \
            _Pragma("unroll") for (int ks = 0; ks < 3; ++ks) { __builtin_amdgcn_sched_group_barrier(0x100, 4, 1); __builtin_amdgcn_sched_group_barrier(0x8, LSUM_MFMA ? 3 : 2, 1); } \
            __builtin_amdgcn_sched_group_barrier(0x8, LSUM_MFMA ? 3 : 2, 1); \
        } \
        if (!(ORDA) && nact) ATT_QK(N0, N1, (t) + 1, sl_nxt); \
        { const int tmp = sl_cur; sl_cur = sl_nxt; sl_nxt = sl_nn; sl_nn = tmp; } } while (0)
    ATT_DMA(0, 0);
    if (ntile > 1) ATT_DMA(1, 1);
    if (PROBE == 2 || PROBE == 3) {} else if (ntile > 1) { if (TYPE == 1 && wid < 4) asm volatile("s_waitcnt vmcnt(3)" ::: "memory"); else asm volatile("s_waitcnt vmcnt(2)" ::: "memory"); } else asm volatile("s_waitcnt vmcnt(0)" ::: "memory");
    asm volatile("s_waitcnt lgkmcnt(0)\n\ts_barrier" ::: "memory");
    if (ta == 0) ATT_QK(sA0, sA1, 0, 0);
    int sl_cur = 0, sl_nxt = 1, sl_nn = 2;
    if (ordA) {
        for (int t = 0; t < ntile; t += 2) { ATT_STEP(true, sA0, sA1, sB0, sB1, t); if (t + 1 < ntile) ATT_STEP(true, sB0, sB1, sA0, sA1, t + 1); }
    } else {
        for (int t = 0; t < ntile; t += 2) { ATT_STEP(false, sA0, sA1, sB0, sB1, t); if (t + 1 < ntile) ATT_STEP(false, sB0, sB1, sA0, sA1, t + 1); }
    }
    LAS bf16* stg = (LAS bf16*)(lds + L_OST) + wid * 2048;
    if (!LSUM_MFMA) { { auto rr = __builtin_amdgcn_permlane32_swap(__float_as_uint(lsum), __float_as_uint(lsum), false, false); lsum = __uint_as_float(rr[0]) + __uint_as_float(rr[1]); }
        if (hi == 0) wsf[32 + r32] = lsum;
#pragma unroll
        for (int g = 0; g < 4; ++g) { const f32x4 lv = *(const LAS f32x4*)(wsf + 32 + 8 * g + 4 * hi);
#pragma unroll
            for (int e = 0; e < 4; ++e) lacc[4 * g + e] = lv[e]; } }
#pragma unroll
    for (int r = 0; r < 16; ++r) { const float iv = __builtin_amdgcn_rcpf(lacc[r]); const int orow = crow(r, hi);
        stg[orow * 64 + r32] = (bf16)(cvtpk(o[0][r] * iv, 0.f) & 0xffff); stg[orow * 64 + 32 + r32] = (bf16)(cvtpk(o[1][r] * iv, 0.f) & 0xffff); }
    const int ocol = (TYPE == 0 ? 0 : (TYPE == 1 ? 256 : 640)) + h * 64, sidx = (TYPE == 0 ? 0 : (TYPE == 1 ? 4 : 10)) + h;
#pragma unroll
    for (int i = 0; i < 4; ++i) { const int row = i * 8 + (lane >> 3), ch = lane & 7; const u32x4 v = *(const LAS u32x4*)(stg + row * 64 + ch * 8);
        const size_t tokn = tokb + qw0 + row; if (PROBE == 0) *(u32x4*)(P.O + tokn * DM + ocol + ch * 8) = v; else asm volatile("" :: "v"(v));
        float sq = 0.f;
#pragma unroll
        for (int e = 0; e < 4; ++e) { const float a = __builtin_bit_cast(float, v[e] << 16), c2 = __builtin_bit_cast(float, v[e] & 0xffff0000u); sq += a * a + c2 * c2; }
        sq += __shfl_xor(sq, 1); sq += __shfl_xor(sq, 2); sq += __shfl_xor(sq, 4);
        if (ch == 0 && PROBE == 0) P.SS[tokn * 16 + sidx] = sq; }
    ATT_WAIT_BAR();
#undef ATT_DMA
#undef ATT_QK
#undef ATT_STEP
#undef ATT_MAX3
}
__device__ __forceinline__ void attn_phase(const AttnP& P, LAS unsigned char* lds, int vcu) {
    const int x = vcu >> 5, cx = vcu & 31;
    for (int i = 0; i < 3; ++i) { const int j = cx * 3 + i, bh = 6 * x + (j >> 4), qb = j & 15; attn_unit<1>(P, bh / 6, bh % 6, qb, lds); }
    if (ATT_PROBE) for (int i = 0; i < 3; ++i) { const int j = cx * 3 + i, bh = 6 * x + (j >> 4), qb = j & 15; attn_unit<1, ATT_PROBE>(P, bh / 6, bh % 6, qb, lds); }
    for (int i = 0; i < 3; ++i) { const int j = cx * 3 + i, bh = 6 * x + (j >> 4), qb = j & 15; attn_unit<2>(P, bh / 6, bh % 6, qb, lds); }
    for (int i = 0; i < 2; ++i) { const int j = cx * 2 + i, bh = 4 * x + (j >> 4), qb = j & 15; attn_unit<0>(P, bh >> 2, bh & 3, qb, lds); }
}
}


constexpr int NWAVES = 8, LDS_BYTES = 147456, RING_BYTES = 131072, MISC_OFF = RING_BYTES + 320;
#define XB_TMO      128
#define XB_XCNT(j)  (256  + 64 * (j))
#define XB_XSUB(j)  (1280 + 64 * (j))
#define XB_XGEN(j)  (2304 + 64 * (j))
#define XB_TOP      3328
#define XB_TOPGEN   3392
#define XCD_BAR_WORDS 3456
#define XB_SPIN_CAP (1u << 18)
constexpr int CW_BAR = 4096;
__device__ __forceinline__ unsigned xb_ld(unsigned* p)              { return __hip_atomic_load(p, __ATOMIC_RELAXED, __HIP_MEMORY_SCOPE_AGENT); }
__device__ __forceinline__ unsigned xb_add(unsigned* p, unsigned v) { return __hip_atomic_fetch_add(p, v, __ATOMIC_RELAXED, __HIP_MEMORY_SCOPE_AGENT); }
__device__ __forceinline__ unsigned xb_xcc_id() { return (unsigned)__builtin_amdgcn_s_getreg((3 << 11) | 20) & 0xFu; }
#define XB_SPIN(cond, bar) do { unsigned _sp = 0; while (cond) { __builtin_amdgcn_s_sleep(1); \
    if ((++_sp & 255u) == 0u) { if (xb_ld(&(bar)[XB_TMO])) break; if (_sp > XB_SPIN_CAP) { atomicAdd(&(bar)[XB_TMO], 1u); break; } } } } while (0)
struct XcdBarrier { unsigned* bar; unsigned x; volatile LAS unsigned* st; };
__device__ __forceinline__ XcdBarrier xcd_barrier_post(unsigned* bar, volatile LAS unsigned* st) {
    XcdBarrier b; b.bar = bar; b.x = xb_xcc_id(); b.st = st;
    if (threadIdx.x == 0) (void)xb_add(&bar[XB_XCNT(b.x)], 1u);
    return b;
}
__device__ __forceinline__ void xcd_barrier_complete(unsigned* bar, unsigned x, unsigned& nloc, unsigned& nx) {
    const unsigned G = gridDim.x * gridDim.y * gridDim.z;
    unsigned sum, cnt, mine, sp = 0u;
    for (;;) {
        sum = 0u; cnt = 0u; mine = 0u;
#pragma unroll
        for (unsigned j = 0; j < 16; ++j) { const unsigned c = xb_ld(&bar[XB_XCNT(j)]); sum += c; cnt += (c > 0u) ? 1u : 0u; mine = (j == x) ? c : mine; }
        if (sum == G) break;
        __builtin_amdgcn_s_sleep(1);
        if ((++sp & 255u) == 0u) { if (xb_ld(&bar[XB_TMO])) break; if (sp > XB_SPIN_CAP) { atomicAdd(&bar[XB_TMO], 1u); break; } }
    }
    nloc = mine > 0u ? mine : 1u; nx = cnt > 0u ? cnt : 1u;
}
__device__ __forceinline__ void xcd_barrier(const XcdBarrier& b) {
    asm volatile("s_waitcnt vmcnt(0)" ::: "memory");
    __syncthreads();
    if (threadIdx.x == 0) {
        unsigned* bar = b.bar; asm volatile("" : "+s"(bar));
        __builtin_amdgcn_s_waitcnt(0);
        unsigned nloc = b.st[0], nx = b.st[1];
        if (nloc == 0u) { xcd_barrier_complete(bar, b.x, nloc, nx); b.st[0] = nloc; b.st[1] = nx; }
        const unsigned old = xb_add(&bar[XB_XSUB(b.x)], 1u);
        const unsigned gen = old / nloc;
        if (old + 1u == (gen + 1u) * nloc) {
            __builtin_amdgcn_fence(__ATOMIC_RELEASE, "agent");
            asm volatile("s_waitcnt vmcnt(0)" ::: "memory");
            const unsigned og = xb_add(&bar[XB_TOP], 1u);
            const unsigned tg = og / nx;
            if (og + 1u == (tg + 1u) * nx) xb_add(&bar[XB_TOPGEN], 1u);
            else XB_SPIN(xb_ld(&bar[XB_TOPGEN]) == tg, bar);
            __builtin_amdgcn_fence(__ATOMIC_ACQUIRE, "agent");
            xb_add(&bar[XB_XGEN(b.x)], 1u);
            asm volatile("s_waitcnt vmcnt(0)" ::: "memory");
        } else {
            XB_SPIN(xb_ld(&bar[XB_XGEN(b.x)]) == gen, bar);
            __builtin_amdgcn_fence(__ATOMIC_ACQUIRE, "agent");
            asm volatile("s_waitcnt vmcnt(0)" ::: "memory");
        }
    }
    __syncthreads();
}

struct MegaArgs {
    const float *x, *attn_norm, *w_in, *na_rpb, *q_norm, *w_uq, *kv_norm, *w_ukv, *swa_sink, *group_norm, *w_out, *ffn_norm, *w_router, *w_gate, *w_up, *w_down, *final_norm;
    float* H; unsigned char* ws;
    int ph_lo, ph_hi;
};

__device__ __forceinline__ void prep_item(int kind, const float* W, const float* W2, const float* kgain, bf16* Wt, int K, int Nsrc, int nblk, int item, LAS float* scr, int lane) {
    const int kb = item / nblk, nb = item % nblk, k0 = 64 * kb, n0 = 32 * nb, r = lane >> 3, q = lane & 7;
    float sc; int which; const int src4 = prep_map(kind, n0 + 4 * q, sc, which); const float* Wb = which ? W2 : W;
    float4 v[8];
#pragma unroll
    for (int i = 0; i < 8; ++i) v[i] = (src4 >= 0) ? *(const float4*)(Wb + (size_t)(k0 + 8 * i + r) * Nsrc + src4) : make_float4(0.f, 0.f, 0.f, 0.f);
#pragma unroll
    for (int i = 0; i < 8; ++i) { const float g = (kgain ? kgain[k0 + 8 * i + r] : 1.f) * sc; LAS float* d = scr + (8 * i + r) * 33 + 4 * q; d[0] = v[i].x * g; d[1] = v[i].y * g; d[2] = v[i].z * g; d[3] = v[i].w * g; }
    asm volatile("s_waitcnt lgkmcnt(0)" ::: "memory");
    const int c = lane & 7;
#pragma unroll
    for (int j = 0; j < 4; ++j) { const int n = (lane >> 3) + 8 * j; const LAS float* s = scr + (8 * c) * 33 + n;
        uint4 o; o.x = f2bf(s[0]) | (f2bf(s[33]) << 16); o.y = f2bf(s[2 * 33]) | (f2bf(s[3 * 33]) << 16); o.z = f2bf(s[4 * 33]) | (f2bf(s[5 * 33]) << 16); o.w = f2bf(s[6 * 33]) | (f2bf(s[7 * 33]) << 16);
        *(uint4*)(Wt + (size_t)(n0 + n) * K + k0 + 8 * c) = o; }
    asm volatile("s_waitcnt lgkmcnt(0)" ::: "memory");
}
__device__ __forceinline__ void ph_prep(const MegaArgs& a, int l, LAS unsigned char* lds, int gw, int ngw, int wave, int lane) {
    unsigned char* ws = a.ws; LAS float* scr = (LAS float*)(lds + wave * 8448);
    constexpr int I_WIN = 16 * 64, I_WUQ = 4 * 24, I_WUKV = 2 * 24, I_WOUT = 16 * 32, I_WGU1 = 16 * 64, I_WGU = NE * I_WGU1, I_WD1 = 16 * 32, I_WD = NE * I_WD1;
    constexpr int NITEMS = I_WIN + I_WUQ + I_WUKV + I_WOUT + I_WGU + I_WD;
    for (int it = gw; it < NITEMS; it += ngw) { int r = it;
        if (r < I_WGU) { const int e = r / I_WGU1; prep_item(PK_WGU, a.w_gate + ((size_t)l * NE + e) * DM * DM, a.w_up + ((size_t)l * NE + e) * DM * DM, nullptr, (bf16*)(ws + WS_WGU) + (size_t)e * 2048 * DM, DM, DM, 64, r % I_WGU1, scr, lane); continue; } r -= I_WGU;
        if (r < I_WD) { const int e = r / I_WD1; prep_item(PK_WD, a.w_down + ((size_t)l * NE + e) * DM * DM, nullptr, nullptr, (bf16*)(ws + WS_WD) + (size_t)e * DM * DM, DM, DM, 32, r % I_WD1, scr, lane); continue; } r -= I_WD;
        if (r < I_WIN) { prep_item(PK_WIN, a.w_in + (size_t)l * DM * C_END, nullptr, nullptr, (bf16*)(ws + WS_WIN), DM, C_END, 64, r, scr, lane); continue; } r -= I_WIN;
        if (r < I_WOUT) { prep_item(PK_WOUT, a.w_out + (size_t)l * DM * DM, nullptr, a.group_norm + l * DM, (bf16*)(ws + WS_WOUT), DM, DM, 32, r, scr, lane); continue; } r -= I_WOUT;
        if (r < I_WUQ) { prep_item(PK_WUQ, a.w_uq + (size_t)l * 256 * 576, nullptr, a.q_norm + l * 256, (bf16*)(ws + WS_WUQ), 256, 576, 24, r, scr, lane); continue; } r -= I_WUQ;
        prep_item(PK_WUKV, a.w_ukv + (size_t)l * 128 * 768, nullptr, a.kv_norm + l * 128, (bf16*)(ws + WS_WUKV), 128, 768, 24, r, scr, lane);
    }
}
__device__ __forceinline__ void ph_rope_tables(unsigned char* ws, int gtid, int ngt) {
    float *c64 = (float*)(ws + WS_COS64), *s64 = (float*)(ws + WS_SIN64), *c32 = (float*)(ws + WS_COS32), *s32 = (float*)(ws + WS_SIN32);
    for (int i = gtid; i < NS * 32; i += ngt) {
        { const int s = i >> 5, j = i & 31; const float inv = 1.0f / powf(10000.f, (float)(2 * j) / 64.f); const float ang = (float)s * inv;
          const double rev = (double)ang * 0.15915494309189535; const float fr = (float)(rev - floor(rev)); c64[i] = __builtin_amdgcn_cosf(fr); s64[i] = __builtin_amdgcn_sinf(fr); }
        if (i < NS * 16) { const int s = i >> 4, j = i & 15; const float inv = 1.0f / powf(10000.f, (float)(2 * j) / 32.f); const float ang = (float)s * inv;
          const double rev = (double)ang * 0.15915494309189535; const float fr = (float)(rev - floor(rev)); c32[i] = __builtin_amdgcn_cosf(fr); s32[i] = __builtin_amdgcn_sinf(fr); }
    }
}
__device__ __forceinline__ void row_norm_store(const float4 (&v)[4], const float* g, bf16* orow, int lane) {
    float s = 0.f;
#pragma unroll
    for (int j = 0; j < 4; ++j) s += v[j].x * v[j].x + v[j].y * v[j].y + v[j].z * v[j].z + v[j].w * v[j].w;
    const float rstd = rsqrtf(wave_sum(s) * (1.f / DM) + EPS);
    uint2* o = (uint2*)orow + lane;
#pragma unroll
    for (int j = 0; j < 4; ++j) { const float4 gg = ((const float4*)g)[lane + 64 * j];
        o[64 * j] = make_uint2(f2bf(v[j].x * rstd * gg.x) | (f2bf(v[j].y * rstd * gg.y) << 16), f2bf(v[j].z * rstd * gg.z) | (f2bf(v[j].w * rstd * gg.w) << 16)); }
}
__device__ __forceinline__ void ph_norm_x(const MegaArgs& a, int gw, int ngw, int lane) {
    bf16* XN = (bf16*)(a.ws + WS_XN);
    for (int row = gw; row < NT; row += ngw) { const float4* hr = (const float4*)(a.x + (size_t)row * DM) + lane; float4 v[4];
#pragma unroll
        for (int j = 0; j < 4; ++j) v[j] = hr[64 * j];
        row_norm_store(v, a.attn_norm, XN + (size_t)row * DM, lane); }
}
__device__ __forceinline__ void ph_gnorm(unsigned char* ws, int gw, int ngw, int lane) {
    bf16* O = (bf16*)(ws + WS_XN); const float* SS = (const float*)(ws + WS_SS);
    for (int row = gw; row < NT; row += ngw) {
        const float4* ss4 = (const float4*)(SS + (size_t)row * 16); const float4 s0 = ss4[0], s1 = ss4[1], s2 = ss4[2], s3 = ss4[3];
        const float ra = rsqrtf((s0.x + s0.y + s0.z + s0.w) * (1.f / 256.f) + EPS);
        const float rb = rsqrtf((s1.x + s1.y + s1.z + s1.w + s2.x + s2.y) * (1.f / 384.f) + EPS);
        const float rc = rsqrtf((s2.z + s2.w + s3.x + s3.y + s3.z + s3.w) * (1.f / 384.f) + EPS);
        uint2* o = (uint2*)(O + (size_t)row * DM) + lane;
#pragma unroll
        for (int j = 0; j < 4; ++j) { const int col = 4 * lane + 256 * j; const float r = col < 256 ? ra : (col < 640 ? rb : rc); uint2 w = o[64 * j];
            w.x = f2bf(bf2f(w.x & 0xffff) * r) | (f2bf(bf2f(w.x >> 16) * r) << 16); w.y = f2bf(bf2f(w.y & 0xffff) * r) | (f2bf(bf2f(w.y >> 16) * r) << 16); o[64 * j] = w; }
    }
}
__device__ __forceinline__ void ph_router(const MegaArgs& a, int l, LAS unsigned char* lds, int gw, int ngw, int lane) {
    LAS float* wl = (LAS float*)lds; const float* wr = a.w_router + (size_t)l * DM * NE; const float* g = a.ffn_norm + l * DM;
    for (int i = threadIdx.x; i < DM * NE; i += NWAVES * 64) wl[(i & 15) * DM + (i >> 4)] = wr[i];
    __syncthreads();
    bf16* XN2 = (bf16*)(a.ws + WS_XN); float* AFF = (float*)(a.ws + WS_AFF);
    for (int row = gw; row < NT; row += ngw) {
        asm volatile("" ::: "memory");
        const float4* hr = (const float4*)(a.H + (size_t)row * DM) + lane; float4 v[4]; float s = 0.f;
#pragma unroll
        for (int j = 0; j < 4; ++j) { v[j] = hr[64 * j]; s += v[j].x * v[j].x + v[j].y * v[j].y + v[j].z * v[j].z + v[j].w * v[j].w; }
        const float rstd = rsqrtf(wave_sum(s) * (1.f / DM) + EPS);
        uint2* o = (uint2*)(XN2 + (size_t)row * DM) + lane; float lg[16];
#pragma unroll
        for (int e = 0; e < 16; ++e) lg[e] = 0.f;
#pragma unroll
        for (int j = 0; j < 4; ++j) { const float4 gg = ((const float4*)g)[lane + 64 * j];
            const float4 xv = make_float4(v[j].x * rstd * gg.x, v[j].y * rstd * gg.y, v[j].z * rstd * gg.z, v[j].w * rstd * gg.w);
            o[64 * j] = make_uint2(f2bf(xv.x) | (f2bf(xv.y) << 16), f2bf(xv.z) | (f2bf(xv.w) << 16));
#pragma unroll
            for (int e = 0; e < 16; ++e) { const pg8::f32x4 w = *(const LAS pg8::f32x4*)(wl + e * DM + 4 * lane + 256 * j); lg[e] += xv.x * w[0] + xv.y * w[1] + xv.z * w[2] + xv.w * w[3]; } }
        float mx = -1e30f;
#pragma unroll
        for (int e = 0; e < 16; ++e) { lg[e] = wave_sum(lg[e]); mx = fmaxf(mx, lg[e]); }
        float den = 0.f;
#pragma unroll
        for (int e = 0; e < 16; ++e) { lg[e] = __expf(lg[e] - mx); den += lg[e]; }
        const int b = row / NS, sidx = row % NS;
        if (lane < 16) { float val = 0.f;
#pragma unroll
            for (int e = 0; e < 16; ++e) if (lane == e) val = lg[e];
            AFF[((size_t)b * NE + lane) * NS + sidx] = val / den; }
    }
    __syncthreads();
}
__device__ __forceinline__ void ph_topk(unsigned char* ws, LAS unsigned char* lds, int bx, int G) {
    LAS unsigned* hist = (LAS unsigned*)lds;
    LAS unsigned* sh = hist + 256;
    LAS unsigned* wcnt = hist + 512;
    const int tid = threadIdx.x, lane = tid & 63, wave = tid >> 6;
    const float* AFF = (const float*)(ws + WS_AFF); int* INV = (int*)(ws + WS_INV); int* IDX = (int*)(ws + WS_IDX); float* GATE = (float*)(ws + WS_GATE);
    for (int be = bx; be < NB * NE; be += G) {
        const int b = be / NE, e = be % NE; const float* src = AFF + (size_t)be * NS;
        unsigned u[8];
#pragma unroll
        for (int i = 0; i < 8; ++i) u[i] = __float_as_uint(src[tid * 8 + i]);
        unsigned prefix = 0u, krem = CAP;
#pragma unroll 1
        for (int pass = 0; pass < 4; ++pass) { const int shift = 24 - 8 * pass; const unsigned pmask = pass == 0 ? 0u : (0xffffffffu << (shift + 8));
            if (tid < 256) hist[tid] = 0u;
            __syncthreads();
#pragma unroll
            for (int i = 0; i < 8; ++i) if ((u[i] & pmask) == prefix) __hip_atomic_fetch_add(&hist[(u[i] >> shift) & 255u], 1u, __ATOMIC_RELAXED, __HIP_MEMORY_SCOPE_WORKGROUP);
            __syncthreads();
            if (wave == 0) {
                unsigned c4[4]; unsigned tot = 0u;
#pragma unroll
                for (int i = 0; i < 4; ++i) { c4[i] = hist[255 - (lane * 4 + i)]; tot += c4[i]; }
                unsigned inc = tot;
#pragma unroll
                for (int o = 1; o < 64; o <<= 1) { const unsigned t = __shfl_up(inc, o); if (lane >= o) inc += t; }
                const unsigned before = inc - tot;
                if (before < krem && inc >= krem) { unsigned acc = before;
#pragma unroll
                    for (int i = 0; i < 4; ++i) { if (acc < krem && acc + c4[i] >= krem) { sh[0] = prefix | ((unsigned)(255 - (lane * 4 + i)) << shift); sh[1] = krem - acc; } acc += c4[i]; } }
            }
            __syncthreads();
            prefix = sh[0]; krem = sh[1];
            __syncthreads();
        }
        unsigned ngt = 0u, neq = 0u;
#pragma unroll
        for (int i = 0; i < 8; ++i) { ngt += (u[i] > prefix) ? 1u : 0u; neq += (u[i] == prefix) ? 1u : 0u; }
        unsigned ig = ngt, iq = neq;
#pragma unroll
        for (int o = 1; o < 64; o <<= 1) { const unsigned tg = __shfl_up(ig, o), tq = __shfl_up(iq, o); if (lane >= o) { ig += tg; iq += tq; } }
        if (lane == 63) { wcnt[wave * 2] = ig; wcnt[wave * 2 + 1] = iq; }
        __syncthreads();
        unsigned bg = 0u, bq = 0u;
        for (int w = 0; w < wave; ++w) { bg += wcnt[w * 2]; bq += wcnt[w * 2 + 1]; }
        unsigned pg = bg + ig - ngt, pq = bq + iq - neq;
#pragma unroll
        for (int i = 0; i < 8; ++i) { const int idx = tid * 8 + i; int slot = -1;
            if (u[i] > prefix) { slot = (int)(pg + min(pq, krem)); ++pg; }
            else if (u[i] == prefix) { if (pq < krem) slot = (int)(pg + pq); ++pq; }
            INV[(size_t)be * NS + idx] = slot;
            if (slot >= 0) { IDX[be * CAP + slot] = idx; GATE[(size_t)e * (NB * CAP) + b * CAP + slot] = __uint_as_float(u[i]); } }
        __syncthreads();
    }
}
__device__ __forceinline__ void ph_gather(unsigned char* ws, int gw, int ngw, int lane) {
    const bf16* XN2 = (const bf16*)(ws + WS_XN); const int* IDX = (const int*)(ws + WS_IDX); bf16* XS = (bf16*)(ws + WS_PROJ);
    for (int r = gw; r < NSLOTS; r += ngw) { const int e = r >> 12, b = (r >> 9) & 7, slot = r & 511; const int tokn = IDX[(b * NE + e) * CAP + slot];
        const uint4* s = (const uint4*)(XN2 + ((size_t)b * NS + tokn) * DM) + lane; uint4* d = (uint4*)(XS + (size_t)r * DM) + lane; const uint4 a0 = s[0], a1 = s[64]; d[0] = a0; d[64] = a1; }
}
__device__ __forceinline__ void ph_combine(const MegaArgs& a, int l, int gw, int ngw, int lane) {
    const bf16* Y = (const bf16*)(a.ws + WS_PROJ); const int* INV = (const int*)(a.ws + WS_INV); bf16* XN = (bf16*)(a.ws + WS_XN); const bool last = (l == DEPTH - 1);
    for (int row = gw; row < NT; row += ngw) { const int b = row / NS, s = row % NS;
        float4* hr = (float4*)(a.H + (size_t)row * DM) + lane; float4 v[4];
#pragma unroll
        for (int j = 0; j < 4; ++j) v[j] = hr[64 * j];
        int slot_l = -1; if (lane < NE) slot_l = INV[((size_t)b * NE + lane) * NS + s];
        unsigned long long msk = __ballot(slot_l >= 0);
        while (msk) { const int e = __builtin_ctzll(msk); msk &= msk - 1; const int slot = __shfl(slot_l, e);
            const uint2* y = (const uint2*)(Y + ((size_t)e * (NB * CAP) + b * CAP + slot) * DM) + lane;
#pragma unroll
            for (int j = 0; j < 4; ++j) { const uint2 w = y[64 * j]; v[j].x += bf2f(w.x & 0xffff); v[j].y += bf2f(w.x >> 16); v[j].z += bf2f(w.y & 0xffff); v[j].w += bf2f(w.y >> 16); } }
        if (last) { float ssum = 0.f;
#pragma unroll
            for (int j = 0; j < 4; ++j) ssum += v[j].x * v[j].x + v[j].y * v[j].y + v[j].z * v[j].z + v[j].w * v[j].w;
            const float rstd = rsqrtf(wave_sum(ssum) * (1.f / DM) + EPS);
#pragma unroll
            for (int j = 0; j < 4; ++j) { const float4 gg = ((const float4*)a.final_norm)[lane + 64 * j]; hr[64 * j] = make_float4(v[j].x * rstd * gg.x, v[j].y * rstd * gg.y, v[j].z * rstd * gg.z, v[j].w * rstd * gg.w); } }
        else {
#pragma unroll
            for (int j = 0; j < 4; ++j) hr[64 * j] = v[j];
            row_norm_store(v, a.attn_norm + (l + 1) * DM, XN + (size_t)row * DM, lane); }
    }
}

enum { PL_PROJ = 0, PL_MLAUP, PL_ATTN, PL_GNORM, PL_OUT, PL_ROUTER, PL_TOPK, PL_GATHER, PL_MOE1, PL_MOE2, PL_COMBINE, PL_COUNT };
constexpr int N_PHASES = 1 + DEPTH * PL_COUNT;
constexpr int REP_PH = -1;
#define REPEAT(ph) for (int rep_ = 0; rep_ < (REP_PH == (ph) ? 2 : 1); ++rep_)
#define IN(k) (lo <= (k) && (k) < hi)
#define SEAM(k) do { if (IN((k) + 1)) xcd_barrier(bar); } while (0)
#define PH_LOCALS unsigned char* ws = a.ws; asm volatile("" : "+s"(ws)); int t_ = threadIdx.x; asm volatile("" : "+v"(t_)); int bx = blockIdx.x; asm volatile("" : "+s"(bx)); \
    const int vcu = (bx % 8) * (G / 8) + bx / 8; const int lane = t_ & 63, wave = __builtin_amdgcn_readfirstlane(t_ >> 6), gw = vcu * NWAVES + wave; (void)lane; (void)gw; (void)ws; (void)vcu;
template <int l> __device__ __forceinline__ void layer_phases(const MegaArgs& a, LAS unsigned char* lds, const XcdBarrier& bar, const int lo, const int hi) {
    constexpr int G = 256, ngw = G * NWAVES, pb = 1 + l * PL_COUNT;
        if (IN(pb + PL_PROJ)) { PH_LOCALS REPEAT(PL_PROJ) {
            pg8::Gemm g{(bf16*)(ws + WS_XN), (bf16*)(ws + WS_WIN), DM, DM, DM}; pg8::StaticOrder S; S.init(NT / 256, NP / 256, G, bx, 0);
            pg8::EpiProj E{(bf16*)(ws + WS_PROJ), (float*)(ws + WS_COS64), (float*)(ws + WS_SIN64), (float*)(ws + WS_COS32), (float*)(ws + WS_SIN32), (float*)(ws + WS_CQSS), (float*)(ws + WS_CKVSS)};
            pg8::gemm_phase<pg8::EpiProj, pg8::StaticOrder, true>(lds, g, S, E); }
            SEAM(pb + PL_PROJ);
        }
        if (IN(pb + PL_MLAUP)) { PH_LOCALS REPEAT(PL_MLAUP) {
            { pg8::Gemm g{(bf16*)(ws + WS_PROJ) + C_CQ, (bf16*)(ws + WS_WUQ), 256, NP, 256}; pg8::StaticOrder S; S.init(NT / 256, 3, G, bx, 0);
              typedef pg8::EpiMla<true, 576, 576> EQ; EQ E{(bf16*)(ws + WS_QB), (float*)(ws + WS_CQSS), 1.f / 256.f, (float*)(ws + WS_COS32), (float*)(ws + WS_SIN32)};
              pg8::gemm_phase<EQ, pg8::StaticOrder, true>(lds, g, S, E); }
            { pg8::Gemm g{(bf16*)(ws + WS_PROJ) + C_CKV, (bf16*)(ws + WS_WUKV), 128, NP, 128}; pg8::StaticOrder S; S.init(NT / 256, 3, G, bx, 0);
              typedef pg8::EpiMla<false, 768, 768> EK; EK E{(bf16*)(ws + WS_KV), (float*)(ws + WS_CKVSS), 1.f / 128.f, (float*)(ws + WS_COS32), (float*)(ws + WS_SIN32)};
              pg8::gemm_phase<EK, pg8::StaticOrder, true>(lds, g, S, E); } }
            SEAM(pb + PL_MLAUP);
        }
        if (IN(pb + PL_ATTN)) { PH_LOCALS
            REPEAT(PL_ATTN) { const att::AttnP P{(bf16*)(ws + WS_PROJ), (bf16*)(ws + WS_QB), (bf16*)(ws + WS_KV), (bf16*)(ws + WS_XN), (float*)(ws + WS_SS), a.na_rpb + (size_t)l * 4 * 15 * 31, a.swa_sink + l * 6}; att::attn_phase(P, lds, vcu); }
            SEAM(pb + PL_ATTN);
        }
        if (IN(pb + PL_GNORM)) { PH_LOCALS ph_gnorm(ws, gw, ngw, lane); SEAM(pb + PL_GNORM); }
        if (IN(pb + PL_OUT)) { PH_LOCALS
            pg8::Gemm g{(bf16*)(ws + WS_XN), (bf16*)(ws + WS_WOUT), DM, DM, DM}; pg8::StaticOrder S; S.init(NT / 256, DM / 256, G, bx, 0);
            pg8::EpiResid E{l == 0 ? a.x : a.H, a.H};
            pg8::gemm_phase<pg8::EpiResid, pg8::StaticOrder, true>(lds, g, S, E);
            SEAM(pb + PL_OUT);
        }
        if (IN(pb + PL_ROUTER)) { PH_LOCALS REPEAT(PL_ROUTER) ph_router(a, l, lds, gw, ngw, lane); SEAM(pb + PL_ROUTER); }
        if (IN(pb + PL_TOPK)) { PH_LOCALS REPEAT(PL_TOPK) ph_topk(ws, lds, bx, G); SEAM(pb + PL_TOPK); }
        if (IN(pb + PL_GATHER)) { PH_LOCALS REPEAT(PL_GATHER) ph_gather(ws, gw, ngw, lane); SEAM(pb + PL_GATHER); }
        if (IN(pb + PL_MOE1)) { PH_LOCALS REPEAT(PL_MOE1) {
            pg8::Gemm g{(bf16*)(ws + WS_PROJ), (bf16*)(ws + WS_WGU), DM, DM, DM}; pg8::StaticOrder S; S.init(NSLOTS / 256, 8, G, bx, 16);
            pg8::EpiSwiglu E{(bf16*)(ws + WS_HID)};
            pg8::gemm_phase<pg8::EpiSwiglu, pg8::StaticOrder, true>(lds, g, S, E); }
            SEAM(pb + PL_MOE1);
        }
        if (IN(pb + PL_MOE2)) { PH_LOCALS REPEAT(PL_MOE2) {
            pg8::Gemm g{(bf16*)(ws + WS_HID), (bf16*)(ws + WS_WD), DM, DM, DM}; pg8::StaticOrder S; S.init(NSLOTS / 256, 4, G, bx, 16);
            pg8::EpiGate E{(bf16*)(ws + WS_PROJ), (float*)(ws + WS_GATE)};
            pg8::gemm_phase<pg8::EpiGate, pg8::StaticOrder, true>(lds, g, S, E); }
            SEAM(pb + PL_MOE2);
        }
        if (IN(pb + PL_COMBINE)) { PH_LOCALS
            ph_combine(a, l, gw, ngw, lane);
            if (l + 1 < DEPTH) { __syncthreads(); REPEAT(100) ph_prep(a, l + 1, lds, gw, ngw, wave, lane); }
            SEAM(pb + PL_COMBINE);
        }
}
__global__ void __launch_bounds__(NWAVES * 64, 2) mega(MegaArgs a) {
    extern __shared__ __attribute__((aligned(16))) unsigned char lds_raw[];
    LAS unsigned char* lds = (LAS unsigned char*)lds_raw;
    constexpr int G = 256;
    constexpr int ngw = G * NWAVES;
    for (int u = threadIdx.x; u < (LDS_BYTES - RING_BYTES) / 4; u += NWAVES * 64) ((LAS unsigned*)(lds + RING_BYTES))[u] = 0u;
    __syncthreads();
    XcdBarrier bar = xcd_barrier_post((unsigned*)(a.ws + WS_CTL) + CW_BAR, (volatile LAS unsigned*)(lds + MISC_OFF) + 8);
    const int lo = a.ph_lo, hi = a.ph_hi;
    if (IN(0)) { PH_LOCALS REPEAT(100) ph_prep(a, 0, lds, gw, ngw, wave, lane); ph_rope_tables(ws, bx * NWAVES * 64 + t_, G * NWAVES * 64); ph_norm_x(a, gw, ngw, lane); SEAM(0); }
    layer_phases<0>(a, lds, bar, lo, hi);
    layer_phases<1>(a, lds, bar, lo, hi);
    static_assert(DEPTH == 2, "two layers are written out");
}


#ifndef MK_PER_PHASE
#define MK_PER_PHASE 0
#endif
extern "C" void kernel_launch(void* const* d_in, const int* in_sizes, int n_in, void* d_out, int out_size, void* d_ws, size_t ws_size, hipStream_t stream) {
    if (n_in != 17 || out_size != NT * DM || ws_size < WS_END) { fprintf(stderr, "kernel_launch: unexpected shapes (n_in %d out %d ws %zu)\n", n_in, out_size, ws_size); return; }
    static int grid = 0;
    if (grid == 0) { int dev = 0, cus = 0; (void)hipGetDevice(&dev); (void)hipDeviceGetAttribute(&cus, hipDeviceAttributeMultiprocessorCount, dev);
        if (hipFuncSetAttribute((const void*)mega, hipFuncAttributeMaxDynamicSharedMemorySize, LDS_BYTES) != hipSuccess) fprintf(stderr, "hipFuncSetAttribute failed\n");
        if (cus != 256) fprintf(stderr, "kernel_launch: built for a 256-CU device (got %d CUs)\n", cus);
        grid = 256; }
    (void)hipMemsetAsync((char*)d_ws + WS_CTL, 0, 1 * MiB, stream);
    MegaArgs ma{};
    ma.x = (const float*)d_in[0]; ma.attn_norm = (const float*)d_in[1]; ma.w_in = (const float*)d_in[2]; ma.na_rpb = (const float*)d_in[3]; ma.q_norm = (const float*)d_in[4]; ma.w_uq = (const float*)d_in[5];
    ma.kv_norm = (const float*)d_in[6]; ma.w_ukv = (const float*)d_in[7]; ma.swa_sink = (const float*)d_in[8]; ma.group_norm = (const float*)d_in[9]; ma.w_out = (const float*)d_in[10]; ma.ffn_norm = (const float*)d_in[11];
    ma.w_router = (const float*)d_in[12]; ma.w_gate = (const float*)d_in[13]; ma.w_up = (const float*)d_in[14]; ma.w_down = (const float*)d_in[15]; ma.final_norm = (const float*)d_in[16];
    ma.H = (float*)d_out; ma.ws = (unsigned char*)d_ws;
#if MK_PER_PHASE
    for (int p = 0; p < N_PHASES; ++p) { ma.ph_lo = p; ma.ph_hi = p + 1; hipLaunchKernelGGL(mega, dim3(grid), dim3(NWAVES * 64), LDS_BYTES, stream, ma); }
#else
    ma.ph_lo = 0; ma.ph_hi = N_PHASES; hipLaunchKernelGGL(mega, dim3(grid), dim3(NWAVES * 64), LDS_BYTES, stream, ma);
#endif
}
```

```cpp
#include <hip/hip_runtime.h>
#include <cstdint>
#include <cstdio>

typedef unsigned short bf16;
constexpr int NB = 8, NS = 4096, DM = 1024, NT = NB * NS, NP = 2048, NE = 16, CAP = 512, DEPTH = 2;
constexpr int NSLOTS = NE * NB * CAP;
constexpr float LOG2E = 1.4426950408889634f;
constexpr float QS64 = 0.125f * LOG2E;
constexpr float QS96 = 0.10206207261596577f * LOG2E;
constexpr float EPS = 1e-6f;
constexpr int C_AQ = 0, C_AK = 256, C_AV = 512, C_CQ = 768, C_CKV = 1024, C_KR = 1152, C_SQ = 1184, C_SK = 1568, C_SV = 1696, C_END = 1824;

constexpr size_t MiB = 1u << 20;
constexpr size_t WS_CTL = 0;
constexpr size_t WS_COS64 = 1 * MiB, WS_SIN64 = WS_COS64 + 512 * 1024, WS_COS32 = 2 * MiB, WS_SIN32 = WS_COS32 + 256 * 1024;
constexpr size_t WS_WIN = 4 * MiB, WS_WUQ = 8 * MiB, WS_WUKV = 8 * MiB + 512 * 1024, WS_WOUT = 9 * MiB, WS_WGU = 12 * MiB, WS_WD = 76 * MiB;
constexpr size_t WS_CQSS = 108 * MiB, WS_CKVSS = WS_CQSS + 512 * 1024, WS_SS = 109 * MiB, WS_AFF = 111 * MiB, WS_INV = 113 * MiB, WS_IDX = 115 * MiB, WS_GATE = WS_IDX + 256 * 1024;
constexpr size_t WS_XN = 120 * MiB;
constexpr size_t WS_PROJ = 184 * MiB;
constexpr size_t WS_QB = 312 * MiB;
constexpr size_t WS_KV = 348 * MiB;
constexpr size_t WS_HID = 312 * MiB;
constexpr size_t WS_END = 440 * MiB;

__device__ __forceinline__ unsigned f2bf(float f) { unsigned u = __builtin_bit_cast(unsigned, f); return (u + 0x7fffu + ((u >> 16) & 1u)) >> 16; }
__device__ __forceinline__ float bf2f(unsigned short b) { return __builtin_bit_cast(float, (unsigned)b << 16); }
__device__ __forceinline__ float wave_sum(float v) {
#pragma unroll
    for (int o = 1; o < 64; o <<= 1) v += __shfl_xor(v, o);
    return v;
}

enum { PK_WIN = 0, PK_WUQ = 1, PK_WUKV = 2, PK_WOUT = 3, PK_WGU = 4, PK_WD = 5 };
__device__ __forceinline__ int prep_map(int kind, int n, float& sc, int& which) {
    sc = 1.f; which = 0;
    switch (kind) {
    case PK_WIN:
        if (n < 256) { sc = QS64; return n; }
        if (n < C_KR) return n;
        if (n < C_SQ) { const int p = n - C_KR, g = p >> 3, e = p & 7; return C_KR + 4 * g + (e & 3) + 16 * (e >> 2); }
        if (n < C_SK) { const int p = n - C_SQ, h = p >> 6, pp = p & 63, g = pp >> 3, e = pp & 7; sc = QS64; return C_SQ + h * 64 + 4 * g + (e & 3) + 32 * (e >> 2); }
        if (n < C_SV) { const int p = n - C_SK, h = p >> 6, pp = p & 63, g = pp >> 3, e = pp & 7; return C_SK + h * 64 + 4 * g + (e & 3) + 32 * (e >> 2); }
        if (n < C_END) return n;
        return -1;
    case PK_WUQ:
        if (n < 576) { const int h = n / 96, d = n % 96; sc = QS96; if (d < 64) return n; const int p = d - 64, g = p >> 3, e = p & 7; return h * 96 + 64 + 4 * g + (e & 3) + 16 * (e >> 2); }
        return -1;
    case PK_WUKV:
        if (n < 384) { const int h = n >> 6, d = n & 63; return h * 128 + d; }
        { const int m = n - 384, h = m >> 6, d = m & 63; return h * 128 + 64 + d; }
    case PK_WGU: { const int pn = n >> 8, half = (n >> 7) & 1, jj = n & 127; which = half; return 128 * pn + jj; }
    default: return n;
    }
}
#define LAS __attribute__((address_space(3)))
#define GAS __attribute__((address_space(1)))
namespace pg8 {
typedef short bf16x8 __attribute__((ext_vector_type(8)));
typedef float f32x4 __attribute__((ext_vector_type(4)));
typedef unsigned u32x4 __attribute__((ext_vector_type(4)));
constexpr int BM = 256, BK = 64, HALF = 128, HTB = HALF * BK * 2, STAGE_BYTES = 8 * HTB, NXCD = 8, WGM = 8;
__host__ __device__ __forceinline__ int lds_byte(int r, int c) { const int st = (r >> 4) * 2 + (c >> 5), rr = r & 15, cc = c & 31, ob = rr * 64 + cc * 2; return st * 1024 + (ob ^ (((ob >> 9) & 1) << 5)); }
__host__ __device__ __forceinline__ void stage_rc(int b, int& R, int& C) { const int st = b / 1024, sb = b % 1024, swz = sb ^ (((sb >> 9) & 1) << 5); R = (st >> 1) * 16 + swz / 64; C = (st & 1) * 32 + (swz % 64) / 2; }
__host__ __device__ __forceinline__ int perm32(int rho) { const int n = rho >> 4, i = rho & 15; return 8 * (i >> 2) + 4 * n + (i & 3); }
struct Unit { int pm, pn, pb; };
struct Gemm { const bf16* A; const bf16* Bt; int K, lda, ldb; const LAS int* gidx; };
struct StaticOrder {
    int nM, nN, nwg, G, c, gm;
    __device__ __forceinline__ void init(int nM_, int nN_, int G_, int c_, int gm_) { nM = nM_; nN = nN_; nwg = nM * nN; G = G_; c = c_; gm = gm_; }
    __device__ __forceinline__ bool next(int i, Unit& u) const {
        const long L = (long)i * G + c; if (L >= nwg) return false;
        int wgid = (int)L; { const int q = nwg / NXCD, r = nwg % NXCD, xcd = wgid % NXCD, off = wgid / NXCD; wgid = (xcd < r ? xcd * (q + 1) : r * (q + 1) + (xcd - r) * q) + off; }
        const int nig = WGM * nN, gid = wgid / nig, fm = gid * WGM, gsz = (nM - fm) < WGM ? (nM - fm) : WGM;
        u.pm = fm + ((wgid % nig) % gsz); u.pn = (wgid % nig) / gsz; u.pb = gm ? (u.pm / gm) * nN + u.pn : u.pn; return true;
    }
};
__device__ __forceinline__ unsigned cvt_pk_bf16(float lo, float hi) { unsigned r; asm volatile("v_cvt_pk_bf16_f32 %0, %1, %2" : "=v"(r) : "v"(lo), "v"(hi)); return r; }

template <class Epi, class Sched, bool ALIGN_EPI, bool GATHER = false>
__device__ __forceinline__ void gemm_phase(LAS unsigned char* lds, const Gemm g, const Sched& S, const Epi& E) {
    int tid = threadIdx.x; asm volatile("" : "+v"(tid));
    const int wid = __builtin_amdgcn_readfirstlane(tid >> 6), lane = tid & 63, wr = wid >> 2, wc = wid & 3, fr = lane & 15, fq = lane >> 4;
    const int K = g.K, nt = K / BK;
    unsigned vC[2][2], vNs[2][2], voffB[2]; int RA[2], CA[2];
    const size_t kstep = (size_t)(BK * 2);
    const size_t hstepA = (size_t)HALF * g.lda * 2, hstepB = (size_t)HALF * g.ldb * 2, tstepA = GATHER ? 0 : 2 * hstepA, tstepB = 2 * hstepB;
#pragma unroll
    for (int i = 0; i < 2; ++i) { int R, C; stage_rc(tid * 16 + i * 8192, R, C); const int Rb = Epi::PERM ? ((R & ~31) + perm32(R & 31)) : R; RA[i] = R; CA[i] = C;
        voffB[i] = (unsigned)(Rb * g.ldb + C) * 2u;
#pragma unroll
        for (int h = 0; h < 2; ++h) { vC[h][i] = GATHER ? ((unsigned)g.gidx[h * HALF + R] * (unsigned)(g.lda * 2) + (unsigned)C * 2u) : ((unsigned)(R * g.lda + C) * 2u + (unsigned)(h * hstepA)); vNs[h][i] = vC[h][i]; } }
    unsigned (&vN)[2][2] = GATHER ? vNs : vC;
    const unsigned ldsw = (unsigned)wid * 1024u;
    const int aoff = lds_byte(wr * 64 + fr, fq * 8), boff = lds_byte(wc * 32 + fr, fq * 8);
#define PG8_SA(b, h) (((b) * 2 + (h)) * HTB)
#define PG8_SB(b, h) ((4 + (b) * 2 + (h)) * HTB)
#define PG8_STAGE(bufoff, gbase, voff) do { _Pragma("unroll") for (int _i = 0; _i < 2; ++_i) \
        __builtin_amdgcn_global_load_lds((const unsigned*)((const char*)(gbase) + (voff)[_i]), (LAS unsigned*)(lds + (bufoff) + ldsw + _i * 8192), 16, 0, 0); } while (0)
#define PG8_STAGEA(bufoff, gbase, V, h) do { _Pragma("unroll") for (int _i = 0; _i < 2; ++_i) \
        __builtin_amdgcn_global_load_lds((const unsigned*)((const char*)(gbase) + (V)[h][_i]), (LAS unsigned*)(lds + (bufoff) + ldsw + _i * 8192), 16, 0, 0); } while (0)
#define PG8_STAGEAL(bufoff, gbase, h) do { _Pragma("unroll") for (int _i = 0; _i < 2; ++_i) { const unsigned _v = (GATHER && last) ? vN[h][_i] : vC[h][_i]; \
        __builtin_amdgcn_global_load_lds((const unsigned*)((const char*)(gbase) + _v), (LAS unsigned*)(lds + (bufoff) + ldsw + _i * 8192), 16, 0, 0); } } while (0)
#define PG8_LDA(dst, b, h) do { _Pragma("unroll") for (int m = 0; m < 4; ++m) _Pragma("unroll") for (int k = 0; k < 2; ++k) dst[m][k] = *(const LAS bf16x8*)(lds + PG8_SA(b, h) + aoff + m * 2048 + k * 1024); } while (0)
#define PG8_LDB(dst, b, h) do { _Pragma("unroll") for (int n = 0; n < 2; ++n) _Pragma("unroll") for (int k = 0; k < 2; ++k) dst[n][k] = *(const LAS bf16x8*)(lds + PG8_SB(b, h) + boff + n * 2048 + k * 1024); } while (0)
#define PG8_MMA(ai, bj, At, Bt) do { __builtin_amdgcn_s_setprio(1); _Pragma("unroll") for (int m = 0; m < 4; ++m) _Pragma("unroll") for (int n = 0; n < 2; ++n) _Pragma("unroll") for (int k = 0; k < 2; ++k) \
        acc[ai][bj][m][n] = __builtin_amdgcn_mfma_f32_16x16x32_bf16(Bt[n][k], At[m][k], acc[ai][bj][m][n], 0, 0, 0); __builtin_amdgcn_s_setprio(0); } while (0)
#define PG8_WAIT_V(n) asm volatile("s_waitcnt vmcnt(" #n ")" ::: "memory")
#define PG8_WAIT_L(n) asm volatile("s_waitcnt lgkmcnt(" #n ")" ::: "memory")
#define PG8_BAR __builtin_amdgcn_s_barrier()
#define PG8_SCHED __builtin_amdgcn_sched_barrier(0)
    Unit cur, nxt; int ui = 0;
    if (!S.next(0, cur)) return;
    f32x4 acc[2][2][4][2];
#pragma unroll
    for (int a = 0; a < 2; ++a)
#pragma unroll
        for (int b = 0; b < 2; ++b)
#pragma unroll
            for (int m = 0; m < 4; ++m)
#pragma unroll
                for (int n = 0; n < 2; ++n) acc[a][b][m][n] = (f32x4){0.f, 0.f, 0.f, 0.f};
    bf16x8 At[4][2], B0[2][2], B1[2][2];
    const char* cA = (const char*)g.A + (size_t)cur.pm * tstepA; const char* cB = (const char*)g.Bt + (size_t)cur.pb * tstepB;
    PG8_STAGE(PG8_SB(0, 0), cB, voffB); PG8_STAGE(PG8_SB(0, 1), cB + hstepB, voffB); PG8_STAGEA(PG8_SA(0, 0), cA, vC, 0); PG8_STAGEA(PG8_SA(0, 1), cA, vC, 1);
    if (wr == 1) PG8_BAR;
    PG8_WAIT_V(2); PG8_BAR;
    PG8_STAGE(PG8_SB(1, 0), cB + kstep, voffB); PG8_STAGEA(PG8_SA(1, 0), cA + kstep, vC, 0); PG8_STAGE(PG8_SB(1, 1), cB + hstepB + kstep, voffB);
    PG8_WAIT_V(6); PG8_BAR;
    for (;;) {
        const bool has_next = S.next(ui + 1, nxt);
        if (GATHER && has_next) {
#pragma unroll
            for (int i = 0; i < 2; ++i)
#pragma unroll
                for (int h = 0; h < 2; ++h) vNs[h][i] = (unsigned)g.gidx[(ui + 1) * BM + h * HALF + RA[i]] * (unsigned)(g.lda * 2) + (unsigned)CA[i] * 2u; }
        const char* nA = has_next ? (const char*)g.A + (size_t)nxt.pm * tstepA : cA; const char* nB = has_next ? (const char*)g.Bt + (size_t)nxt.pb * tstepB : cB;
        for (int t = 0; t < nt; t += 2) {
            const bool last = (t == nt - 2);
            const char* a1 = cA + (size_t)(t + 1) * kstep;
            const char* a2 = last ? nA : cA + (size_t)(t + 2) * kstep; const char* b2 = last ? nB : cB + (size_t)(t + 2) * kstep;
            const char* a3 = a2 + kstep; const char* b3 = b2 + kstep;
            PG8_LDB(B0, 0, 0); PG8_LDB(B1, 0, 1); PG8_SCHED; PG8_LDA(At, 0, 0); PG8_STAGEA(PG8_SA(1, 1), a1, vC, 1);
            PG8_WAIT_V(8); PG8_WAIT_L(0); PG8_BAR; PG8_MMA(0, 0, At, B0); PG8_MMA(0, 1, At, B1); PG8_BAR; PG8_SCHED;
            PG8_LDA(At, 0, 1); PG8_STAGE(PG8_SB(0, 0), b2, voffB); PG8_STAGE(PG8_SB(0, 1), b2 + hstepB, voffB); PG8_STAGEAL(PG8_SA(0, 0), a2, 0);
            PG8_WAIT_V(8); PG8_WAIT_L(0); PG8_BAR; PG8_MMA(1, 0, At, B0); PG8_MMA(1, 1, At, B1); PG8_BAR; PG8_SCHED;
            PG8_LDB(B0, 1, 0); PG8_LDB(B1, 1, 1); PG8_SCHED; PG8_LDA(At, 1, 0); PG8_STAGEAL(PG8_SA(0, 1), a2, 1);
            PG8_WAIT_V(8); PG8_WAIT_L(0); PG8_BAR; PG8_MMA(0, 0, At, B0); PG8_MMA(0, 1, At, B1); PG8_BAR; PG8_SCHED;
            PG8_LDA(At, 1, 1); PG8_STAGE(PG8_SB(1, 0), b3, voffB); PG8_STAGE(PG8_SB(1, 1), b3 + hstepB, voffB); PG8_STAGEAL(PG8_SA(1, 0), a3, 0);
            PG8_WAIT_V(8); PG8_WAIT_L(0); PG8_BAR; PG8_MMA(1, 0, At, B0); PG8_MMA(1, 1, At, B1); PG8_BAR; PG8_SCHED;
            if constexpr (Epi::KHOOK) { if (t == 2 || t == 8) { asm volatile("" ::: "memory"); E.khook(acc, ui, t == 2 ? 0 : 1, wr, fr); asm volatile("" ::: "memory"); } }
        }
        if constexpr (ALIGN_EPI) { if (wr == 0) PG8_BAR; }
        { int t2 = threadIdx.x; asm volatile("" : "+v"(t2)); E(acc, cur, wr, wc, t2 & 15, (t2 >> 4) & 3, ui); }
        if (!has_next) break;
#pragma unroll
        for (int a = 0; a < 2; ++a)
#pragma unroll
            for (int b = 0; b < 2; ++b)
#pragma unroll
                for (int m = 0; m < 4; ++m)
#pragma unroll
                    for (int n = 0; n < 2; ++n) acc[a][b][m][n] = (f32x4){0.f, 0.f, 0.f, 0.f};
        cur = nxt; cA = nA; cB = nB; ++ui;
        if (GATHER) {
#pragma unroll
            for (int i = 0; i < 2; ++i)
#pragma unroll
                for (int h = 0; h < 2; ++h) vC[h][i] = vNs[h][i]; }
        if constexpr (ALIGN_EPI) { if (wr == 1) PG8_BAR; }
    }
    PG8_WAIT_V(0);
    if constexpr (!ALIGN_EPI) { if (wr == 0) PG8_BAR; }
    PG8_BAR;
#undef PG8_SA
#undef PG8_SB
#undef PG8_STAGE
#undef PG8_STAGEA
#undef PG8_STAGEAL
#undef PG8_LDA
#undef PG8_LDB
#undef PG8_MMA
#undef PG8_WAIT_V
#undef PG8_WAIT_L
#undef PG8_BAR
#undef PG8_SCHED
}

typedef const f32x4 (&AccRef)[2][2][4][2];
__device__ __forceinline__ void st_bf16x8(bf16* p, f32x4 v0, f32x4 v1) { u32x4 w; w.x = cvt_pk_bf16(v0[0], v0[1]); w.y = cvt_pk_bf16(v0[2], v0[3]); w.z = cvt_pk_bf16(v1[0], v1[1]); w.w = cvt_pk_bf16(v1[2], v1[3]); *(u32x4*)p = w; }
struct EpiProj {
    static constexpr bool PERM = true, KHOOK = false;
    bf16* P; const float *c64, *s64, *c32, *s32; float *cqss, *ckvss;
    __device__ __forceinline__ void operator()(AccRef acc, const Unit& u, int wr, int wc, int fr, int fq, int ui) const {
#pragma unroll
        for (int ai = 0; ai < 2; ++ai)
#pragma unroll
            for (int m = 0; m < 4; ++m) { const int row = u.pm * BM + ai * HALF + wr * 64 + m * 16 + fr; const int pos = row & (NS - 1); float ssq = 0.f;
#pragma unroll
                for (int bj = 0; bj < 2; ++bj) { const int cw = u.pn * BM + bj * HALF + wc * 32, col0 = cw + 8 * fq; f32x4 v0 = acc[ai][bj][m][0], v1 = acc[ai][bj][m][1];
                    if (cw >= C_SQ && cw < C_SV) { const int g = ((col0 - C_SQ) & 63) >> 3; const f32x4 c = *(const f32x4*)(c64 + pos * 32 + 4 * g), s = *(const f32x4*)(s64 + pos * 32 + 4 * g);
                        const f32x4 o0 = v0 * c - v1 * s, o1 = v1 * c + v0 * s; v0 = o0; v1 = o1; }
                    else if (cw == C_KR) { const f32x4 c = *(const f32x4*)(c32 + pos * 16 + 4 * fq), s = *(const f32x4*)(s32 + pos * 16 + 4 * fq);
                        const f32x4 o0 = v0 * c - v1 * s, o1 = v1 * c + v0 * s; v0 = o0; v1 = o1; }
                    if (u.pn == 3 || (u.pn == 4 && bj == 0)) ssq += (v0[0] * v0[0] + v0[1] * v0[1]) + (v0[2] * v0[2] + v0[3] * v0[3]) + (v1[0] * v1[0] + v1[1] * v1[1]) + (v1[2] * v1[2] + v1[3] * v1[3]);
                    st_bf16x8(P + (size_t)row * NP + col0, v0, v1); }
                if (u.pn == 3 || u.pn == 4) { ssq += __shfl_xor(ssq, 16); ssq += __shfl_xor(ssq, 32); if (fq == 0) (u.pn == 3 ? cqss : ckvss)[(size_t)row * 4 + wc] = ssq; }
            }
    }
};
template <bool QMODE, int ldc, int ncols> struct EpiMla {
    static constexpr bool PERM = true, KHOOK = false;
    bf16* O; const float* ss; float ssinv; const float *c32, *s32;
    __device__ __forceinline__ void operator()(AccRef acc, const Unit& u, int wr, int wc, int fr, int fq, int ui) const {
#pragma unroll
        for (int ai = 0; ai < 2; ++ai)
#pragma unroll
            for (int m = 0; m < 4; ++m) { const int row = u.pm * BM + ai * HALF + wr * 64 + m * 16 + fr; const int pos = row & (NS - 1);
                const f32x4 p = *(const f32x4*)(ss + (size_t)row * 4); const float rs = rsqrtf(((p[0] + p[1]) + (p[2] + p[3])) * ssinv + EPS);
#pragma unroll
                for (int bj = 0; bj < 2; ++bj) { const int cw = u.pn * BM + bj * HALF + wc * 32, col0 = cw + 8 * fq; if (cw >= ncols) continue;
                    f32x4 v0 = acc[ai][bj][m][0] * rs, v1 = acc[ai][bj][m][1] * rs;
                    if (QMODE && (cw % 96) == 64) { const f32x4 c = *(const f32x4*)(c32 + pos * 16 + 4 * fq), s = *(const f32x4*)(s32 + pos * 16 + 4 * fq);
                        const f32x4 o0 = v0 * c - v1 * s, o1 = v1 * c + v0 * s; v0 = o0; v1 = o1; }
                    st_bf16x8(O + (size_t)row * ldc + col0, v0, v1); }
                asm volatile("" ::: "memory"); }
    }
};
struct EpiResid {
    static constexpr bool PERM = false, KHOOK = true;
    const float* Hin; float* Hout; const LAS float* fac;
    __device__ __forceinline__ void khook(f32x4 (&acc)[2][2][4][2], int ui, int which, int wr, int fr) const {
#pragma unroll
        for (int ai = 0; ai < 2; ++ai)
#pragma unroll
            for (int m = 0; m < 4; ++m) { const float f = fac[(ui * BM + ai * HALF + wr * 64 + m * 16 + fr) * 4 + which];
#pragma unroll
                for (int bj = 0; bj < 2; ++bj)
#pragma unroll
                    for (int n = 0; n < 2; ++n) acc[ai][bj][m][n] *= f; }
    }
    __device__ __forceinline__ void operator()(AccRef acc, const Unit& u, int wr, int wc, int fr, int fq, int ui) const {
#pragma unroll
        for (int ai = 0; ai < 2; ++ai)
#pragma unroll
            for (int m = 0; m < 4; ++m) { const int rl = ai * HALF + wr * 64 + m * 16 + fr; const float f = fac[(ui * BM + rl) * 4 + 2]; const size_t off = (size_t)(u.pm * BM + rl) * DM + u.pn * BM + wc * 32 + 4 * fq;
#pragma unroll
                for (int bj = 0; bj < 2; ++bj)
#pragma unroll
                    for (int n = 0; n < 2; ++n) { const f32x4 b = *(const f32x4*)(Hin + off + bj * HALF + n * 16); *(f32x4*)(Hout + off + bj * HALF + n * 16) = b + acc[ai][bj][m][n] * f; } }
    }
};
struct EpiSwiglu {
    static constexpr bool PERM = true, KHOOK = false;
    bf16* Hd;
    __device__ __forceinline__ void operator()(AccRef acc, const Unit& u, int wr, int wc, int fr, int fq, int ui) const {
#pragma unroll
        for (int ai = 0; ai < 2; ++ai)
#pragma unroll
            for (int m = 0; m < 4; ++m) { const size_t row = (size_t)(u.pm * BM + ai * HALF + wr * 64 + m * 16 + fr); f32x4 o[2];
#pragma unroll
                for (int n = 0; n < 2; ++n) { const f32x4 gt = acc[ai][0][m][n], up = acc[ai][1][m][n];
#pragma unroll
                    for (int e = 0; e < 4; ++e) o[n][e] = gt[e] * __builtin_amdgcn_rcpf(1.f + __builtin_amdgcn_exp2f(-gt[e] * LOG2E)) * up[e]; }
                st_bf16x8(Hd + row * DM + u.pn * HALF + wc * 32 + 8 * fq, o[0], o[1]); }
    }
};
struct EpiGate {
    static constexpr bool PERM = true, KHOOK = false;
    bf16* Y; const float* gate;
    __device__ __forceinline__ void operator()(AccRef acc, const Unit& u, int wr, int wc, int fr, int fq, int ui) const {
#pragma unroll
        for (int ai = 0; ai < 2; ++ai)
#pragma unroll
            for (int m = 0; m < 4; ++m) { const size_t row = (size_t)(u.pm * BM + ai * HALF + wr * 64 + m * 16 + fr); const float gt = gate[row];
#pragma unroll
                for (int bj = 0; bj < 2; ++bj) st_bf16x8(Y + row * DM + u.pn * BM + bj * HALF + wc * 32 + 8 * fq, acc[ai][bj][m][0] * gt, acc[ai][bj][m][1] * gt); }
    }
};
}


namespace att {
typedef short bf16x8 __attribute__((ext_vector_type(8)));
typedef short s16x4 __attribute__((ext_vector_type(4)));
typedef float f32x16 __attribute__((ext_vector_type(16)));
typedef float f32x4 __attribute__((ext_vector_type(4)));
typedef unsigned u32x4 __attribute__((ext_vector_type(4)));
typedef float f32x2_t __attribute__((ext_vector_type(2))); typedef __bf16 bf16x2_t __attribute__((ext_vector_type(2)));
typedef short v4i16_t __attribute__((ext_vector_type(4)));
constexpr int KSLOT = 12288, VSLOT = 8192, NSL = 3;
constexpr int L_K = 0, L_V = NSL * KSLOT, L_WS = L_V + NSL * VSLOT, L_OST = L_WS + 8 * 256, L_BIAS = L_OST + 8 * 4096, L_END = L_BIAS + 2048;
constexpr float THR = 8.f;
constexpr int ATT_PROBE = 0;
constexpr bool LSUM_MFMA = true;
__device__ __forceinline__ int crow(int r, int hi) { return (r & 3) + 8 * (r >> 2) + 4 * hi; }
__device__ __forceinline__ unsigned cvtpk(float lo, float hi) { f32x2_t v = {lo, hi}; bf16x2_t b = __builtin_convertvector(v, bf16x2_t); return __builtin_bit_cast(unsigned, b); }
__device__ __forceinline__ s16x4 vtr(const LAS unsigned char* p) { return __builtin_bit_cast(s16x4, __builtin_amdgcn_ds_read_tr16_b64_v4i16((LAS v4i16_t*)p)); }
__device__ __forceinline__ void glds(const bf16* src, unsigned lds_dst) { unsigned keep;
    asm volatile("s_mov_b32 %0, m0\n\ts_mov_b32 m0, %2\n\ts_nop 0\n\tglobal_load_lds_dwordx4 %1, off\n\ts_mov_b32 m0, %0" : "=&s"(keep) : "v"(src), "s"(lds_dst) : "memory"); }
struct AttnP { const bf16 *PROJ, *QB, *KV; bf16* O; float* SS; const float* rpb; const float* sink; };
#define ATT_WAIT_BAR() do { if (PROBE != 3) asm volatile("s_waitcnt vmcnt(0) lgkmcnt(0)\n\ts_barrier" ::: "memory"); } while (0)

template <int TYPE, int PROBE = 0> __device__ __forceinline__ void attn_unit(const AttnP& P, int b, int h, int qb, LAS unsigned char* lds) {
    constexpr int ND0 = (TYPE == 1) ? 6 : 4;
    int tid = threadIdx.x; asm volatile("" : "+v"(tid));
    const int lane = tid & 63, r32 = lane & 31, hi = lane >> 5, wid = __builtin_amdgcn_readfirstlane(tid >> 6);
    const bool ordA = wid < 4;
    const int q0 = qb * 256, qw0 = q0 + wid * 32; const size_t tokb = (size_t)b * NS;
    int ntile, kbase, ta, tb;
    if (TYPE == 1) { ntile = NS / 64; kbase = 0; ta = 0; tb = ntile - 1; }
    else if (TYPE == 2) { kbase = max(q0 - 128, 0); const int ke = min(q0 + 384, NS); ntile = (ke - kbase) >> 6; ta = max(qw0 - 128 - kbase, 0) >> 6; tb = min(ntile - 1, (qw0 + 159 - kbase) >> 6); }
    else { const int r0 = qb * 4; kbase = min(max(r0 - 4, 0), 56); ntile = min(max(r0 - 1, 0), 56) + 7 - kbase + 1; const int r = r0 + (wid >> 1); ta = min(max(r - 4, 0), 56) - kbase; tb = ta + 7; }
    const int kvh = (TYPE == 2) ? h / 3 : h;
    const bf16 *ksrc, *ksrc2 = nullptr, *vsrc; size_t kpitch, vpitch;
    { const size_t key0 = tokb + (TYPE == 0 ? (size_t)kbase * 64 : (size_t)kbase); const int vrow = 16 * (wid & 3) + (lane >> 2), vcol = (wid >> 2) * 32 + (lane & 3) * 8;
      if (TYPE == 0) { ksrc = P.PROJ + (key0 + lane) * NP + C_AK + h * 64 + wid * 8; vsrc = P.PROJ + (key0 + vrow) * NP + C_AV + h * 64 + vcol; kpitch = vpitch = NP; }
      else if (TYPE == 1) { ksrc = P.KV + (key0 + lane) * 768 + h * 64 + wid * 8; ksrc2 = P.PROJ + (key0 + lane) * NP + C_KR + (wid & 3) * 8; vsrc = P.KV + (key0 + vrow) * 768 + 384 + h * 64 + vcol; kpitch = vpitch = 768; }
      else { ksrc = P.PROJ + (key0 + lane) * NP + C_SK + kvh * 64 + wid * 8; vsrc = P.PROJ + (key0 + vrow) * NP + C_SV + kvh * 64 + vcol; kpitch = vpitch = NP; } }
    const unsigned kdst = (unsigned)(uintptr_t)(lds + L_K) + wid * 1024, vdst = (unsigned)(uintptr_t)(lds + L_V) + wid * 1024;
#define ATT_DMA(t, slot) do { if (PROBE == 2 || PROBE == 3) break; glds(ksrc + (size_t)(t) * 64 * kpitch, (unsigned)__builtin_amdgcn_readfirstlane(kdst + (slot) * KSLOT)); if (TYPE == 1 && wid < 4) glds(ksrc2 + (size_t)(t) * 64 * NP, (unsigned)__builtin_amdgcn_readfirstlane(kdst + (slot) * KSLOT + 8192)); \
        glds(vsrc + (size_t)(t) * 64 * vpitch, (unsigned)__builtin_amdgcn_readfirstlane(vdst + (slot) * VSLOT)); } while (0)
    LAS float* biasL = (LAS float*)(lds + L_BIAS);
    if (TYPE == 0) { for (int i = tid; i < 15 * 31; i += 512) biasL[i] = P.rpb[h * 465 + i] * LOG2E; }
    bf16x8 qr[ND0];
    { const bf16* qp = (TYPE == 1) ? P.QB + (tokb + qw0 + r32) * 576 + h * 96 : P.PROJ + (tokb + qw0 + r32) * NP + (TYPE == 0 ? C_AQ : C_SQ) + h * 64;
#pragma unroll
      for (int d0 = 0; d0 < ND0; ++d0) qr[d0] = *(const bf16x8*)(qp + d0 * 16 + hi * 8); }
    LAS float* wsf = (LAS float*)(lds + L_WS) + wid * 64;
    float m = (TYPE == 2) ? P.sink[h] * LOG2E : 0.f;
    f32x16 negm; { const float nm = -m;
#pragma unroll
      for (int r = 0; r < 16; ++r) negm[r] = nm; }
    f32x16 o[2]; o[0] = f32x16{}; o[1] = f32x16{};
    f32x16 lacc;
    { const float l0 = (TYPE == 2) ? 1.f : 0.f;
#pragma unroll
      for (int r = 0; r < 16; ++r) lacc[r] = l0; }
    float lsum = (TYPE == 2 && hi == 0) ? 1.f : 0.f;
    const bf16x8 ones = (bf16x8){0x3F80, 0x3F80, 0x3F80, 0x3F80, 0x3F80, 0x3F80, 0x3F80, 0x3F80};
    f32x16 sA0, sA1, sB0, sB1;
#define ATT_QK(X0, X1, tt, sl) do { const LAS unsigned char* Kp = lds + L_K + (sl) * KSLOT + hi * 1024 + r32 * 16; X0 = negm; X1 = negm; \
        bf16x8 ka0 = *(const LAS bf16x8*)(Kp), ka1 = *(const LAS bf16x8*)(Kp + 512); \
        _Pragma("unroll") for (int d0 = 0; d0 < ND0; ++d0) { bf16x8 kb0 = ka0, kb1 = ka1; \
            if (d0 + 1 < ND0) { kb0 = *(const LAS bf16x8*)(Kp + (d0 + 1) * 2048); kb1 = *(const LAS bf16x8*)(Kp + (d0 + 1) * 2048 + 512); }     \
            X0 = __builtin_amdgcn_mfma_f32_32x32x16_bf16(ka0, qr[d0], X0, 0, 0, 0); X1 = __builtin_amdgcn_mfma_f32_32x32x16_bf16(ka1, qr[d0], X1, 0, 0, 0); ka0 = kb0; ka1 = kb1; } \
        __builtin_amdgcn_sched_group_barrier(0x100, 2, 0); __builtin_amdgcn_sched_group_barrier(0x100, 2, 0);        \
        _Pragma("unroll") for (int d0 = 0; d0 + 2 < ND0; ++d0) { __builtin_amdgcn_sched_group_barrier(0x8, 2, 0); __builtin_amdgcn_sched_group_barrier(0x100, 2, 0); } \
        __builtin_amdgcn_sched_group_barrier(0x8, 2, 0); __builtin_amdgcn_sched_group_barrier(0x8, 2, 0); \
        if (TYPE == 2) { const int dq = qw0 + r32 - (kbase + (tt) * 64) - 4 * hi; \
            _Pragma("unroll") for (int r = 0; r < 16; ++r) { const int d0_ = dq - ((r & 3) + 8 * (r >> 2)), d1_ = d0_ - 32; \
                if (d0_ > 128 || d0_ < -128) X0[r] = -INFINITY; if (d1_ > 128 || d1_ < -128) X1[r] = -INFINITY; } } \
        if (TYPE == 0) { const int c = (wid & 1) * 32 + r32, cs = min(max(c - 8, 0), 48); const int rq = qb * 4 + (wid >> 1), kr = kbase + (tt); const LAS float* brow = biasL + (kr - rq + 7) * 31 + 15 - c; \
            _Pragma("unroll") for (int rr = 0; rr < 16; ++rr) { const int kc0 = crow(rr, hi), kc1 = kc0 + 32; \
                const bool v0 = kc0 >= cs && kc0 < cs + 16, v1 = kc1 >= cs && kc1 < cs + 16; \
                X0[rr] = v0 ? X0[rr] + brow[v0 ? kc0 : c] : -INFINITY; X1[rr] = v1 ? X1[rr] + brow[v1 ? kc1 : c] : -INFINITY; } } \
        asm volatile("s_nop 15\n\ts_nop 7" : "+v"(X0), "+v"(X1)); } while (0)
#define ATT_MAX3(a, b, c) ({ float r_; asm("v_max3_f32 %0, %1, %2, %3" : "=v"(r_) : "v"(a), "v"(b), "v"(c)); r_; })
#define ATT_STEP(ORDA, C0, C1, N0, N1, t) do { \
        if ((t) + 1 < ntile) ATT_WAIT_BAR(); \
        if ((t) + 2 < ntile) ATT_DMA((t) + 2, sl_nn); \
        const bool act = ((t) >= ta && (t) <= tb), nact = ((t) + 1 >= ta && (t) + 1 <= tb); \
        if (ORDA && nact) ATT_QK(N0, N1, (t) + 1, sl_nxt); \
        if (act) { \
            float ma = 0.f, mb = 0.f; if (PROBE != 4) { ma = ATT_MAX3(C0[0], C0[1], C1[0]); mb = ATT_MAX3(C0[2], C0[3], C1[1]); ma = ATT_MAX3(ma, C1[2], C1[3]); \
            _Pragma("unroll") for (int r = 4; r < 16; r += 4) { ma = ATT_MAX3(ma, C0[r], C0[r + 1]); mb = ATT_MAX3(mb, C0[r + 2], C0[r + 3]); ma = ATT_MAX3(ma, C1[r], C1[r + 1]); mb = ATT_MAX3(mb, C1[r + 2], C1[r + 3]); } } \
            float rm = fmaxf(ma, mb); \
            { auto rr = __builtin_amdgcn_permlane32_swap(__float_as_uint(rm), __float_as_uint(rm), false, false); rm = fmaxf(__uint_as_float(rr[0]), __uint_as_float(rr[1])); } \
            const bool first = (TYPE != 2) && ((t) == ta); \
            if (first || __any(rm > THR)) { const float dl = first ? rm : fmaxf(rm, 0.f), f = first ? 1.f : __builtin_amdgcn_exp2f(-dl); m += dl; lsum *= f; \
                _Pragma("unroll") for (int r = 0; r < 16; ++r) { C0[r] -= dl; C1[r] -= dl; negm[r] = -m; } \
                if (ORDA && nact) { _Pragma("unroll") for (int r = 0; r < 16; ++r) { N0[r] -= dl; N1[r] -= dl; } } \
                if (hi == 0) wsf[r32] = f; \
                _Pragma("unroll") for (int g = 0; g < 4; ++g) { const f32x4 fv = *(const LAS f32x4*)(wsf + 8 * g + 4 * hi); \
                    _Pragma("unroll") for (int e = 0; e < 4; ++e) { o[0][4 * g + e] *= fv[e]; o[1][4 * g + e] *= fv[e]; lacc[4 * g + e] *= fv[e]; } } } \
            const LAS unsigned char* Vp = lds + L_V + sl_cur * VSLOT + ((lane >> 4) & 1) * 32 + (lane & 3) * 8 + (4 * hi + ((lane & 15) >> 2)) * 64; \
            s16x4 va[4], vb[4]; \
            va[0] = vtr(Vp); va[1] = vtr(Vp + 512); va[2] = vtr(Vp + 4096); va[3] = vtr(Vp + 4096 + 512);        \
            if (PROBE != 4) { _Pragma("unroll") for (int r = 0; r < 16; ++r) { C0[r] = __builtin_amdgcn_exp2f(C0[r]); C1[r] = __builtin_amdgcn_exp2f(C1[r]); } } \
            if (!LSUM_MFMA) { float sa = 0.f, sb = 0.f; _Pragma("unroll") for (int r = 0; r < 16; ++r) { sa += C0[r]; sb += C1[r]; } lsum += sa + sb; } \
            u32x4 pw[4]; \
            _Pragma("unroll") for (int e = 0; e < 4; ++e) { pw[0][e] = cvtpk(C0[2 * e], C0[2 * e + 1]); pw[1][e] = cvtpk(C0[8 + 2 * e], C0[9 + 2 * e]); pw[2][e] = cvtpk(C1[2 * e], C1[2 * e + 1]); pw[3][e] = cvtpk(C1[8 + 2 * e], C1[9 + 2 * e]); } \
            _Pragma("unroll") for (int ks = 0; ks < 4; ++ks) { const bf16x8 pa = __builtin_bit_cast(bf16x8, pw[ks]); \
                if (ks + 1 < 4) { vb[0] = vtr(Vp + (ks + 1) * 1024); vb[1] = vtr(Vp + (ks + 1) * 1024 + 512); vb[2] = vtr(Vp + 4096 + (ks + 1) * 1024); vb[3] = vtr(Vp + 4096 + (ks + 1) * 1024 + 512); }     \
                o[0] = __builtin_amdgcn_mfma_f32_32x32x16_bf16(pa, ((bf16x8){va[0][0], va[0][1], va[0][2], va[0][3], va[1][0], va[1][1], va[1][2], va[1][3]}), o[0], 0, 0, 0); \
                o[1] = __builtin_amdgcn_mfma_f32_32x32x16_bf16(pa, ((bf16x8){va[2][0], va[2][1], va[2][2], va[2][3], va[3][0], va[3][1], va[3][2], va[3][3]}), o[1], 0, 0, 0); \
                if (LSUM_MFMA) lacc = __builtin_amdgcn_mfma_f32_32x32x16_bf16(pa, ones, lacc, 0, 0, 0); \
                _Pragma("unroll") for (int q_ = 0; q_ < 4; ++q_) va[q_] = vb[q_]; } \
            __builtin_amdgcn_sched_group_barrier(0x100, 4, 1); \
            _Pragma("unroll") for (int ks = 0; ks < 3; ++ks) { __builtin_amdgcn_sched_group_barrier(0x100, 4, 1); __builtin_amdgcn_sched_group_barrier(0x8, LSUM_MFMA ? 3 : 2, 1); } \
            __builtin_amdgcn_sched_group_barrier(0x8, LSUM_MFMA ? 3 : 2, 1); \
        } \
        if (!(ORDA) && nact) ATT_QK(N0, N1, (t) + 1, sl_nxt); \
        { const int tmp = sl_cur; sl_cur = sl_nxt; sl_nxt = sl_nn; sl_nn = tmp; } } while (0)
    ATT_DMA(0, 0);
    if (ntile > 1) ATT_DMA(1, 1);
    if (PROBE == 2 || PROBE == 3) {} else if (ntile > 1) { if (TYPE == 1 && wid < 4) asm volatile("s_waitcnt vmcnt(3)" ::: "memory"); else asm volatile("s_waitcnt vmcnt(2)" ::: "memory"); } else asm volatile("s_waitcnt vmcnt(0)" ::: "memory");
    asm volatile("s_waitcnt lgkmcnt(0)\n\ts_barrier" ::: "memory");
    if (ta == 0) ATT_QK(sA0, sA1, 0, 0);
    int sl_cur = 0, sl_nxt = 1, sl_nn = 2;
    if (ordA) {
        for (int t = 0; t < ntile; t += 2) { ATT_STEP(true, sA0, sA1, sB0, sB1, t); if (t + 1 < ntile) ATT_STEP(true, sB0, sB1, sA0, sA1, t + 1); }
    } else {
        for (int t = 0; t < ntile; t += 2) { ATT_STEP(false, sA0, sA1, sB0, sB1, t); if (t + 1 < ntile) ATT_STEP(false, sB0, sB1, sA0, sA1, t + 1); }
    }
    LAS bf16* stg = (LAS bf16*)(lds + L_OST) + wid * 2048;
    if (!LSUM_MFMA) { { auto rr = __builtin_amdgcn_permlane32_swap(__float_as_uint(lsum), __float_as_uint(lsum), false, false); lsum = __uint_as_float(rr[0]) + __uint_as_float(rr[1]); }
        if (hi == 0) wsf[32 + r32] = lsum;
#pragma unroll
        for (int g = 0; g < 4; ++g) { const f32x4 lv = *(const LAS f32x4*)(wsf + 32 + 8 * g + 4 * hi);
#pragma unroll
            for (int e = 0; e < 4; ++e) lacc[4 * g + e] = lv[e]; } }
#pragma unroll
    for (int r = 0; r < 16; ++r) { const float iv = __builtin_amdgcn_rcpf(lacc[r]); const int orow = crow(r, hi);
        stg[orow * 64 + r32] = (bf16)(cvtpk(o[0][r] * iv, 0.f) & 0xffff); stg[orow * 64 + 32 + r32] = (bf16)(cvtpk(o[1][r] * iv, 0.f) & 0xffff); }
    const int ocol = (TYPE == 0 ? 0 : (TYPE == 1 ? 256 : 640)) + h * 64, sidx = (TYPE == 0 ? 0 : (TYPE == 1 ? 4 : 10)) + h;
#pragma unroll
    for (int i = 0; i < 4; ++i) { const int row = i * 8 + (lane >> 3), ch = lane & 7; const u32x4 v = *(const LAS u32x4*)(stg + row * 64 + ch * 8);
        const size_t tokn = tokb + qw0 + row; if (PROBE == 0) *(u32x4*)(P.O + tokn * DM + ocol + ch * 8) = v; else asm volatile("" :: "v"(v));
        float sq = 0.f;
#pragma unroll
        for (int e = 0; e < 4; ++e) { const float a = __builtin_bit_cast(float, v[e] << 16), c2 = __builtin_bit_cast(float, v[e] & 0xffff0000u); sq += a * a + c2 * c2; }
        sq += __shfl_xor(sq, 1); sq += __shfl_xor(sq, 2); sq += __shfl_xor(sq, 4);
        if (ch == 0 && PROBE == 0) P.SS[tokn * 16 + sidx] = sq; }
    ATT_WAIT_BAR();
#undef ATT_DMA
#undef ATT_QK
#undef ATT_STEP
#undef ATT_MAX3
}
__device__ __forceinline__ void attn_phase(const AttnP& P, LAS unsigned char* lds, int vcu) {
    const int x = vcu >> 5, cx = vcu & 31;
    for (int i = 0; i < 3; ++i) { const int j = cx * 3 + i, bh = 6 * x + (j >> 4), qb = j & 15; attn_unit<1>(P, bh / 6, bh % 6, qb, lds); }
    if (ATT_PROBE) for (int i = 0; i < 3; ++i) { const int j = cx * 3 + i, bh = 6 * x + (j >> 4), qb = j & 15; attn_unit<1, ATT_PROBE>(P, bh / 6, bh % 6, qb, lds); }
    for (int i = 0; i < 3; ++i) { const int j = cx * 3 + i, bh = 6 * x + (j >> 4), qb = j & 15; attn_unit<2>(P, bh / 6, bh % 6, qb, lds); }
    for (int i = 0; i < 2; ++i) { const int j = cx * 2 + i, bh = 4 * x + (j >> 4), qb = j & 15; attn_unit<0>(P, bh >> 2, bh & 3, qb, lds); }
}
}


constexpr int NWAVES = 8, LDS_BYTES = 147456, RING_BYTES = 131072, MISC_OFF = RING_BYTES + 320;
#define XB_TMO      128
#define XB_XCNT(j)  (256  + 64 * (j))
#define XB_XSUB(j)  (1280 + 64 * (j))
#define XB_XGEN(j)  (2304 + 64 * (j))
#define XB_TOP      3328
#define XB_TOPGEN   3392
#define XCD_BAR_WORDS 3456
#define XB_SPIN_CAP (1u << 18)
constexpr int CW_BAR = 4096;
__device__ __forceinline__ unsigned xb_ld(unsigned* p)              { return __hip_atomic_load(p, __ATOMIC_RELAXED, __HIP_MEMORY_SCOPE_AGENT); }
__device__ __forceinline__ unsigned xb_add(unsigned* p, unsigned v) { return __hip_atomic_fetch_add(p, v, __ATOMIC_RELAXED, __HIP_MEMORY_SCOPE_AGENT); }
__device__ __forceinline__ unsigned xb_xcc_id() { return (unsigned)__builtin_amdgcn_s_getreg((3 << 11) | 20) & 0xFu; }
#define XB_SPIN(cond, bar) do { unsigned _sp = 0; while (cond) { __builtin_amdgcn_s_sleep(1); \
    if ((++_sp & 255u) == 0u) { if (xb_ld(&(bar)[XB_TMO])) break; if (_sp > XB_SPIN_CAP) { atomicAdd(&(bar)[XB_TMO], 1u); break; } } } } while (0)
struct XcdBarrier { unsigned* bar; unsigned x; volatile LAS unsigned* st; };
__device__ __forceinline__ XcdBarrier xcd_barrier_post(unsigned* bar, volatile LAS unsigned* st) {
    XcdBarrier b; b.bar = bar; b.x = xb_xcc_id(); b.st = st;
    if (threadIdx.x == 0) (void)xb_add(&bar[XB_XCNT(b.x)], 1u);
    return b;
}
__device__ __forceinline__ void xcd_barrier_complete(unsigned* bar, unsigned x, unsigned& nloc, unsigned& nx) {
    const unsigned G = gridDim.x * gridDim.y * gridDim.z;
    unsigned sum, cnt, mine, sp = 0u;
    for (;;) {
        sum = 0u; cnt = 0u; mine = 0u;
#pragma unroll
        for (unsigned j = 0; j < 16; ++j) { const unsigned c = xb_ld(&bar[XB_XCNT(j)]); sum += c; cnt += (c > 0u) ? 1u : 0u; mine = (j == x) ? c : mine; }
        if (sum == G) break;
        __builtin_amdgcn_s_sleep(1);
        if ((++sp & 255u) == 0u) { if (xb_ld(&bar[XB_TMO])) break; if (sp > XB_SPIN_CAP) { atomicAdd(&bar[XB_TMO], 1u); break; } }
    }
    nloc = mine > 0u ? mine : 1u; nx = cnt > 0u ? cnt : 1u;
}
__device__ __forceinline__ void xcd_barrier(const XcdBarrier& b) {
    asm volatile("s_waitcnt vmcnt(0)" ::: "memory");
    __syncthreads();
    if (threadIdx.x == 0) {
        unsigned* bar = b.bar; asm volatile("" : "+s"(bar));
        __builtin_amdgcn_s_waitcnt(0);
        unsigned nloc = b.st[0], nx = b.st[1];
        if (nloc == 0u) { xcd_barrier_complete(bar, b.x, nloc, nx); b.st[0] = nloc; b.st[1] = nx; }
        const unsigned old = xb_add(&bar[XB_XSUB(b.x)], 1u);
        const unsigned gen = old / nloc;
        if (old + 1u == (gen + 1u) * nloc) {
            __builtin_amdgcn_fence(__ATOMIC_RELEASE, "agent");
            asm volatile("s_waitcnt vmcnt(0)" ::: "memory");
            const unsigned og = xb_add(&bar[XB_TOP], 1u);
            const unsigned tg = og / nx;
            if (og + 1u == (tg + 1u) * nx) xb_add(&bar[XB_TOPGEN], 1u);
            else XB_SPIN(xb_ld(&bar[XB_TOPGEN]) == tg, bar);
            __builtin_amdgcn_fence(__ATOMIC_ACQUIRE, "agent");
            xb_add(&bar[XB_XGEN(b.x)], 1u);
            asm volatile("s_waitcnt vmcnt(0)" ::: "memory");
        } else {
            XB_SPIN(xb_ld(&bar[XB_XGEN(b.x)]) == gen, bar);
            __builtin_amdgcn_fence(__ATOMIC_ACQUIRE, "agent");
            asm volatile("s_waitcnt vmcnt(0)" ::: "memory");
        }
    }
    __syncthreads();
}

struct MegaArgs {
    const float *x, *attn_norm, *w_in, *na_rpb, *q_norm, *w_uq, *kv_norm, *w_ukv, *swa_sink, *group_norm, *w_out, *ffn_norm, *w_router, *w_gate, *w_up, *w_down, *final_norm;
    float* H; unsigned char* ws;
    int ph_lo, ph_hi;
};

__device__ __forceinline__ void prep_item(int kind, const float* W, const float* W2, const float* kgain, bf16* Wt, int K, int Nsrc, int nblk, int item, LAS float* scr, int lane) {
    const int kb = item / nblk, nb = item % nblk, k0 = 64 * kb, n0 = 32 * nb, r = lane >> 3, q = lane & 7;
    float sc; int which; const int src4 = prep_map(kind, n0 + 4 * q, sc, which); const float* Wb = which ? W2 : W;
    float4 v[8];
#pragma unroll
    for (int i = 0; i < 8; ++i) v[i] = (src4 >= 0) ? *(const float4*)(Wb + (size_t)(k0 + 8 * i + r) * Nsrc + src4) : make_float4(0.f, 0.f, 0.f, 0.f);
#pragma unroll
    for (int i = 0; i < 8; ++i) { const float g = (kgain ? kgain[k0 + 8 * i + r] : 1.f) * sc; LAS float* d = scr + (8 * i + r) * 33 + 4 * q; d[0] = v[i].x * g; d[1] = v[i].y * g; d[2] = v[i].z * g; d[3] = v[i].w * g; }
    asm volatile("s_waitcnt lgkmcnt(0)" ::: "memory");
    const int c = lane & 7;
#pragma unroll
    for (int j = 0; j < 4; ++j) { const int n = (lane >> 3) + 8 * j; const LAS float* s = scr + (8 * c) * 33 + n;
        uint4 o; o.x = f2bf(s[0]) | (f2bf(s[33]) << 16); o.y = f2bf(s[2 * 33]) | (f2bf(s[3 * 33]) << 16); o.z = f2bf(s[4 * 33]) | (f2bf(s[5 * 33]) << 16); o.w = f2bf(s[6 * 33]) | (f2bf(s[7 * 33]) << 16);
        *(uint4*)(Wt + (size_t)(n0 + n) * K + k0 + 8 * c) = o; }
    asm volatile("s_waitcnt lgkmcnt(0)" ::: "memory");
}
__device__ __forceinline__ void ph_prep(const MegaArgs& a, int l, LAS unsigned char* lds, int gw, int ngw, int wave, int lane) {
    unsigned char* ws = a.ws; LAS float* scr = (LAS float*)(lds + wave * 8448);
    constexpr int I_WIN = 16 * 64, I_WUQ = 4 * 24, I_WUKV = 2 * 24, I_WOUT = 16 * 32, I_WGU1 = 16 * 64, I_WGU = NE * I_WGU1, I_WD1 = 16 * 32, I_WD = NE * I_WD1;
    constexpr int NITEMS = I_WIN + I_WUQ + I_WUKV + I_WOUT + I_WGU + I_WD;
    for (int it = gw; it < NITEMS; it += ngw) { int r = it;
        if (r < I_WGU) { const int e = r / I_WGU1; prep_item(PK_WGU, a.w_gate + ((size_t)l * NE + e) * DM * DM, a.w_up + ((size_t)l * NE + e) * DM * DM, nullptr, (bf16*)(ws + WS_WGU) + (size_t)e * 2048 * DM, DM, DM, 64, r % I_WGU1, scr, lane); continue; } r -= I_WGU;
        if (r < I_WD) { const int e = r / I_WD1; prep_item(PK_WD, a.w_down + ((size_t)l * NE + e) * DM * DM, nullptr, nullptr, (bf16*)(ws + WS_WD) + (size_t)e * DM * DM, DM, DM, 32, r % I_WD1, scr, lane); continue; } r -= I_WD;
        if (r < I_WIN) { prep_item(PK_WIN, a.w_in + (size_t)l * DM * C_END, nullptr, nullptr, (bf16*)(ws + WS_WIN), DM, C_END, 64, r, scr, lane); continue; } r -= I_WIN;
        if (r < I_WOUT) { prep_item(PK_WOUT, a.w_out + (size_t)l * DM * DM, nullptr, a.group_norm + l * DM, (bf16*)(ws + WS_WOUT), DM, DM, 32, r, scr, lane); continue; } r -= I_WOUT;
        if (r < I_WUQ) { prep_item(PK_WUQ, a.w_uq + (size_t)l * 256 * 576, nullptr, a.q_norm + l * 256, (bf16*)(ws + WS_WUQ), 256, 576, 24, r, scr, lane); continue; } r -= I_WUQ;
        prep_item(PK_WUKV, a.w_ukv + (size_t)l * 128 * 768, nullptr, a.kv_norm + l * 128, (bf16*)(ws + WS_WUKV), 128, 768, 24, r, scr, lane);
    }
}
__device__ __forceinline__ void ph_rope_tables(unsigned char* ws, int gtid, int ngt) {
    float *c64 = (float*)(ws + WS_COS64), *s64 = (float*)(ws + WS_SIN64), *c32 = (float*)(ws + WS_COS32), *s32 = (float*)(ws + WS_SIN32);
    for (int i = gtid; i < NS * 32; i += ngt) {
        { const int s = i >> 5, j = i & 31; const float inv = 1.0f / powf(10000.f, (float)(2 * j) / 64.f); const float ang = (float)s * inv;
          const double rev = (double)ang * 0.15915494309189535; const float fr = (float)(rev - floor(rev)); c64[i] = __builtin_amdgcn_cosf(fr); s64[i] = __builtin_amdgcn_sinf(fr); }
        if (i < NS * 16) { const int s = i >> 4, j = i & 15; const float inv = 1.0f / powf(10000.f, (float)(2 * j) / 32.f); const float ang = (float)s * inv;
          const double rev = (double)ang * 0.15915494309189535; const float fr = (float)(rev - floor(rev)); c32[i] = __builtin_amdgcn_cosf(fr); s32[i] = __builtin_amdgcn_sinf(fr); }
    }
}
__device__ __forceinline__ void row_norm_store(const float4 (&v)[4], const float* g, bf16* orow, int lane) {
    float s = 0.f;
#pragma unroll
    for (int j = 0; j < 4; ++j) s += v[j].x * v[j].x + v[j].y * v[j].y + v[j].z * v[j].z + v[j].w * v[j].w;
    const float rstd = rsqrtf(wave_sum(s) * (1.f / DM) + EPS);
    uint2* o = (uint2*)orow + lane;
#pragma unroll
    for (int j = 0; j < 4; ++j) { const float4 gg = ((const float4*)g)[lane + 64 * j];
        o[64 * j] = make_uint2(f2bf(v[j].x * rstd * gg.x) | (f2bf(v[j].y * rstd * gg.y) << 16), f2bf(v[j].z * rstd * gg.z) | (f2bf(v[j].w * rstd * gg.w) << 16)); }
}
__device__ __forceinline__ void ph_norm_x(const MegaArgs& a, int gw, int ngw, int lane) {
    bf16* XN = (bf16*)(a.ws + WS_XN);
    for (int row = gw; row < NT; row += ngw) { const float4* hr = (const float4*)(a.x + (size_t)row * DM) + lane; float4 v[4];
#pragma unroll
        for (int j = 0; j < 4; ++j) v[j] = hr[64 * j];
        row_norm_store(v, a.attn_norm, XN + (size_t)row * DM, lane); }
}
__device__ __forceinline__ void ph_router(const MegaArgs& a, int l, LAS unsigned char* lds, int gw, int ngw, int lane) {
    LAS float* wl = (LAS float*)lds; const float* wr = a.w_router + (size_t)l * DM * NE; const float* g = a.ffn_norm + l * DM;
    for (int i = threadIdx.x; i < DM * NE; i += NWAVES * 64) wl[(i & 15) * DM + (i >> 4)] = wr[i];
    __syncthreads();
    bf16* XN2 = (bf16*)(a.ws + WS_XN); float* AFF = (float*)(a.ws + WS_AFF);
    for (int row = gw; row < NT; row += ngw) {
        asm volatile("" ::: "memory");
        const float4* hr = (const float4*)(a.H + (size_t)row * DM) + lane; float4 v[4]; float s = 0.f;
#pragma unroll
        for (int j = 0; j < 4; ++j) { v[j] = hr[64 * j]; s += v[j].x * v[j].x + v[j].y * v[j].y + v[j].z * v[j].z + v[j].w * v[j].w; }
        const float rstd = rsqrtf(wave_sum(s) * (1.f / DM) + EPS);
        uint2* o = (uint2*)(XN2 + (size_t)row * DM) + lane; float lg[16];
#pragma unroll
        for (int e = 0; e < 16; ++e) lg[e] = 0.f;
#pragma unroll
        for (int j = 0; j < 4; ++j) { const float4 gg = ((const float4*)g)[lane + 64 * j];
            const float4 xv = make_float4(v[j].x * rstd * gg.x, v[j].y * rstd * gg.y, v[j].z * rstd * gg.z, v[j].w * rstd * gg.w);
            o[64 * j] = make_uint2(f2bf(xv.x) | (f2bf(xv.y) << 16), f2bf(xv.z) | (f2bf(xv.w) << 16));
#pragma unroll
            for (int e = 0; e < 16; ++e) { const pg8::f32x4 w = *(const LAS pg8::f32x4*)(wl + e * DM + 4 * lane + 256 * j); lg[e] += xv.x * w[0] + xv.y * w[1] + xv.z * w[2] + xv.w * w[3]; } }
        float mx = -1e30f;
#pragma unroll
        for (int e = 0; e < 16; ++e) { lg[e] = wave_sum(lg[e]); mx = fmaxf(mx, lg[e]); }
        float den = 0.f;
#pragma unroll
        for (int e = 0; e < 16; ++e) { lg[e] = __expf(lg[e] - mx); den += lg[e]; }
        const int b = row / NS, sidx = row % NS;
        if (lane < 16) { float val = 0.f;
#pragma unroll
            for (int e = 0; e < 16; ++e) if (lane == e) val = lg[e];
            AFF[((size_t)b * NE + lane) * NS + sidx] = val / den; }
    }
    __syncthreads();
}
__device__ __forceinline__ void ph_topk(unsigned char* ws, LAS unsigned char* lds, int bx, int G) {
    LAS unsigned* hist = (LAS unsigned*)lds;
    LAS unsigned* sh = hist + 256;
    LAS unsigned* wcnt = hist + 512;
    const int tid = threadIdx.x, lane = tid & 63, wave = tid >> 6;
    const float* AFF = (const float*)(ws + WS_AFF); int* INV = (int*)(ws + WS_INV); int* IDX = (int*)(ws + WS_IDX); float* GATE = (float*)(ws + WS_GATE);
    for (int be = bx; be < NB * NE; be += G) {
        const int b = be / NE, e = be % NE; const float* src = AFF + (size_t)be * NS;
        unsigned u[8];
#pragma unroll
        for (int i = 0; i < 8; ++i) u[i] = __float_as_uint(src[tid * 8 + i]);
        unsigned prefix = 0u, krem = CAP;
#pragma unroll 1
        for (int pass = 0; pass < 4; ++pass) { const int shift = 24 - 8 * pass; const unsigned pmask = pass == 0 ? 0u : (0xffffffffu << (shift + 8));
            if (tid < 256) hist[tid] = 0u;
            __syncthreads();
#pragma unroll
            for (int i = 0; i < 8; ++i) if ((u[i] & pmask) == prefix) __hip_atomic_fetch_add(&hist[(u[i] >> shift) & 255u], 1u, __ATOMIC_RELAXED, __HIP_MEMORY_SCOPE_WORKGROUP);
            __syncthreads();
            if (wave == 0) {
                unsigned c4[4]; unsigned tot = 0u;
#pragma unroll
                for (int i = 0; i < 4; ++i) { c4[i] = hist[255 - (lane * 4 + i)]; tot += c4[i]; }
                unsigned inc = tot;
#pragma unroll
                for (int o = 1; o < 64; o <<= 1) { const unsigned t = __shfl_up(inc, o); if (lane >= o) inc += t; }
                const unsigned before = inc - tot;
                if (before < krem && inc >= krem) { unsigned acc = before;
#pragma unroll
                    for (int i = 0; i < 4; ++i) { if (acc < krem && acc + c4[i] >= krem) { sh[0] = prefix | ((unsigned)(255 - (lane * 4 + i)) << shift); sh[1] = krem - acc; } acc += c4[i]; } }
            }
            __syncthreads();
            prefix = sh[0]; krem = sh[1];
            __syncthreads();
        }
        unsigned ngt = 0u, neq = 0u;
#pragma unroll
        for (int i = 0; i < 8; ++i) { ngt += (u[i] > prefix) ? 1u : 0u; neq += (u[i] == prefix) ? 1u : 0u; }
        unsigned ig = ngt, iq = neq;
#pragma unroll
        for (int o = 1; o < 64; o <<= 1) { const unsigned tg = __shfl_up(ig, o), tq = __shfl_up(iq, o); if (lane >= o) { ig += tg; iq += tq; } }
        if (lane == 63) { wcnt[wave * 2] = ig; wcnt[wave * 2 + 1] = iq; }
        __syncthreads();
        unsigned bg = 0u, bq = 0u;
        for (int w = 0; w < wave; ++w) { bg += wcnt[w * 2]; bq += wcnt[w * 2 + 1]; }
        unsigned pg = bg + ig - ngt, pq = bq + iq - neq;
#pragma unroll
        for (int i = 0; i < 8; ++i) { const int idx = tid * 8 + i; int slot = -1;
            if (u[i] > prefix) { slot = (int)(pg + min(pq, krem)); ++pg; }
            else if (u[i] == prefix) { if (pq < krem) slot = (int)(pg + pq); ++pq; }
            INV[(size_t)be * NS + idx] = slot;
            if (slot >= 0) { IDX[e * (NB * CAP) + b * CAP + slot] = b * NS + idx; GATE[(size_t)e * (NB * CAP) + b * CAP + slot] = __uint_as_float(u[i]); } }
        __syncthreads();
    }
}
__device__ __forceinline__ void ph_combine(const MegaArgs& a, int l, int gw, int ngw, int lane) {
    const bf16* Y = (const bf16*)(a.ws + WS_PROJ); const int* INV = (const int*)(a.ws + WS_INV); bf16* XN = (bf16*)(a.ws + WS_XN); const bool last = (l == DEPTH - 1);
    for (int row = gw; row < NT; row += ngw) { const int b = row / NS, s = row % NS;
        float4* hr = (float4*)(a.H + (size_t)row * DM) + lane; float4 v[4];
#pragma unroll
        for (int j = 0; j < 4; ++j) v[j] = hr[64 * j];
        int slot_l = -1; if (lane < NE) slot_l = INV[((size_t)b * NE + lane) * NS + s];
        unsigned long long msk = __ballot(slot_l >= 0);
        while (msk) { const int e = __builtin_ctzll(msk); msk &= msk - 1; const int slot = __shfl(slot_l, e);
            const uint2* y = (const uint2*)(Y + ((size_t)e * (NB * CAP) + b * CAP + slot) * DM) + lane;
#pragma unroll
            for (int j = 0; j < 4; ++j) { const uint2 w = y[64 * j]; v[j].x += bf2f(w.x & 0xffff); v[j].y += bf2f(w.x >> 16); v[j].z += bf2f(w.y & 0xffff); v[j].w += bf2f(w.y >> 16); } }
        if (last) { float ssum = 0.f;
#pragma unroll
            for (int j = 0; j < 4; ++j) ssum += v[j].x * v[j].x + v[j].y * v[j].y + v[j].z * v[j].z + v[j].w * v[j].w;
            const float rstd = rsqrtf(wave_sum(ssum) * (1.f / DM) + EPS);
#pragma unroll
            for (int j = 0; j < 4; ++j) { const float4 gg = ((const float4*)a.final_norm)[lane + 64 * j]; hr[64 * j] = make_float4(v[j].x * rstd * gg.x, v[j].y * rstd * gg.y, v[j].z * rstd * gg.z, v[j].w * rstd * gg.w); } }
        else {
#pragma unroll
            for (int j = 0; j < 4; ++j) hr[64 * j] = v[j];
            row_norm_store(v, a.attn_norm + (l + 1) * DM, XN + (size_t)row * DM, lane); }
    }
}

enum { PL_PROJ = 0, PL_MLAUP, PL_ATTN, PL_OUT, PL_ROUTER, PL_TOPK, PL_MOE1, PL_MOE2, PL_COMBINE, PL_COUNT };
constexpr int N_PHASES = 1 + DEPTH * PL_COUNT;
constexpr int REP_PH = -1;
#define REPEAT(ph) for (int rep_ = 0; rep_ < (REP_PH == (ph) ? 2 : 1); ++rep_)
#define IN(k) (lo <= (k) && (k) < hi)
#define SEAM(k) do { if (IN((k) + 1)) xcd_barrier(bar); } while (0)
#define PH_LOCALS unsigned char* ws = a.ws; asm volatile("" : "+s"(ws)); int t_ = threadIdx.x; asm volatile("" : "+v"(t_)); int bx = blockIdx.x; asm volatile("" : "+s"(bx)); \
    const int vcu = (bx % 8) * (G / 8) + bx / 8; const int lane = t_ & 63, wave = __builtin_amdgcn_readfirstlane(t_ >> 6), gw = vcu * NWAVES + wave; (void)lane; (void)gw; (void)ws; (void)vcu;
template <int l> __device__ __forceinline__ void layer_phases(const MegaArgs& a, LAS unsigned char* lds, const XcdBarrier& bar, const int lo, const int hi) {
    constexpr int G = 256, ngw = G * NWAVES, pb = 1 + l * PL_COUNT;
        if (IN(pb + PL_PROJ)) { PH_LOCALS REPEAT(PL_PROJ) {
            pg8::Gemm g{(bf16*)(ws + WS_XN), (bf16*)(ws + WS_WIN), DM, DM, DM, nullptr}; pg8::StaticOrder S; S.init(NT / 256, NP / 256, G, bx, 0);
            pg8::EpiProj E{(bf16*)(ws + WS_PROJ), (float*)(ws + WS_COS64), (float*)(ws + WS_SIN64), (float*)(ws + WS_COS32), (float*)(ws + WS_SIN32), (float*)(ws + WS_CQSS), (float*)(ws + WS_CKVSS)};
            pg8::gemm_phase<pg8::EpiProj, pg8::StaticOrder, true>(lds, g, S, E); }
            SEAM(pb + PL_PROJ);
        }
        if (IN(pb + PL_MLAUP)) { PH_LOCALS REPEAT(PL_MLAUP) {
            { pg8::Gemm g{(bf16*)(ws + WS_PROJ) + C_CQ, (bf16*)(ws + WS_WUQ), 256, NP, 256, nullptr}; pg8::StaticOrder S; S.init(NT / 256, 3, G, bx, 0);
              typedef pg8::EpiMla<true, 576, 576> EQ; EQ E{(bf16*)(ws + WS_QB), (float*)(ws + WS_CQSS), 1.f / 256.f, (float*)(ws + WS_COS32), (float*)(ws + WS_SIN32)};
              pg8::gemm_phase<EQ, pg8::StaticOrder, true>(lds, g, S, E); }
            { pg8::Gemm g{(bf16*)(ws + WS_PROJ) + C_CKV, (bf16*)(ws + WS_WUKV), 128, NP, 128, nullptr}; pg8::StaticOrder S; S.init(NT / 256, 3, G, bx, 0);
              typedef pg8::EpiMla<false, 768, 768> EK; EK E{(bf16*)(ws + WS_KV), (float*)(ws + WS_CKVSS), 1.f / 128.f, (float*)(ws + WS_COS32), (float*)(ws + WS_SIN32)};
              pg8::gemm_phase<EK, pg8::StaticOrder, true>(lds, g, S, E); } }
            SEAM(pb + PL_MLAUP);
        }
        if (IN(pb + PL_ATTN)) { PH_LOCALS
            REPEAT(PL_ATTN) { const att::AttnP P{(bf16*)(ws + WS_PROJ), (bf16*)(ws + WS_QB), (bf16*)(ws + WS_KV), (bf16*)(ws + WS_XN), (float*)(ws + WS_SS), a.na_rpb + (size_t)l * 4 * 15 * 31, a.swa_sink + l * 6}; att::attn_phase(P, lds, vcu); }
            SEAM(pb + PL_ATTN);
        }
        if (IN(pb + PL_OUT)) { PH_LOCALS
            pg8::StaticOrder S; S.init(NT / 256, DM / 256, G, bx, 0);
            LAS float* fac = (LAS float*)(lds + RING_BYTES + 1024);
            { pg8::Unit u; const float* SS = (const float*)(ws + WS_SS);
              for (int i = 0; i < 2 && S.next(i, u); ++i) if (t_ < 256) { const float4* ss4 = (const float4*)(SS + (size_t)(u.pm * 256 + t_) * 16); const float4 s0 = ss4[0], s1 = ss4[1], s2 = ss4[2], s3 = ss4[3];
                  const float ra = rsqrtf((s0.x + s0.y + s0.z + s0.w) * (1.f / 256.f) + EPS), rb = rsqrtf((s1.x + s1.y + s1.z + s1.w + s2.x + s2.y) * (1.f / 384.f) + EPS), rc = rsqrtf((s2.z + s2.w + s3.x + s3.y + s3.z + s3.w) * (1.f / 384.f) + EPS);
                  LAS float* f = fac + (i * 256 + t_) * 4; f[0] = ra / rb; f[1] = rb / rc; f[2] = rc; f[3] = 0.f; } }
            __syncthreads();
            pg8::Gemm g{(bf16*)(ws + WS_XN), (bf16*)(ws + WS_WOUT), DM, DM, DM, nullptr};
            pg8::EpiResid E{l == 0 ? a.x : a.H, a.H, fac};
            pg8::gemm_phase<pg8::EpiResid, pg8::StaticOrder, true>(lds, g, S, E);
            SEAM(pb + PL_OUT);
        }
        if (IN(pb + PL_ROUTER)) { PH_LOCALS REPEAT(PL_ROUTER) ph_router(a, l, lds, gw, ngw, lane); SEAM(pb + PL_ROUTER); }
        if (IN(pb + PL_TOPK)) { PH_LOCALS REPEAT(PL_TOPK) ph_topk(ws, lds, bx, G); SEAM(pb + PL_TOPK); }
        if (IN(pb + PL_MOE1)) { PH_LOCALS
            pg8::StaticOrder S; S.init(NSLOTS / 256, 8, G, bx, 16);
            LAS int* gidx = (LAS int*)(lds + RING_BYTES + 1024);
            { pg8::Unit u; const int* IDX = (const int*)(ws + WS_IDX);
              for (int i = 0; i < 8 && S.next(i, u); ++i) if (t_ < 256) gidx[i * 256 + t_] = IDX[u.pm * 256 + t_]; }
            __syncthreads();
            REPEAT(PL_MOE1) {
            pg8::Gemm g{(bf16*)(ws + WS_XN), (bf16*)(ws + WS_WGU), DM, DM, DM, gidx};
            pg8::EpiSwiglu E{(bf16*)(ws + WS_HID)};
            pg8::gemm_phase<pg8::EpiSwiglu, pg8::StaticOrder, true, true>(lds, g, S, E); }
            SEAM(pb + PL_MOE1);
        }
        if (IN(pb + PL_MOE2)) { PH_LOCALS REPEAT(PL_MOE2) {
            pg8::Gemm g{(bf16*)(ws + WS_HID), (bf16*)(ws + WS_WD), DM, DM, DM, nullptr}; pg8::StaticOrder S; S.init(NSLOTS / 256, 4, G, bx, 16);
            pg8::EpiGate E{(bf16*)(ws + WS_PROJ), (float*)(ws + WS_GATE)};
            pg8::gemm_phase<pg8::EpiGate, pg8::StaticOrder, true>(lds, g, S, E); }
            SEAM(pb + PL_MOE2);
        }
        if (IN(pb + PL_COMBINE)) { PH_LOCALS
            ph_combine(a, l, gw, ngw, lane);
            if (l + 1 < DEPTH) { __syncthreads(); REPEAT(100) ph_prep(a, l + 1, lds, gw, ngw, wave, lane); }
            SEAM(pb + PL_COMBINE);
        }
}
__global__ void __launch_bounds__(NWAVES * 64, 2) mega(MegaArgs a) {
    extern __shared__ __attribute__((aligned(16))) unsigned char lds_raw[];
    LAS unsigned char* lds = (LAS unsigned char*)lds_raw;
    constexpr int G = 256;
    constexpr int ngw = G * NWAVES;
    for (int u = threadIdx.x; u < (LDS_BYTES - RING_BYTES) / 4; u += NWAVES * 64) ((LAS unsigned*)(lds + RING_BYTES))[u] = 0u;
    __syncthreads();
    XcdBarrier bar = xcd_barrier_post((unsigned*)(a.ws + WS_CTL) + CW_BAR, (volatile LAS unsigned*)(lds + MISC_OFF) + 8);
    const int lo = a.ph_lo, hi = a.ph_hi;
    if (IN(0)) { PH_LOCALS REPEAT(100) ph_prep(a, 0, lds, gw, ngw, wave, lane); ph_rope_tables(ws, bx * NWAVES * 64 + t_, G * NWAVES * 64); ph_norm_x(a, gw, ngw, lane); SEAM(0); }
    layer_phases<0>(a, lds, bar, lo, hi);
    layer_phases<1>(a, lds, bar, lo, hi);
    static_assert(DEPTH == 2, "two layers are written out");
}


#ifndef MK_PER_PHASE
#define MK_PER_PHASE 0
#endif
extern "C" void kernel_launch(void* const* d_in, const int* in_sizes, int n_in, void* d_out, int out_size, void* d_ws, size_t ws_size, hipStream_t stream) {
    if (n_in != 17 || out_size != NT * DM || ws_size < WS_END) { fprintf(stderr, "kernel_launch: unexpected shapes (n_in %d out %d ws %zu)\n", n_in, out_size, ws_size); return; }
    static int grid = 0;
    if (grid == 0) { int dev = 0, cus = 0; (void)hipGetDevice(&dev); (void)hipDeviceGetAttribute(&cus, hipDeviceAttributeMultiprocessorCount, dev);
        if (hipFuncSetAttribute((const void*)mega, hipFuncAttributeMaxDynamicSharedMemorySize, LDS_BYTES) != hipSuccess) fprintf(stderr, "hipFuncSetAttribute failed\n");
        if (cus != 256) fprintf(stderr, "kernel_launch: built for a 256-CU device (got %d CUs)\n", cus);
        grid = 256; }
    (void)hipMemsetAsync((char*)d_ws + WS_CTL, 0, 1 * MiB, stream);
    MegaArgs ma{};
    ma.x = (const float*)d_in[0]; ma.attn_norm = (const float*)d_in[1]; ma.w_in = (const float*)d_in[2]; ma.na_rpb = (const float*)d_in[3]; ma.q_norm = (const float*)d_in[4]; ma.w_uq = (const float*)d_in[5];
    ma.kv_norm = (const float*)d_in[6]; ma.w_ukv = (const float*)d_in[7]; ma.swa_sink = (const float*)d_in[8]; ma.group_norm = (const float*)d_in[9]; ma.w_out = (const float*)d_in[10]; ma.ffn_norm = (const float*)d_in[11];
    ma.w_router = (const float*)d_in[12]; ma.w_gate = (const float*)d_in[13]; ma.w_up = (const float*)d_in[14]; ma.w_down = (const float*)d_in[15]; ma.final_norm = (const float*)d_in[16];
    ma.H = (float*)d_out; ma.ws = (unsigned char*)d_ws;
#if MK_PER_PHASE
    for (int p = 0; p < N_PHASES; ++p) { ma.ph_lo = p; ma.ph_hi = p + 1; hipLaunchKernelGGL(mega, dim3(grid), dim3(NWAVES * 64), LDS_BYTES, stream, ma); }
#else
    ma.ph_lo = 0; ma.ph_hi = N_PHASES; hipLaunchKernelGGL(mega, dim3(grid), dim3(NWAVES * 64), LDS_BYTES, stream, ma);
#endif
}
```

```cpp
#include <hip/hip_runtime.h>
#include <cstdint>
#include <cstdio>

typedef unsigned short bf16;
constexpr int NB = 8, NS = 4096, DM = 1024, NT = NB * NS, NP = 2048, NE = 16, CAP = 512, DEPTH = 2;
constexpr int NSLOTS = NE * NB * CAP;
constexpr float LOG2E = 1.4426950408889634f;
constexpr float QS64 = 0.125f * LOG2E;
constexpr float QS96 = 0.10206207261596577f * LOG2E;
constexpr float EPS = 1e-6f;
constexpr int C_AQ = 0, C_AK = 256, C_AV = 512, C_CQ = 768, C_CKV = 1024, C_KR = 1152, C_SQ = 1184, C_SK = 1568, C_SV = 1696, C_END = 1824;

constexpr size_t MiB = 1u << 20;
constexpr size_t WS_CTL = 0;
constexpr size_t WS_COS64 = 1 * MiB, WS_SIN64 = WS_COS64 + 512 * 1024, WS_COS32 = 2 * MiB, WS_SIN32 = WS_COS32 + 256 * 1024;
constexpr size_t WS_WIN = 4 * MiB, WS_WUQ = 8 * MiB, WS_WUKV = 8 * MiB + 512 * 1024, WS_WOUT = 9 * MiB, WS_WGU = 12 * MiB, WS_WD = 76 * MiB;
constexpr size_t WS_CQSS = 108 * MiB, WS_CKVSS = WS_CQSS + 512 * 1024, WS_SS = 109 * MiB, WS_AFF = 111 * MiB, WS_INV = 113 * MiB, WS_IDX = 115 * MiB, WS_GATE = WS_IDX + 256 * 1024;
constexpr size_t WS_XN = 120 * MiB;
constexpr size_t WS_PROJ = 184 * MiB;
constexpr size_t WS_QB = 312 * MiB;
constexpr size_t WS_KV = 348 * MiB;
constexpr size_t WS_HID = 312 * MiB;
constexpr size_t WS_HB = 440 * MiB;
constexpr size_t WS_RSTD1 = 504 * MiB, WS_RSTD2 = WS_RSTD1 + 256 * 1024;
constexpr size_t WS_END = 505 * MiB;

__device__ __forceinline__ unsigned f2bf(float f) { unsigned u = __builtin_bit_cast(unsigned, f); return (u + 0x7fffu + ((u >> 16) & 1u)) >> 16; }
__device__ __forceinline__ float bf2f(unsigned short b) { return __builtin_bit_cast(float, (unsigned)b << 16); }
__device__ __forceinline__ float wave_sum(float v) {
#pragma unroll
    for (int o = 1; o < 64; o <<= 1) v += __shfl_xor(v, o);
    return v;
}

enum { PK_WIN = 0, PK_WUQ = 1, PK_WUKV = 2, PK_WOUT = 3, PK_WGU = 4, PK_WD = 5 };
__device__ __forceinline__ int prep_map(int kind, int n, float& sc, int& which) {
    sc = 1.f; which = 0;
    switch (kind) {
    case PK_WIN:
        if (n < 256) { sc = QS64; return n; }
        if (n < C_KR) return n;
        if (n < C_SQ) { const int p = n - C_KR, g = p >> 3, e = p & 7; return C_KR + 4 * g + (e & 3) + 16 * (e >> 2); }
        if (n < C_SK) { const int p = n - C_SQ, h = p >> 6, pp = p & 63, g = pp >> 3, e = pp & 7; sc = QS64; return C_SQ + h * 64 + 4 * g + (e & 3) + 32 * (e >> 2); }
        if (n < C_SV) { const int p = n - C_SK, h = p >> 6, pp = p & 63, g = pp >> 3, e = pp & 7; return C_SK + h * 64 + 4 * g + (e & 3) + 32 * (e >> 2); }
        if (n < C_END) return n;
        return -1;
    case PK_WUQ:
        if (n < 576) { const int h = n / 96, d = n % 96; sc = QS96; if (d < 64) return n; const int p = d - 64, g = p >> 3, e = p & 7; return h * 96 + 64 + 4 * g + (e & 3) + 16 * (e >> 2); }
        return -1;
    case PK_WUKV:
        if (n < 384) { const int h = n >> 6, d = n & 63; return h * 128 + d; }
        { const int m = n - 384, h = m >> 6, d = m & 63; return h * 128 + 64 + d; }
    case PK_WGU: { const int pn = n >> 8, half = (n >> 7) & 1, jj = n & 127; which = half; return 128 * pn + jj; }
    default: return n;
    }
}
#define LAS __attribute__((address_space(3)))
#define GAS __attribute__((address_space(1)))
namespace pg8 {
typedef short bf16x8 __attribute__((ext_vector_type(8)));
typedef float f32x4 __attribute__((ext_vector_type(4)));
typedef unsigned u32x4 __attribute__((ext_vector_type(4)));
constexpr int BM = 256, BK = 64, HALF = 128, HTB = HALF * BK * 2, STAGE_BYTES = 8 * HTB, NXCD = 8, WGM = 8;
__host__ __device__ __forceinline__ int lds_byte(int r, int c) { const int st = (r >> 4) * 2 + (c >> 5), rr = r & 15, cc = c & 31, ob = rr * 64 + cc * 2; return st * 1024 + (ob ^ (((ob >> 9) & 1) << 5)); }
__host__ __device__ __forceinline__ void stage_rc(int b, int& R, int& C) { const int st = b / 1024, sb = b % 1024, swz = sb ^ (((sb >> 9) & 1) << 5); R = (st >> 1) * 16 + swz / 64; C = (st & 1) * 32 + (swz % 64) / 2; }
__host__ __device__ __forceinline__ int perm32(int rho) { const int n = rho >> 4, i = rho & 15; return 8 * (i >> 2) + 4 * n + (i & 3); }
struct Unit { int pm, pn, pb; };
struct Gemm { const bf16* A; const bf16* Bt; int K, lda, ldb; const LAS int* gidx; };
struct StaticOrder {
    int nM, nN, nwg, G, c, gm;
    __device__ __forceinline__ void init(int nM_, int nN_, int G_, int c_, int gm_) { nM = nM_; nN = nN_; nwg = nM * nN; G = G_; c = c_; gm = gm_; }
    __device__ __forceinline__ bool next(int i, Unit& u) const {
        const long L = (long)i * G + c; if (L >= nwg) return false;
        int wgid = (int)L; { const int q = nwg / NXCD, r = nwg % NXCD, xcd = wgid % NXCD, off = wgid / NXCD; wgid = (xcd < r ? xcd * (q + 1) : r * (q + 1) + (xcd - r) * q) + off; }
        const int nig = WGM * nN, gid = wgid / nig, fm = gid * WGM, gsz = (nM - fm) < WGM ? (nM - fm) : WGM;
        u.pm = fm + ((wgid % nig) % gsz); u.pn = (wgid % nig) / gsz; u.pb = gm ? (u.pm / gm) * nN + u.pn : u.pn; return true;
    }
};
__device__ __forceinline__ unsigned cvt_pk_bf16(float lo, float hi) { unsigned r; asm volatile("v_cvt_pk_bf16_f32 %0, %1, %2" : "=v"(r) : "v"(lo), "v"(hi)); return r; }

template <class Epi, class Sched, bool ALIGN_EPI, bool GATHER = false>
__device__ __forceinline__ void gemm_phase(LAS unsigned char* lds, const Gemm g, const Sched& S, const Epi& E) {
    int tid = threadIdx.x; asm volatile("" : "+v"(tid));
    const int wid = __builtin_amdgcn_readfirstlane(tid >> 6), lane = tid & 63, wr = wid >> 2, wc = wid & 3, fr = lane & 15, fq = lane >> 4;
    const int K = g.K, nt = K / BK;
    unsigned vC[2][2], vNs[2][2], voffB[2]; int RA[2], CA[2];
    const size_t kstep = (size_t)(BK * 2);
    const size_t hstepA = (size_t)HALF * g.lda * 2, hstepB = (size_t)HALF * g.ldb * 2, tstepA = GATHER ? 0 : 2 * hstepA, tstepB = 2 * hstepB;
#pragma unroll
    for (int i = 0; i < 2; ++i) { int R, C; stage_rc(tid * 16 + i * 8192, R, C); const int Rb = Epi::PERM ? ((R & ~31) + perm32(R & 31)) : R; RA[i] = R; CA[i] = C;
        voffB[i] = (unsigned)(Rb * g.ldb + C) * 2u;
#pragma unroll
        for (int h = 0; h < 2; ++h) { vC[h][i] = GATHER ? ((unsigned)g.gidx[h * HALF + R] * (unsigned)(g.lda * 2) + (unsigned)C * 2u) : ((unsigned)(R * g.lda + C) * 2u + (unsigned)(h * hstepA)); vNs[h][i] = vC[h][i]; } }
    unsigned (&vN)[2][2] = GATHER ? vNs : vC;
    const unsigned ldsw = (unsigned)wid * 1024u;
    const int aoff = lds_byte(wr * 64 + fr, fq * 8), boff = lds_byte(wc * 32 + fr, fq * 8);
#define PG8_SA(b, h) (((b) * 2 + (h)) * HTB)
#define PG8_SB(b, h) ((4 + (b) * 2 + (h)) * HTB)
#define PG8_STAGE(bufoff, gbase, voff) do { _Pragma("unroll") for (int _i = 0; _i < 2; ++_i) \
        __builtin_amdgcn_global_load_lds((const unsigned*)((const char*)(gbase) + (voff)[_i]), (LAS unsigned*)(lds + (bufoff) + ldsw + _i * 8192), 16, 0, 0); } while (0)
#define PG8_STAGEA(bufoff, gbase, V, h) do { _Pragma("unroll") for (int _i = 0; _i < 2; ++_i) \
        __builtin_amdgcn_global_load_lds((const unsigned*)((const char*)(gbase) + (V)[h][_i]), (LAS unsigned*)(lds + (bufoff) + ldsw + _i * 8192), 16, 0, 0); } while (0)
#define PG8_STAGEAL(bufoff, gbase, h) do { _Pragma("unroll") for (int _i = 0; _i < 2; ++_i) { const unsigned _v = (GATHER && last) ? vN[h][_i] : vC[h][_i]; \
        __builtin_amdgcn_global_load_lds((const unsigned*)((const char*)(gbase) + _v), (LAS unsigned*)(lds + (bufoff) + ldsw + _i * 8192), 16, 0, 0); } } while (0)
#define PG8_LDA(dst, b, h) do { _Pragma("unroll") for (int m = 0; m < 4; ++m) _Pragma("unroll") for (int k = 0; k < 2; ++k) dst[m][k] = *(const LAS bf16x8*)(lds + PG8_SA(b, h) + aoff + m * 2048 + k * 1024); } while (0)
#define PG8_LDB(dst, b, h) do { _Pragma("unroll") for (int n = 0; n < 2; ++n) _Pragma("unroll") for (int k = 0; k < 2; ++k) dst[n][k] = *(const LAS bf16x8*)(lds + PG8_SB(b, h) + boff + n * 2048 + k * 1024); } while (0)
#define PG8_MMA(ai, bj, At, Bt) do { __builtin_amdgcn_s_setprio(1); _Pragma("unroll") for (int m = 0; m < 4; ++m) _Pragma("unroll") for (int n = 0; n < 2; ++n) _Pragma("unroll") for (int k = 0; k < 2; ++k) \
        acc[ai][bj][m][n] = __builtin_amdgcn_mfma_f32_16x16x32_bf16(Bt[n][k], At[m][k], acc[ai][bj][m][n], 0, 0, 0); __builtin_amdgcn_s_setprio(0); } while (0)
#define PG8_WAIT_V(n) asm volatile("s_waitcnt vmcnt(" #n ")" ::: "memory")
#define PG8_WAIT_L(n) asm volatile("s_waitcnt lgkmcnt(" #n ")" ::: "memory")
#define PG8_BAR __builtin_amdgcn_s_barrier()
#define PG8_SCHED __builtin_amdgcn_sched_barrier(0)
    Unit cur, nxt; int ui = 0;
    if (!S.next(0, cur)) return;
    f32x4 acc[2][2][4][2];
#pragma unroll
    for (int a = 0; a < 2; ++a)
#pragma unroll
        for (int b = 0; b < 2; ++b)
#pragma unroll
            for (int m = 0; m < 4; ++m)
#pragma unroll
                for (int n = 0; n < 2; ++n) acc[a][b][m][n] = (f32x4){0.f, 0.f, 0.f, 0.f};
    bf16x8 At[4][2], B0[2][2], B1[2][2];
    const char* cA = (const char*)g.A + (size_t)cur.pm * tstepA; const char* cB = (const char*)g.Bt + (size_t)cur.pb * tstepB;
    PG8_STAGE(PG8_SB(0, 0), cB, voffB); PG8_STAGE(PG8_SB(0, 1), cB + hstepB, voffB); PG8_STAGEA(PG8_SA(0, 0), cA, vC, 0); PG8_STAGEA(PG8_SA(0, 1), cA, vC, 1);
    if (wr == 1) PG8_BAR;
    PG8_WAIT_V(2); PG8_BAR;
    PG8_STAGE(PG8_SB(1, 0), cB + kstep, voffB); PG8_STAGEA(PG8_SA(1, 0), cA + kstep, vC, 0); PG8_STAGE(PG8_SB(1, 1), cB + hstepB + kstep, voffB);
    PG8_WAIT_V(6); PG8_BAR;
    for (;;) {
        const bool has_next = S.next(ui + 1, nxt);
        if (GATHER && has_next) {
#pragma unroll
            for (int i = 0; i < 2; ++i)
#pragma unroll
                for (int h = 0; h < 2; ++h) vNs[h][i] = (unsigned)g.gidx[(ui + 1) * BM + h * HALF + RA[i]] * (unsigned)(g.lda * 2) + (unsigned)CA[i] * 2u; }
        const char* nA = has_next ? (const char*)g.A + (size_t)nxt.pm * tstepA : cA; const char* nB = has_next ? (const char*)g.Bt + (size_t)nxt.pb * tstepB : cB;
        for (int t = 0; t < nt; t += 2) {
            const bool last = (t == nt - 2);
            const char* a1 = cA + (size_t)(t + 1) * kstep;
            const char* a2 = last ? nA : cA + (size_t)(t + 2) * kstep; const char* b2 = last ? nB : cB + (size_t)(t + 2) * kstep;
            const char* a3 = a2 + kstep; const char* b3 = b2 + kstep;
            PG8_LDB(B0, 0, 0); PG8_LDB(B1, 0, 1); PG8_SCHED; PG8_LDA(At, 0, 0); PG8_STAGEA(PG8_SA(1, 1), a1, vC, 1);
            PG8_WAIT_V(8); PG8_WAIT_L(0); PG8_BAR; PG8_MMA(0, 0, At, B0); PG8_MMA(0, 1, At, B1); PG8_BAR; PG8_SCHED;
            PG8_LDA(At, 0, 1); PG8_STAGE(PG8_SB(0, 0), b2, voffB); PG8_STAGE(PG8_SB(0, 1), b2 + hstepB, voffB); PG8_STAGEAL(PG8_SA(0, 0), a2, 0);
            PG8_WAIT_V(8); PG8_WAIT_L(0); PG8_BAR; PG8_MMA(1, 0, At, B0); PG8_MMA(1, 1, At, B1); PG8_BAR; PG8_SCHED;
            PG8_LDB(B0, 1, 0); PG8_LDB(B1, 1, 1); PG8_SCHED; PG8_LDA(At, 1, 0); PG8_STAGEAL(PG8_SA(0, 1), a2, 1);
            PG8_WAIT_V(8); PG8_WAIT_L(0); PG8_BAR; PG8_MMA(0, 0, At, B0); PG8_MMA(0, 1, At, B1); PG8_BAR; PG8_SCHED;
            PG8_LDA(At, 1, 1); PG8_STAGE(PG8_SB(1, 0), b3, voffB); PG8_STAGE(PG8_SB(1, 1), b3 + hstepB, voffB); PG8_STAGEAL(PG8_SA(1, 0), a3, 0);
            PG8_WAIT_V(8); PG8_WAIT_L(0); PG8_BAR; PG8_MMA(1, 0, At, B0); PG8_MMA(1, 1, At, B1); PG8_BAR; PG8_SCHED;
            if constexpr (Epi::KHOOK) { if (t == 2 || t == 8) { asm volatile("" ::: "memory"); E.khook(acc, ui, t == 2 ? 0 : 1, wr, fr); asm volatile("" ::: "memory"); } }
        }
        if constexpr (ALIGN_EPI) { if (wr == 0) PG8_BAR; }
        { int t2 = threadIdx.x; asm volatile("" : "+v"(t2)); E(acc, cur, wr, wc, t2 & 15, (t2 >> 4) & 3, ui); }
        if (!has_next) break;
#pragma unroll
        for (int a = 0; a < 2; ++a)
#pragma unroll
            for (int b = 0; b < 2; ++b)
#pragma unroll
                for (int m = 0; m < 4; ++m)
#pragma unroll
                    for (int n = 0; n < 2; ++n) acc[a][b][m][n] = (f32x4){0.f, 0.f, 0.f, 0.f};
        cur = nxt; cA = nA; cB = nB; ++ui;
        if (GATHER) {
#pragma unroll
            for (int i = 0; i < 2; ++i)
#pragma unroll
                for (int h = 0; h < 2; ++h) vC[h][i] = vNs[h][i]; }
        if constexpr (ALIGN_EPI) { if (wr == 1) PG8_BAR; }
    }
    PG8_WAIT_V(0);
    if constexpr (!ALIGN_EPI) { if (wr == 0) PG8_BAR; }
    PG8_BAR;
#undef PG8_SA
#undef PG8_SB
#undef PG8_STAGE
#undef PG8_STAGEA
#undef PG8_STAGEAL
#undef PG8_LDA
#undef PG8_LDB
#undef PG8_MMA
#undef PG8_WAIT_V
#undef PG8_WAIT_L
#undef PG8_BAR
#undef PG8_SCHED
}

typedef const f32x4 (&AccRef)[2][2][4][2];
template <int DIM> __device__ __forceinline__ void rope_cs(int pos, int j0, f32x4& c, f32x4& s) {
    constexpr float KEXP = 13.287712379549449f * 2.f / DIM;
#pragma unroll
    for (int e = 0; e < 4; ++e) { const float inv = __builtin_amdgcn_exp2f(-(float)(j0 + e) * KEXP), ang = (float)pos * inv, rev = ang * 0.15915494309189535f, fr = __builtin_amdgcn_fractf(rev);
        c[e] = __builtin_amdgcn_cosf(fr); s[e] = __builtin_amdgcn_sinf(fr); }
}
__device__ __forceinline__ void st_bf16x8(bf16* p, f32x4 v0, f32x4 v1) { u32x4 w; w.x = cvt_pk_bf16(v0[0], v0[1]); w.y = cvt_pk_bf16(v0[2], v0[3]); w.z = cvt_pk_bf16(v1[0], v1[1]); w.w = cvt_pk_bf16(v1[2], v1[3]); *(u32x4*)p = w; }
struct EpiProj {
    static constexpr bool PERM = true, KHOOK = false;
    bf16* P; float *cqss, *ckvss; const LAS float* rs;
    __device__ __forceinline__ void operator()(AccRef acc, const Unit& u, int wr, int wc, int fr, int fq, int ui) const {
#pragma unroll
        for (int ai = 0; ai < 2; ++ai)
#pragma unroll
            for (int m = 0; m < 4; ++m) { const int row = u.pm * BM + ai * HALF + wr * 64 + m * 16 + fr; const int pos = row & (NS - 1); float ssq = 0.f; const float rsv = rs[ui * BM + ai * HALF + wr * 64 + m * 16 + fr];
#pragma unroll
                for (int bj = 0; bj < 2; ++bj) { const int cw = u.pn * BM + bj * HALF + wc * 32, col0 = cw + 8 * fq; f32x4 v0 = acc[ai][bj][m][0] * rsv, v1 = acc[ai][bj][m][1] * rsv;
                    if (cw >= C_SQ && cw < C_SV) { const int g = ((col0 - C_SQ) & 63) >> 3; f32x4 c, s; rope_cs<64>(pos, 4 * g, c, s);
                        const f32x4 o0 = v0 * c - v1 * s, o1 = v1 * c + v0 * s; v0 = o0; v1 = o1; }
                    else if (cw == C_KR) { f32x4 c, s; rope_cs<32>(pos, 4 * fq, c, s);
                        const f32x4 o0 = v0 * c - v1 * s, o1 = v1 * c + v0 * s; v0 = o0; v1 = o1; }
                    if (u.pn == 3 || (u.pn == 4 && bj == 0)) ssq += (v0[0] * v0[0] + v0[1] * v0[1]) + (v0[2] * v0[2] + v0[3] * v0[3]) + (v1[0] * v1[0] + v1[1] * v1[1]) + (v1[2] * v1[2] + v1[3] * v1[3]);
                    st_bf16x8(P + (size_t)row * NP + col0, v0, v1); }
                if (u.pn == 3 || u.pn == 4) { ssq += __shfl_xor(ssq, 16); ssq += __shfl_xor(ssq, 32); if (fq == 0) (u.pn == 3 ? cqss : ckvss)[(size_t)row * 4 + wc] = ssq; }
            }
    }
};
template <bool QMODE, int ldc, int ncols> struct EpiMla {
    static constexpr bool PERM = true, KHOOK = false;
    bf16* O; const LAS float* rs;
    __device__ __forceinline__ void operator()(AccRef acc, const Unit& u, int wr, int wc, int fr, int fq, int ui) const {
#pragma unroll
        for (int ai = 0; ai < 2; ++ai)
#pragma unroll
            for (int m = 0; m < 4; ++m) { const int row = u.pm * BM + ai * HALF + wr * 64 + m * 16 + fr; const int pos = row & (NS - 1);
                const float rsv = rs[ui * BM + ai * HALF + wr * 64 + m * 16 + fr];
#pragma unroll
                for (int bj = 0; bj < 2; ++bj) { const int cw = u.pn * BM + bj * HALF + wc * 32, col0 = cw + 8 * fq; if (cw >= ncols) continue;
                    f32x4 v0 = acc[ai][bj][m][0] * rsv, v1 = acc[ai][bj][m][1] * rsv;
                    if (QMODE && (cw % 96) == 64) { f32x4 c, s; rope_cs<32>(pos, 4 * fq, c, s);
                        const f32x4 o0 = v0 * c - v1 * s, o1 = v1 * c + v0 * s; v0 = o0; v1 = o1; }
                    st_bf16x8(O + (size_t)row * ldc + col0, v0, v1); }
                asm volatile("" ::: "memory"); }
    }
};
struct EpiResid {
    static constexpr bool PERM = true, KHOOK = true;
    bf16* HB; const LAS float* fac;
    __device__ __forceinline__ void khook(f32x4 (&acc)[2][2][4][2], int ui, int which, int wr, int fr) const {
#pragma unroll
        for (int ai = 0; ai < 2; ++ai)
#pragma unroll
            for (int m = 0; m < 4; ++m) { const float f = fac[(ui * BM + ai * HALF + wr * 64 + m * 16 + fr) * 4 + which];
#pragma unroll
                for (int bj = 0; bj < 2; ++bj)
#pragma unroll
                    for (int n = 0; n < 2; ++n) acc[ai][bj][m][n] *= f; }
    }
    __device__ __forceinline__ void operator()(AccRef acc, const Unit& u, int wr, int wc, int fr, int fq, int ui) const {
#pragma unroll
        for (int ai = 0; ai < 2; ++ai)
#pragma unroll
            for (int m = 0; m < 4; ++m) { const int rl = ai * HALF + wr * 64 + m * 16 + fr; const float f = fac[(ui * BM + rl) * 4 + 2]; bf16* p = HB + (size_t)(u.pm * BM + rl) * DM + u.pn * BM + wc * 32 + 8 * fq;
#pragma unroll
                for (int bj = 0; bj < 2; ++bj) { const u32x4 w = *(const u32x4*)(p + bj * HALF); f32x4 h0, h1;
                    h0[0] = __builtin_bit_cast(float, w[0] << 16); h0[1] = __builtin_bit_cast(float, w[0] & 0xffff0000u); h0[2] = __builtin_bit_cast(float, w[1] << 16); h0[3] = __builtin_bit_cast(float, w[1] & 0xffff0000u);
                    h1[0] = __builtin_bit_cast(float, w[2] << 16); h1[1] = __builtin_bit_cast(float, w[2] & 0xffff0000u); h1[2] = __builtin_bit_cast(float, w[3] << 16); h1[3] = __builtin_bit_cast(float, w[3] & 0xffff0000u);
                    st_bf16x8(p + bj * HALF, h0 + acc[ai][bj][m][0] * f, h1 + acc[ai][bj][m][1] * f); } }
    }
};
struct EpiSwiglu {
    static constexpr bool PERM = true, KHOOK = false;
    bf16* Hd; const LAS float* rs;
    __device__ __forceinline__ void operator()(AccRef acc, const Unit& u, int wr, int wc, int fr, int fq, int ui) const {
#pragma unroll
        for (int ai = 0; ai < 2; ++ai)
#pragma unroll
            for (int m = 0; m < 4; ++m) { const size_t row = (size_t)(u.pm * BM + ai * HALF + wr * 64 + m * 16 + fr); f32x4 o[2]; const float rsv = rs[ui * BM + ai * HALF + wr * 64 + m * 16 + fr];
#pragma unroll
                for (int n = 0; n < 2; ++n) { const f32x4 gt = acc[ai][0][m][n] * rsv, up = acc[ai][1][m][n] * rsv;
#pragma unroll
                    for (int e = 0; e < 4; ++e) o[n][e] = gt[e] * __builtin_amdgcn_rcpf(1.f + __builtin_amdgcn_exp2f(-gt[e] * LOG2E)) * up[e]; }
                st_bf16x8(Hd + row * DM + u.pn * HALF + wc * 32 + 8 * fq, o[0], o[1]); }
    }
};
struct EpiGate {
    static constexpr bool PERM = true, KHOOK = false;
    bf16* Y; const LAS float* gate;
    __device__ __forceinline__ void operator()(AccRef acc, const Unit& u, int wr, int wc, int fr, int fq, int ui) const {
#pragma unroll
        for (int ai = 0; ai < 2; ++ai)
#pragma unroll
            for (int m = 0; m < 4; ++m) { const size_t row = (size_t)(u.pm * BM + ai * HALF + wr * 64 + m * 16 + fr); const float gt = gate[ui * BM + ai * HALF + wr * 64 + m * 16 + fr];
#pragma unroll
                for (int bj = 0; bj < 2; ++bj) st_bf16x8(Y + row * DM + u.pn * BM + bj * HALF + wc * 32 + 8 * fq, acc[ai][bj][m][0] * gt, acc[ai][bj][m][1] * gt); }
    }
};
}


namespace att {
typedef short bf16x8 __attribute__((ext_vector_type(8)));
typedef short s16x4 __attribute__((ext_vector_type(4)));
typedef float f32x16 __attribute__((ext_vector_type(16)));
typedef float f32x4 __attribute__((ext_vector_type(4)));
typedef unsigned u32x4 __attribute__((ext_vector_type(4)));
typedef float f32x2_t __attribute__((ext_vector_type(2))); typedef __bf16 bf16x2_t __attribute__((ext_vector_type(2)));
typedef short v4i16_t __attribute__((ext_vector_type(4)));
constexpr int KSLOT = 12288, VSLOT = 8192, NSL = 3;
constexpr int L_K = 0, L_V = NSL * KSLOT, L_WS = L_V + NSL * VSLOT, L_OST = L_WS + 8 * 256, L_BIAS = L_OST + 8 * 4096, L_END = L_BIAS + 2048;
constexpr float THR = 8.f;
constexpr int ATT_PROBE = 0;
constexpr bool LSUM_MFMA = true;
__device__ __forceinline__ int crow(int r, int hi) { return (r & 3) + 8 * (r >> 2) + 4 * hi; }
__device__ __forceinline__ unsigned cvtpk(float lo, float hi) { f32x2_t v = {lo, hi}; bf16x2_t b = __builtin_convertvector(v, bf16x2_t); return __builtin_bit_cast(unsigned, b); }
__device__ __forceinline__ s16x4 vtr(const LAS unsigned char* p) { return __builtin_bit_cast(s16x4, __builtin_amdgcn_ds_read_tr16_b64_v4i16((LAS v4i16_t*)p)); }
__device__ __forceinline__ void glds(const bf16* src, unsigned lds_dst) { unsigned keep;
    asm volatile("s_mov_b32 %0, m0\n\ts_mov_b32 m0, %2\n\ts_nop 0\n\tglobal_load_lds_dwordx4 %1, off\n\ts_mov_b32 m0, %0" : "=&s"(keep) : "v"(src), "s"(lds_dst) : "memory"); }
struct AttnP { const bf16 *PROJ, *QB, *KV; bf16* O; float* SS; const float* rpb; const float* sink; };
#define ATT_WAIT_BAR() do { if (PROBE != 3) asm volatile("s_waitcnt vmcnt(0) lgkmcnt(0)\n\ts_barrier" ::: "memory"); } while (0)

template <int TYPE, int PROBE = 0> __device__ __forceinline__ void attn_unit(const AttnP& P, int b, int h, int qb, LAS unsigned char* lds) {
    constexpr int ND0 = (TYPE == 1) ? 6 : 4;
    int tid = threadIdx.x; asm volatile("" : "+v"(tid));
    const int lane = tid & 63, r32 = lane & 31, hi = lane >> 5, wid = __builtin_amdgcn_readfirstlane(tid >> 6);
    const bool ordA = wid < 4;
    const int q0 = qb * 256, qw0 = q0 + wid * 32; const size_t tokb = (size_t)b * NS;
    int ntile, kbase, ta, tb;
    if (TYPE == 1) { ntile = NS / 64; kbase = 0; ta = 0; tb = ntile - 1; }
    else if (TYPE == 2) { kbase = max(q0 - 128, 0); const int ke = min(q0 + 384, NS); ntile = (ke - kbase) >> 6; ta = max(qw0 - 128 - kbase, 0) >> 6; tb = min(ntile - 1, (qw0 + 159 - kbase) >> 6); }
    else { const int r0 = qb * 4; kbase = min(max(r0 - 4, 0), 56); ntile = min(max(r0 - 1, 0), 56) + 7 - kbase + 1; const int r = r0 + (wid >> 1); ta = min(max(r - 4, 0), 56) - kbase; tb = ta + 7; }
    const int kvh = (TYPE == 2) ? h / 3 : h;
    const bf16 *ksrc, *ksrc2 = nullptr, *vsrc; size_t kpitch, vpitch;
    { const size_t key0 = tokb + (TYPE == 0 ? (size_t)kbase * 64 : (size_t)kbase); const int vrow = 16 * (wid & 3) + (lane >> 2), vcol = (wid >> 2) * 32 + (lane & 3) * 8;
      if (TYPE == 0) { ksrc = P.PROJ + (key0 + lane) * NP + C_AK + h * 64 + wid * 8; vsrc = P.PROJ + (key0 + vrow) * NP + C_AV + h * 64 + vcol; kpitch = vpitch = NP; }
      else if (TYPE == 1) { ksrc = P.KV + (key0 + lane) * 768 + h * 64 + wid * 8; ksrc2 = P.PROJ + (key0 + lane) * NP + C_KR + (wid & 3) * 8; vsrc = P.KV + (key0 + vrow) * 768 + 384 + h * 64 + vcol; kpitch = vpitch = 768; }
      else { ksrc = P.PROJ + (key0 + lane) * NP + C_SK + kvh * 64 + wid * 8; vsrc = P.PROJ + (key0 + vrow) * NP + C_SV + kvh * 64 + vcol; kpitch = vpitch = NP; } }
    const unsigned kdst = (unsigned)(uintptr_t)(lds + L_K) + wid * 1024, vdst = (unsigned)(uintptr_t)(lds + L_V) + wid * 1024;
#define ATT_DMA(t, slot) do { if (PROBE == 2 || PROBE == 3) break; glds(ksrc + (size_t)(t) * 64 * kpitch, (unsigned)__builtin_amdgcn_readfirstlane(kdst + (slot) * KSLOT)); if (TYPE == 1 && wid < 4) glds(ksrc2 + (size_t)(t) * 64 * NP, (unsigned)__builtin_amdgcn_readfirstlane(kdst + (slot) * KSLOT + 8192)); \
        glds(vsrc + (size_t)(t) * 64 * vpitch, (unsigned)__builtin_amdgcn_readfirstlane(vdst + (slot) * VSLOT)); } while (0)
    LAS float* biasL = (LAS float*)(lds + L_BIAS);
    if (TYPE == 0) { for (int i = tid; i < 15 * 31; i += 512) biasL[i] = P.rpb[h * 465 + i] * LOG2E; }
    bf16x8 qr[ND0];
    { const bf16* qp = (TYPE == 1) ? P.QB + (tokb + qw0 + r32) * 576 + h * 96 : P.PROJ + (tokb + qw0 + r32) * NP + (TYPE == 0 ? C_AQ : C_SQ) + h * 64;
#pragma unroll
      for (int d0 = 0; d0 < ND0; ++d0) qr[d0] = *(const bf16x8*)(qp + d0 * 16 + hi * 8); }
    LAS float* wsf = (LAS float*)(lds + L_WS) + wid * 64;
    float m = (TYPE == 2) ? P.sink[h] * LOG2E : 0.f;
    f32x16 negm; { const float nm = -m;
#pragma unroll
      for (int r = 0; r < 16; ++r) negm[r] = nm; }
    f32x16 o[2]; o[0] = f32x16{}; o[1] = f32x16{};
    f32x16 lacc;
    { const float l0 = (TYPE == 2) ? 1.f : 0.f;
#pragma unroll
      for (int r = 0; r < 16; ++r) lacc[r] = l0; }
    float lsum = (TYPE == 2 && hi == 0) ? 1.f : 0.f;
    const bf16x8 ones = (bf16x8){0x3F80, 0x3F80, 0x3F80, 0x3F80, 0x3F80, 0x3F80, 0x3F80, 0x3F80};
    f32x16 sA0, sA1, sB0, sB1;
#define ATT_QK(X0, X1, tt, sl) do { const LAS unsigned char* Kp = lds + L_K + (sl) * KSLOT + hi * 1024 + r32 * 16; X0 = negm; X1 = negm; \
        bf16x8 ka0 = *(const LAS bf16x8*)(Kp), ka1 = *(const LAS bf16x8*)(Kp + 512); \
        _Pragma("unroll") for (int d0 = 0; d0 < ND0; ++d0) { bf16x8 kb0 = ka0, kb1 = ka1; \
            if (d0 + 1 < ND0) { kb0 = *(const LAS bf16x8*)(Kp + (d0 + 1) * 2048); kb1 = *(const LAS bf16x8*)(Kp + (d0 + 1) * 2048 + 512); }     \
            X0 = __builtin_amdgcn_mfma_f32_32x32x16_bf16(ka0, qr[d0], X0, 0, 0, 0); X1 = __builtin_amdgcn_mfma_f32_32x32x16_bf16(ka1, qr[d0], X1, 0, 0, 0); ka0 = kb0; ka1 = kb1; } \
        __builtin_amdgcn_sched_group_barrier(0x100, 2, 0); __builtin_amdgcn_sched_group_barrier(0x100, 2, 0);        \
        _Pragma("unroll") for (int d0 = 0; d0 + 2 < ND0; ++d0) { __builtin_amdgcn_sched_group_barrier(0x8, 2, 0); __builtin_amdgcn_sched_group_barrier(0x100, 2, 0); } \
        __builtin_amdgcn_sched_group_barrier(0x8, 2, 0); __builtin_amdgcn_sched_group_barrier(0x8, 2, 0); \
        if (TYPE == 2) { const int dq = qw0 + r32 - (kbase + (tt) * 64) - 4 * hi; \
            _Pragma("unroll") for (int r = 0; r < 16; ++r) { const int d0_ = dq - ((r & 3) + 8 * (r >> 2)), d1_ = d0_ - 32; \
                if (d0_ > 128 || d0_ < -128) X0[r] = -INFINITY; if (d1_ > 128 || d1_ < -128) X1[r] = -INFINITY; } } \
        if (TYPE == 0) { const int c = (wid & 1) * 32 + r32, cs = min(max(c - 8, 0), 48); const int rq = qb * 4 + (wid >> 1), kr = kbase + (tt); const LAS float* brow = biasL + (kr - rq + 7) * 31 + 15 - c; \
            _Pragma("unroll") for (int rr = 0; rr < 16; ++rr) { const int kc0 = crow(rr, hi), kc1 = kc0 + 32; \
                const bool v0 = kc0 >= cs && kc0 < cs + 16, v1 = kc1 >= cs && kc1 < cs + 16; \
                X0[rr] = v0 ? X0[rr] + brow[v0 ? kc0 : c] : -INFINITY; X1[rr] = v1 ? X1[rr] + brow[v1 ? kc1 : c] : -INFINITY; } } \
        asm volatile("s_nop 15\n\ts_nop 7" : "+v"(X0), "+v"(X1)); } while (0)
#define ATT_MAX3(a, b, c) ({ float r_; asm("v_max3_f32 %0, %1, %2, %3" : "=v"(r_) : "v"(a), "v"(b), "v"(c)); r_; })
#define ATT_STEP(ORDA, C0, C1, N0, N1, t) do { \
        if ((t) + 1 < ntile) ATT_WAIT_BAR(); \
        if ((t) + 2 < ntile) ATT_DMA((t) + 2, sl_nn); \
        const bool act = ((t) >= ta && (t) <= tb), nact = ((t) + 1 >= ta && (t) + 1 <= tb); \
        if (ORDA && nact) ATT_QK(N0, N1, (t) + 1, sl_nxt); \
        if (act) { \
            float ma = 0.f, mb = 0.f; if (PROBE != 4) { ma = ATT_MAX3(C0[0], C0[1], C1[0]); mb = ATT_MAX3(C0[2], C0[3], C1[1]); ma = ATT_MAX3(ma, C1[2], C1[3]); \
            _Pragma("unroll") for (int r = 4; r < 16; r += 4) { ma = ATT_MAX3(ma, C0[r], C0[r + 1]); mb = ATT_MAX3(mb, C0[r + 2], C0[r + 3]); ma = ATT_MAX3(ma, C1[r], C1[r + 1]); mb = ATT_MAX3(mb, C1[r + 2], C1[r + 3]); } } \
            float rm = fmaxf(ma, mb); \
            { auto rr = __builtin_amdgcn_permlane32_swap(__float_as_uint(rm), __float_as_uint(rm), false, false); rm = fmaxf(__uint_as_float(rr[0]), __uint_as_float(rr[1])); } \
            const bool first = (TYPE != 2) && ((t) == ta); \
            if (first || __any(rm > THR)) { const float dl = first ? rm : fmaxf(rm, 0.f), f = first ? 1.f : __builtin_amdgcn_exp2f(-dl); m += dl; lsum *= f; \
                _Pragma("unroll") for (int r = 0; r < 16; ++r) { C0[r] -= dl; C1[r] -= dl; negm[r] = -m; } \
                if (ORDA && nact) { _Pragma("unroll") for (int r = 0; r < 16; ++r) { N0[r] -= dl; N1[r] -= dl; } } \
                if (hi == 0) wsf[r32] = f; \
                _Pragma("unroll") for (int g = 0; g < 4; ++g) { const f32x4 fv = *(const LAS f32x4*)(wsf + 8 * g + 4 * hi); \
                    _Pragma("unroll") for (int e = 0; e < 4; ++e) { o[0][4 * g + e] *= fv[e]; o[1][4 * g + e] *= fv[e]; lacc[4 * g + e] *= fv[e]; } } } \
            const LAS unsigned char* Vp = lds + L_V + sl_cur * VSLOT + ((lane >> 4) & 1) * 32 + (lane & 3) * 8 + (4 * hi + ((lane & 15) >> 2)) * 64; \
            s16x4 va[4], vb[4]; \
            va[0] = vtr(Vp); va[1] = vtr(Vp + 512); va[2] = vtr(Vp + 4096); va[3] = vtr(Vp + 4096 + 512);        \
            if (PROBE != 4) { _Pragma("unroll") for (int r = 0; r < 16; ++r) { C0[r] = __builtin_amdgcn_exp2f(C0[r]); C1[r] = __builtin_amdgcn_exp2f(C1[r]); } } \
            if (!LSUM_MFMA) { float sa = 0.f, sb = 0.f; _Pragma("unroll") for (int r = 0; r < 16; ++r) { sa += C0[r]; sb += C1[r]; } lsum += sa + sb; } \
            u32x4 pw[4]; \
            _Pragma("unroll") for (int e = 0; e < 4; ++e) { pw[0][e] = cvtpk(C0[2 * e], C0[2 * e + 1]); pw[1][e] = cvtpk(C0[8 + 2 * e], C0[9 + 2 * e]); pw[2][e] = cvtpk(C1[2 * e], C1[2 * e + 1]); pw[3][e] = cvtpk(C1[8 + 2 * e], C1[9 + 2 * e]); } \
            _Pragma("unroll") for (int ks = 0; ks < 4; ++ks) { const bf16x8 pa = __builtin_bit_cast(bf16x8, pw[ks]); \
                if (ks + 1 < 4) { vb[0] = vtr(Vp + (ks + 1) * 1024); vb[1] = vtr(Vp + (ks + 1) * 1024 + 512); vb[2] = vtr(Vp + 4096 + (ks + 1) * 1024); vb[3] = vtr(Vp + 4096 + (ks + 1) * 1024 + 512); }     \
                o[0] = __builtin_amdgcn_mfma_f32_32x32x16_bf16(pa, ((bf16x8){va[0][0], va[0][1], va[0][2], va[0][3], va[1][0], va[1][1], va[1][2], va[1][3]}), o[0], 0, 0, 0); \
                o[1] = __builtin_amdgcn_mfma_f32_32x32x16_bf16(pa, ((bf16x8){va[2][0], va[2][1], va[2][2], va[2][3], va[3][0], va[3][1], va[3][2], va[3][3]}), o[1], 0, 0, 0); \
                if (LSUM_MFMA) lacc = __builtin_amdgcn_mfma_f32_32x32x16_bf16(pa, ones, lacc, 0, 0, 0); \
                _Pragma("unroll") for (int q_ = 0; q_ < 4; ++q_) va[q_] = vb[q_]; } \
            __builtin_amdgcn_sched_group_barrier(0x100, 4, 1); \
            _Pragma("unroll") for (int ks = 0; ks < 3; ++ks) { __builtin_amdgcn_sched_group_barrier(0x100, 4, 1); __builtin_amdgcn_sched_group_barrier(0x8, LSUM_MFMA ? 3 : 2, 1); } \
            __builtin_amdgcn_sched_group_barrier(0x8, LSUM_MFMA ? 3 : 2, 1); \
        } \
        if (!(ORDA) && nact) ATT_QK(N0, N1, (t) + 1, sl_nxt); \
        { const int tmp = sl_cur; sl_cur = sl_nxt; sl_nxt = sl_nn; sl_nn = tmp; } } while (0)
    ATT_DMA(0, 0);
    if (ntile > 1) ATT_DMA(1, 1);
    if (PROBE == 2 || PROBE == 3) {} else if (ntile > 1) { if (TYPE == 1 && wid < 4) asm volatile("s_waitcnt vmcnt(3)" ::: "memory"); else asm volatile("s_waitcnt vmcnt(2)" ::: "memory"); } else asm volatile("s_waitcnt vmcnt(0)" ::: "memory");
    asm volatile("s_waitcnt lgkmcnt(0)\n\ts_barrier" ::: "memory");
    if (ta == 0) ATT_QK(sA0, sA1, 0, 0);
    int sl_cur = 0, sl_nxt = 1, sl_nn = 2;
    if (ordA) {
        for (int t = 0; t < ntile; t += 2) { ATT_STEP(true, sA0, sA1, sB0, sB1, t); if (t + 1 < ntile) ATT_STEP(true, sB0, sB1, sA0, sA1, t + 1); }
    } else {
        for (int t = 0; t < ntile; t += 2) { ATT_STEP(false, sA0, sA1, sB0, sB1, t); if (t + 1 < ntile) ATT_STEP(false, sB0, sB1, sA0, sA1, t + 1); }
    }
    LAS bf16* stg = (LAS bf16*)(lds + L_OST) + wid * 2048;
    if (!LSUM_MFMA) { { auto rr = __builtin_amdgcn_permlane32_swap(__float_as_uint(lsum), __float_as_uint(lsum), false, false); lsum = __uint_as_float(rr[0]) + __uint_as_float(rr[1]); }
        if (hi == 0) wsf[32 + r32] = lsum;
#pragma unroll
        for (int g = 0; g < 4; ++g) { const f32x4 lv = *(const LAS f32x4*)(wsf + 32 + 8 * g + 4 * hi);
#pragma unroll
            for (int e = 0; e < 4; ++e) lacc[4 * g + e] = lv[e]; } }
#pragma unroll
    for (int r = 0; r < 16; ++r) { const float iv = __builtin_amdgcn_rcpf(lacc[r]); const int orow = crow(r, hi);
        stg[orow * 64 + r32] = (bf16)(cvtpk(o[0][r] * iv, 0.f) & 0xffff); stg[orow * 64 + 32 + r32] = (bf16)(cvtpk(o[1][r] * iv, 0.f) & 0xffff); }
    const int ocol = (TYPE == 0 ? 0 : (TYPE == 1 ? 256 : 640)) + h * 64, sidx = (TYPE == 0 ? 0 : (TYPE == 1 ? 4 : 10)) + h;
#pragma unroll
    for (int i = 0; i < 4; ++i) { const int row = i * 8 + (lane >> 3), ch = lane & 7; const u32x4 v = *(const LAS u32x4*)(stg + row * 64 + ch * 8);
        const size_t tokn = tokb + qw0 + row; if (PROBE == 0) *(u32x4*)(P.O + tokn * DM + ocol + ch * 8) = v; else asm volatile("" :: "v"(v));
        float sq = 0.f;
#pragma unroll
        for (int e = 0; e < 4; ++e) { const float a = __builtin_bit_cast(float, v[e] << 16), c2 = __builtin_bit_cast(float, v[e] & 0xffff0000u); sq += a * a + c2 * c2; }
        sq += __shfl_xor(sq, 1); sq += __shfl_xor(sq, 2); sq += __shfl_xor(sq, 4);
        if (ch == 0 && PROBE == 0) P.SS[tokn * 16 + sidx] = sq; }
    ATT_WAIT_BAR();
#undef ATT_DMA
#undef ATT_QK
#undef ATT_STEP
#undef ATT_MAX3
}
__device__ __forceinline__ void attn_phase(const AttnP& P, LAS unsigned char* lds, int vcu) {
    const int x = vcu >> 5, cx = vcu & 31;
    for (int i = 0; i < 3; ++i) { const int j = cx * 3 + i, bh = 6 * x + (j >> 4), qb = j & 15; attn_unit<1>(P, bh / 6, bh % 6, qb, lds); }
    if (ATT_PROBE) for (int i = 0; i < 3; ++i) { const int j = cx * 3 + i, bh = 6 * x + (j >> 4), qb = j & 15; attn_unit<1, ATT_PROBE>(P, bh / 6, bh % 6, qb, lds); }
    for (int i = 0; i < 3; ++i) { const int j = cx * 3 + i, bh = 6 * x + (j >> 4), qb = j & 15; attn_unit<2>(P, bh / 6, bh % 6, qb, lds); }
    for (int i = 0; i < 2; ++i) { const int j = cx * 2 + i, bh = 4 * x + (j >> 4), qb = j & 15; attn_unit<0>(P, bh >> 2, bh & 3, qb, lds); }
}
}


constexpr int NWAVES = 8, LDS_BYTES = 155648, RING_BYTES = 131072, MISC_OFF = RING_BYTES + 320, TAB_OFF = RING_BYTES + 512;
#define XB_TMO      128
#define XB_XCNT(j)  (256  + 64 * (j))
#define XB_XSUB(j)  (1280 + 64 * (j))
#define XB_XGEN(j)  (2304 + 64 * (j))
#define XB_TOP      3328
#define XB_TOPGEN   3392
#define XCD_BAR_WORDS 3456
#define XB_SPIN_CAP (1u << 18)
constexpr int CW_BAR = 4096;
__device__ __forceinline__ unsigned xb_ld(unsigned* p)              { return __hip_atomic_load(p, __ATOMIC_RELAXED, __HIP_MEMORY_SCOPE_AGENT); }
__device__ __forceinline__ unsigned xb_add(unsigned* p, unsigned v) { return __hip_atomic_fetch_add(p, v, __ATOMIC_RELAXED, __HIP_MEMORY_SCOPE_AGENT); }
__device__ __forceinline__ unsigned xb_xcc_id() { return (unsigned)__builtin_amdgcn_s_getreg((3 << 11) | 20) & 0xFu; }
#define XB_SPIN(cond, bar) do { unsigned _sp = 0; while (cond) { __builtin_amdgcn_s_sleep(1); \
    if ((++_sp & 255u) == 0u) { if (xb_ld(&(bar)[XB_TMO])) break; if (_sp > XB_SPIN_CAP) { atomicAdd(&(bar)[XB_TMO], 1u); break; } } } } while (0)
struct XcdBarrier { unsigned* bar; unsigned x; volatile LAS unsigned* st; };
__device__ __forceinline__ XcdBarrier xcd_barrier_post(unsigned* bar, volatile LAS unsigned* st) {
    XcdBarrier b; b.bar = bar; b.x = xb_xcc_id(); b.st = st;
    if (threadIdx.x == 0) (void)xb_add(&bar[XB_XCNT(b.x)], 1u);
    return b;
}
__device__ __forceinline__ void xcd_barrier_complete(unsigned* bar, unsigned x, unsigned& nloc, unsigned& nx) {
    const unsigned G = gridDim.x * gridDim.y * gridDim.z;
    unsigned sum, cnt, mine, sp = 0u;
    for (;;) {
        sum = 0u; cnt = 0u; mine = 0u;
#pragma unroll
        for (unsigned j = 0; j < 16; ++j) { const unsigned c = xb_ld(&bar[XB_XCNT(j)]); sum += c; cnt += (c > 0u) ? 1u : 0u; mine = (j == x) ? c : mine; }
        if (sum == G) break;
        __builtin_amdgcn_s_sleep(1);
        if ((++sp & 255u) == 0u) { if (xb_ld(&bar[XB_TMO])) break; if (sp > XB_SPIN_CAP) { atomicAdd(&bar[XB_TMO], 1u); break; } }
    }
    nloc = mine > 0u ? mine : 1u; nx = cnt > 0u ? cnt : 1u;
}
__device__ __forceinline__ void xcd_barrier(const XcdBarrier& b) {
    asm volatile("s_waitcnt vmcnt(0)" ::: "memory");
    __syncthreads();
    if (threadIdx.x == 0) {
        unsigned* bar = b.bar; asm volatile("" : "+s"(bar));
        __builtin_amdgcn_s_waitcnt(0);
        unsigned nloc = b.st[0], nx = b.st[1];
        if (nloc == 0u) { xcd_barrier_complete(bar, b.x, nloc, nx); b.st[0] = nloc; b.st[1] = nx; }
        const unsigned old = xb_add(&bar[XB_XSUB(b.x)], 1u);
        const unsigned gen = old / nloc;
        if (old + 1u == (gen + 1u) * nloc) {
            __builtin_amdgcn_fence(__ATOMIC_RELEASE, "agent");
            asm volatile("s_waitcnt vmcnt(0)" ::: "memory");
            const unsigned og = xb_add(&bar[XB_TOP], 1u);
            const unsigned tg = og / nx;
            if (og + 1u == (tg + 1u) * nx) xb_add(&bar[XB_TOPGEN], 1u);
            else XB_SPIN(xb_ld(&bar[XB_TOPGEN]) == tg, bar);
            __builtin_amdgcn_fence(__ATOMIC_ACQUIRE, "agent");
            xb_add(&bar[XB_XGEN(b.x)], 1u);
            asm volatile("s_waitcnt vmcnt(0)" ::: "memory");
        } else {
            XB_SPIN(xb_ld(&bar[XB_XGEN(b.x)]) == gen, bar);
            __builtin_amdgcn_fence(__ATOMIC_ACQUIRE, "agent");
            asm volatile("s_waitcnt vmcnt(0)" ::: "memory");
        }
    }
    __syncthreads();
}

struct MegaArgs {
    const float *x, *attn_norm, *w_in, *na_rpb, *q_norm, *w_uq, *kv_norm, *w_ukv, *swa_sink, *group_norm, *w_out, *ffn_norm, *w_router, *w_gate, *w_up, *w_down, *final_norm;
    float* out; unsigned char* ws;
    int ph_lo, ph_hi;
};

__device__ __forceinline__ void prep_item(int kind, const float* W, const float* W2, const float* kgain, bf16* Wt, int K, int Nsrc, int nblk, int item, LAS float* scr, int lane) {
    const int kb = item / nblk, nb = item % nblk, k0 = 64 * kb, n0 = 32 * nb, r = lane >> 3, q = lane & 7;
    float sc; int which; const int src4 = prep_map(kind, n0 + 4 * q, sc, which); const float* Wb = which ? W2 : W;
    float4 v[8];
#pragma unroll
    for (int i = 0; i < 8; ++i) v[i] = (src4 >= 0) ? *(const float4*)(Wb + (size_t)(k0 + 8 * i + r) * Nsrc + src4) : make_float4(0.f, 0.f, 0.f, 0.f);
#pragma unroll
    for (int i = 0; i < 8; ++i) { const float g = (kgain ? kgain[k0 + 8 * i + r] : 1.f) * sc; LAS float* d = scr + (8 * i + r) * 33 + 4 * q; d[0] = v[i].x * g; d[1] = v[i].y * g; d[2] = v[i].z * g; d[3] = v[i].w * g; }
    asm volatile("s_waitcnt lgkmcnt(0)" ::: "memory");
    const int c = lane & 7;
#pragma unroll
    for (int j = 0; j < 4; ++j) { const int n = (lane >> 3) + 8 * j; const LAS float* s = scr + (8 * c) * 33 + n;
        uint4 o; o.x = f2bf(s[0]) | (f2bf(s[33]) << 16); o.y = f2bf(s[2 * 33]) | (f2bf(s[3 * 33]) << 16); o.z = f2bf(s[4 * 33]) | (f2bf(s[5 * 33]) << 16); o.w = f2bf(s[6 * 33]) | (f2bf(s[7 * 33]) << 16);
        *(uint4*)(Wt + (size_t)(n0 + n) * K + k0 + 8 * c) = o; }
    asm volatile("s_waitcnt lgkmcnt(0)" ::: "memory");
}
__device__ __forceinline__ void ph_prep(const MegaArgs& a, int l, LAS unsigned char* lds, int gw, int ngw, int wave, int lane) {
    unsigned char* ws = a.ws; LAS float* scr = (LAS float*)(lds + wave * 8448);
    constexpr int I_WIN = 16 * 64, I_WUQ = 4 * 24, I_WUKV = 2 * 24, I_WOUT = 16 * 32, I_WGU1 = 16 * 64, I_WGU = NE * I_WGU1, I_WD1 = 16 * 32, I_WD = NE * I_WD1;
    constexpr int NITEMS = I_WIN + I_WUQ + I_WUKV + I_WOUT + I_WGU + I_WD;
    for (int it = gw; it < NITEMS; it += ngw) { int r = it;
        if (r < I_WGU) { const int e = r / I_WGU1; prep_item(PK_WGU, a.w_gate + ((size_t)l * NE + e) * DM * DM, a.w_up + ((size_t)l * NE + e) * DM * DM, a.ffn_norm + l * DM, (bf16*)(ws + WS_WGU) + (size_t)e * 2048 * DM, DM, DM, 64, r % I_WGU1, scr, lane); continue; } r -= I_WGU;
        if (r < I_WD) { const int e = r / I_WD1; prep_item(PK_WD, a.w_down + ((size_t)l * NE + e) * DM * DM, nullptr, nullptr, (bf16*)(ws + WS_WD) + (size_t)e * DM * DM, DM, DM, 32, r % I_WD1, scr, lane); continue; } r -= I_WD;
        if (r < I_WIN) { prep_item(PK_WIN, a.w_in + (size_t)l * DM * C_END, nullptr, a.attn_norm + l * DM, (bf16*)(ws + WS_WIN), DM, C_END, 64, r, scr, lane); continue; } r -= I_WIN;
        if (r < I_WOUT) { prep_item(PK_WOUT, a.w_out + (size_t)l * DM * DM, nullptr, a.group_norm + l * DM, (bf16*)(ws + WS_WOUT), DM, DM, 32, r, scr, lane); continue; } r -= I_WOUT;
        if (r < I_WUQ) { prep_item(PK_WUQ, a.w_uq + (size_t)l * 256 * 576, nullptr, a.q_norm + l * 256, (bf16*)(ws + WS_WUQ), 256, 576, 24, r, scr, lane); continue; } r -= I_WUQ;
        prep_item(PK_WUKV, a.w_ukv + (size_t)l * 128 * 768, nullptr, a.kv_norm + l * 128, (bf16*)(ws + WS_WUKV), 128, 768, 24, r, scr, lane);
    }
}
__device__ __forceinline__ void row_store_bf16(const float4 (&v)[4], bf16* orow, float* rstd_out, int lane) {
    float s = 0.f;
#pragma unroll
    for (int j = 0; j < 4; ++j) s += v[j].x * v[j].x + v[j].y * v[j].y + v[j].z * v[j].z + v[j].w * v[j].w;
    const float rstd = rsqrtf(wave_sum(s) * (1.f / DM) + EPS);
    uint2* o = (uint2*)orow + lane;
#pragma unroll
    for (int j = 0; j < 4; ++j) o[64 * j] = make_uint2(f2bf(v[j].x) | (f2bf(v[j].y) << 16), f2bf(v[j].z) | (f2bf(v[j].w) << 16));
    if (lane == 0) *rstd_out = rstd;
}
__device__ __forceinline__ void ph_norm_x(const MegaArgs& a, int gw, int ngw, int lane) {
    bf16* HB = (bf16*)(a.ws + WS_HB); float* R1 = (float*)(a.ws + WS_RSTD1);
    for (int row = gw; row < NT; row += ngw) { const float4* hr = (const float4*)(a.x + (size_t)row * DM) + lane; float4 v[4];
#pragma unroll
        for (int j = 0; j < 4; ++j) v[j] = hr[64 * j];
        row_store_bf16(v, HB + (size_t)row * DM, R1 + row, lane); }
}
__device__ __forceinline__ void ld_row_bf16(const bf16* row, float4 (&v)[4], int lane) {
    const uint2* p = (const uint2*)row + lane;
#pragma unroll
    for (int j = 0; j < 4; ++j) { const uint2 w = p[64 * j]; v[j] = make_float4(bf2f(w.x & 0xffff), bf2f(w.x >> 16), bf2f(w.y & 0xffff), bf2f(w.y >> 16)); }
}
__device__ __forceinline__ void ph_router(const MegaArgs& a, int l, LAS unsigned char* lds, int gw, int ngw, int lane) {
    LAS float* wl = (LAS float*)lds; const float* wr = a.w_router + (size_t)l * DM * NE; const float* g = a.ffn_norm + l * DM;
    for (int i = threadIdx.x; i < DM * NE; i += NWAVES * 64) wl[(i & 15) * DM + (i >> 4)] = wr[i] * g[i >> 4];
    __syncthreads();
    const bf16* HB = (const bf16*)(a.ws + WS_HB); float* AFF = (float*)(a.ws + WS_AFF); float* R2 = (float*)(a.ws + WS_RSTD2);
    for (int row = gw; row < NT; row += ngw) {
        asm volatile("" ::: "memory");
        float4 v[4]; ld_row_bf16(HB + (size_t)row * DM, v, lane); float s = 0.f;
#pragma unroll
        for (int j = 0; j < 4; ++j) s += v[j].x * v[j].x + v[j].y * v[j].y + v[j].z * v[j].z + v[j].w * v[j].w;
        const float rstd = rsqrtf(wave_sum(s) * (1.f / DM) + EPS);
        float lg[16];
#pragma unroll
        for (int e = 0; e < 16; ++e) lg[e] = 0.f;
#pragma unroll
        for (int j = 0; j < 4; ++j) {
#pragma unroll
            for (int e = 0; e < 16; ++e) { const pg8::f32x4 w = *(const LAS pg8::f32x4*)(wl + e * DM + 4 * lane + 256 * j); lg[e] += v[j].x * w[0] + v[j].y * w[1] + v[j].z * w[2] + v[j].w * w[3]; } }
        float mx = -1e30f;
#pragma unroll
        for (int e = 0; e < 16; ++e) { lg[e] = wave_sum(lg[e]) * rstd; mx = fmaxf(mx, lg[e]); }
        float den = 0.f;
#pragma unroll
        for (int e = 0; e < 16; ++e) { lg[e] = __expf(lg[e] - mx); den += lg[e]; }
        const int b = row / NS, sidx = row % NS;
        if (lane < 16) { float val = 0.f;
#pragma unroll
            for (int e = 0; e < 16; ++e) if (lane == e) val = lg[e];
            AFF[((size_t)b * NE + lane) * NS + sidx] = val / den; }
        if (lane == 0) R2[row] = rstd;
    }
    __syncthreads();
}
__device__ __forceinline__ void ph_topk(unsigned char* ws, LAS unsigned char* lds, int bx, int G) {
    LAS unsigned* hist = (LAS unsigned*)lds;
    LAS unsigned* sh = hist + 256;
    LAS unsigned* wcnt = hist + 512;
    const int tid = threadIdx.x, lane = tid & 63, wave = tid >> 6;
    const float* AFF = (const float*)(ws + WS_AFF); int* INV = (int*)(ws + WS_INV); int* IDX = (int*)(ws + WS_IDX); float* GATE = (float*)(ws + WS_GATE);
    for (int be = bx; be < NB * NE; be += G) {
        const int b = be / NE, e = be % NE; const float* src = AFF + (size_t)be * NS;
        unsigned u[8];
#pragma unroll
        for (int i = 0; i < 8; ++i) u[i] = __float_as_uint(src[tid * 8 + i]);
        unsigned prefix = 0u, krem = CAP;
#pragma unroll 1
        for (int pass = 0; pass < 4; ++pass) { const int shift = 24 - 8 * pass; const unsigned pmask = pass == 0 ? 0u : (0xffffffffu << (shift + 8));
            if (tid < 256) hist[tid] = 0u;
            __syncthreads();
#pragma unroll
            for (int i = 0; i < 8; ++i) if ((u[i] & pmask) == prefix) __hip_atomic_fetch_add(&hist[(u[i] >> shift) & 255u], 1u, __ATOMIC_RELAXED, __HIP_MEMORY_SCOPE_WORKGROUP);
            __syncthreads();
            if (wave == 0) {
                unsigned c4[4]; unsigned tot = 0u;
#pragma unroll
                for (int i = 0; i < 4; ++i) { c4[i] = hist[255 - (lane * 4 + i)]; tot += c4[i]; }
                unsigned inc = tot;
#pragma unroll
                for (int o = 1; o < 64; o <<= 1) { const unsigned t = __shfl_up(inc, o); if (lane >= o) inc += t; }
                const unsigned before = inc - tot;
                if (before < krem && inc >= krem) { unsigned acc = before;
#pragma unroll
                    for (int i = 0; i < 4; ++i) { if (acc < krem && acc + c4[i] >= krem) { sh[0] = prefix | ((unsigned)(255 - (lane * 4 + i)) << shift); sh[1] = krem - acc; } acc += c4[i]; } }
            }
            __syncthreads();
            prefix = sh[0]; krem = sh[1];
            __syncthreads();
        }
        unsigned ngt = 0u, neq = 0u;
#pragma unroll
        for (int i = 0; i < 8; ++i) { ngt += (u[i] > prefix) ? 1u : 0u; neq += (u[i] == prefix) ? 1u : 0u; }
        unsigned ig = ngt, iq = neq;
#pragma unroll
        for (int o = 1; o < 64; o <<= 1) { const unsigned tg = __shfl_up(ig, o), tq = __shfl_up(iq, o); if (lane >= o) { ig += tg; iq += tq; } }
        if (lane == 63) { wcnt[wave * 2] = ig; wcnt[wave * 2 + 1] = iq; }
        __syncthreads();
        unsigned bg = 0u, bq = 0u;
        for (int w = 0; w < wave; ++w) { bg += wcnt[w * 2]; bq += wcnt[w * 2 + 1]; }
        unsigned pg = bg + ig - ngt, pq = bq + iq - neq;
#pragma unroll
        for (int i = 0; i < 8; ++i) { const int idx = tid * 8 + i; int slot = -1;
            if (u[i] > prefix) { slot = (int)(pg + min(pq, krem)); ++pg; }
            else if (u[i] == prefix) { if (pq < krem) slot = (int)(pg + pq); ++pq; }
            INV[(size_t)be * NS + idx] = slot;
            if (slot >= 0) { IDX[e * (NB * CAP) + b * CAP + slot] = b * NS + idx; GATE[(size_t)e * (NB * CAP) + b * CAP + slot] = __uint_as_float(u[i]); } }
        __syncthreads();
    }
}
__device__ __forceinline__ void ph_combine(const MegaArgs& a, int l, int gw, int ngw, int lane) {
    const bf16* Y = (const bf16*)(a.ws + WS_PROJ); const int* INV = (const int*)(a.ws + WS_INV); bf16* HB = (bf16*)(a.ws + WS_HB); float* R1 = (float*)(a.ws + WS_RSTD1); const bool last = (l == DEPTH - 1);
    for (int row = gw; row < NT; row += ngw) { const int b = row / NS, s = row % NS;
        float4 v[4]; ld_row_bf16(HB + (size_t)row * DM, v, lane);
        int slot_l = -1; if (lane < NE) slot_l = INV[((size_t)b * NE + lane) * NS + s];
        unsigned long long msk = __ballot(slot_l >= 0);
        while (msk) { const int e = __builtin_ctzll(msk); msk &= msk - 1; const int slot = __shfl(slot_l, e);
            const uint2* y = (const uint2*)(Y + ((size_t)e * (NB * CAP) + b * CAP + slot) * DM) + lane;
#pragma unroll
            for (int j = 0; j < 4; ++j) { const uint2 w = y[64 * j]; v[j].x += bf2f(w.x & 0xffff); v[j].y += bf2f(w.x >> 16); v[j].z += bf2f(w.y & 0xffff); v[j].w += bf2f(w.y >> 16); } }
        if (last) { float ssum = 0.f;
#pragma unroll
            for (int j = 0; j < 4; ++j) ssum += v[j].x * v[j].x + v[j].y * v[j].y + v[j].z * v[j].z + v[j].w * v[j].w;
            const float rstd = rsqrtf(wave_sum(ssum) * (1.f / DM) + EPS); float4* orow = (float4*)(a.out + (size_t)row * DM) + lane;
#pragma unroll
            for (int j = 0; j < 4; ++j) { const float4 gg = ((const float4*)a.final_norm)[lane + 64 * j]; orow[64 * j] = make_float4(v[j].x * rstd * gg.x, v[j].y * rstd * gg.y, v[j].z * rstd * gg.z, v[j].w * rstd * gg.w); } }
        else row_store_bf16(v, HB + (size_t)row * DM, R1 + row, lane);
    }
}

enum { PL_PROJ = 0, PL_MLAUP, PL_ATTN, PL_OUT, PL_ROUTER, PL_TOPK, PL_MOE1, PL_MOE2, PL_COMBINE, PL_COUNT };
constexpr int N_PHASES = 1 + DEPTH * PL_COUNT;
constexpr int REP_PH = -1;
#define REPEAT(ph) for (int rep_ = 0; rep_ < (REP_PH == (ph) ? 2 : 1); ++rep_)
#define IN(k) (lo <= (k) && (k) < hi)
#define SEAM(k) do { if (IN((k) + 1)) xcd_barrier(bar); } while (0)
#define PH_LOCALS unsigned char* ws = a.ws; asm volatile("" : "+s"(ws)); int t_ = threadIdx.x; asm volatile("" : "+v"(t_)); int bx = blockIdx.x; asm volatile("" : "+s"(bx)); \
    const int vcu = (bx % 8) * (G / 8) + bx / 8; const int lane = t_ & 63, wave = __builtin_amdgcn_readfirstlane(t_ >> 6), gw = vcu * NWAVES + wave; (void)lane; (void)gw; (void)ws; (void)vcu;
template <int l> __device__ __forceinline__ void layer_phases(const MegaArgs& a, LAS unsigned char* lds, const XcdBarrier& bar, const int lo, const int hi) {
    constexpr int G = 256, ngw = G * NWAVES, pb = 1 + l * PL_COUNT;
        if (IN(pb + PL_PROJ)) { PH_LOCALS
            pg8::StaticOrder S; S.init(NT / 256, NP / 256, G, bx, 0);
            LAS float* rst = (LAS float*)(lds + TAB_OFF);
            { pg8::Unit u; const float* R1 = (const float*)(ws + WS_RSTD1);
              for (int i = 0; i < 4 && S.next(i, u); ++i) if (t_ < 256) rst[i * 256 + t_] = R1[u.pm * 256 + t_]; }
            __syncthreads();
            REPEAT(PL_PROJ) {
            pg8::Gemm g{(bf16*)(ws + WS_HB), (bf16*)(ws + WS_WIN), DM, DM, DM, nullptr};
            pg8::EpiProj E{(bf16*)(ws + WS_PROJ), (float*)(ws + WS_CQSS), (float*)(ws + WS_CKVSS), rst};
            pg8::gemm_phase<pg8::EpiProj, pg8::StaticOrder, true>(lds, g, S, E); }
            SEAM(pb + PL_PROJ);
        }
        if (IN(pb + PL_MLAUP)) { PH_LOCALS REPEAT(PL_MLAUP) {
            LAS float* rst = (LAS float*)(lds + TAB_OFF);
            { pg8::StaticOrder S; S.init(NT / 256, 3, G, bx, 0); pg8::Unit u; const float* SSQ = (const float*)(ws + WS_CQSS);
              for (int i = 0; i < 2 && S.next(i, u); ++i) if (t_ < 256) { const float4 p = *(const float4*)(SSQ + (size_t)(u.pm * 256 + t_) * 4); rst[i * 256 + t_] = rsqrtf((p.x + p.y + p.z + p.w) * (1.f / 256.f) + EPS); }
              __syncthreads();
              pg8::Gemm g{(bf16*)(ws + WS_PROJ) + C_CQ, (bf16*)(ws + WS_WUQ), 256, NP, 256, nullptr};
              typedef pg8::EpiMla<true, 576, 576> EQ; EQ E{(bf16*)(ws + WS_QB), rst};
              pg8::gemm_phase<EQ, pg8::StaticOrder, true>(lds, g, S, E); }
            __syncthreads();
            { pg8::StaticOrder S; S.init(NT / 256, 3, G, bx, 0); pg8::Unit u; const float* SSQ = (const float*)(ws + WS_CKVSS);
              for (int i = 0; i < 2 && S.next(i, u); ++i) if (t_ < 256) { const float4 p = *(const float4*)(SSQ + (size_t)(u.pm * 256 + t_) * 4); rst[i * 256 + t_] = rsqrtf((p.x + p.y + p.z + p.w) * (1.f / 128.f) + EPS); }
              __syncthreads();
              pg8::Gemm g{(bf16*)(ws + WS_PROJ) + C_CKV, (bf16*)(ws + WS_WUKV), 128, NP, 128, nullptr};
              typedef pg8::EpiMla<false, 768, 768> EK; EK E{(bf16*)(ws + WS_KV), rst};
              pg8::gemm_phase<EK, pg8::StaticOrder, true>(lds, g, S, E); } }
            SEAM(pb + PL_MLAUP);
        }
        if (IN(pb + PL_ATTN)) { PH_LOCALS
            REPEAT(PL_ATTN) { const att::AttnP P{(bf16*)(ws + WS_PROJ), (bf16*)(ws + WS_QB), (bf16*)(ws + WS_KV), (bf16*)(ws + WS_XN), (float*)(ws + WS_SS), a.na_rpb + (size_t)l * 4 * 15 * 31, a.swa_sink + l * 6}; att::attn_phase(P, lds, vcu); }
            SEAM(pb + PL_ATTN);
        }
        if (IN(pb + PL_OUT)) { PH_LOCALS
            pg8::StaticOrder S; S.init(NT / 256, DM / 256, G, bx, 0);
            LAS float* fac = (LAS float*)(lds + TAB_OFF);
            { pg8::Unit u; const float* SS = (const float*)(ws + WS_SS);
              for (int i = 0; i < 2 && S.next(i, u); ++i) if (t_ < 256) { const float4* ss4 = (const float4*)(SS + (size_t)(u.pm * 256 + t_) * 16); const float4 s0 = ss4[0], s1 = ss4[1], s2 = ss4[2], s3 = ss4[3];
                  const float ra = rsqrtf((s0.x + s0.y + s0.z + s0.w) * (1.f / 256.f) + EPS), rb = rsqrtf((s1.x + s1.y + s1.z + s1.w + s2.x + s2.y) * (1.f / 384.f) + EPS), rc = rsqrtf((s2.z + s2.w + s3.x + s3.y + s3.z + s3.w) * (1.f / 384.f) + EPS);
                  LAS float* f = fac + (i * 256 + t_) * 4; f[0] = ra / rb; f[1] = rb / rc; f[2] = rc; f[3] = 0.f; } }
            __syncthreads();
            pg8::Gemm g{(bf16*)(ws + WS_XN), (bf16*)(ws + WS_WOUT), DM, DM, DM, nullptr};
            pg8::EpiResid E{(bf16*)(ws + WS_HB), fac};
            pg8::gemm_phase<pg8::EpiResid, pg8::StaticOrder, true>(lds, g, S, E);
            SEAM(pb + PL_OUT);
        }
        if (IN(pb + PL_ROUTER)) { PH_LOCALS REPEAT(PL_ROUTER) ph_router(a, l, lds, gw, ngw, lane); SEAM(pb + PL_ROUTER); }
        if (IN(pb + PL_TOPK)) { PH_LOCALS REPEAT(PL_TOPK) ph_topk(ws, lds, bx, G); SEAM(pb + PL_TOPK); }
        if (IN(pb + PL_MOE1)) { PH_LOCALS
            pg8::StaticOrder S; S.init(NSLOTS / 256, 8, G, bx, 16);
            LAS int* gidx = (LAS int*)(lds + TAB_OFF);
            LAS float* rst = (LAS float*)(lds + TAB_OFF + 8192);
            { pg8::Unit u; const int* IDX = (const int*)(ws + WS_IDX); const float* R2 = (const float*)(ws + WS_RSTD2);
              for (int i = 0; i < 8 && S.next(i, u); ++i) if (t_ < 256) { const int tok = IDX[u.pm * 256 + t_]; gidx[i * 256 + t_] = tok; rst[i * 256 + t_] = R2[tok]; } }
            __syncthreads();
            REPEAT(PL_MOE1) {
            pg8::Gemm g{(bf16*)(ws + WS_HB), (bf16*)(ws + WS_WGU), DM, DM, DM, gidx};
            pg8::EpiSwiglu E{(bf16*)(ws + WS_HID), rst};
            pg8::gemm_phase<pg8::EpiSwiglu, pg8::StaticOrder, true, true>(lds, g, S, E); }
            SEAM(pb + PL_MOE1);
        }
        if (IN(pb + PL_MOE2)) { PH_LOCALS
            pg8::StaticOrder S; S.init(NSLOTS / 256, 4, G, bx, 16);
            LAS float* gtab = (LAS float*)(lds + TAB_OFF);
            { pg8::Unit u; const float* GATE = (const float*)(ws + WS_GATE);
              for (int i = 0; i < 4 && S.next(i, u); ++i) if (t_ < 256) gtab[i * 256 + t_] = GATE[u.pm * 256 + t_]; }
            __syncthreads();
            REPEAT(PL_MOE2) {
            pg8::Gemm g{(bf16*)(ws + WS_HID), (bf16*)(ws + WS_WD), DM, DM, DM, nullptr};
            pg8::EpiGate E{(bf16*)(ws + WS_PROJ), gtab};
            pg8::gemm_phase<pg8::EpiGate, pg8::StaticOrder, true>(lds, g, S, E); }
            SEAM(pb + PL_MOE2);
        }
        if (IN(pb + PL_COMBINE)) { PH_LOCALS
            ph_combine(a, l, gw, ngw, lane);
            if (l + 1 < DEPTH) { __syncthreads(); REPEAT(100) ph_prep(a, l + 1, lds, gw, ngw, wave, lane); }
            SEAM(pb + PL_COMBINE);
        }
}
__global__ void __launch_bounds__(NWAVES * 64, 2) mega(MegaArgs a) {
    extern __shared__ __attribute__((aligned(16))) unsigned char lds_raw[];
    LAS unsigned char* lds = (LAS unsigned char*)lds_raw;
    constexpr int G = 256;
    constexpr int ngw = G * NWAVES;
    for (int u = threadIdx.x; u < (LDS_BYTES - RING_BYTES) / 4; u += NWAVES * 64) ((LAS unsigned*)(lds + RING_BYTES))[u] = 0u;
    __syncthreads();
    XcdBarrier bar = xcd_barrier_post((unsigned*)(a.ws + WS_CTL) + CW_BAR, (volatile LAS unsigned*)(lds + MISC_OFF) + 8);
    const int lo = a.ph_lo, hi = a.ph_hi;
    if (IN(0)) { PH_LOCALS REPEAT(100) ph_prep(a, 0, lds, gw, ngw, wave, lane); ph_norm_x(a, gw, ngw, lane); SEAM(0); }
    layer_phases<0>(a, lds, bar, lo, hi);
    layer_phases<1>(a, lds, bar, lo, hi);
    static_assert(DEPTH == 2, "two layers are written out");
}


#ifndef MK_PER_PHASE
#define MK_PER_PHASE 0
#endif
extern "C" void kernel_launch(void* const* d_in, const int* in_sizes, int n_in, void* d_out, int out_size, void* d_ws, size_t ws_size, hipStream_t stream) {
    if (n_in != 17 || out_size != NT * DM || ws_size < WS_END) { fprintf(stderr, "kernel_launch: unexpected shapes (n_in %d out %d ws %zu)\n", n_in, out_size, ws_size); return; }
    static int grid = 0;
    if (grid == 0) { int dev = 0, cus = 0; (void)hipGetDevice(&dev); (void)hipDeviceGetAttribute(&cus, hipDeviceAttributeMultiprocessorCount, dev);
        if (hipFuncSetAttribute((const void*)mega, hipFuncAttributeMaxDynamicSharedMemorySize, LDS_BYTES) != hipSuccess) fprintf(stderr, "hipFuncSetAttribute failed\n");
        if (cus != 256) fprintf(stderr, "kernel_launch: built for a 256-CU device (got %d CUs)\n", cus);
        grid = 256; }
    (void)hipMemsetAsync((char*)d_ws + WS_CTL, 0, 1 * MiB, stream);
    MegaArgs ma{};
    ma.x = (const float*)d_in[0]; ma.attn_norm = (const float*)d_in[1]; ma.w_in = (const float*)d_in[2]; ma.na_rpb = (const float*)d_in[3]; ma.q_norm = (const float*)d_in[4]; ma.w_uq = (const float*)d_in[5];
    ma.kv_norm = (const float*)d_in[6]; ma.w_ukv = (const float*)d_in[7]; ma.swa_sink = (const float*)d_in[8]; ma.group_norm = (const float*)d_in[9]; ma.w_out = (const float*)d_in[10]; ma.ffn_norm = (const float*)d_in[11];
    ma.w_router = (const float*)d_in[12]; ma.w_gate = (const float*)d_in[13]; ma.w_up = (const float*)d_in[14]; ma.w_down = (const float*)d_in[15]; ma.final_norm = (const float*)d_in[16];
    ma.out = (float*)d_out; ma.ws = (unsigned char*)d_ws;
#if MK_PER_PHASE
    for (int p = 0; p < N_PHASES; ++p) { ma.ph_lo = p; ma.ph_hi = p + 1; hipLaunchKernelGGL(mega, dim3(grid), dim3(NWAVES * 64), LDS_BYTES, stream, ma); }
#else
    ma.ph_lo = 0; ma.ph_hi = N_PHASES; hipLaunchKernelGGL(mega, dim3(grid), dim3(NWAVES * 64), LDS_BYTES, stream, ma);
#endif
}
```

```cpp
#include <hip/hip_runtime.h>
#include <cstdint>
#include <cstdio>

typedef unsigned short bf16;
constexpr int NB = 8, NS = 4096, DM = 1024, NT = NB * NS, NP = 2048, NE = 16, CAP = 512, DEPTH = 2;
constexpr int NSLOTS = NE * NB * CAP;
constexpr float LOG2E = 1.4426950408889634f;
constexpr float QS64 = 0.125f * LOG2E;
constexpr float QS96 = 0.10206207261596577f * LOG2E;
constexpr float EPS = 1e-6f;
constexpr int C_AQ = 0, C_AK = 256, C_AV = 512, C_CQ = 768, C_CKV = 1024, C_KR = 1152, C_SQ = 1184, C_SK = 1568, C_SV = 1696, C_END = 1824;

constexpr size_t MiB = 1u << 20;
constexpr size_t WS_CTL = 0;
constexpr size_t WS_COS64 = 1 * MiB, WS_SIN64 = WS_COS64 + 512 * 1024, WS_COS32 = 2 * MiB, WS_SIN32 = WS_COS32 + 256 * 1024;
constexpr size_t WS_WIN = 4 * MiB, WS_WUQ = 8 * MiB, WS_WUKV = 8 * MiB + 512 * 1024, WS_WOUT = 9 * MiB, WS_WGU = 12 * MiB, WS_WD = 76 * MiB;
constexpr size_t WS_CQSS = 108 * MiB, WS_CKVSS = WS_CQSS + 512 * 1024, WS_SS = 109 * MiB, WS_AFF = 111 * MiB, WS_INV = 113 * MiB, WS_IDX = 115 * MiB, WS_GATE = WS_IDX + 256 * 1024;
constexpr size_t WS_XN = 120 * MiB;
constexpr size_t WS_PROJ = 184 * MiB;
constexpr size_t WS_QB = 312 * MiB;
constexpr size_t WS_KV = 348 * MiB;
constexpr size_t WS_HID = 312 * MiB;
constexpr size_t WS_HB = 440 * MiB;
constexpr size_t WS_RSTD1 = 504 * MiB, WS_RSTD2 = WS_RSTD1 + 256 * 1024;
constexpr size_t WS_END = 505 * MiB;

__device__ __forceinline__ unsigned f2bf(float f) { unsigned u = __builtin_bit_cast(unsigned, f); return (u + 0x7fffu + ((u >> 16) & 1u)) >> 16; }
__device__ __forceinline__ float bf2f(unsigned short b) { return __builtin_bit_cast(float, (unsigned)b << 16); }
__device__ __forceinline__ float wave_sum(float v) {
#pragma unroll
    for (int o = 1; o < 64; o <<= 1) v += __shfl_xor(v, o);
    return v;
}

enum { PK_WIN = 0, PK_WUQ = 1, PK_WUKV = 2, PK_WOUT = 3, PK_WGU = 4, PK_WD = 5 };
__device__ __forceinline__ int prep_map(int kind, int n, float& sc, int& which) {
    sc = 1.f; which = 0;
    switch (kind) {
    case PK_WIN:
        if (n < 256) { sc = QS64; return n; }
        if (n < C_KR) return n;
        if (n < C_SQ) { const int p = n - C_KR, g = p >> 3, e = p & 7; return C_KR + 4 * g + (e & 3) + 16 * (e >> 2); }
        if (n < C_SK) { const int p = n - C_SQ, h = p >> 6, pp = p & 63, g = pp >> 3, e = pp & 7; sc = QS64; return C_SQ + h * 64 + 4 * g + (e & 3) + 32 * (e >> 2); }
        if (n < C_SV) { const int p = n - C_SK, h = p >> 6, pp = p & 63, g = pp >> 3, e = pp & 7; return C_SK + h * 64 + 4 * g + (e & 3) + 32 * (e >> 2); }
        if (n < C_END) return n;
        return -1;
    case PK_WUQ:
        if (n < 576) { const int h = n / 96, d = n % 96; sc = QS96; if (d < 64) return n; const int p = d - 64, g = p >> 3, e = p & 7; return h * 96 + 64 + 4 * g + (e & 3) + 16 * (e >> 2); }
        return -1;
    case PK_WUKV:
        if (n < 384) { const int h = n >> 6, d = n & 63; return h * 128 + d; }
        { const int m = n - 384, h = m >> 6, d = m & 63; return h * 128 + 64 + d; }
    case PK_WGU: { const int pn = n >> 8, half = (n >> 7) & 1, jj = n & 127; which = half; return 128 * pn + jj; }
    default: return n;
    }
}
#define LAS __attribute__((address_space(3)))
#define GAS __attribute__((address_space(1)))
namespace pg8 {
typedef short bf16x8 __attribute__((ext_vector_type(8)));
typedef float f32x4 __attribute__((ext_vector_type(4)));
typedef unsigned u32x4 __attribute__((ext_vector_type(4)));
constexpr int BM = 256, BK = 64, HALF = 128, HTB = HALF * BK * 2, STAGE_BYTES = 8 * HTB, NXCD = 8, WGM = 8;
__host__ __device__ __forceinline__ int lds_byte(int r, int c) { const int st = (r >> 4) * 2 + (c >> 5), rr = r & 15, cc = c & 31, ob = rr * 64 + cc * 2; return st * 1024 + (ob ^ (((ob >> 9) & 1) << 5)); }
__host__ __device__ __forceinline__ void stage_rc(int b, int& R, int& C) { const int st = b / 1024, sb = b % 1024, swz = sb ^ (((sb >> 9) & 1) << 5); R = (st >> 1) * 16 + swz / 64; C = (st & 1) * 32 + (swz % 64) / 2; }
__host__ __device__ __forceinline__ int perm32(int rho) { const int n = rho >> 4, i = rho & 15; return 8 * (i >> 2) + 4 * n + (i & 3); }
struct Unit { int pm, pn, pb; };
struct Gemm { const bf16* A; const bf16* Bt; int K, lda, ldb; const LAS int* gidx; };
struct StaticOrder {
    int nM, nN, nwg, G, c, gm, rev = 0;
    __device__ __forceinline__ void init(int nM_, int nN_, int G_, int c_, int gm_) { nM = nM_; nN = nN_; nwg = nM * nN; G = G_; c = c_; gm = gm_; }
    __device__ __forceinline__ bool next(int i, Unit& u) const {
        const long L = (long)i * G + c; if (L >= nwg) return false;
        int wgid = (int)L; { const int q = nwg / NXCD, r = nwg % NXCD, xcd = wgid % NXCD, off = wgid / NXCD; wgid = (xcd < r ? xcd * (q + 1) : r * (q + 1) + (xcd - r) * q) + off; }
        const int nig = WGM * nN, gid = wgid / nig, fm = gid * WGM, gsz = (nM - fm) < WGM ? (nM - fm) : WGM;
        u.pm = fm + ((wgid % nig) % gsz); if (rev) u.pm = nM - 1 - u.pm; u.pn = (wgid % nig) / gsz; u.pb = gm ? (u.pm / gm) * nN + u.pn : u.pn; return true;
    }
};
__device__ __forceinline__ unsigned cvt_pk_bf16(float lo, float hi) { unsigned r; asm volatile("v_cvt_pk_bf16_f32 %0, %1, %2" : "=v"(r) : "v"(lo), "v"(hi)); return r; }

template <class Epi, class Sched, bool ALIGN_EPI, bool GATHER = false>
__device__ __forceinline__ void gemm_phase(LAS unsigned char* lds, const Gemm g, const Sched& S, const Epi& E) {
    int tid = threadIdx.x; asm volatile("" : "+v"(tid));
    const int wid = __builtin_amdgcn_readfirstlane(tid >> 6), lane = tid & 63, wr = wid >> 2, wc = wid & 3, fr = lane & 15, fq = lane >> 4;
    const int K = g.K, nt = K / BK;
    unsigned vC[2][2], vNs[2][2], voffB[2]; int RA[2], CA[2];
    const size_t kstep = (size_t)(BK * 2);
    const size_t hstepA = (size_t)HALF * g.lda * 2, hstepB = (size_t)HALF * g.ldb * 2, tstepA = GATHER ? 0 : 2 * hstepA, tstepB = 2 * hstepB;
#pragma unroll
    for (int i = 0; i < 2; ++i) { int R, C; stage_rc(tid * 16 + i * 8192, R, C); const int Rb = Epi::PERM ? ((R & ~31) + perm32(R & 31)) : R; RA[i] = R; CA[i] = C;
        voffB[i] = (unsigned)(Rb * g.ldb + C) * 2u;
#pragma unroll
        for (int h = 0; h < 2; ++h) { vC[h][i] = GATHER ? ((unsigned)g.gidx[h * HALF + R] * (unsigned)(g.lda * 2) + (unsigned)C * 2u) : ((unsigned)(R * g.lda + C) * 2u + (unsigned)(h * hstepA)); vNs[h][i] = vC[h][i]; } }
    unsigned (&vN)[2][2] = GATHER ? vNs : vC;
    const unsigned ldsw = (unsigned)wid * 1024u;
    const int aoff = lds_byte(wr * 64 + fr, fq * 8), boff = lds_byte(wc * 32 + fr, fq * 8);
#define PG8_SA(b, h) (((b) * 2 + (h)) * HTB)
#define PG8_SB(b, h) ((4 + (b) * 2 + (h)) * HTB)
#define PG8_STAGE(bufoff, gbase, voff) do { _Pragma("unroll") for (int _i = 0; _i < 2; ++_i) \
        __builtin_amdgcn_global_load_lds((const unsigned*)((const char*)(gbase) + (voff)[_i]), (LAS unsigned*)(lds + (bufoff) + ldsw + _i * 8192), 16, 0, 0); } while (0)
#define PG8_STAGEA(bufoff, gbase, V, h) do { _Pragma("unroll") for (int _i = 0; _i < 2; ++_i) \
        __builtin_amdgcn_global_load_lds((const unsigned*)((const char*)(gbase) + (V)[h][_i]), (LAS unsigned*)(lds + (bufoff) + ldsw + _i * 8192), 16, 0, 0); } while (0)
#define PG8_STAGEAL(bufoff, gbase, h) do { _Pragma("unroll") for (int _i = 0; _i < 2; ++_i) { const unsigned _v = (GATHER && last) ? vN[h][_i] : vC[h][_i]; \
        __builtin_amdgcn_global_load_lds((const unsigned*)((const char*)(gbase) + _v), (LAS unsigned*)(lds + (bufoff) + ldsw + _i * 8192), 16, 0, 0); } } while (0)
#define PG8_LDA(dst, b, h) do { _Pragma("unroll") for (int m = 0; m < 4; ++m) _Pragma("unroll") for (int k = 0; k < 2; ++k) dst[m][k] = *(const LAS bf16x8*)(lds + PG8_SA(b, h) + aoff + m * 2048 + k * 1024); } while (0)
#define PG8_LDB(dst, b, h) do { _Pragma("unroll") for (int n = 0; n < 2; ++n) _Pragma("unroll") for (int k = 0; k < 2; ++k) dst[n][k] = *(const LAS bf16x8*)(lds + PG8_SB(b, h) + boff + n * 2048 + k * 1024); } while (0)
#define PG8_MMA(ai, bj, At, Bt) do { __builtin_amdgcn_s_setprio(1); _Pragma("unroll") for (int m = 0; m < 4; ++m) _Pragma("unroll") for (int n = 0; n < 2; ++n) _Pragma("unroll") for (int k = 0; k < 2; ++k) \
        acc[ai][bj][m][n] = __builtin_amdgcn_mfma_f32_16x16x32_bf16(Bt[n][k], At[m][k], acc[ai][bj][m][n], 0, 0, 0); __builtin_amdgcn_s_setprio(0); } while (0)
#define PG8_WAIT_V(n) asm volatile("s_waitcnt vmcnt(" #n ")" ::: "memory")
#define PG8_WAIT_L(n) asm volatile("s_waitcnt lgkmcnt(" #n ")" ::: "memory")
#define PG8_BAR __builtin_amdgcn_s_barrier()
#define PG8_SCHED __builtin_amdgcn_sched_barrier(0)
    Unit cur, nxt; int ui = 0;
    if (!S.next(0, cur)) return;
    f32x4 acc[2][2][4][2];
#pragma unroll
    for (int a = 0; a < 2; ++a)
#pragma unroll
        for (int b = 0; b < 2; ++b)
#pragma unroll
            for (int m = 0; m < 4; ++m)
#pragma unroll
                for (int n = 0; n < 2; ++n) acc[a][b][m][n] = (f32x4){0.f, 0.f, 0.f, 0.f};
    bf16x8 At[4][2], B0[2][2], B1[2][2];
    const char* cA = (const char*)g.A + (size_t)cur.pm * tstepA; const char* cB = (const char*)g.Bt + (size_t)cur.pb * tstepB;
    PG8_STAGE(PG8_SB(0, 0), cB, voffB); PG8_STAGE(PG8_SB(0, 1), cB + hstepB, voffB); PG8_STAGEA(PG8_SA(0, 0), cA, vC, 0); PG8_STAGEA(PG8_SA(0, 1), cA, vC, 1);
    if (wr == 1) PG8_BAR;
    PG8_WAIT_V(2); PG8_BAR;
    PG8_STAGE(PG8_SB(1, 0), cB + kstep, voffB); PG8_STAGEA(PG8_SA(1, 0), cA + kstep, vC, 0); PG8_STAGE(PG8_SB(1, 1), cB + hstepB + kstep, voffB);
    PG8_WAIT_V(6); PG8_BAR;
    for (;;) {
        const bool has_next = S.next(ui + 1, nxt);
        if (GATHER && has_next) {
#pragma unroll
            for (int i = 0; i < 2; ++i)
#pragma unroll
                for (int h = 0; h < 2; ++h) vNs[h][i] = (unsigned)g.gidx[(ui + 1) * BM + h * HALF + RA[i]] * (unsigned)(g.lda * 2) + (unsigned)CA[i] * 2u; }
        const char* nA = has_next ? (const char*)g.A + (size_t)nxt.pm * tstepA : cA; const char* nB = has_next ? (const char*)g.Bt + (size_t)nxt.pb * tstepB : cB;
        for (int t = 0; t < nt; t += 2) {
            const bool last = (t == nt - 2);
            const char* a1 = cA + (size_t)(t + 1) * kstep;
            const char* a2 = last ? nA : cA + (size_t)(t + 2) * kstep; const char* b2 = last ? nB : cB + (size_t)(t + 2) * kstep;
            const char* a3 = a2 + kstep; const char* b3 = b2 + kstep;
            PG8_LDB(B0, 0, 0); PG8_LDB(B1, 0, 1); PG8_SCHED; PG8_LDA(At, 0, 0); PG8_STAGEA(PG8_SA(1, 1), a1, vC, 1);
            PG8_WAIT_V(8); PG8_WAIT_L(0); PG8_BAR; PG8_MMA(0, 0, At, B0); PG8_MMA(0, 1, At, B1); PG8_BAR; PG8_SCHED;
            PG8_LDA(At, 0, 1); PG8_STAGE(PG8_SB(0, 0), b2, voffB); PG8_STAGE(PG8_SB(0, 1), b2 + hstepB, voffB); PG8_STAGEAL(PG8_SA(0, 0), a2, 0);
            PG8_WAIT_V(8); PG8_WAIT_L(0); PG8_BAR; PG8_MMA(1, 0, At, B0); PG8_MMA(1, 1, At, B1); PG8_BAR; PG8_SCHED;
            PG8_LDB(B0, 1, 0); PG8_LDB(B1, 1, 1); PG8_SCHED; PG8_LDA(At, 1, 0); PG8_STAGEAL(PG8_SA(0, 1), a2, 1);
            PG8_WAIT_V(8); PG8_WAIT_L(0); PG8_BAR; PG8_MMA(0, 0, At, B0); PG8_MMA(0, 1, At, B1); PG8_BAR; PG8_SCHED;
            PG8_LDA(At, 1, 1); PG8_STAGE(PG8_SB(1, 0), b3, voffB); PG8_STAGE(PG8_SB(1, 1), b3 + hstepB, voffB); PG8_STAGEAL(PG8_SA(1, 0), a3, 0);
            PG8_WAIT_V(8); PG8_WAIT_L(0); PG8_BAR; PG8_MMA(1, 0, At, B0); PG8_MMA(1, 1, At, B1); PG8_BAR; PG8_SCHED;
            if constexpr (Epi::KHOOK) { if (t == 2 || t == 8) { asm volatile("" ::: "memory"); E.khook(acc, ui, t == 2 ? 0 : 1, wr, fr); asm volatile("" ::: "memory"); } }
        }
        if constexpr (ALIGN_EPI) { if (wr == 0) PG8_BAR; }
        { int t2 = threadIdx.x; asm volatile("" : "+v"(t2)); E(acc, cur, wr, wc, t2 & 15, (t2 >> 4) & 3, ui); }
        if (!has_next) break;
#pragma unroll
        for (int a = 0; a < 2; ++a)
#pragma unroll
            for (int b = 0; b < 2; ++b)
#pragma unroll
                for (int m = 0; m < 4; ++m)
#pragma unroll
                    for (int n = 0; n < 2; ++n) acc[a][b][m][n] = (f32x4){0.f, 0.f, 0.f, 0.f};
        cur = nxt; cA = nA; cB = nB; ++ui;
        if (GATHER) {
#pragma unroll
            for (int i = 0; i < 2; ++i)
#pragma unroll
                for (int h = 0; h < 2; ++h) vC[h][i] = vNs[h][i]; }
        if constexpr (ALIGN_EPI) { if (wr == 1) PG8_BAR; }
    }
    PG8_WAIT_V(0);
    if constexpr (!ALIGN_EPI) { if (wr == 0) PG8_BAR; }
    PG8_BAR;
#undef PG8_SA
#undef PG8_SB
#undef PG8_STAGE
#undef PG8_STAGEA
#undef PG8_STAGEAL
#undef PG8_LDA
#undef PG8_LDB
#undef PG8_MMA
#undef PG8_WAIT_V
#undef PG8_WAIT_L
#undef PG8_BAR
#undef PG8_SCHED
}

typedef const f32x4 (&AccRef)[2][2][4][2];
template <int DIM> __device__ __forceinline__ void rope_cs(int pos, int j0, f32x4& c, f32x4& s) {
    constexpr float KEXP = 13.287712379549449f * 2.f / DIM;
#pragma unroll
    for (int e = 0; e < 4; ++e) { const float inv = __builtin_amdgcn_exp2f(-(float)(j0 + e) * KEXP), ang = (float)pos * inv, rev = ang * 0.15915494309189535f, fr = __builtin_amdgcn_fractf(rev);
        c[e] = __builtin_amdgcn_cosf(fr); s[e] = __builtin_amdgcn_sinf(fr); }
}
__device__ __forceinline__ void st_bf16x8(bf16* p, f32x4 v0, f32x4 v1) { u32x4 w; w.x = cvt_pk_bf16(v0[0], v0[1]); w.y = cvt_pk_bf16(v0[2], v0[3]); w.z = cvt_pk_bf16(v1[0], v1[1]); w.w = cvt_pk_bf16(v1[2], v1[3]); *(u32x4*)p = w; }
struct EpiProj {
    static constexpr bool PERM = true, KHOOK = false;
    bf16* P; float *cqss, *ckvss; const LAS float* rs;
    __device__ __forceinline__ void operator()(AccRef acc, const Unit& u, int wr, int wc, int fr, int fq, int ui) const {
#pragma unroll
        for (int ai = 0; ai < 2; ++ai)
#pragma unroll
            for (int m = 0; m < 4; ++m) { const int row = u.pm * BM + ai * HALF + wr * 64 + m * 16 + fr; const int pos = row & (NS - 1); float ssq = 0.f; const float rsv = rs[ui * BM + ai * HALF + wr * 64 + m * 16 + fr];
#pragma unroll
                for (int bj = 0; bj < 2; ++bj) { const int cw = u.pn * BM + bj * HALF + wc * 32, col0 = cw + 8 * fq; f32x4 v0 = acc[ai][bj][m][0] * rsv, v1 = acc[ai][bj][m][1] * rsv;
                    if (cw >= C_SQ && cw < C_SV) { const int g = ((col0 - C_SQ) & 63) >> 3; f32x4 c, s; rope_cs<64>(pos, 4 * g, c, s);
                        const f32x4 o0 = v0 * c - v1 * s, o1 = v1 * c + v0 * s; v0 = o0; v1 = o1; }
                    else if (cw == C_KR) { f32x4 c, s; rope_cs<32>(pos, 4 * fq, c, s);
                        const f32x4 o0 = v0 * c - v1 * s, o1 = v1 * c + v0 * s; v0 = o0; v1 = o1; }
                    if (u.pn == 3 || (u.pn == 4 && bj == 0)) ssq += (v0[0] * v0[0] + v0[1] * v0[1]) + (v0[2] * v0[2] + v0[3] * v0[3]) + (v1[0] * v1[0] + v1[1] * v1[1]) + (v1[2] * v1[2] + v1[3] * v1[3]);
                    st_bf16x8(P + (size_t)row * NP + col0, v0, v1); }
                if (u.pn == 3 || u.pn == 4) { ssq += __shfl_xor(ssq, 16); ssq += __shfl_xor(ssq, 32); if (fq == 0) (u.pn == 3 ? cqss : ckvss)[(size_t)row * 4 + wc] = ssq; }
            }
    }
};
template <bool QMODE, int ldc, int ncols> struct EpiMla {
    static constexpr bool PERM = true, KHOOK = false;
    bf16* O; const LAS float* rs;
    __device__ __forceinline__ void operator()(AccRef acc, const Unit& u, int wr, int wc, int fr, int fq, int ui) const {
#pragma unroll
        for (int ai = 0; ai < 2; ++ai)
#pragma unroll
            for (int m = 0; m < 4; ++m) { const int row = u.pm * BM + ai * HALF + wr * 64 + m * 16 + fr; const int pos = row & (NS - 1);
                const float rsv = rs[ui * BM + ai * HALF + wr * 64 + m * 16 + fr];
#pragma unroll
                for (int bj = 0; bj < 2; ++bj) { const int cw = u.pn * BM + bj * HALF + wc * 32, col0 = cw + 8 * fq; if (cw >= ncols) continue;
                    f32x4 v0 = acc[ai][bj][m][0] * rsv, v1 = acc[ai][bj][m][1] * rsv;
                    if (QMODE && (cw % 96) == 64) { f32x4 c, s; rope_cs<32>(pos, 4 * fq, c, s);
                        const f32x4 o0 = v0 * c - v1 * s, o1 = v1 * c + v0 * s; v0 = o0; v1 = o1; }
                    st_bf16x8(O + (size_t)row * ldc + col0, v0, v1); }
                asm volatile("" ::: "memory"); }
    }
};
struct EpiResid {
    static constexpr bool PERM = true, KHOOK = true;
    bf16* HB; const LAS float* fac;
    __device__ __forceinline__ void khook(f32x4 (&acc)[2][2][4][2], int ui, int which, int wr, int fr) const {
#pragma unroll
        for (int ai = 0; ai < 2; ++ai)
#pragma unroll
            for (int m = 0; m < 4; ++m) { const float f = fac[(ui * BM + ai * HALF + wr * 64 + m * 16 + fr) * 4 + which];
#pragma unroll
                for (int bj = 0; bj < 2; ++bj)
#pragma unroll
                    for (int n = 0; n < 2; ++n) acc[ai][bj][m][n] *= f; }
    }
    __device__ __forceinline__ void operator()(AccRef acc, const Unit& u, int wr, int wc, int fr, int fq, int ui) const {
#pragma unroll
        for (int ai = 0; ai < 2; ++ai)
#pragma unroll
            for (int m = 0; m < 4; ++m) { const int rl = ai * HALF + wr * 64 + m * 16 + fr; const float f = fac[(ui * BM + rl) * 4 + 2]; bf16* p = HB + (size_t)(u.pm * BM + rl) * DM + u.pn * BM + wc * 32 + 8 * fq;
#pragma unroll
                for (int bj = 0; bj < 2; ++bj) { const u32x4 w = *(const u32x4*)(p + bj * HALF); f32x4 h0, h1;
                    h0[0] = __builtin_bit_cast(float, w[0] << 16); h0[1] = __builtin_bit_cast(float, w[0] & 0xffff0000u); h0[2] = __builtin_bit_cast(float, w[1] << 16); h0[3] = __builtin_bit_cast(float, w[1] & 0xffff0000u);
                    h1[0] = __builtin_bit_cast(float, w[2] << 16); h1[1] = __builtin_bit_cast(float, w[2] & 0xffff0000u); h1[2] = __builtin_bit_cast(float, w[3] << 16); h1[3] = __builtin_bit_cast(float, w[3] & 0xffff0000u);
                    st_bf16x8(p + bj * HALF, h0 + acc[ai][bj][m][0] * f, h1 + acc[ai][bj][m][1] * f); } }
    }
};
struct EpiSwiglu {
    static constexpr bool PERM = true, KHOOK = false;
    bf16* Hd; const LAS float* rs;
    __device__ __forceinline__ void operator()(AccRef acc, const Unit& u, int wr, int wc, int fr, int fq, int ui) const {
#pragma unroll
        for (int ai = 0; ai < 2; ++ai)
#pragma unroll
            for (int m = 0; m < 4; ++m) { const size_t row = (size_t)(u.pm * BM + ai * HALF + wr * 64 + m * 16 + fr); f32x4 o[2]; const float rsv = rs[ui * BM + ai * HALF + wr * 64 + m * 16 + fr];
#pragma unroll
                for (int n = 0; n < 2; ++n) { const f32x4 gt = acc[ai][0][m][n] * rsv, up = acc[ai][1][m][n] * rsv;
#pragma unroll
                    for (int e = 0; e < 4; ++e) o[n][e] = gt[e] * __builtin_amdgcn_rcpf(1.f + __builtin_amdgcn_exp2f(-gt[e] * LOG2E)) * up[e]; }
                st_bf16x8(Hd + row * DM + u.pn * HALF + wc * 32 + 8 * fq, o[0], o[1]); }
    }
};
struct EpiGate {
    static constexpr bool PERM = true, KHOOK = false;
    bf16* Y; const LAS float* gate;
    __device__ __forceinline__ void operator()(AccRef acc, const Unit& u, int wr, int wc, int fr, int fq, int ui) const {
#pragma unroll
        for (int ai = 0; ai < 2; ++ai)
#pragma unroll
            for (int m = 0; m < 4; ++m) { const size_t row = (size_t)(u.pm * BM + ai * HALF + wr * 64 + m * 16 + fr); const float gt = gate[ui * BM + ai * HALF + wr * 64 + m * 16 + fr];
#pragma unroll
                for (int bj = 0; bj < 2; ++bj) st_bf16x8(Y + row * DM + u.pn * BM + bj * HALF + wc * 32 + 8 * fq, acc[ai][bj][m][0] * gt, acc[ai][bj][m][1] * gt); }
    }
};
}


namespace att {
typedef short bf16x8 __attribute__((ext_vector_type(8)));
typedef short s16x4 __attribute__((ext_vector_type(4)));
typedef float f32x16 __attribute__((ext_vector_type(16)));
typedef float f32x4 __attribute__((ext_vector_type(4)));
typedef unsigned u32x4 __attribute__((ext_vector_type(4)));
typedef float f32x2_t __attribute__((ext_vector_type(2))); typedef __bf16 bf16x2_t __attribute__((ext_vector_type(2)));
typedef short v4i16_t __attribute__((ext_vector_type(4)));
constexpr int KSLOT = 12288, VSLOT = 8192, NSL = 3;
constexpr int L_K = 0, L_V = NSL * KSLOT, L_WS = L_V + NSL * VSLOT, L_OST = L_WS + 8 * 256, L_BIAS = L_OST + 8 * 4096, L_END = L_BIAS + 2048;
constexpr float THR = 8.f;
constexpr int ATT_PROBE = 0;
constexpr bool LSUM_MFMA = true;
__device__ __forceinline__ int crow(int r, int hi) { return (r & 3) + 8 * (r >> 2) + 4 * hi; }
__device__ __forceinline__ unsigned cvtpk(float lo, float hi) { f32x2_t v = {lo, hi}; bf16x2_t b = __builtin_convertvector(v, bf16x2_t); return __builtin_bit_cast(unsigned, b); }
__device__ __forceinline__ s16x4 vtr(const LAS unsigned char* p) { return __builtin_bit_cast(s16x4, __builtin_amdgcn_ds_read_tr16_b64_v4i16((LAS v4i16_t*)p)); }
__device__ __forceinline__ void glds(const bf16* src, unsigned lds_dst) { unsigned keep;
    asm volatile("s_mov_b32 %0, m0\n\ts_mov_b32 m0, %2\n\ts_nop 0\n\tglobal_load_lds_dwordx4 %1, off\n\ts_mov_b32 m0, %0" : "=&s"(keep) : "v"(src), "s"(lds_dst) : "memory"); }
struct AttnP { const bf16 *PROJ, *QB, *KV; bf16* O; float* SS; const float* rpb; const float* sink; };
#define ATT_WAIT_BAR() do { if (PROBE != 3) asm volatile("s_waitcnt vmcnt(0) lgkmcnt(0)\n\ts_barrier" ::: "memory"); } while (0)

template <int TYPE, int PROBE = 0> __device__ __forceinline__ void attn_unit(const AttnP& P, int b, int h, int qb, LAS unsigned char* lds) {
    constexpr int ND0 = (TYPE == 1) ? 6 : 4;
    int tid = threadIdx.x; asm volatile("" : "+v"(tid));
    const int lane = tid & 63, r32 = lane & 31, hi = lane >> 5, wid = __builtin_amdgcn_readfirstlane(tid >> 6);
    const bool ordA = wid < 4;
    const int q0 = qb * 256, qw0 = q0 + wid * 32; const size_t tokb = (size_t)b * NS;
    int ntile, kbase, ta, tb;
    if (TYPE == 1) { ntile = NS / 64; kbase = 0; ta = 0; tb = ntile - 1; }
    else if (TYPE == 2) { kbase = max(q0 - 128, 0); const int ke = min(q0 + 384, NS); ntile = (ke - kbase) >> 6; ta = max(qw0 - 128 - kbase, 0) >> 6; tb = min(ntile - 1, (qw0 + 159 - kbase) >> 6); }
    else { const int r0 = qb * 4; kbase = min(max(r0 - 4, 0), 56); ntile = min(max(r0 - 1, 0), 56) + 7 - kbase + 1; const int r = r0 + (wid >> 1); ta = min(max(r - 4, 0), 56) - kbase; tb = ta + 7; }
    const int kvh = (TYPE == 2) ? h / 3 : h;
    const bf16 *ksrc, *ksrc2 = nullptr, *vsrc; size_t kpitch, vpitch;
    { const size_t key0 = tokb + (TYPE == 0 ? (size_t)kbase * 64 : (size_t)kbase); const int vrow = 16 * (wid & 3) + (lane >> 2), vcol = (wid >> 2) * 32 + (lane & 3) * 8;
      if (TYPE == 0) { ksrc = P.PROJ + (key0 + lane) * NP + C_AK + h * 64 + wid * 8; vsrc = P.PROJ + (key0 + vrow) * NP + C_AV + h * 64 + vcol; kpitch = vpitch = NP; }
      else if (TYPE == 1) { ksrc = P.KV + (key0 + lane) * 768 + h * 64 + wid * 8; ksrc2 = P.PROJ + (key0 + lane) * NP + C_KR + (wid & 3) * 8; vsrc = P.KV + (key0 + vrow) * 768 + 384 + h * 64 + vcol; kpitch = vpitch = 768; }
      else { ksrc = P.PROJ + (key0 + lane) * NP + C_SK + kvh * 64 + wid * 8; vsrc = P.PROJ + (key0 + vrow) * NP + C_SV + kvh * 64 + vcol; kpitch = vpitch = NP; } }
    const unsigned kdst = (unsigned)(uintptr_t)(lds + L_K) + wid * 1024, vdst = (unsigned)(uintptr_t)(lds + L_V) + wid * 1024;
#define ATT_DMA(t, slot) do { if (PROBE == 2 || PROBE == 3) break; glds(ksrc + (size_t)(t) * 64 * kpitch, (unsigned)__builtin_amdgcn_readfirstlane(kdst + (slot) * KSLOT)); if (TYPE == 1 && wid < 4) glds(ksrc2 + (size_t)(t) * 64 * NP, (unsigned)__builtin_amdgcn_readfirstlane(kdst + (slot) * KSLOT + 8192)); \
        glds(vsrc + (size_t)(t) * 64 * vpitch, (unsigned)__builtin_amdgcn_readfirstlane(vdst + (slot) * VSLOT)); } while (0)
    LAS float* biasL = (LAS float*)(lds + L_BIAS);
    if (TYPE == 0) { for (int i = tid; i < 15 * 31; i += 512) biasL[i] = P.rpb[h * 465 + i] * LOG2E; }
    bf16x8 qr[ND0];
    { const bf16* qp = (TYPE == 1) ? P.QB + (tokb + qw0 + r32) * 576 + h * 96 : P.PROJ + (tokb + qw0 + r32) * NP + (TYPE == 0 ? C_AQ : C_SQ) + h * 64;
#pragma unroll
      for (int d0 = 0; d0 < ND0; ++d0) qr[d0] = *(const bf16x8*)(qp + d0 * 16 + hi * 8); }
    LAS float* wsf = (LAS float*)(lds + L_WS) + wid * 64;
    float m = (TYPE == 2) ? P.sink[h] * LOG2E : 0.f;
    f32x16 negm; { const float nm = -m;
#pragma unroll
      for (int r = 0; r < 16; ++r) negm[r] = nm; }
    f32x16 o[2]; o[0] = f32x16{}; o[1] = f32x16{};
    f32x16 lacc;
    { const float l0 = (TYPE == 2) ? 1.f : 0.f;
#pragma unroll
      for (int r = 0; r < 16; ++r) lacc[r] = l0; }
    float lsum = (TYPE == 2 && hi == 0) ? 1.f : 0.f;
    const bf16x8 ones = (bf16x8){0x3F80, 0x3F80, 0x3F80, 0x3F80, 0x3F80, 0x3F80, 0x3F80, 0x3F80};
    f32x16 sA0, sA1, sB0, sB1;
#define ATT_QK(X0, X1, tt, sl) do { const LAS unsigned char* Kp = lds + L_K + (sl) * KSLOT + hi * 1024 + r32 * 16; X0 = negm; X1 = negm; \
        bf16x8 ka0 = *(const LAS bf16x8*)(Kp), ka1 = *(const LAS bf16x8*)(Kp + 512); \
        _Pragma("unroll") for (int d0 = 0; d0 < ND0; ++d0) { bf16x8 kb0 = ka0, kb1 = ka1; \
            if (d0 + 1 < ND0) { kb0 = *(const LAS bf16x8*)(Kp + (d0 + 1) * 2048); kb1 = *(const LAS bf16x8*)(Kp + (d0 + 1) * 2048 + 512); }     \
            X0 = __builtin_amdgcn_mfma_f32_32x32x16_bf16(ka0, qr[d0], X0, 0, 0, 0); X1 = __builtin_amdgcn_mfma_f32_32x32x16_bf16(ka1, qr[d0], X1, 0, 0, 0); ka0 = kb0; ka1 = kb1; } \
        __builtin_amdgcn_sched_group_barrier(0x100, 2, 0); __builtin_amdgcn_sched_group_barrier(0x100, 2, 0);        \
        _Pragma("unroll") for (int d0 = 0; d0 + 2 < ND0; ++d0) { __builtin_amdgcn_sched_group_barrier(0x8, 2, 0); __builtin_amdgcn_sched_group_barrier(0x100, 2, 0); } \
        __builtin_amdgcn_sched_group_barrier(0x8, 2, 0); __builtin_amdgcn_sched_group_barrier(0x8, 2, 0); \
        if (TYPE == 2) { const int dq = qw0 + r32 - (kbase + (tt) * 64) - 4 * hi; \
            _Pragma("unroll") for (int r = 0; r < 16; ++r) { const int d0_ = dq - ((r & 3) + 8 * (r >> 2)), d1_ = d0_ - 32; \
                if (d0_ > 128 || d0_ < -128) X0[r] = -INFINITY; if (d1_ > 128 || d1_ < -128) X1[r] = -INFINITY; } } \
        if (TYPE == 0) { const int c = (wid & 1) * 32 + r32, cs = min(max(c - 8, 0), 48); const int rq = qb * 4 + (wid >> 1), kr = kbase + (tt); const LAS float* brow = biasL + (kr - rq + 7) * 31 + 15 - c; \
            _Pragma("unroll") for (int rr = 0; rr < 16; ++rr) { const int kc0 = crow(rr, hi), kc1 = kc0 + 32; \
                const bool v0 = kc0 >= cs && kc0 < cs + 16, v1 = kc1 >= cs && kc1 < cs + 16; \
                X0[rr] = v0 ? X0[rr] + brow[v0 ? kc0 : c] : -INFINITY; X1[rr] = v1 ? X1[rr] + brow[v1 ? kc1 : c] : -INFINITY; } } \
        asm volatile("s_nop 15\n\ts_nop 7" : "+v"(X0), "+v"(X1)); } while (0)
#define ATT_MAX3(a, b, c) ({ float r_; asm("v_max3_f32 %0, %1, %2, %3" : "=v"(r_) : "v"(a), "v"(b), "v"(c)); r_; })
#define ATT_STEP(ORDA, C0, C1, N0, N1, t) do { \
        if ((t) + 1 < ntile) ATT_WAIT_BAR(); \
        if ((t) + 2 < ntile) ATT_DMA((t) + 2, sl_nn); \
        const bool act = ((t) >= ta && (t) <= tb), nact = ((t) + 1 >= ta && (t) + 1 <= tb); \
        if (ORDA && nact) ATT_QK(N0, N1, (t) + 1, sl_nxt); \
        if (act) { \
            float ma = 0.f, mb = 0.f; if (PROBE != 4) { ma = ATT_MAX3(C0[0], C0[1], C1[0]); mb = ATT_MAX3(C0[2], C0[3], C1[1]); ma = ATT_MAX3(ma, C1[2], C1[3]); \
            _Pragma("unroll") for (int r = 4; r < 16; r += 4) { ma = ATT_MAX3(ma, C0[r], C0[r + 1]); mb = ATT_MAX3(mb, C0[r + 2], C0[r + 3]); ma = ATT_MAX3(ma, C1[r], C1[r + 1]); mb = ATT_MAX3(mb, C1[r + 2], C1[r + 3]); } } \
            float rm = fmaxf(ma, mb); \
            { auto rr = __builtin_amdgcn_permlane32_swap(__float_as_uint(rm), __float_as_uint(rm), false, false); rm = fmaxf(__uint_as_float(rr[0]), __uint_as_float(rr[1])); } \
            const bool first = (TYPE != 2) && ((t) == ta); \
            if (first || __any(rm > THR)) { const float dl = first ? rm : fmaxf(rm, 0.f), f = first ? 1.f : __builtin_amdgcn_exp2f(-dl); m += dl; lsum *= f; \
                _Pragma("unroll") for (int r = 0; r < 16; ++r) { C0[r] -= dl; C1[r] -= dl; negm[r] = -m; } \
                if (ORDA && nact) { _Pragma("unroll") for (int r = 0; r < 16; ++r) { N0[r] -= dl; N1[r] -= dl; } } \
                if (hi == 0) wsf[r32] = f; \
                _Pragma("unroll") for (int g = 0; g < 4; ++g) { const f32x4 fv = *(const LAS f32x4*)(wsf + 8 * g + 4 * hi); \
                    _Pragma("unroll") for (int e = 0; e < 4; ++e) { o[0][4 * g + e] *= fv[e]; o[1][4 * g + e] *= fv[e]; lacc[4 * g + e] *= fv[e]; } } } \
            const LAS unsigned char* Vp = lds + L_V + sl_cur * VSLOT + ((lane >> 4) & 1) * 32 + (lane & 3) * 8 + (4 * hi + ((lane & 15) >> 2)) * 64; \
            s16x4 va[4], vb[4]; \
            va[0] = vtr(Vp); va[1] = vtr(Vp + 512); va[2] = vtr(Vp + 4096); va[3] = vtr(Vp + 4096 + 512);        \
            if (PROBE != 4) { _Pragma("unroll") for (int r = 0; r < 16; ++r) { C0[r] = __builtin_amdgcn_exp2f(C0[r]); C1[r] = __builtin_amdgcn_exp2f(C1[r]); } } \
            if (!LSUM_MFMA) { float sa = 0.f, sb = 0.f; _Pragma("unroll") for (int r = 0; r < 16; ++r) { sa += C0[r]; sb += C1[r]; } lsum += sa + sb; } \
            u32x4 pw[4]; \
            _Pragma("unroll") for (int e = 0; e < 4; ++e) { pw[0][e] = cvtpk(C0[2 * e], C0[2 * e + 1]); pw[1][e] = cvtpk(C0[8 + 2 * e], C0[9 + 2 * e]); pw[2][e] = cvtpk(C1[2 * e], C1[2 * e + 1]); pw[3][e] = cvtpk(C1[8 + 2 * e], C1[9 + 2 * e]); } \
            _Pragma("unroll") for (int ks = 0; ks < 4; ++ks) { const bf16x8 pa = __builtin_bit_cast(bf16x8, pw[ks]); \
                if (ks + 1 < 4) { vb[0] = vtr(Vp + (ks + 1) * 1024); vb[1] = vtr(Vp + (ks + 1) * 1024 + 512); vb[2] = vtr(Vp + 4096 + (ks + 1) * 1024); vb[3] = vtr(Vp + 4096 + (ks + 1) * 1024 + 512); }     \
                o[0] = __builtin_amdgcn_mfma_f32_32x32x16_bf16(pa, ((bf16x8){va[0][0], va[0][1], va[0][2], va[0][3], va[1][0], va[1][1], va[1][2], va[1][3]}), o[0], 0, 0, 0); \
                o[1] = __builtin_amdgcn_mfma_f32_32x32x16_bf16(pa, ((bf16x8){va[2][0], va[2][1], va[2][2], va[2][3], va[3][0], va[3][1], va[3][2], va[3][3]}), o[1], 0, 0, 0); \
                if (LSUM_MFMA) lacc = __builtin_amdgcn_mfma_f32_32x32x16_bf16(pa, ones, lacc, 0, 0, 0); \
                _Pragma("unroll") for (int q_ = 0; q_ < 4; ++q_) va[q_] = vb[q_]; } \
            __builtin_amdgcn_sched_group_barrier(0x100, 4, 1); \
            _Pragma("unroll") for (int ks = 0; ks < 3; ++ks) { __builtin_amdgcn_sched_group_barrier(0x100, 4, 1); __builtin_amdgcn_sched_group_barrier(0x8, LSUM_MFMA ? 3 : 2, 1); } \
            __builtin_amdgcn_sched_group_barrier(0x8, LSUM_MFMA ? 3 : 2, 1); \
        } \
        if (!(ORDA) && nact) ATT_QK(N0, N1, (t) + 1, sl_nxt); \
        { const int tmp = sl_cur; sl_cur = sl_nxt; sl_nxt = sl_nn; sl_nn = tmp; } } while (0)
    ATT_DMA(0, 0);
    if (ntile > 1) ATT_DMA(1, 1);
    if (PROBE == 2 || PROBE == 3) {} else if (ntile > 1) { if (TYPE == 1 && wid < 4) asm volatile("s_waitcnt vmcnt(3)" ::: "memory"); else asm volatile("s_waitcnt vmcnt(2)" ::: "memory"); } else asm volatile("s_waitcnt vmcnt(0)" ::: "memory");
    asm volatile("s_waitcnt lgkmcnt(0)\n\ts_barrier" ::: "memory");
    if (ta == 0) ATT_QK(sA0, sA1, 0, 0);
    int sl_cur = 0, sl_nxt = 1, sl_nn = 2;
    if (ordA) {
        for (int t = 0; t < ntile; t += 2) { ATT_STEP(true, sA0, sA1, sB0, sB1, t); if (t + 1 < ntile) ATT_STEP(true, sB0, sB1, sA0, sA1, t + 1); }
    } else {
        for (int t = 0; t < ntile; t += 2) { ATT_STEP(false, sA0, sA1, sB0, sB1, t); if (t + 1 < ntile) ATT_STEP(false, sB0, sB1, sA0, sA1, t + 1); }
    }
    LAS bf16* stg = (LAS bf16*)(lds + L_OST) + wid * 2048;
    if (!LSUM_MFMA) { { auto rr = __builtin_amdgcn_permlane32_swap(__float_as_uint(lsum), __float_as_uint(lsum), false, false); lsum = __uint_as_float(rr[0]) + __uint_as_float(rr[1]); }
        if (hi == 0) wsf[32 + r32] = lsum;
#pragma unroll
        for (int g = 0; g < 4; ++g) { const f32x4 lv = *(const LAS f32x4*)(wsf + 32 + 8 * g + 4 * hi);
#pragma unroll
            for (int e = 0; e < 4; ++e) lacc[4 * g + e] = lv[e]; } }
#pragma unroll
    for (int r = 0; r < 16; ++r) { const float iv = __builtin_amdgcn_rcpf(lacc[r]); const int orow = crow(r, hi);
        stg[orow * 64 + r32] = (bf16)(cvtpk(o[0][r] * iv, 0.f) & 0xffff); stg[orow * 64 + 32 + r32] = (bf16)(cvtpk(o[1][r] * iv, 0.f) & 0xffff); }
    const int ocol = (TYPE == 0 ? 0 : (TYPE == 1 ? 256 : 640)) + h * 64, sidx = (TYPE == 0 ? 0 : (TYPE == 1 ? 4 : 10)) + h;
#pragma unroll
    for (int i = 0; i < 4; ++i) { const int row = i * 8 + (lane >> 3), ch = lane & 7; const u32x4 v = *(const LAS u32x4*)(stg + row * 64 + ch * 8);
        const size_t tokn = tokb + qw0 + row; if (PROBE == 0) *(u32x4*)(P.O + tokn * DM + ocol + ch * 8) = v; else asm volatile("" :: "v"(v));
        float sq = 0.f;
#pragma unroll
        for (int e = 0; e < 4; ++e) { const float a = __builtin_bit_cast(float, v[e] << 16), c2 = __builtin_bit_cast(float, v[e] & 0xffff0000u); sq += a * a + c2 * c2; }
        sq += __shfl_xor(sq, 1); sq += __shfl_xor(sq, 2); sq += __shfl_xor(sq, 4);
        if (ch == 0 && PROBE == 0) P.SS[tokn * 16 + sidx] = sq; }
    ATT_WAIT_BAR();
#undef ATT_DMA
#undef ATT_QK
#undef ATT_STEP
#undef ATT_MAX3
}
__device__ __forceinline__ void attn_phase(const AttnP& P, LAS unsigned char* lds, int vcu) {
    const int x = vcu >> 5, cx = vcu & 31;
    for (int i = 0; i < 3; ++i) { const int j = cx * 3 + i, bh = 6 * x + (j >> 4), qb = j & 15; attn_unit<1>(P, bh / 6, bh % 6, qb, lds); }
    if (ATT_PROBE) for (int i = 0; i < 3; ++i) { const int j = cx * 3 + i, bh = 6 * x + (j >> 4), qb = j & 15; attn_unit<1, ATT_PROBE>(P, bh / 6, bh % 6, qb, lds); }
    for (int i = 0; i < 3; ++i) { const int j = cx * 3 + i, bh = 6 * x + (j >> 4), qb = j & 15; attn_unit<2>(P, bh / 6, bh % 6, qb, lds); }
    for (int i = 0; i < 2; ++i) { const int j = cx * 2 + i, bh = 4 * x + (j >> 4), qb = j & 15; attn_unit<0>(P, bh >> 2, bh & 3, qb, lds); }
}
}


constexpr int NWAVES = 8, LDS_BYTES = 155648, RING_BYTES = 131072, MISC_OFF = RING_BYTES + 320, TAB_OFF = RING_BYTES + 512;
#define XB_TMO      128
#define XB_XCNT(j)  (256  + 64 * (j))
#define XB_XSUB(j)  (1280 + 64 * (j))
#define XB_XGEN(j)  (2304 + 64 * (j))
#define XB_TOP      3328
#define XB_TOPGEN   3392
#define XCD_BAR_WORDS 3456
#define XB_SPIN_CAP (1u << 18)
constexpr int CW_BAR = 4096;
__device__ __forceinline__ unsigned xb_ld(unsigned* p)              { return __hip_atomic_load(p, __ATOMIC_RELAXED, __HIP_MEMORY_SCOPE_AGENT); }
__device__ __forceinline__ unsigned xb_add(unsigned* p, unsigned v) { return __hip_atomic_fetch_add(p, v, __ATOMIC_RELAXED, __HIP_MEMORY_SCOPE_AGENT); }
__device__ __forceinline__ unsigned xb_xcc_id() { return (unsigned)__builtin_amdgcn_s_getreg((3 << 11) | 20) & 0xFu; }
#define XB_SPIN(cond, bar) do { unsigned _sp = 0; while (cond) { __builtin_amdgcn_s_sleep(1); \
    if ((++_sp & 255u) == 0u) { if (xb_ld(&(bar)[XB_TMO])) break; if (_sp > XB_SPIN_CAP) { atomicAdd(&(bar)[XB_TMO], 1u); break; } } } } while (0)
struct XcdBarrier { unsigned* bar; unsigned x; volatile LAS unsigned* st; };
__device__ __forceinline__ XcdBarrier xcd_barrier_post(unsigned* bar, volatile LAS unsigned* st) {
    XcdBarrier b; b.bar = bar; b.x = xb_xcc_id(); b.st = st;
    if (threadIdx.x == 0) (void)xb_add(&bar[XB_XCNT(b.x)], 1u);
    return b;
}
__device__ __forceinline__ void xcd_barrier_complete(unsigned* bar, unsigned x, unsigned& nloc, unsigned& nx) {
    const unsigned G = gridDim.x * gridDim.y * gridDim.z;
    unsigned sum, cnt, mine, sp = 0u;
    for (;;) {
        sum = 0u; cnt = 0u; mine = 0u;
#pragma unroll
        for (unsigned j = 0; j < 16; ++j) { const unsigned c = xb_ld(&bar[XB_XCNT(j)]); sum += c; cnt += (c > 0u) ? 1u : 0u; mine = (j == x) ? c : mine; }
        if (sum == G) break;
        __builtin_amdgcn_s_sleep(1);
        if ((++sp & 255u) == 0u) { if (xb_ld(&bar[XB_TMO])) break; if (sp > XB_SPIN_CAP) { atomicAdd(&bar[XB_TMO], 1u); break; } }
    }
    nloc = mine > 0u ? mine : 1u; nx = cnt > 0u ? cnt : 1u;
}
__device__ __forceinline__ void xcd_barrier(const XcdBarrier& b) {
    asm volatile("s_waitcnt vmcnt(0)" ::: "memory");
    __syncthreads();
    if (threadIdx.x == 0) {
        unsigned* bar = b.bar; asm volatile("" : "+s"(bar));
        __builtin_amdgcn_s_waitcnt(0);
        unsigned nloc = b.st[0], nx = b.st[1];
        if (nloc == 0u) { xcd_barrier_complete(bar, b.x, nloc, nx); b.st[0] = nloc; b.st[1] = nx; }
        const unsigned old = xb_add(&bar[XB_XSUB(b.x)], 1u);
        const unsigned gen = old / nloc;
        if (old + 1u == (gen + 1u) * nloc) {
            __builtin_amdgcn_fence(__ATOMIC_RELEASE, "agent");
            asm volatile("s_waitcnt vmcnt(0)" ::: "memory");
            const unsigned og = xb_add(&bar[XB_TOP], 1u);
            const unsigned tg = og / nx;
            if (og + 1u == (tg + 1u) * nx) xb_add(&bar[XB_TOPGEN], 1u);
            else XB_SPIN(xb_ld(&bar[XB_TOPGEN]) == tg, bar);
            __builtin_amdgcn_fence(__ATOMIC_ACQUIRE, "agent");
            xb_add(&bar[XB_XGEN(b.x)], 1u);
            asm volatile("s_waitcnt vmcnt(0)" ::: "memory");
        } else {
            XB_SPIN(xb_ld(&bar[XB_XGEN(b.x)]) == gen, bar);
            __builtin_amdgcn_fence(__ATOMIC_ACQUIRE, "agent");
            asm volatile("s_waitcnt vmcnt(0)" ::: "memory");
        }
    }
    __syncthreads();
}

struct MegaArgs {
    const float *x, *attn_norm, *w_in, *na_rpb, *q_norm, *w_uq, *kv_norm, *w_ukv, *swa_sink, *group_norm, *w_out, *ffn_norm, *w_router, *w_gate, *w_up, *w_down, *final_norm;
    float* out; unsigned char* ws;
    int ph_lo, ph_hi;
};

__device__ __forceinline__ void prep_item(int kind, const float* W, const float* W2, const float* kgain, bf16* Wt, int K, int Nsrc, int nblk, int item, LAS float* scr, int lane) {
    const int kb = item / nblk, nb = item % nblk, k0 = 64 * kb, n0 = 32 * nb, r = lane >> 3, q = lane & 7;
    float sc; int which; const int src4 = prep_map(kind, n0 + 4 * q, sc, which); const float* Wb = which ? W2 : W;
    float4 v[8];
#pragma unroll
    for (int i = 0; i < 8; ++i) v[i] = (src4 >= 0) ? *(const float4*)(Wb + (size_t)(k0 + 8 * i + r) * Nsrc + src4) : make_float4(0.f, 0.f, 0.f, 0.f);
#pragma unroll
    for (int i = 0; i < 8; ++i) { const float g = (kgain ? kgain[k0 + 8 * i + r] : 1.f) * sc; LAS float* d = scr + (8 * i + r) * 33 + 4 * q; d[0] = v[i].x * g; d[1] = v[i].y * g; d[2] = v[i].z * g; d[3] = v[i].w * g; }
    asm volatile("s_waitcnt lgkmcnt(0)" ::: "memory");
    const int c = lane & 7;
#pragma unroll
    for (int j = 0; j < 4; ++j) { const int n = (lane >> 3) + 8 * j; const LAS float* s = scr + (8 * c) * 33 + n;
        uint4 o; o.x = f2bf(s[0]) | (f2bf(s[33]) << 16); o.y = f2bf(s[2 * 33]) | (f2bf(s[3 * 33]) << 16); o.z = f2bf(s[4 * 33]) | (f2bf(s[5 * 33]) << 16); o.w = f2bf(s[6 * 33]) | (f2bf(s[7 * 33]) << 16);
        *(uint4*)(Wt + (size_t)(n0 + n) * K + k0 + 8 * c) = o; }
    asm volatile("s_waitcnt lgkmcnt(0)" ::: "memory");
}
__device__ __forceinline__ void ph_prep(const MegaArgs& a, int l, int part, LAS unsigned char* lds, int gw, int ngw, int wave, int lane) {
    unsigned char* ws = a.ws; LAS float* scr = (LAS float*)(lds + wave * 8448);
    constexpr int I_WIN = 16 * 64, I_WUQ = 4 * 24, I_WUKV = 2 * 24, I_WOUT = 16 * 32, I_WGU1 = 16 * 64, I_WGU = NE * I_WGU1, I_WD1 = 16 * 32, I_WD = NE * I_WD1;
    constexpr int NITEMS = I_WIN + I_WUQ + I_WUKV + I_WOUT + I_WGU + I_WD;
    const int it0 = part == 0 ? 0 : I_WGU + I_WD, it1 = part == 0 ? I_WGU + I_WD : NITEMS;
    for (int it = it0 + gw; it < it1; it += ngw) { int r = it;
        if (r < I_WGU) { const int e = r / I_WGU1; prep_item(PK_WGU, a.w_gate + ((size_t)l * NE + e) * DM * DM, a.w_up + ((size_t)l * NE + e) * DM * DM, a.ffn_norm + l * DM, (bf16*)(ws + WS_WGU) + (size_t)e * 2048 * DM, DM, DM, 64, r % I_WGU1, scr, lane); continue; } r -= I_WGU;
        if (r < I_WD) { const int e = r / I_WD1; prep_item(PK_WD, a.w_down + ((size_t)l * NE + e) * DM * DM, nullptr, nullptr, (bf16*)(ws + WS_WD) + (size_t)e * DM * DM, DM, DM, 32, r % I_WD1, scr, lane); continue; } r -= I_WD;
        if (r < I_WIN) { prep_item(PK_WIN, a.w_in + (size_t)l * DM * C_END, nullptr, a.attn_norm + l * DM, (bf16*)(ws + WS_WIN), DM, C_END, 64, r, scr, lane); continue; } r -= I_WIN;
        if (r < I_WOUT) { prep_item(PK_WOUT, a.w_out + (size_t)l * DM * DM, nullptr, a.group_norm + l * DM, (bf16*)(ws + WS_WOUT), DM, DM, 32, r, scr, lane); continue; } r -= I_WOUT;
        if (r < I_WUQ) { prep_item(PK_WUQ, a.w_uq + (size_t)l * 256 * 576, nullptr, a.q_norm + l * 256, (bf16*)(ws + WS_WUQ), 256, 576, 24, r, scr, lane); continue; } r -= I_WUQ;
        prep_item(PK_WUKV, a.w_ukv + (size_t)l * 128 * 768, nullptr, a.kv_norm + l * 128, (bf16*)(ws + WS_WUKV), 128, 768, 24, r, scr, lane);
    }
}
__device__ __forceinline__ void row_store_bf16(const float4 (&v)[4], bf16* orow, float* rstd_out, int lane) {
    float s = 0.f;
#pragma unroll
    for (int j = 0; j < 4; ++j) s += v[j].x * v[j].x + v[j].y * v[j].y + v[j].z * v[j].z + v[j].w * v[j].w;
    const float rstd = rsqrtf(wave_sum(s) * (1.f / DM) + EPS);
    uint2* o = (uint2*)orow + lane;
#pragma unroll
    for (int j = 0; j < 4; ++j) o[64 * j] = make_uint2(f2bf(v[j].x) | (f2bf(v[j].y) << 16), f2bf(v[j].z) | (f2bf(v[j].w) << 16));
    if (lane == 0) *rstd_out = rstd;
}
__device__ __forceinline__ void ph_norm_x(const MegaArgs& a, int gw, int ngw, int lane) {
    bf16* HB = (bf16*)(a.ws + WS_HB); float* R1 = (float*)(a.ws + WS_RSTD1);
    for (int row = gw; row < NT; row += ngw) { const float4* hr = (const float4*)(a.x + (size_t)row * DM) + lane; float4 v[4];
#pragma unroll
        for (int j = 0; j < 4; ++j) v[j] = hr[64 * j];
        row_store_bf16(v, HB + (size_t)row * DM, R1 + row, lane); }
}
__device__ __forceinline__ void ld_row_bf16(const bf16* row, float4 (&v)[4], int lane) {
    const uint2* p = (const uint2*)row + lane;
#pragma unroll
    for (int j = 0; j < 4; ++j) { const uint2 w = p[64 * j]; v[j] = make_float4(bf2f(w.x & 0xffff), bf2f(w.x >> 16), bf2f(w.y & 0xffff), bf2f(w.y >> 16)); }
}
__device__ __forceinline__ void ph_router(const MegaArgs& a, int l, LAS unsigned char* lds, int gw, int ngw, int lane) {
    LAS float* wl = (LAS float*)lds; const float* wr = a.w_router + (size_t)l * DM * NE; const float* g = a.ffn_norm + l * DM;
    for (int i = threadIdx.x; i < DM * NE; i += NWAVES * 64) wl[(i & 15) * DM + (i >> 4)] = wr[i] * g[i >> 4];
    __syncthreads();
    const bf16* HB = (const bf16*)(a.ws + WS_HB); float* AFF = (float*)(a.ws + WS_AFF); float* R2 = (float*)(a.ws + WS_RSTD2);
    for (int row = gw; row < NT; row += ngw) {
        asm volatile("" ::: "memory");
        float4 v[4]; ld_row_bf16(HB + (size_t)row * DM, v, lane); float s = 0.f;
#pragma unroll
        for (int j = 0; j < 4; ++j) s += v[j].x * v[j].x + v[j].y * v[j].y + v[j].z * v[j].z + v[j].w * v[j].w;
        const float rstd = rsqrtf(wave_sum(s) * (1.f / DM) + EPS);
        float lg[16];
#pragma unroll
        for (int e = 0; e < 16; ++e) lg[e] = 0.f;
#pragma unroll
        for (int j = 0; j < 4; ++j) {
#pragma unroll
            for (int e = 0; e < 16; ++e) { const pg8::f32x4 w = *(const LAS pg8::f32x4*)(wl + e * DM + 4 * lane + 256 * j); lg[e] += v[j].x * w[0] + v[j].y * w[1] + v[j].z * w[2] + v[j].w * w[3]; } }
        float mx = -1e30f;
#pragma unroll
        for (int e = 0; e < 16; ++e) { lg[e] = wave_sum(lg[e]) * rstd; mx = fmaxf(mx, lg[e]); }
        float den = 0.f;
#pragma unroll
        for (int e = 0; e < 16; ++e) { lg[e] = __expf(lg[e] - mx); den += lg[e]; }
        const int b = row / NS, sidx = row % NS;
        if (lane < 16) { float val = 0.f;
#pragma unroll
            for (int e = 0; e < 16; ++e) if (lane == e) val = lg[e];
            AFF[((size_t)b * NE + lane) * NS + sidx] = val / den; }
        if (lane == 0) R2[row] = rstd;
    }
    __syncthreads();
}
__device__ __forceinline__ void ph_topk(unsigned char* ws, LAS unsigned char* lds, int bx, int G) {
    LAS unsigned* hist = (LAS unsigned*)lds;
    LAS unsigned* sh = hist + 256;
    LAS unsigned* wcnt = hist + 512;
    const int tid = threadIdx.x, lane = tid & 63, wave = tid >> 6;
    const float* AFF = (const float*)(ws + WS_AFF); int* INV = (int*)(ws + WS_INV); int* IDX = (int*)(ws + WS_IDX); float* GATE = (float*)(ws + WS_GATE);
    for (int be = bx; be < NB * NE; be += G) {
        const int b = be / NE, e = be % NE; const float* src = AFF + (size_t)be * NS;
        unsigned u[8];
#pragma unroll
        for (int i = 0; i < 8; ++i) u[i] = __float_as_uint(src[tid * 8 + i]);
        unsigned prefix = 0u, krem = CAP;
#pragma unroll 1
        for (int pass = 0; pass < 4; ++pass) { const int shift = 24 - 8 * pass; const unsigned pmask = pass == 0 ? 0u : (0xffffffffu << (shift + 8));
            if (tid < 256) hist[tid] = 0u;
            __syncthreads();
#pragma unroll
            for (int i = 0; i < 8; ++i) if ((u[i] & pmask) == prefix) __hip_atomic_fetch_add(&hist[(u[i] >> shift) & 255u], 1u, __ATOMIC_RELAXED, __HIP_MEMORY_SCOPE_WORKGROUP);
            __syncthreads();
            if (wave == 0) {
                unsigned c4[4]; unsigned tot = 0u;
#pragma unroll
                for (int i = 0; i < 4; ++i) { c4[i] = hist[255 - (lane * 4 + i)]; tot += c4[i]; }
                unsigned inc = tot;
#pragma unroll
                for (int o = 1; o < 64; o <<= 1) { const unsigned t = __shfl_up(inc, o); if (lane >= o) inc += t; }
                const unsigned before = inc - tot;
                if (before < krem && inc >= krem) { unsigned acc = before;
#pragma unroll
                    for (int i = 0; i < 4; ++i) { if (acc < krem && acc + c4[i] >= krem) { sh[0] = prefix | ((unsigned)(255 - (lane * 4 + i)) << shift); sh[1] = krem - acc; } acc += c4[i]; } }
            }
            __syncthreads();
            prefix = sh[0]; krem = sh[1];
            __syncthreads();
        }
        unsigned ngt = 0u, neq = 0u;
#pragma unroll
        for (int i = 0; i < 8; ++i) { ngt += (u[i] > prefix) ? 1u : 0u; neq += (u[i] == prefix) ? 1u : 0u; }
        unsigned ig = ngt, iq = neq;
#pragma unroll
        for (int o = 1; o < 64; o <<= 1) { const unsigned tg = __shfl_up(ig, o), tq = __shfl_up(iq, o); if (lane >= o) { ig += tg; iq += tq; } }
        if (lane == 63) { wcnt[wave * 2] = ig; wcnt[wave * 2 + 1] = iq; }
        __syncthreads();
        unsigned bg = 0u, bq = 0u;
        for (int w = 0; w < wave; ++w) { bg += wcnt[w * 2]; bq += wcnt[w * 2 + 1]; }
        unsigned pg = bg + ig - ngt, pq = bq + iq - neq;
#pragma unroll
        for (int i = 0; i < 8; ++i) { const int idx = tid * 8 + i; int slot = -1;
            if (u[i] > prefix) { slot = (int)(pg + min(pq, krem)); ++pg; }
            else if (u[i] == prefix) { if (pq < krem) slot = (int)(pg + pq); ++pq; }
            INV[(size_t)be * NS + idx] = slot;
            if (slot >= 0) { IDX[e * (NB * CAP) + b * CAP + slot] = b * NS + idx; GATE[(size_t)e * (NB * CAP) + b * CAP + slot] = __uint_as_float(u[i]); } }
        __syncthreads();
    }
}
__device__ __forceinline__ void ph_combine(const MegaArgs& a, int l, int gw, int ngw, int lane) {
    const bf16* Y = (const bf16*)(a.ws + WS_PROJ); const int* INV = (const int*)(a.ws + WS_INV); bf16* HB = (bf16*)(a.ws + WS_HB); float* R1 = (float*)(a.ws + WS_RSTD1); const bool last = (l == DEPTH - 1);
    for (int row = gw; row < NT; row += ngw) { const int b = row / NS, s = row % NS;
        float4 v[4]; ld_row_bf16(HB + (size_t)row * DM, v, lane);
        int slot_l = -1; if (lane < NE) slot_l = INV[((size_t)b * NE + lane) * NS + s];
        unsigned long long msk = __ballot(slot_l >= 0);
        while (msk) { const int e = __builtin_ctzll(msk); msk &= msk - 1; const int slot = __shfl(slot_l, e);
            const uint2* y = (const uint2*)(Y + ((size_t)e * (NB * CAP) + b * CAP + slot) * DM) + lane;
#pragma unroll
            for (int j = 0; j < 4; ++j) { const uint2 w = y[64 * j]; v[j].x += bf2f(w.x & 0xffff); v[j].y += bf2f(w.x >> 16); v[j].z += bf2f(w.y & 0xffff); v[j].w += bf2f(w.y >> 16); } }
        if (last) { float ssum = 0.f;
#pragma unroll
            for (int j = 0; j < 4; ++j) ssum += v[j].x * v[j].x + v[j].y * v[j].y + v[j].z * v[j].z + v[j].w * v[j].w;
            const float rstd = rsqrtf(wave_sum(ssum) * (1.f / DM) + EPS); float4* orow = (float4*)(a.out + (size_t)row * DM) + lane;
#pragma unroll
            for (int j = 0; j < 4; ++j) { const float4 gg = ((const float4*)a.final_norm)[lane + 64 * j]; orow[64 * j] = make_float4(v[j].x * rstd * gg.x, v[j].y * rstd * gg.y, v[j].z * rstd * gg.z, v[j].w * rstd * gg.w); } }
        else row_store_bf16(v, HB + (size_t)row * DM, R1 + row, lane);
    }
}

enum { PL_PROJ = 0, PL_MLAUP, PL_ATTN, PL_OUT, PL_ROUTER, PL_TOPK, PL_MOE1, PL_MOE2, PL_COMBINE, PL_COUNT };
constexpr int N_PHASES = 1 + DEPTH * PL_COUNT;
constexpr int REP_PH = -1;
#define REPEAT(ph) for (int rep_ = 0; rep_ < (REP_PH == (ph) ? 2 : 1); ++rep_)
#define IN(k) (lo <= (k) && (k) < hi)
#define SEAM(k) do { if (IN((k) + 1)) xcd_barrier(bar); } while (0)
#define PH_LOCALS unsigned char* ws = a.ws; asm volatile("" : "+s"(ws)); int t_ = threadIdx.x; asm volatile("" : "+v"(t_)); int bx = blockIdx.x; asm volatile("" : "+s"(bx)); \
    const int vcu = (bx % 8) * (G / 8) + bx / 8; const int lane = t_ & 63, wave = __builtin_amdgcn_readfirstlane(t_ >> 6), gw = vcu * NWAVES + wave; (void)lane; (void)gw; (void)ws; (void)vcu;
template <int l> __device__ __forceinline__ void layer_phases(const MegaArgs& a, LAS unsigned char* lds, const XcdBarrier& bar, const int lo, const int hi) {
    constexpr int G = 256, ngw = G * NWAVES, pb = 1 + l * PL_COUNT;
        if (IN(pb + PL_PROJ)) { PH_LOCALS
            pg8::StaticOrder S; S.init(NT / 256, NP / 256, G, bx, 0);
            LAS float* rst = (LAS float*)(lds + TAB_OFF);
            { pg8::Unit u; const float* R1 = (const float*)(ws + WS_RSTD1);
              for (int i = 0; i < 4 && S.next(i, u); ++i) if (t_ < 256) rst[i * 256 + t_] = R1[u.pm * 256 + t_]; }
            __syncthreads();
            REPEAT(PL_PROJ) {
            pg8::Gemm g{(bf16*)(ws + WS_HB), (bf16*)(ws + WS_WIN), DM, DM, DM, nullptr};
            pg8::EpiProj E{(bf16*)(ws + WS_PROJ), (float*)(ws + WS_CQSS), (float*)(ws + WS_CKVSS), rst};
            pg8::gemm_phase<pg8::EpiProj, pg8::StaticOrder, true>(lds, g, S, E); }
            SEAM(pb + PL_PROJ);
        }
        if (IN(pb + PL_MLAUP)) { PH_LOCALS REPEAT(PL_MLAUP) {
            LAS float* rst = (LAS float*)(lds + TAB_OFF);
            { pg8::StaticOrder S; S.init(NT / 256, 3, G, bx, 0); pg8::Unit u; const float* SSQ = (const float*)(ws + WS_CQSS);
              for (int i = 0; i < 2 && S.next(i, u); ++i) if (t_ < 256) { const float4 p = *(const float4*)(SSQ + (size_t)(u.pm * 256 + t_) * 4); rst[i * 256 + t_] = rsqrtf((p.x + p.y + p.z + p.w) * (1.f / 256.f) + EPS); }
              __syncthreads();
              pg8::Gemm g{(bf16*)(ws + WS_PROJ) + C_CQ, (bf16*)(ws + WS_WUQ), 256, NP, 256, nullptr};
              typedef pg8::EpiMla<true, 576, 576> EQ; EQ E{(bf16*)(ws + WS_QB), rst};
              pg8::gemm_phase<EQ, pg8::StaticOrder, true>(lds, g, S, E); }
            __syncthreads();
            { pg8::StaticOrder S; S.init(NT / 256, 3, G, bx, 0); pg8::Unit u; const float* SSQ = (const float*)(ws + WS_CKVSS);
              for (int i = 0; i < 2 && S.next(i, u); ++i) if (t_ < 256) { const float4 p = *(const float4*)(SSQ + (size_t)(u.pm * 256 + t_) * 4); rst[i * 256 + t_] = rsqrtf((p.x + p.y + p.z + p.w) * (1.f / 128.f) + EPS); }
              __syncthreads();
              pg8::Gemm g{(bf16*)(ws + WS_PROJ) + C_CKV, (bf16*)(ws + WS_WUKV), 128, NP, 128, nullptr};
              typedef pg8::EpiMla<false, 768, 768> EK; EK E{(bf16*)(ws + WS_KV), rst};
              pg8::gemm_phase<EK, pg8::StaticOrder, true>(lds, g, S, E); } }
            SEAM(pb + PL_MLAUP);
        }
        if (IN(pb + PL_ATTN)) { PH_LOCALS
            REPEAT(PL_ATTN) { const att::AttnP P{(bf16*)(ws + WS_PROJ), (bf16*)(ws + WS_QB), (bf16*)(ws + WS_KV), (bf16*)(ws + WS_XN), (float*)(ws + WS_SS), a.na_rpb + (size_t)l * 4 * 15 * 31, a.swa_sink + l * 6}; att::attn_phase(P, lds, vcu); }
            SEAM(pb + PL_ATTN);
        }
        if (IN(pb + PL_OUT)) { PH_LOCALS
            pg8::StaticOrder S; S.init(NT / 256, DM / 256, G, bx, 0);
            LAS float* fac = (LAS float*)(lds + TAB_OFF);
            { pg8::Unit u; const float* SS = (const float*)(ws + WS_SS);
              for (int i = 0; i < 2 && S.next(i, u); ++i) if (t_ < 256) { const float4* ss4 = (const float4*)(SS + (size_t)(u.pm * 256 + t_) * 16); const float4 s0 = ss4[0], s1 = ss4[1], s2 = ss4[2], s3 = ss4[3];
                  const float ra = rsqrtf((s0.x + s0.y + s0.z + s0.w) * (1.f / 256.f) + EPS), rb = rsqrtf((s1.x + s1.y + s1.z + s1.w + s2.x + s2.y) * (1.f / 384.f) + EPS), rc = rsqrtf((s2.z + s2.w + s3.x + s3.y + s3.z + s3.w) * (1.f / 384.f) + EPS);
                  LAS float* f = fac + (i * 256 + t_) * 4; f[0] = ra / rb; f[1] = rb / rc; f[2] = rc; f[3] = 0.f; } }
            __syncthreads();
            pg8::Gemm g{(bf16*)(ws + WS_XN), (bf16*)(ws + WS_WOUT), DM, DM, DM, nullptr};
            pg8::EpiResid E{(bf16*)(ws + WS_HB), fac};
            pg8::gemm_phase<pg8::EpiResid, pg8::StaticOrder, true>(lds, g, S, E);
            SEAM(pb + PL_OUT);
        }
        if (IN(pb + PL_ROUTER)) { PH_LOCALS REPEAT(PL_ROUTER) ph_router(a, l, lds, gw, ngw, lane); SEAM(pb + PL_ROUTER); }
        if (IN(pb + PL_TOPK)) { PH_LOCALS ph_topk(ws, lds, bx, G); __syncthreads(); REPEAT(100) ph_prep(a, l, 0, lds, gw, ngw, wave, lane); SEAM(pb + PL_TOPK); }
        if (IN(pb + PL_MOE1)) { PH_LOCALS
            pg8::StaticOrder S; S.init(NSLOTS / 256, 8, G, bx, 16);
            LAS int* gidx = (LAS int*)(lds + TAB_OFF);
            LAS float* rst = (LAS float*)(lds + TAB_OFF + 8192);
            { pg8::Unit u; const int* IDX = (const int*)(ws + WS_IDX); const float* R2 = (const float*)(ws + WS_RSTD2);
              for (int i = 0; i < 8 && S.next(i, u); ++i) if (t_ < 256) { const int tok = IDX[u.pm * 256 + t_]; gidx[i * 256 + t_] = tok; rst[i * 256 + t_] = R2[tok]; } }
            __syncthreads();
            REPEAT(PL_MOE1) {
            pg8::Gemm g{(bf16*)(ws + WS_HB), (bf16*)(ws + WS_WGU), DM, DM, DM, gidx};
            pg8::EpiSwiglu E{(bf16*)(ws + WS_HID), rst};
            pg8::gemm_phase<pg8::EpiSwiglu, pg8::StaticOrder, true, true>(lds, g, S, E); }
            SEAM(pb + PL_MOE1);
        }
        if (IN(pb + PL_MOE2)) { PH_LOCALS
            pg8::StaticOrder S; S.init(NSLOTS / 256, 4, G, bx, 16); S.rev = 1;
            LAS float* gtab = (LAS float*)(lds + TAB_OFF);
            { pg8::Unit u; const float* GATE = (const float*)(ws + WS_GATE);
              for (int i = 0; i < 4 && S.next(i, u); ++i) if (t_ < 256) gtab[i * 256 + t_] = GATE[u.pm * 256 + t_]; }
            __syncthreads();
            REPEAT(PL_MOE2) {
            pg8::Gemm g{(bf16*)(ws + WS_HID), (bf16*)(ws + WS_WD), DM, DM, DM, nullptr};
            pg8::EpiGate E{(bf16*)(ws + WS_PROJ), gtab};
            pg8::gemm_phase<pg8::EpiGate, pg8::StaticOrder, true>(lds, g, S, E); }
            SEAM(pb + PL_MOE2);
        }
        if (IN(pb + PL_COMBINE)) { PH_LOCALS
            ph_combine(a, l, gw, ngw, lane);
            if (l + 1 < DEPTH) { __syncthreads(); ph_prep(a, l + 1, 1, lds, gw, ngw, wave, lane); }
            SEAM(pb + PL_COMBINE);
        }
}
__global__ void __launch_bounds__(NWAVES * 64, 2) mega(MegaArgs a) {
    extern __shared__ __attribute__((aligned(16))) unsigned char lds_raw[];
    LAS unsigned char* lds = (LAS unsigned char*)lds_raw;
    constexpr int G = 256;
    constexpr int ngw = G * NWAVES;
    for (int u = threadIdx.x; u < (LDS_BYTES - RING_BYTES) / 4; u += NWAVES * 64) ((LAS unsigned*)(lds + RING_BYTES))[u] = 0u;
    __syncthreads();
    XcdBarrier bar = xcd_barrier_post((unsigned*)(a.ws + WS_CTL) + CW_BAR, (volatile LAS unsigned*)(lds + MISC_OFF) + 8);
    const int lo = a.ph_lo, hi = a.ph_hi;
    if (IN(0)) { PH_LOCALS ph_prep(a, 0, 1, lds, gw, ngw, wave, lane); ph_norm_x(a, gw, ngw, lane); SEAM(0); }
    layer_phases<0>(a, lds, bar, lo, hi);
    layer_phases<1>(a, lds, bar, lo, hi);
    static_assert(DEPTH == 2, "two layers are written out");
}


#ifndef MK_PER_PHASE
#define MK_PER_PHASE 0
#endif
extern "C" void kernel_launch(void* const* d_in, const int* in_sizes, int n_in, void* d_out, int out_size, void* d_ws, size_t ws_size, hipStream_t stream) {
    if (n_in != 17 || out_size != NT * DM || ws_size < WS_END) { fprintf(stderr, "kernel_launch: unexpected shapes (n_in %d out %d ws %zu)\n", n_in, out_size, ws_size); return; }
    static int grid = 0;
    if (grid == 0) { int dev = 0, cus = 0; (void)hipGetDevice(&dev); (void)hipDeviceGetAttribute(&cus, hipDeviceAttributeMultiprocessorCount, dev);
        if (hipFuncSetAttribute((const void*)mega, hipFuncAttributeMaxDynamicSharedMemorySize, LDS_BYTES) != hipSuccess) fprintf(stderr, "hipFuncSetAttribute failed\n");
        if (cus != 256) fprintf(stderr, "kernel_launch: built for a 256-CU device (got %d CUs)\n", cus);
        grid = 256; }
    (void)hipMemsetAsync((char*)d_ws + WS_CTL, 0, 1 * MiB, stream);
    MegaArgs ma{};
    ma.x = (const float*)d_in[0]; ma.attn_norm = (const float*)d_in[1]; ma.w_in = (const float*)d_in[2]; ma.na_rpb = (const float*)d_in[3]; ma.q_norm = (const float*)d_in[4]; ma.w_uq = (const float*)d_in[5];
    ma.kv_norm = (const float*)d_in[6]; ma.w_ukv = (const float*)d_in[7]; ma.swa_sink = (const float*)d_in[8]; ma.group_norm = (const float*)d_in[9]; ma.w_out = (const float*)d_in[10]; ma.ffn_norm = (const float*)d_in[11];
    ma.w_router = (const float*)d_in[12]; ma.w_gate = (const float*)d_in[13]; ma.w_up = (const float*)d_in[14]; ma.w_down = (const float*)d_in[15]; ma.final_norm = (const float*)d_in[16];
    ma.out = (float*)d_out; ma.ws = (unsigned char*)d_ws;
#if MK_PER_PHASE
    for (int p = 0; p < N_PHASES; ++p) { ma.ph_lo = p; ma.ph_hi = p + 1; hipLaunchKernelGGL(mega, dim3(grid), dim3(NWAVES * 64), LDS_BYTES, stream, ma); }
#else
    ma.ph_lo = 0; ma.ph_hi = N_PHASES; hipLaunchKernelGGL(mega, dim3(grid), dim3(NWAVES * 64), LDS_BYTES, stream, ma);
#endif
}
```

```cpp
#include <hip/hip_runtime.h>
#include <cstdint>
#include <cstdio>

typedef unsigned short bf16;
constexpr int NB = 8, NS = 4096, DM = 1024, NT = NB * NS, NP = 2048, NE = 16, CAP = 512, DEPTH = 2;
constexpr int NSLOTS = NE * NB * CAP;
constexpr float LOG2E = 1.4426950408889634f;
constexpr float QS64 = 0.125f * LOG2E;
constexpr float QS96 = 0.10206207261596577f * LOG2E;
constexpr float EPS = 1e-6f;
constexpr int C_AQ = 0, C_AK = 256, C_AV = 512, C_CQ = 768, C_CKV = 1024, C_KR = 1152, C_SQ = 1184, C_SK = 1568, C_SV = 1696, C_END = 1824;

constexpr size_t MiB = 1u << 20;
constexpr size_t WS_CTL = 0;
constexpr size_t WS_COS64 = 1 * MiB, WS_SIN64 = WS_COS64 + 512 * 1024, WS_COS32 = 2 * MiB, WS_SIN32 = WS_COS32 + 256 * 1024;
constexpr size_t WS_WIN = 4 * MiB, WS_WUQ = 8 * MiB, WS_WUKV = 8 * MiB + 512 * 1024, WS_WOUT = 9 * MiB, WS_WGU = 12 * MiB, WS_WD = 76 * MiB;
constexpr size_t WS_CQSS = 108 * MiB, WS_CKVSS = WS_CQSS + 512 * 1024, WS_SS = 109 * MiB, WS_AFF = 111 * MiB, WS_INV = 113 * MiB, WS_IDX = 115 * MiB, WS_GATE = WS_IDX + 256 * 1024;
constexpr size_t WS_XN = 120 * MiB;
constexpr size_t WS_PROJ = 184 * MiB;
constexpr size_t WS_QB = 312 * MiB;
constexpr size_t WS_KV = 348 * MiB;
constexpr size_t WS_HID = 312 * MiB;
constexpr size_t WS_HB = 440 * MiB;
constexpr size_t WS_RSTD1 = 504 * MiB, WS_RSTD2 = WS_RSTD1 + 256 * 1024;
constexpr size_t WS_END = 505 * MiB;

__device__ __forceinline__ unsigned f2bf(float f) { unsigned u = __builtin_bit_cast(unsigned, f); return (u + 0x7fffu + ((u >> 16) & 1u)) >> 16; }
__device__ __forceinline__ float bf2f(unsigned short b) { return __builtin_bit_cast(float, (unsigned)b << 16); }
__device__ __forceinline__ float wave_sum(float v) {
#pragma unroll
    for (int o = 1; o < 64; o <<= 1) v += __shfl_xor(v, o);
    return v;
}

enum { PK_WIN = 0, PK_WUQ = 1, PK_WUKV = 2, PK_WOUT = 3, PK_WGU = 4, PK_WD = 5 };
__device__ __forceinline__ int prep_map(int kind, int n, float& sc, int& which) {
    sc = 1.f; which = 0;
    switch (kind) {
    case PK_WIN:
        if (n < 256) { sc = QS64; return n; }
        if (n < C_KR) return n;
        if (n < C_SQ) { const int p = n - C_KR, g = p >> 3, e = p & 7; return C_KR + 4 * g + (e & 3) + 16 * (e >> 2); }
        if (n < C_SK) { const int p = n - C_SQ, h = p >> 6, pp = p & 63, g = pp >> 3, e = pp & 7; sc = QS64; return C_SQ + h * 64 + 4 * g + (e & 3) + 32 * (e >> 2); }
        if (n < C_SV) { const int p = n - C_SK, h = p >> 6, pp = p & 63, g = pp >> 3, e = pp & 7; return C_SK + h * 64 + 4 * g + (e & 3) + 32 * (e >> 2); }
        if (n < C_END) return n;
        return -1;
    case PK_WUQ:
        if (n < 576) { const int h = n / 96, d = n % 96; sc = QS96; if (d < 64) return n; const int p = d - 64, g = p >> 3, e = p & 7; return h * 96 + 64 + 4 * g + (e & 3) + 16 * (e >> 2); }
        return -1;
    case PK_WUKV:
        if (n < 384) { const int h = n >> 6, d = n & 63; return h * 128 + d; }
        { const int m = n - 384, h = m >> 6, d = m & 63; return h * 128 + 64 + d; }
    case PK_WGU: { const int pn = n >> 8, half = (n >> 7) & 1, jj = n & 127; which = half; return 128 * pn + jj; }
    default: return n;
    }
}
#define LAS __attribute__((address_space(3)))
#define GAS __attribute__((address_space(1)))
namespace pg8 {
typedef short bf16x8 __attribute__((ext_vector_type(8)));
typedef float f32x4 __attribute__((ext_vector_type(4)));
typedef unsigned u32x4 __attribute__((ext_vector_type(4)));
constexpr int BM = 256, BK = 64, HALF = 128, HTB = HALF * BK * 2, STAGE_BYTES = 8 * HTB, NXCD = 8, WGM = 8;
__host__ __device__ __forceinline__ int lds_byte(int r, int c) { const int st = (r >> 4) * 2 + (c >> 5), rr = r & 15, cc = c & 31, ob = rr * 64 + cc * 2; return st * 1024 + (ob ^ (((ob >> 9) & 1) << 5)); }
__host__ __device__ __forceinline__ void stage_rc(int b, int& R, int& C) { const int st = b / 1024, sb = b % 1024, swz = sb ^ (((sb >> 9) & 1) << 5); R = (st >> 1) * 16 + swz / 64; C = (st & 1) * 32 + (swz % 64) / 2; }
__host__ __device__ __forceinline__ int perm32(int rho) { const int n = rho >> 4, i = rho & 15; return 8 * (i >> 2) + 4 * n + (i & 3); }
struct Unit { int pm, pn, pb; };
struct Gemm { const bf16* A; const bf16* Bt; int K, lda, ldb; const LAS int* gidx; };
struct StaticOrder {
    int nM, nN, nwg, G, c, gm, rev = 0;
    __device__ __forceinline__ void init(int nM_, int nN_, int G_, int c_, int gm_) { nM = nM_; nN = nN_; nwg = nM * nN; G = G_; c = c_; gm = gm_; }
    __device__ __forceinline__ bool next(int i, Unit& u) const {
        const long L = (long)i * G + c; if (L >= nwg) return false;
        int wgid = (int)L; { const int q = nwg / NXCD, r = nwg % NXCD, xcd = wgid % NXCD, off = wgid / NXCD; wgid = (xcd < r ? xcd * (q + 1) : r * (q + 1) + (xcd - r) * q) + off; }
        const int nig = WGM * nN, gid = wgid / nig, fm = gid * WGM, gsz = (nM - fm) < WGM ? (nM - fm) : WGM;
        u.pm = fm + ((wgid % nig) % gsz); if (rev) u.pm = nM - 1 - u.pm; u.pn = (wgid % nig) / gsz; u.pb = gm ? (u.pm / gm) * nN + u.pn : u.pn; return true;
    }
};
__device__ __forceinline__ unsigned cvt_pk_bf16(float lo, float hi) { unsigned r; asm volatile("v_cvt_pk_bf16_f32 %0, %1, %2" : "=v"(r) : "v"(lo), "v"(hi)); return r; }

template <class Epi, class Sched, bool ALIGN_EPI, bool GATHER = false>
__device__ __forceinline__ void gemm_phase(LAS unsigned char* lds, const Gemm g, const Sched& S, const Epi& E) {
    int tid = threadIdx.x; asm volatile("" : "+v"(tid));
    const int wid = __builtin_amdgcn_readfirstlane(tid >> 6), lane = tid & 63, wr = wid >> 2, wc = wid & 3, fr = lane & 15, fq = lane >> 4;
    const int K = g.K, nt = K / BK;
    unsigned vC[2][2], vNs[2][2], voffB[2]; int RA[2], CA[2];
    const size_t kstep = (size_t)(BK * 2);
    const size_t hstepA = (size_t)HALF * g.lda * 2, hstepB = (size_t)HALF * g.ldb * 2, tstepA = GATHER ? 0 : 2 * hstepA, tstepB = 2 * hstepB;
#pragma unroll
    for (int i = 0; i < 2; ++i) { int R, C; stage_rc(tid * 16 + i * 8192, R, C); const int Rb = Epi::PERM ? ((R & ~31) + perm32(R & 31)) : R; RA[i] = R; CA[i] = C;
        voffB[i] = (unsigned)(Rb * g.ldb + C) * 2u;
#pragma unroll
        for (int h = 0; h < 2; ++h) { vC[h][i] = GATHER ? ((unsigned)g.gidx[h * HALF + R] * (unsigned)(g.lda * 2) + (unsigned)C * 2u) : ((unsigned)(R * g.lda + C) * 2u + (unsigned)(h * hstepA)); vNs[h][i] = vC[h][i]; } }
    unsigned (&vN)[2][2] = GATHER ? vNs : vC;
    const unsigned ldsw = (unsigned)wid * 1024u;
    const int aoff = lds_byte(wr * 64 + fr, fq * 8), boff = lds_byte(wc * 32 + fr, fq * 8);
#define PG8_SA(b, h) (((b) * 2 + (h)) * HTB)
#define PG8_SB(b, h) ((4 + (b) * 2 + (h)) * HTB)
#define PG8_STAGE(bufoff, gbase, voff) do { _Pragma("unroll") for (int _i = 0; _i < 2; ++_i) \
        __builtin_amdgcn_global_load_lds((const unsigned*)((const char*)(gbase) + (voff)[_i]), (LAS unsigned*)(lds + (bufoff) + ldsw + _i * 8192), 16, 0, 0); } while (0)
#define PG8_STAGEA(bufoff, gbase, V, h) do { _Pragma("unroll") for (int _i = 0; _i < 2; ++_i) \
        __builtin_amdgcn_global_load_lds((const unsigned*)((const char*)(gbase) + (V)[h][_i]), (LAS unsigned*)(lds + (bufoff) + ldsw + _i * 8192), 16, 0, 0); } while (0)
#define PG8_STAGEAL(bufoff, gbase, h) do { _Pragma("unroll") for (int _i = 0; _i < 2; ++_i) { const unsigned _v = (GATHER && last) ? vN[h][_i] : vC[h][_i]; \
        __builtin_amdgcn_global_load_lds((const unsigned*)((const char*)(gbase) + _v), (LAS unsigned*)(lds + (bufoff) + ldsw + _i * 8192), 16, 0, 0); } } while (0)
#define PG8_LDA(dst, b, h) do { _Pragma("unroll") for (int m = 0; m < 4; ++m) _Pragma("unroll") for (int k = 0; k < 2; ++k) dst[m][k] = *(const LAS bf16x8*)(lds + PG8_SA(b, h) + aoff + m * 2048 + k * 1024); } while (0)
#define PG8_LDB(dst, b, h) do { _Pragma("unroll") for (int n = 0; n < 2; ++n) _Pragma("unroll") for (int k = 0; k < 2; ++k) dst[n][k] = *(const LAS bf16x8*)(lds + PG8_SB(b, h) + boff + n * 2048 + k * 1024); } while (0)
#define PG8_MMA(ai, bj, At, Bt) do { __builtin_amdgcn_s_setprio(1); _Pragma("unroll") for (int m = 0; m < 4; ++m) _Pragma("unroll") for (int n = 0; n < 2; ++n) _Pragma("unroll") for (int k = 0; k < 2; ++k) \
        acc[ai][bj][m][n] = __builtin_amdgcn_mfma_f32_16x16x32_bf16(Bt[n][k], At[m][k], acc[ai][bj][m][n], 0, 0, 0); __builtin_amdgcn_s_setprio(0); } while (0)
#define PG8_WAIT_V(n) asm volatile("s_waitcnt vmcnt(" #n ")" ::: "memory")
#define PG8_WAIT_L(n) asm volatile("s_waitcnt lgkmcnt(" #n ")" ::: "memory")
#define PG8_BAR __builtin_amdgcn_s_barrier()
#define PG8_SCHED __builtin_amdgcn_sched_barrier(0)
    Unit cur, nxt; int ui = 0;
    if (!S.next(0, cur)) return;
    f32x4 acc[2][2][4][2];
#pragma unroll
    for (int a = 0; a < 2; ++a)
#pragma unroll
        for (int b = 0; b < 2; ++b)
#pragma unroll
            for (int m = 0; m < 4; ++m)
#pragma unroll
                for (int n = 0; n < 2; ++n) acc[a][b][m][n] = (f32x4){0.f, 0.f, 0.f, 0.f};
    bf16x8 At[4][2], B0[2][2], B1[2][2];
    const char* cA = (const char*)g.A + (size_t)cur.pm * tstepA; const char* cB = (const char*)g.Bt + (size_t)cur.pb * tstepB;
    PG8_STAGE(PG8_SB(0, 0), cB, voffB); PG8_STAGE(PG8_SB(0, 1), cB + hstepB, voffB); PG8_STAGEA(PG8_SA(0, 0), cA, vC, 0); PG8_STAGEA(PG8_SA(0, 1), cA, vC, 1);
    if (wr == 1) PG8_BAR;
    PG8_WAIT_V(2); PG8_BAR;
    PG8_STAGE(PG8_SB(1, 0), cB + kstep, voffB); PG8_STAGEA(PG8_SA(1, 0), cA + kstep, vC, 0); PG8_STAGE(PG8_SB(1, 1), cB + hstepB + kstep, voffB);
    PG8_WAIT_V(6); PG8_BAR;
    for (;;) {
        const bool has_next = S.next(ui + 1, nxt);
        if (GATHER && has_next) {
#pragma unroll
            for (int i = 0; i < 2; ++i)
#pragma unroll
                for (int h = 0; h < 2; ++h) vNs[h][i] = (unsigned)g.gidx[(ui + 1) * BM + h * HALF + RA[i]] * (unsigned)(g.lda * 2) + (unsigned)CA[i] * 2u; }
        const char* nA = has_next ? (const char*)g.A + (size_t)nxt.pm * tstepA : cA; const char* nB = has_next ? (const char*)g.Bt + (size_t)nxt.pb * tstepB : cB;
        for (int t = 0; t < nt; t += 2) {
            const bool last = (t == nt - 2);
            const char* a1 = cA + (size_t)(t + 1) * kstep;
            const char* a2 = last ? nA : cA + (size_t)(t + 2) * kstep; const char* b2 = last ? nB : cB + (size_t)(t + 2) * kstep;
            const char* a3 = a2 + kstep; const char* b3 = b2 + kstep;
            PG8_LDB(B0, 0, 0); PG8_LDB(B1, 0, 1); PG8_SCHED; PG8_LDA(At, 0, 0); PG8_STAGEA(PG8_SA(1, 1), a1, vC, 1);
            PG8_WAIT_V(8); PG8_WAIT_L(0); PG8_BAR; PG8_MMA(0, 0, At, B0); PG8_MMA(0, 1, At, B1); PG8_BAR; PG8_SCHED;
            PG8_LDA(At, 0, 1); PG8_STAGE(PG8_SB(0, 0), b2, voffB); PG8_STAGE(PG8_SB(0, 1), b2 + hstepB, voffB); PG8_STAGEAL(PG8_SA(0, 0), a2, 0);
            PG8_WAIT_V(8); PG8_WAIT_L(0); PG8_BAR; PG8_MMA(1, 0, At, B0); PG8_MMA(1, 1, At, B1); PG8_BAR; PG8_SCHED;
            PG8_LDB(B0, 1, 0); PG8_LDB(B1, 1, 1); PG8_SCHED; PG8_LDA(At, 1, 0); PG8_STAGEAL(PG8_SA(0, 1), a2, 1);
            PG8_WAIT_V(8); PG8_WAIT_L(0); PG8_BAR; PG8_MMA(0, 0, At, B0); PG8_MMA(0, 1, At, B1); PG8_BAR; PG8_SCHED;
            PG8_LDA(At, 1, 1); PG8_STAGE(PG8_SB(1, 0), b3, voffB); PG8_STAGE(PG8_SB(1, 1), b3 + hstepB, voffB); PG8_STAGEAL(PG8_SA(1, 0), a3, 0);
            PG8_WAIT_V(8); PG8_WAIT_L(0); PG8_BAR; PG8_MMA(1, 0, At, B0); PG8_MMA(1, 1, At, B1); PG8_BAR; PG8_SCHED;
            if constexpr (Epi::KHOOK) { if (t == 2 || t == 8) { asm volatile("" ::: "memory"); E.khook(acc, ui, t == 2 ? 0 : 1, wr, fr); asm volatile("" ::: "memory"); } }
        }
        if constexpr (ALIGN_EPI) { if (wr == 0) PG8_BAR; }
        { int t2 = threadIdx.x; asm volatile("" : "+v"(t2)); E(acc, cur, wr, wc, t2 & 15, (t2 >> 4) & 3, ui); }
        if (!has_next) break;
#pragma unroll
        for (int a = 0; a < 2; ++a)
#pragma unroll
            for (int b = 0; b < 2; ++b)
#pragma unroll
                for (int m = 0; m < 4; ++m)
#pragma unroll
                    for (int n = 0; n < 2; ++n) acc[a][b][m][n] = (f32x4){0.f, 0.f, 0.f, 0.f};
        cur = nxt; cA = nA; cB = nB; ++ui;
        if (GATHER) {
#pragma unroll
            for (int i = 0; i < 2; ++i)
#pragma unroll
                for (int h = 0; h < 2; ++h) vC[h][i] = vNs[h][i]; }
        if constexpr (ALIGN_EPI) { if (wr == 1) PG8_BAR; }
    }
    PG8_WAIT_V(0);
    if constexpr (!ALIGN_EPI) { if (wr == 0) PG8_BAR; }
    PG8_BAR;
#undef PG8_SA
#undef PG8_SB
#undef PG8_STAGE
#undef PG8_STAGEA
#undef PG8_STAGEAL
#undef PG8_LDA
#undef PG8_LDB
#undef PG8_MMA
#undef PG8_WAIT_V
#undef PG8_WAIT_L
#undef PG8_BAR
#undef PG8_SCHED
}

typedef const f32x4 (&AccRef)[2][2][4][2];
template <int DIM> __device__ __forceinline__ void rope_cs(int pos, int j0, f32x4& c, f32x4& s) {
    constexpr float KEXP = 13.287712379549449f * 2.f / DIM;
#pragma unroll
    for (int e = 0; e < 4; ++e) { const float inv = __builtin_amdgcn_exp2f(-(float)(j0 + e) * KEXP), ang = (float)pos * inv, rev = ang * 0.15915494309189535f, fr = __builtin_amdgcn_fractf(rev);
        c[e] = __builtin_amdgcn_cosf(fr); s[e] = __builtin_amdgcn_sinf(fr); }
}
__device__ __forceinline__ void st_bf16x8(bf16* p, f32x4 v0, f32x4 v1) { u32x4 w; w.x = cvt_pk_bf16(v0[0], v0[1]); w.y = cvt_pk_bf16(v0[2], v0[3]); w.z = cvt_pk_bf16(v1[0], v1[1]); w.w = cvt_pk_bf16(v1[2], v1[3]); *(u32x4*)p = w; }
struct EpiProj {
    static constexpr bool PERM = true, KHOOK = false;
    bf16* P; float *cqss, *ckvss; const LAS float* rs;
    __device__ __forceinline__ void operator()(AccRef acc, const Unit& u, int wr, int wc, int fr, int fq, int ui) const {
#pragma unroll
        for (int ai = 0; ai < 2; ++ai)
#pragma unroll
            for (int m = 0; m < 4; ++m) { const int row = u.pm * BM + ai * HALF + wr * 64 + m * 16 + fr; const int pos = row & (NS - 1); float ssq = 0.f; const float rsv = rs[ui * BM + ai * HALF + wr * 64 + m * 16 + fr];
#pragma unroll
                for (int bj = 0; bj < 2; ++bj) { const int cw = u.pn * BM + bj * HALF + wc * 32, col0 = cw + 8 * fq; f32x4 v0 = acc[ai][bj][m][0] * rsv, v1 = acc[ai][bj][m][1] * rsv;
                    if (cw >= C_SQ && cw < C_SV) { const int g = ((col0 - C_SQ) & 63) >> 3; f32x4 c, s; rope_cs<64>(pos, 4 * g, c, s);
                        const f32x4 o0 = v0 * c - v1 * s, o1 = v1 * c + v0 * s; v0 = o0; v1 = o1; }
                    else if (cw == C_KR) { f32x4 c, s; rope_cs<32>(pos, 4 * fq, c, s);
                        const f32x4 o0 = v0 * c - v1 * s, o1 = v1 * c + v0 * s; v0 = o0; v1 = o1; }
                    if (u.pn == 3 || (u.pn == 4 && bj == 0)) ssq += (v0[0] * v0[0] + v0[1] * v0[1]) + (v0[2] * v0[2] + v0[3] * v0[3]) + (v1[0] * v1[0] + v1[1] * v1[1]) + (v1[2] * v1[2] + v1[3] * v1[3]);
                    st_bf16x8(P + (size_t)row * NP + col0, v0, v1); }
                if (u.pn == 3 || u.pn == 4) { ssq += __shfl_xor(ssq, 16); ssq += __shfl_xor(ssq, 32); if (fq == 0) (u.pn == 3 ? cqss : ckvss)[(size_t)row * 4 + wc] = ssq; }
            }
    }
};
template <bool QMODE, int ldc, int ncols> struct EpiMla {
    static constexpr bool PERM = true, KHOOK = false;
    bf16* O; const LAS float* rs;
    __device__ __forceinline__ void operator()(AccRef acc, const Unit& u, int wr, int wc, int fr, int fq, int ui) const {
#pragma unroll
        for (int ai = 0; ai < 2; ++ai)
#pragma unroll
            for (int m = 0; m < 4; ++m) { const int row = u.pm * BM + ai * HALF + wr * 64 + m * 16 + fr; const int pos = row & (NS - 1);
                const float rsv = rs[ui * BM + ai * HALF + wr * 64 + m * 16 + fr];
#pragma unroll
                for (int bj = 0; bj < 2; ++bj) { const int cw = u.pn * BM + bj * HALF + wc * 32, col0 = cw + 8 * fq; if (cw >= ncols) continue;
                    f32x4 v0 = acc[ai][bj][m][0] * rsv, v1 = acc[ai][bj][m][1] * rsv;
                    if (QMODE && (cw % 96) == 64) { f32x4 c, s; rope_cs<32>(pos, 4 * fq, c, s);
                        const f32x4 o0 = v0 * c - v1 * s, o1 = v1 * c + v0 * s; v0 = o0; v1 = o1; }
                    st_bf16x8(O + (size_t)row * ldc + col0, v0, v1); }
                asm volatile("" ::: "memory"); }
    }
};
struct EpiResid {
    static constexpr bool PERM = true, KHOOK = true;
    bf16* HB; const LAS float* fac;
    __device__ __forceinline__ void khook(f32x4 (&acc)[2][2][4][2], int ui, int which, int wr, int fr) const {
#pragma unroll
        for (int ai = 0; ai < 2; ++ai)
#pragma unroll
            for (int m = 0; m < 4; ++m) { const float f = fac[(ui * BM + ai * HALF + wr * 64 + m * 16 + fr) * 4 + which];
#pragma unroll
                for (int bj = 0; bj < 2; ++bj)
#pragma unroll
                    for (int n = 0; n < 2; ++n) acc[ai][bj][m][n] *= f; }
    }
    __device__ __forceinline__ void operator()(AccRef acc, const Unit& u, int wr, int wc, int fr, int fq, int ui) const {
#pragma unroll
        for (int ai = 0; ai < 2; ++ai)
#pragma unroll
            for (int m = 0; m < 4; ++m) { const int rl = ai * HALF + wr * 64 + m * 16 + fr; const float f = fac[(ui * BM + rl) * 4 + 2]; bf16* p = HB + (size_t)(u.pm * BM + rl) * DM + u.pn * BM + wc * 32 + 8 * fq;
#pragma unroll
                for (int bj = 0; bj < 2; ++bj) { const u32x4 w = *(const u32x4*)(p + bj * HALF); f32x4 h0, h1;
                    h0[0] = __builtin_bit_cast(float, w[0] << 16); h0[1] = __builtin_bit_cast(float, w[0] & 0xffff0000u); h0[2] = __builtin_bit_cast(float, w[1] << 16); h0[3] = __builtin_bit_cast(float, w[1] & 0xffff0000u);
                    h1[0] = __builtin_bit_cast(float, w[2] << 16); h1[1] = __builtin_bit_cast(float, w[2] & 0xffff0000u); h1[2] = __builtin_bit_cast(float, w[3] << 16); h1[3] = __builtin_bit_cast(float, w[3] & 0xffff0000u);
                    st_bf16x8(p + bj * HALF, h0 + acc[ai][bj][m][0] * f, h1 + acc[ai][bj][m][1] * f); } }
    }
};
struct EpiSwiglu {
    static constexpr bool PERM = true, KHOOK = false;
    bf16* Hd; const LAS float* rs;
    __device__ __forceinline__ void operator()(AccRef acc, const Unit& u, int wr, int wc, int fr, int fq, int ui) const {
#pragma unroll
        for (int ai = 0; ai < 2; ++ai)
#pragma unroll
            for (int m = 0; m < 4; ++m) { const size_t row = (size_t)(u.pm * BM + ai * HALF + wr * 64 + m * 16 + fr); f32x4 o[2]; const float rsv = rs[ui * BM + ai * HALF + wr * 64 + m * 16 + fr];
#pragma unroll
                for (int n = 0; n < 2; ++n) { const f32x4 gt = acc[ai][0][m][n] * rsv, up = acc[ai][1][m][n] * rsv;
#pragma unroll
                    for (int e = 0; e < 4; ++e) o[n][e] = gt[e] * __builtin_amdgcn_rcpf(1.f + __builtin_amdgcn_exp2f(-gt[e] * LOG2E)) * up[e]; }
                st_bf16x8(Hd + row * DM + u.pn * HALF + wc * 32 + 8 * fq, o[0], o[1]); }
    }
};
struct EpiGate {
    static constexpr bool PERM = true, KHOOK = false;
    bf16* Y; const LAS float* gate;
    __device__ __forceinline__ void operator()(AccRef acc, const Unit& u, int wr, int wc, int fr, int fq, int ui) const {
#pragma unroll
        for (int ai = 0; ai < 2; ++ai)
#pragma unroll
            for (int m = 0; m < 4; ++m) { const size_t row = (size_t)(u.pm * BM + ai * HALF + wr * 64 + m * 16 + fr); const float gt = gate[ui * BM + ai * HALF + wr * 64 + m * 16 + fr];
#pragma unroll
                for (int bj = 0; bj < 2; ++bj) st_bf16x8(Y + row * DM + u.pn * BM + bj * HALF + wc * 32 + 8 * fq, acc[ai][bj][m][0] * gt, acc[ai][bj][m][1] * gt); }
    }
};
}


namespace att {
typedef short bf16x8 __attribute__((ext_vector_type(8)));
typedef short s16x4 __attribute__((ext_vector_type(4)));
typedef float f32x16 __attribute__((ext_vector_type(16)));
typedef float f32x4 __attribute__((ext_vector_type(4)));
typedef unsigned u32x4 __attribute__((ext_vector_type(4)));
typedef float f32x2_t __attribute__((ext_vector_type(2))); typedef __bf16 bf16x2_t __attribute__((ext_vector_type(2)));
typedef short v4i16_t __attribute__((ext_vector_type(4)));
constexpr int KSLOT = 12288, VSLOT = 8192, NSL = 3;
constexpr int L_K = 0, L_V = NSL * KSLOT, L_WS = L_V + NSL * VSLOT, L_OST = L_WS + 8 * 256, L_BIAS = L_OST + 8 * 4096, L_END = L_BIAS + 2048;
constexpr float THR = 8.f;
constexpr int ATT_PROBE = 0;
constexpr bool LSUM_MFMA = true;
__device__ __forceinline__ int crow(int r, int hi) { return (r & 3) + 8 * (r >> 2) + 4 * hi; }
__device__ __forceinline__ unsigned cvtpk(float lo, float hi) { f32x2_t v = {lo, hi}; bf16x2_t b = __builtin_convertvector(v, bf16x2_t); return __builtin_bit_cast(unsigned, b); }
__device__ __forceinline__ s16x4 vtr(const LAS unsigned char* p) { return __builtin_bit_cast(s16x4, __builtin_amdgcn_ds_read_tr16_b64_v4i16((LAS v4i16_t*)p)); }
__device__ __forceinline__ void glds(const bf16* src, unsigned lds_dst) { unsigned keep;
    asm volatile("s_mov_b32 %0, m0\n\ts_mov_b32 m0, %2\n\ts_nop 0\n\tglobal_load_lds_dwordx4 %1, off\n\ts_mov_b32 m0, %0" : "=&s"(keep) : "v"(src), "s"(lds_dst) : "memory"); }
struct AttnP { const bf16 *PROJ, *QB, *KV; bf16* O; float* SS; const float* rpb; const float* sink; };
#define ATT_WAIT_BAR() do { if (PROBE != 3) asm volatile("s_waitcnt vmcnt(0) lgkmcnt(0)\n\ts_barrier" ::: "memory"); } while (0)

template <int TYPE, int PROBE = 0> __device__ __forceinline__ void attn_unit(const AttnP& P, int b, int h, int qb, LAS unsigned char* lds) {
    constexpr int ND0 = (TYPE == 1) ? 6 : 4;
    int tid = threadIdx.x; asm volatile("" : "+v"(tid));
    const int lane = tid & 63, r32 = lane & 31, hi = lane >> 5, wid = __builtin_amdgcn_readfirstlane(tid >> 6);
    const bool ordA = wid < 4;
    const int q0 = qb * 256, qw0 = q0 + wid * 32; const size_t tokb = (size_t)b * NS;
    int ntile, kbase, ta, tb;
    if (TYPE == 1) { ntile = NS / 64; kbase = 0; ta = 0; tb = ntile - 1; }
    else if (TYPE == 2) { kbase = max(q0 - 128, 0); const int ke = min(q0 + 384, NS); ntile = (ke - kbase) >> 6; ta = max(qw0 - 128 - kbase, 0) >> 6; tb = min(ntile - 1, (qw0 + 159 - kbase) >> 6); }
    else { const int r0 = qb * 4; kbase = min(max(r0 - 4, 0), 56); ntile = min(max(r0 - 1, 0), 56) + 7 - kbase + 1; const int r = r0 + (wid >> 1); ta = min(max(r - 4, 0), 56) - kbase; tb = ta + 7; }
    const int kvh = (TYPE == 2) ? h / 3 : h;
    const bf16 *ksrc, *ksrc2 = nullptr, *vsrc; size_t kpitch, vpitch;
    { const size_t key0 = tokb + (TYPE == 0 ? (size_t)kbase * 64 : (size_t)kbase); const int vrow = 16 * (wid & 3) + (lane >> 2), vcol = (wid >> 2) * 32 + (lane & 3) * 8;
      if (TYPE == 0) { ksrc = P.PROJ + (key0 + lane) * NP + C_AK + h * 64 + wid * 8; vsrc = P.PROJ + (key0 + vrow) * NP + C_AV + h * 64 + vcol; kpitch = vpitch = NP; }
      else if (TYPE == 1) { ksrc = P.KV + (key0 + lane) * 768 + h * 64 + wid * 8; ksrc2 = P.PROJ + (key0 + lane) * NP + C_KR + (wid & 3) * 8; vsrc = P.KV + (key0 + vrow) * 768 + 384 + h * 64 + vcol; kpitch = vpitch = 768; }
      else { ksrc = P.PROJ + (key0 + lane) * NP + C_SK + kvh * 64 + wid * 8; vsrc = P.PROJ + (key0 + vrow) * NP + C_SV + kvh * 64 + vcol; kpitch = vpitch = NP; } }
    const unsigned kdst = (unsigned)(uintptr_t)(lds + L_K) + wid * 1024, vdst = (unsigned)(uintptr_t)(lds + L_V) + wid * 1024;
#define ATT_DMA(t, slot) do { if (PROBE == 2 || PROBE == 3) break; glds(ksrc + (size_t)(t) * 64 * kpitch, (unsigned)__builtin_amdgcn_readfirstlane(kdst + (slot) * KSLOT)); if (TYPE == 1 && wid < 4) glds(ksrc2 + (size_t)(t) * 64 * NP, (unsigned)__builtin_amdgcn_readfirstlane(kdst + (slot) * KSLOT + 8192)); \
        glds(vsrc + (size_t)(t) * 64 * vpitch, (unsigned)__builtin_amdgcn_readfirstlane(vdst + (slot) * VSLOT)); } while (0)
    LAS float* biasL = (LAS float*)(lds + L_BIAS);
    if (TYPE == 0) { for (int i = tid; i < 15 * 31; i += 512) biasL[i] = P.rpb[h * 465 + i] * LOG2E; }
    bf16x8 qr[ND0];
    { const bf16* qp = (TYPE == 1) ? P.QB + (tokb + qw0 + r32) * 576 + h * 96 : P.PROJ + (tokb + qw0 + r32) * NP + (TYPE == 0 ? C_AQ : C_SQ) + h * 64;
#pragma unroll
      for (int d0 = 0; d0 < ND0; ++d0) qr[d0] = *(const bf16x8*)(qp + d0 * 16 + hi * 8); }
    LAS float* wsf = (LAS float*)(lds + L_WS) + wid * 64;
    float m = (TYPE == 2) ? P.sink[h] * LOG2E : 0.f;
    f32x16 negm; { const float nm = -m;
#pragma unroll
      for (int r = 0; r < 16; ++r) negm[r] = nm; }
    f32x16 o[2]; o[0] = f32x16{}; o[1] = f32x16{};
    f32x16 lacc;
    { const float l0 = (TYPE == 2) ? 1.f : 0.f;
#pragma unroll
      for (int r = 0; r < 16; ++r) lacc[r] = l0; }
    float lsum = (TYPE == 2 && hi == 0) ? 1.f : 0.f;
    const bf16x8 ones = (bf16x8){0x3F80, 0x3F80, 0x3F80, 0x3F80, 0x3F80, 0x3F80, 0x3F80, 0x3F80};
    f32x16 sA0, sA1, sB0, sB1;
#define ATT_QK(X0, X1, tt, sl) do { const LAS unsigned char* Kp = lds + L_K + (sl) * KSLOT + hi * 1024 + r32 * 16; X0 = negm; X1 = negm; \
        bf16x8 ka0 = *(const LAS bf16x8*)(Kp), ka1 = *(const LAS bf16x8*)(Kp + 512); \
        _Pragma("unroll") for (int d0 = 0; d0 < ND0; ++d0) { bf16x8 kb0 = ka0, kb1 = ka1; \
            if (d0 + 1 < ND0) { kb0 = *(const LAS bf16x8*)(Kp + (d0 + 1) * 2048); kb1 = *(const LAS bf16x8*)(Kp + (d0 + 1) * 2048 + 512); }     \
            X0 = __builtin_amdgcn_mfma_f32_32x32x16_bf16(ka0, qr[d0], X0, 0, 0, 0); X1 = __builtin_amdgcn_mfma_f32_32x32x16_bf16(ka1, qr[d0], X1, 0, 0, 0); ka0 = kb0; ka1 = kb1; } \
        __builtin_amdgcn_sched_group_barrier(0x100, 2, 0); __builtin_amdgcn_sched_group_barrier(0x100, 2, 0);        \
        _Pragma("unroll") for (int d0 = 0; d0 + 2 < ND0; ++d0) { __builtin_amdgcn_sched_group_barrier(0x8, 2, 0); __builtin_amdgcn_sched_group_barrier(0x100, 2, 0); } \
        __builtin_amdgcn_sched_group_barrier(0x8, 2, 0); __builtin_amdgcn_sched_group_barrier(0x8, 2, 0); \
        if (TYPE == 2) { const int dq = qw0 + r32 - (kbase + (tt) * 64) - 4 * hi; \
            _Pragma("unroll") for (int r = 0; r < 16; ++r) { const int d0_ = dq - ((r & 3) + 8 * (r >> 2)), d1_ = d0_ - 32; \
                if (d0_ > 128 || d0_ < -128) X0[r] = -INFINITY; if (d1_ > 128 || d1_ < -128) X1[r] = -INFINITY; } } \
        if (TYPE == 0) { const int c = (wid & 1) * 32 + r32, cs = min(max(c - 8, 0), 48); const int rq = qb * 4 + (wid >> 1), kr = kbase + (tt); const LAS float* brow = biasL + (kr - rq + 7) * 31 + 15 - c; \
            _Pragma("unroll") for (int rr = 0; rr < 16; ++rr) { const int kc0 = crow(rr, hi), kc1 = kc0 + 32; \
                const bool v0 = kc0 >= cs && kc0 < cs + 16, v1 = kc1 >= cs && kc1 < cs + 16; \
                X0[rr] = v0 ? X0[rr] + brow[v0 ? kc0 : c] : -INFINITY; X1[rr] = v1 ? X1[rr] + brow[v1 ? kc1 : c] : -INFINITY; } } \
        asm volatile("s_nop 15\n\ts_nop 7" : "+v"(X0), "+v"(X1)); } while (0)
#define ATT_MAX3(a, b, c) ({ float r_; asm("v_max3_f32 %0, %1, %2, %3" : "=v"(r_) : "v"(a), "v"(b), "v"(c)); r_; })
#define ATT_STEP(ORDA, C0, C1, N0, N1, t) do { \
        if ((t) + 1 < ntile) ATT_WAIT_BAR(); \
        if ((t) + 2 < ntile) ATT_DMA((t) + 2, sl_nn); \
        const bool act = ((t) >= ta && (t) <= tb), nact = ((t) + 1 >= ta && (t) + 1 <= tb); \
        if (ORDA && nact) ATT_QK(N0, N1, (t) + 1, sl_nxt); \
        if (act) { \
            float ma = 0.f, mb = 0.f; if (PROBE != 4) { ma = ATT_MAX3(C0[0], C0[1], C1[0]); mb = ATT_MAX3(C0[2], C0[3], C1[1]); ma = ATT_MAX3(ma, C1[2], C1[3]); \
            _Pragma("unroll") for (int r = 4; r < 16; r += 4) { ma = ATT_MAX3(ma, C0[r], C0[r + 1]); mb = ATT_MAX3(mb, C0[r + 2], C0[r + 3]); ma = ATT_MAX3(ma, C1[r], C1[r + 1]); mb = ATT_MAX3(mb, C1[r + 2], C1[r + 3]); } } \
            float rm = fmaxf(ma, mb); \
            { auto rr = __builtin_amdgcn_permlane32_swap(__float_as_uint(rm), __float_as_uint(rm), false, false); rm = fmaxf(__uint_as_float(rr[0]), __uint_as_float(rr[1])); } \
            const bool first = (TYPE != 2) && ((t) == ta); \
            if (first || __any(rm > THR)) { const float dl = first ? rm : fmaxf(rm, 0.f), f = first ? 1.f : __builtin_amdgcn_exp2f(-dl); m += dl; lsum *= f; \
                _Pragma("unroll") for (int r = 0; r < 16; ++r) { C0[r] -= dl; C1[r] -= dl; negm[r] = -m; } \
                if (ORDA && nact) { _Pragma("unroll") for (int r = 0; r < 16; ++r) { N0[r] -= dl; N1[r] -= dl; } } \
                if (hi == 0) wsf[r32] = f; \
                _Pragma("unroll") for (int g = 0; g < 4; ++g) { const f32x4 fv = *(const LAS f32x4*)(wsf + 8 * g + 4 * hi); \
                    _Pragma("unroll") for (int e = 0; e < 4; ++e) { o[0][4 * g + e] *= fv[e]; o[1][4 * g + e] *= fv[e]; lacc[4 * g + e] *= fv[e]; } } } \
            const LAS unsigned char* Vp = lds + L_V + sl_cur * VSLOT + ((lane >> 4) & 1) * 32 + (lane & 3) * 8 + (4 * hi + ((lane & 15) >> 2)) * 64; \
            s16x4 va[4], vb[4]; \
            va[0] = vtr(Vp); va[1] = vtr(Vp + 512); va[2] = vtr(Vp + 4096); va[3] = vtr(Vp + 4096 + 512);        \
            if (PROBE != 4) { _Pragma("unroll") for (int r = 0; r < 16; ++r) { C0[r] = __builtin_amdgcn_exp2f(C0[r]); C1[r] = __builtin_amdgcn_exp2f(C1[r]); } } \
            if (!LSUM_MFMA) { float sa = 0.f, sb = 0.f; _Pragma("unroll") for (int r = 0; r < 16; ++r) { sa += C0[r]; sb += C1[r]; } lsum += sa + sb; } \
            u32x4 pw[4]; \
            _Pragma("unroll") for (int e = 0; e < 4; ++e) { pw[0][e] = cvtpk(C0[2 * e], C0[2 * e + 1]); pw[1][e] = cvtpk(C0[8 + 2 * e], C0[9 + 2 * e]); pw[2][e] = cvtpk(C1[2 * e], C1[2 * e + 1]); pw[3][e] = cvtpk(C1[8 + 2 * e], C1[9 + 2 * e]); } \
            _Pragma("unroll") for (int ks = 0; ks < 4; ++ks) { const bf16x8 pa = __builtin_bit_cast(bf16x8, pw[ks]); \
                if (ks + 1 < 4) { vb[0] = vtr(Vp + (ks + 1) * 1024); vb[1] = vtr(Vp + (ks + 1) * 1024 + 512); vb[2] = vtr(Vp + 4096 + (ks + 1) * 1024); vb[3] = vtr(Vp + 4096 + (ks + 1) * 1024 + 512); }     \
                o[0] = __builtin_amdgcn_mfma_f32_32x32x16_bf16(pa, ((bf16x8){va[0][0], va[0][1], va[0][2], va[0][3], va[1][0], va[1][1], va[1][2], va[1][3]}), o[0], 0, 0, 0); \
                o[1] = __builtin_amdgcn_mfma_f32_32x32x16_bf16(pa, ((bf16x8){va[2][0], va[2][1], va[2][2], va[2][3], va[3][0], va[3][1], va[3][2], va[3][3]}), o[1], 0, 0, 0); \
                if (LSUM_MFMA) lacc = __builtin_amdgcn_mfma_f32_32x32x16_bf16(pa, ones, lacc, 0, 0, 0); \
                _Pragma("unroll") for (int q_ = 0; q_ < 4; ++q_) va[q_] = vb[q_]; } \
            __builtin_amdgcn_sched_group_barrier(0x100, 4, 1); \
            _Pragma("unroll") for (int ks = 0; ks < 3; ++ks) { __builtin_amdgcn_sched_group_barrier(0x100, 4, 1); __builtin_amdgcn_sched_group_barrier(0x8, LSUM_MFMA ? 3 : 2, 1); } \
            __builtin_amdgcn_sched_group_barrier(0x8, LSUM_MFMA ? 3 : 2, 1); \
        } \
        if (!(ORDA) && nact) ATT_QK(N0, N1, (t) + 1, sl_nxt); \
        { const int tmp = sl_cur; sl_cur = sl_nxt; sl_nxt = sl_nn; sl_nn = tmp; } } while (0)
    ATT_DMA(0, 0);
    if (ntile > 1) ATT_DMA(1, 1);
    if (PROBE == 2 || PROBE == 3) {} else if (ntile > 1) { if (TYPE == 1 && wid < 4) asm volatile("s_waitcnt vmcnt(3)" ::: "memory"); else asm volatile("s_waitcnt vmcnt(2)" ::: "memory"); } else asm volatile("s_waitcnt vmcnt(0)" ::: "memory");
    asm volatile("s_waitcnt lgkmcnt(0)\n\ts_barrier" ::: "memory");
    if (ta == 0) ATT_QK(sA0, sA1, 0, 0);
    int sl_cur = 0, sl_nxt = 1, sl_nn = 2;
    if (ordA) {
        for (int t = 0; t < ntile; t += 2) { ATT_STEP(true, sA0, sA1, sB0, sB1, t); if (t + 1 < ntile) ATT_STEP(true, sB0, sB1, sA0, sA1, t + 1); }
    } else {
        for (int t = 0; t < ntile; t += 2) { ATT_STEP(false, sA0, sA1, sB0, sB1, t); if (t + 1 < ntile) ATT_STEP(false, sB0, sB1, sA0, sA1, t + 1); }
    }
    LAS bf16* stg = (LAS bf16*)(lds + L_OST) + wid * 2048;
    if (!LSUM_MFMA) { { auto rr = __builtin_amdgcn_permlane32_swap(__float_as_uint(lsum), __float_as_uint(lsum), false, false); lsum = __uint_as_float(rr[0]) + __uint_as_float(rr[1]); }
        if (hi == 0) wsf[32 + r32] = lsum;
#pragma unroll
        for (int g = 0; g < 4; ++g) { const f32x4 lv = *(const LAS f32x4*)(wsf + 32 + 8 * g + 4 * hi);
#pragma unroll
            for (int e = 0; e < 4; ++e) lacc[4 * g + e] = lv[e]; } }
#pragma unroll
    for (int r = 0; r < 16; ++r) { const float iv = __builtin_amdgcn_rcpf(lacc[r]); const int orow = crow(r, hi);
        stg[orow * 64 + r32] = (bf16)(cvtpk(o[0][r] * iv, 0.f) & 0xffff); stg[orow * 64 + 32 + r32] = (bf16)(cvtpk(o[1][r] * iv, 0.f) & 0xffff); }
    const int ocol = (TYPE == 0 ? 0 : (TYPE == 1 ? 256 : 640)) + h * 64, sidx = (TYPE == 0 ? 0 : (TYPE == 1 ? 4 : 10)) + h;
#pragma unroll
    for (int i = 0; i < 4; ++i) { const int row = i * 8 + (lane >> 3), ch = lane & 7; const u32x4 v = *(const LAS u32x4*)(stg + row * 64 + ch * 8);
        const size_t tokn = tokb + qw0 + row; if (PROBE == 0) *(u32x4*)(P.O + tokn * DM + ocol + ch * 8) = v; else asm volatile("" :: "v"(v));
        float sq = 0.f;
#pragma unroll
        for (int e = 0; e < 4; ++e) { const float a = __builtin_bit_cast(float, v[e] << 16), c2 = __builtin_bit_cast(float, v[e] & 0xffff0000u); sq += a * a + c2 * c2; }
        sq += __shfl_xor(sq, 1); sq += __shfl_xor(sq, 2); sq += __shfl_xor(sq, 4);
        if (ch == 0 && PROBE == 0) P.SS[tokn * 16 + sidx] = sq; }
    ATT_WAIT_BAR();
#undef ATT_DMA
#undef ATT_QK
#undef ATT_STEP
#undef ATT_MAX3
}
__device__ __forceinline__ void attn_phase(const AttnP& P, LAS unsigned char* lds, int vcu) {
    const int x = vcu >> 5, cx = vcu & 31;
    for (int i = 0; i < 3; ++i) { const int j = cx * 3 + i, bh = 6 * x + (j >> 4), qb = j & 15; attn_unit<1>(P, bh / 6, bh % 6, qb, lds); }
    if (ATT_PROBE) for (int i = 0; i < 3; ++i) { const int j = cx * 3 + i, bh = 6 * x + (j >> 4), qb = j & 15; attn_unit<1, ATT_PROBE>(P, bh / 6, bh % 6, qb, lds); }
    for (int i = 0; i < 3; ++i) { const int j = cx * 3 + i, bh = 6 * x + (j >> 4), qb = j & 15; attn_unit<2>(P, bh / 6, bh % 6, qb, lds); }
    for (int i = 0; i < 2; ++i) { const int j = cx * 2 + i, bh = 4 * x + (j >> 4), qb = j & 15; attn_unit<0>(P, bh >> 2, bh & 3, qb, lds); }
}
}


constexpr int NWAVES = 8, LDS_BYTES = 155648, RING_BYTES = 131072, MISC_OFF = RING_BYTES + 320, TAB_OFF = RING_BYTES + 512;
#define XB_TMO      128
#define XB_XCNT(j)  (256  + 64 * (j))
#define XB_XSUB(j)  (1280 + 64 * (j))
#define XB_XGEN(j)  (2304 + 64 * (j))
#define XB_TOP      3328
#define XB_TOPGEN   3392
#define XCD_BAR_WORDS 3456
#define XB_SPIN_CAP (1u << 18)
constexpr int CW_BAR = 4096;
__device__ __forceinline__ unsigned xb_ld(unsigned* p)              { return __hip_atomic_load(p, __ATOMIC_RELAXED, __HIP_MEMORY_SCOPE_AGENT); }
__device__ __forceinline__ unsigned xb_add(unsigned* p, unsigned v) { return __hip_atomic_fetch_add(p, v, __ATOMIC_RELAXED, __HIP_MEMORY_SCOPE_AGENT); }
__device__ __forceinline__ unsigned xb_xcc_id() { return (unsigned)__builtin_amdgcn_s_getreg((3 << 11) | 20) & 0xFu; }
#define XB_SPIN(cond, bar) do { unsigned _sp = 0; while (cond) { __builtin_amdgcn_s_sleep(1); \
    if ((++_sp & 255u) == 0u) { if (xb_ld(&(bar)[XB_TMO])) break; if (_sp > XB_SPIN_CAP) { atomicAdd(&(bar)[XB_TMO], 1u); break; } } } } while (0)
struct XcdBarrier { unsigned* bar; unsigned x; volatile LAS unsigned* st; };
__device__ __forceinline__ XcdBarrier xcd_barrier_post(unsigned* bar, volatile LAS unsigned* st) {
    XcdBarrier b; b.bar = bar; b.x = xb_xcc_id(); b.st = st;
    if (threadIdx.x == 0) (void)xb_add(&bar[XB_XCNT(b.x)], 1u);
    return b;
}
__device__ __forceinline__ void xcd_barrier_complete(unsigned* bar, unsigned x, unsigned& nloc, unsigned& nx) {
    const unsigned G = gridDim.x * gridDim.y * gridDim.z;
    unsigned sum, cnt, mine, sp = 0u;
    for (;;) {
        sum = 0u; cnt = 0u; mine = 0u;
#pragma unroll
        for (unsigned j = 0; j < 16; ++j) { const unsigned c = xb_ld(&bar[XB_XCNT(j)]); sum += c; cnt += (c > 0u) ? 1u : 0u; mine = (j == x) ? c : mine; }
        if (sum == G) break;
        __builtin_amdgcn_s_sleep(1);
        if ((++sp & 255u) == 0u) { if (xb_ld(&bar[XB_TMO])) break; if (sp > XB_SPIN_CAP) { atomicAdd(&bar[XB_TMO], 1u); break; } }
    }
    nloc = mine > 0u ? mine : 1u; nx = cnt > 0u ? cnt : 1u;
}
__device__ __forceinline__ void xcd_barrier(const XcdBarrier& b) {
    asm volatile("s_waitcnt vmcnt(0)" ::: "memory");
    __syncthreads();
    if (threadIdx.x == 0) {
        unsigned long long zb = 0; asm volatile("" : "+s"(zb)); unsigned* bar = b.bar + zb;
        __builtin_amdgcn_s_waitcnt(0);
        unsigned nloc = b.st[0], nx = b.st[1];
        if (nloc == 0u) { xcd_barrier_complete(bar, b.x, nloc, nx); b.st[0] = nloc; b.st[1] = nx; }
        const unsigned old = xb_add(&bar[XB_XSUB(b.x)], 1u);
        const unsigned gen = old / nloc;
        if (old + 1u == (gen + 1u) * nloc) {
            __builtin_amdgcn_fence(__ATOMIC_RELEASE, "agent");
            asm volatile("s_waitcnt vmcnt(0)" ::: "memory");
            const unsigned og = xb_add(&bar[XB_TOP], 1u);
            const unsigned tg = og / nx;
            if (og + 1u == (tg + 1u) * nx) xb_add(&bar[XB_TOPGEN], 1u);
            else XB_SPIN(xb_ld(&bar[XB_TOPGEN]) == tg, bar);
            __builtin_amdgcn_fence(__ATOMIC_ACQUIRE, "agent");
            xb_add(&bar[XB_XGEN(b.x)], 1u);
            asm volatile("s_waitcnt vmcnt(0)" ::: "memory");
        } else {
            XB_SPIN(xb_ld(&bar[XB_XGEN(b.x)]) == gen, bar);
            __builtin_amdgcn_fence(__ATOMIC_ACQUIRE, "agent");
            asm volatile("s_waitcnt vmcnt(0)" ::: "memory");
        }
    }
    __syncthreads();
}

struct MegaArgs {
    const float *x, *attn_norm, *w_in, *na_rpb, *q_norm, *w_uq, *kv_norm, *w_ukv, *swa_sink, *group_norm, *w_out, *ffn_norm, *w_router, *w_gate, *w_up, *w_down, *final_norm;
    float* out; unsigned char* ws;
    int ph_lo, ph_hi;
};

__device__ __forceinline__ void prep_item(int kind, const float* W, const float* W2, const float* kgain, bf16* Wt, int K, int Nsrc, int nblk, int item, LAS float* scr, int lane) {
    const int kb = item / nblk, nb = item % nblk, k0 = 64 * kb, n0 = 32 * nb, r = lane >> 3, q = lane & 7;
    float sc; int which; const int src4 = prep_map(kind, n0 + 4 * q, sc, which); const float* Wb = which ? W2 : W;
    float4 v[8];
#pragma unroll
    for (int i = 0; i < 8; ++i) v[i] = (src4 >= 0) ? *(const float4*)(Wb + (size_t)(k0 + 8 * i + r) * Nsrc + src4) : make_float4(0.f, 0.f, 0.f, 0.f);
#pragma unroll
    for (int i = 0; i < 8; ++i) { const float g = (kgain ? kgain[k0 + 8 * i + r] : 1.f) * sc; LAS float* d = scr + (8 * i + r) * 33 + 4 * q; d[0] = v[i].x * g; d[1] = v[i].y * g; d[2] = v[i].z * g; d[3] = v[i].w * g; }
    asm volatile("s_waitcnt lgkmcnt(0)" ::: "memory");
    const int c = lane & 7;
#pragma unroll
    for (int j = 0; j < 4; ++j) { const int n = (lane >> 3) + 8 * j; const LAS float* s = scr + (8 * c) * 33 + n;
        uint4 o; o.x = f2bf(s[0]) | (f2bf(s[33]) << 16); o.y = f2bf(s[2 * 33]) | (f2bf(s[3 * 33]) << 16); o.z = f2bf(s[4 * 33]) | (f2bf(s[5 * 33]) << 16); o.w = f2bf(s[6 * 33]) | (f2bf(s[7 * 33]) << 16);
        *(uint4*)(Wt + (size_t)(n0 + n) * K + k0 + 8 * c) = o; }
    asm volatile("s_waitcnt lgkmcnt(0)" ::: "memory");
}
__device__ __forceinline__ void ph_prep(const MegaArgs& a, int l, int part, LAS unsigned char* lds, int gw, int ngw, int wave, int lane) {
    unsigned char* ws = a.ws; LAS float* scr = (LAS float*)(lds + wave * 8448);
    constexpr int I_WIN = 16 * 64, I_WUQ = 4 * 24, I_WUKV = 2 * 24, I_WOUT = 16 * 32, I_WGU1 = 16 * 64, I_WGU = NE * I_WGU1, I_WD1 = 16 * 32, I_WD = NE * I_WD1;
    constexpr int NITEMS = I_WIN + I_WUQ + I_WUKV + I_WOUT + I_WGU + I_WD;
    const int it0 = part == 0 ? 0 : I_WGU + I_WD, it1 = part == 0 ? I_WGU + I_WD : NITEMS;
    for (int it = it0 + gw; it < it1; it += ngw) { int r = it;
        if (r < I_WGU) { const int e = r / I_WGU1; prep_item(PK_WGU, a.w_gate + ((size_t)l * NE + e) * DM * DM, a.w_up + ((size_t)l * NE + e) * DM * DM, a.ffn_norm + l * DM, (bf16*)(ws + WS_WGU) + (size_t)e * 2048 * DM, DM, DM, 64, r % I_WGU1, scr, lane); continue; } r -= I_WGU;
        if (r < I_WD) { const int e = r / I_WD1; prep_item(PK_WD, a.w_down + ((size_t)l * NE + e) * DM * DM, nullptr, nullptr, (bf16*)(ws + WS_WD) + (size_t)e * DM * DM, DM, DM, 32, r % I_WD1, scr, lane); continue; } r -= I_WD;
        if (r < I_WIN) { prep_item(PK_WIN, a.w_in + (size_t)l * DM * C_END, nullptr, a.attn_norm + l * DM, (bf16*)(ws + WS_WIN), DM, C_END, 64, r, scr, lane); continue; } r -= I_WIN;
        if (r < I_WOUT) { prep_item(PK_WOUT, a.w_out + (size_t)l * DM * DM, nullptr, a.group_norm + l * DM, (bf16*)(ws + WS_WOUT), DM, DM, 32, r, scr, lane); continue; } r -= I_WOUT;
        if (r < I_WUQ) { prep_item(PK_WUQ, a.w_uq + (size_t)l * 256 * 576, nullptr, a.q_norm + l * 256, (bf16*)(ws + WS_WUQ), 256, 576, 24, r, scr, lane); continue; } r -= I_WUQ;
        prep_item(PK_WUKV, a.w_ukv + (size_t)l * 128 * 768, nullptr, a.kv_norm + l * 128, (bf16*)(ws + WS_WUKV), 128, 768, 24, r, scr, lane);
    }
}
__device__ __forceinline__ void row_store_bf16(const float4 (&v)[4], bf16* orow, float* rstd_out, int lane) {
    float s = 0.f;
#pragma unroll
    for (int j = 0; j < 4; ++j) s += v[j].x * v[j].x + v[j].y * v[j].y + v[j].z * v[j].z + v[j].w * v[j].w;
    const float rstd = rsqrtf(wave_sum(s) * (1.f / DM) + EPS);
    uint2* o = (uint2*)orow + lane;
#pragma unroll
    for (int j = 0; j < 4; ++j) o[64 * j] = make_uint2(f2bf(v[j].x) | (f2bf(v[j].y) << 16), f2bf(v[j].z) | (f2bf(v[j].w) << 16));
    if (lane == 0) *rstd_out = rstd;
}
__device__ __forceinline__ void ph_norm_x(const MegaArgs& a, int gw, int ngw, int lane) {
    bf16* HB = (bf16*)(a.ws + WS_HB); float* R1 = (float*)(a.ws + WS_RSTD1);
    for (int row = gw; row < NT; row += ngw) { const float4* hr = (const float4*)(a.x + (size_t)row * DM) + lane; float4 v[4];
#pragma unroll
        for (int j = 0; j < 4; ++j) v[j] = hr[64 * j];
        row_store_bf16(v, HB + (size_t)row * DM, R1 + row, lane); }
}
__device__ __forceinline__ void ld_row_bf16(const bf16* row, float4 (&v)[4], int lane) {
    const uint2* p = (const uint2*)row + lane;
#pragma unroll
    for (int j = 0; j < 4; ++j) { const uint2 w = p[64 * j]; v[j] = make_float4(bf2f(w.x & 0xffff), bf2f(w.x >> 16), bf2f(w.y & 0xffff), bf2f(w.y >> 16)); }
}
__device__ __forceinline__ void ph_router(const MegaArgs& a, int l, LAS unsigned char* lds, int gw, int ngw, int lane) {
    LAS float* wl = (LAS float*)lds; const float* wr = a.w_router + (size_t)l * DM * NE; const float* g = a.ffn_norm + l * DM;
    for (int i = threadIdx.x; i < DM * NE; i += NWAVES * 64) wl[(i & 15) * DM + (i >> 4)] = wr[i] * g[i >> 4];
    __syncthreads();
    const bf16* HB = (const bf16*)(a.ws + WS_HB); float* AFF = (float*)(a.ws + WS_AFF); float* R2 = (float*)(a.ws + WS_RSTD2);
    for (int row = gw; row < NT; row += ngw) {
        asm volatile("" ::: "memory");
        float4 v[4]; ld_row_bf16(HB + (size_t)row * DM, v, lane); float s = 0.f;
#pragma unroll
        for (int j = 0; j < 4; ++j) s += v[j].x * v[j].x + v[j].y * v[j].y + v[j].z * v[j].z + v[j].w * v[j].w;
        const float rstd = rsqrtf(wave_sum(s) * (1.f / DM) + EPS);
        float lg[16];
#pragma unroll
        for (int e = 0; e < 16; ++e) lg[e] = 0.f;
#pragma unroll
        for (int j = 0; j < 4; ++j) {
#pragma unroll
            for (int e = 0; e < 16; ++e) { const pg8::f32x4 w = *(const LAS pg8::f32x4*)(wl + e * DM + 4 * lane + 256 * j); lg[e] += v[j].x * w[0] + v[j].y * w[1] + v[j].z * w[2] + v[j].w * w[3]; } }
        float mx = -1e30f;
#pragma unroll
        for (int e = 0; e < 16; ++e) { lg[e] = wave_sum(lg[e]) * rstd; mx = fmaxf(mx, lg[e]); }
        float den = 0.f;
#pragma unroll
        for (int e = 0; e < 16; ++e) { lg[e] = __expf(lg[e] - mx); den += lg[e]; }
        const int b = row / NS, sidx = row % NS;
        if (lane < 16) { float val = 0.f;
#pragma unroll
            for (int e = 0; e < 16; ++e) if (lane == e) val = lg[e];
            AFF[((size_t)b * NE + lane) * NS + sidx] = val / den; }
        if (lane == 0) R2[row] = rstd;
    }
    __syncthreads();
}
__device__ __forceinline__ void ph_topk(unsigned char* ws, LAS unsigned char* lds, int bx, int G) {
    LAS unsigned* hist = (LAS unsigned*)lds;
    LAS unsigned* sh = hist + 256;
    LAS unsigned* wcnt = hist + 512;
    const int tid = threadIdx.x, lane = tid & 63, wave = tid >> 6;
    const float* AFF = (const float*)(ws + WS_AFF); int* INV = (int*)(ws + WS_INV); int* IDX = (int*)(ws + WS_IDX); float* GATE = (float*)(ws + WS_GATE);
    for (int be = bx; be < NB * NE; be += G) {
        const int b = be / NE, e = be % NE; const float* src = AFF + (size_t)be * NS;
        unsigned u[8];
#pragma unroll
        for (int i = 0; i < 8; ++i) u[i] = __float_as_uint(src[tid * 8 + i]);
        unsigned prefix = 0u, krem = CAP;
#pragma unroll 1
        for (int pass = 0; pass < 4; ++pass) { const int shift = 24 - 8 * pass; const unsigned pmask = pass == 0 ? 0u : (0xffffffffu << (shift + 8));
            if (tid < 256) hist[tid] = 0u;
            __syncthreads();
#pragma unroll
            for (int i = 0; i < 8; ++i) if ((u[i] & pmask) == prefix) __hip_atomic_fetch_add(&hist[(u[i] >> shift) & 255u], 1u, __ATOMIC_RELAXED, __HIP_MEMORY_SCOPE_WORKGROUP);
            __syncthreads();
            if (wave == 0) {
                unsigned c4[4]; unsigned tot = 0u;
#pragma unroll
                for (int i = 0; i < 4; ++i) { c4[i] = hist[255 - (lane * 4 + i)]; tot += c4[i]; }
                unsigned inc = tot;
#pragma unroll
                for (int o = 1; o < 64; o <<= 1) { const unsigned t = __shfl_up(inc, o); if (lane >= o) inc += t; }
                const unsigned before = inc - tot;
                if (before < krem && inc >= krem) { unsigned acc = before;
#pragma unroll
                    for (int i = 0; i < 4; ++i) { if (acc < krem && acc + c4[i] >= krem) { sh[0] = prefix | ((unsigned)(255 - (lane * 4 + i)) << shift); sh[1] = krem - acc; } acc += c4[i]; } }
            }
            __syncthreads();
            prefix = sh[0]; krem = sh[1];
            __syncthreads();
        }
        unsigned ngt = 0u, neq = 0u;
#pragma unroll
        for (int i = 0; i < 8; ++i) { ngt += (u[i] > prefix) ? 1u : 0u; neq += (u[i] == prefix) ? 1u : 0u; }
        unsigned ig = ngt, iq = neq;
#pragma unroll
        for (int o = 1; o < 64; o <<= 1) { const unsigned tg = __shfl_up(ig, o), tq = __shfl_up(iq, o); if (lane >= o) { ig += tg; iq += tq; } }
        if (lane == 63) { wcnt[wave * 2] = ig; wcnt[wave * 2 + 1] = iq; }
        __syncthreads();
        unsigned bg = 0u, bq = 0u;
        for (int w = 0; w < wave; ++w) { bg += wcnt[w * 2]; bq += wcnt[w * 2 + 1]; }
        unsigned pg = bg + ig - ngt, pq = bq + iq - neq;
#pragma unroll
        for (int i = 0; i < 8; ++i) { const int idx = tid * 8 + i; int slot = -1;
            if (u[i] > prefix) { slot = (int)(pg + min(pq, krem)); ++pg; }
            else if (u[i] == prefix) { if (pq < krem) slot = (int)(pg + pq); ++pq; }
            INV[(size_t)be * NS + idx] = slot;
            if (slot >= 0) { IDX[e * (NB * CAP) + b * CAP + slot] = b * NS + idx; GATE[(size_t)e * (NB * CAP) + b * CAP + slot] = __uint_as_float(u[i]); } }
        __syncthreads();
    }
}
__device__ __forceinline__ void ph_combine(const MegaArgs& a, int l, int gw, int ngw, int lane) {
    const bf16* Y = (const bf16*)(a.ws + WS_PROJ); const int* INV = (const int*)(a.ws + WS_INV); bf16* HB = (bf16*)(a.ws + WS_HB); float* R1 = (float*)(a.ws + WS_RSTD1); const bool last = (l == DEPTH - 1);
    for (int row = gw; row < NT; row += ngw) { const int b = row / NS, s = row % NS;
        float4 v[4]; ld_row_bf16(HB + (size_t)row * DM, v, lane);
        int slot_l = -1; if (lane < NE) slot_l = INV[((size_t)b * NE + lane) * NS + s];
        unsigned long long msk = __ballot(slot_l >= 0);
        while (msk) { const int e = __builtin_ctzll(msk); msk &= msk - 1; const int slot = __shfl(slot_l, e);
            const uint2* y = (const uint2*)(Y + ((size_t)e * (NB * CAP) + b * CAP + slot) * DM) + lane;
#pragma unroll
            for (int j = 0; j < 4; ++j) { const uint2 w = y[64 * j]; v[j].x += bf2f(w.x & 0xffff); v[j].y += bf2f(w.x >> 16); v[j].z += bf2f(w.y & 0xffff); v[j].w += bf2f(w.y >> 16); } }
        if (last) { float ssum = 0.f;
#pragma unroll
            for (int j = 0; j < 4; ++j) ssum += v[j].x * v[j].x + v[j].y * v[j].y + v[j].z * v[j].z + v[j].w * v[j].w;
            const float rstd = rsqrtf(wave_sum(ssum) * (1.f / DM) + EPS); float4* orow = (float4*)(a.out + (size_t)row * DM) + lane;
#pragma unroll
            for (int j = 0; j < 4; ++j) { const float4 gg = ((const float4*)a.final_norm)[lane + 64 * j]; orow[64 * j] = make_float4(v[j].x * rstd * gg.x, v[j].y * rstd * gg.y, v[j].z * rstd * gg.z, v[j].w * rstd * gg.w); } }
        else row_store_bf16(v, HB + (size_t)row * DM, R1 + row, lane);
    }
}

enum { PL_PROJ = 0, PL_MLAUP, PL_ATTN, PL_OUT, PL_ROUTER, PL_TOPK, PL_MOE1, PL_MOE2, PL_COMBINE, PL_COUNT };
constexpr int N_PHASES = 1 + DEPTH * PL_COUNT;
constexpr int REP_PH = -1;
#define REPEAT(ph) for (int rep_ = 0; rep_ < (REP_PH == (ph) ? 2 : 1); ++rep_)
#define IN(k) (lo <= (k) && (k) < hi)
#define SEAM(k) do { if (IN((k) + 1)) xcd_barrier(bar); } while (0)
#define PH_LOCALS unsigned long long z_ = 0; asm volatile("" : "+s"(z_)); unsigned char* ws = a.ws + z_;     \
    int t_ = threadIdx.x; asm volatile("" : "+v"(t_)); int bx = blockIdx.x; asm volatile("" : "+s"(bx)); \
    const int vcu = (bx % 8) * (G / 8) + bx / 8; const int lane = t_ & 63, wave = __builtin_amdgcn_readfirstlane(t_ >> 6), gw = vcu * NWAVES + wave; (void)lane; (void)gw; (void)ws; (void)vcu;
template <int l> __device__ __forceinline__ void layer_phases(const MegaArgs& a, LAS unsigned char* lds, const XcdBarrier& bar, const int lo, const int hi) {
    constexpr int G = 256, ngw = G * NWAVES, pb = 1 + l * PL_COUNT;
        if (IN(pb + PL_PROJ)) { PH_LOCALS
            pg8::StaticOrder S; S.init(NT / 256, NP / 256, G, bx, 0);
            LAS float* rst = (LAS float*)(lds + TAB_OFF);
            { pg8::Unit u; const float* R1 = (const float*)(ws + WS_RSTD1);
              for (int i = 0; i < 4 && S.next(i, u); ++i) if (t_ < 256) rst[i * 256 + t_] = R1[u.pm * 256 + t_]; }
            __syncthreads();
            REPEAT(PL_PROJ) {
            pg8::Gemm g{(bf16*)(ws + WS_HB), (bf16*)(ws + WS_WIN), DM, DM, DM, nullptr};
            pg8::EpiProj E{(bf16*)(ws + WS_PROJ), (float*)(ws + WS_CQSS), (float*)(ws + WS_CKVSS), rst};
            pg8::gemm_phase<pg8::EpiProj, pg8::StaticOrder, true>(lds, g, S, E); }
            SEAM(pb + PL_PROJ);
        }
        if (IN(pb + PL_MLAUP)) { PH_LOCALS REPEAT(PL_MLAUP) {
            LAS float* rst = (LAS float*)(lds + TAB_OFF);
            { pg8::StaticOrder S; S.init(NT / 256, 3, G, bx, 0); pg8::Unit u; const float* SSQ = (const float*)(ws + WS_CQSS);
              for (int i = 0; i < 2 && S.next(i, u); ++i) if (t_ < 256) { const float4 p = *(const float4*)(SSQ + (size_t)(u.pm * 256 + t_) * 4); rst[i * 256 + t_] = rsqrtf((p.x + p.y + p.z + p.w) * (1.f / 256.f) + EPS); }
              __syncthreads();
              pg8::Gemm g{(bf16*)(ws + WS_PROJ) + C_CQ, (bf16*)(ws + WS_WUQ), 256, NP, 256, nullptr};
              typedef pg8::EpiMla<true, 576, 576> EQ; EQ E{(bf16*)(ws + WS_QB), rst};
              pg8::gemm_phase<EQ, pg8::StaticOrder, true>(lds, g, S, E); }
            __syncthreads();
            { pg8::StaticOrder S; S.init(NT / 256, 3, G, bx, 0); pg8::Unit u; const float* SSQ = (const float*)(ws + WS_CKVSS);
              for (int i = 0; i < 2 && S.next(i, u); ++i) if (t_ < 256) { const float4 p = *(const float4*)(SSQ + (size_t)(u.pm * 256 + t_) * 4); rst[i * 256 + t_] = rsqrtf((p.x + p.y + p.z + p.w) * (1.f / 128.f) + EPS); }
              __syncthreads();
              pg8::Gemm g{(bf16*)(ws + WS_PROJ) + C_CKV, (bf16*)(ws + WS_WUKV), 128, NP, 128, nullptr};
              typedef pg8::EpiMla<false, 768, 768> EK; EK E{(bf16*)(ws + WS_KV), rst};
              pg8::gemm_phase<EK, pg8::StaticOrder, true>(lds, g, S, E); } }
            SEAM(pb + PL_MLAUP);
        }
        if (IN(pb + PL_ATTN)) { PH_LOCALS
            REPEAT(PL_ATTN) { const att::AttnP P{(bf16*)(ws + WS_PROJ), (bf16*)(ws + WS_QB), (bf16*)(ws + WS_KV), (bf16*)(ws + WS_XN), (float*)(ws + WS_SS), a.na_rpb + (size_t)l * 4 * 15 * 31, a.swa_sink + l * 6}; att::attn_phase(P, lds, vcu); }
            SEAM(pb + PL_ATTN);
        }
        if (IN(pb + PL_OUT)) { PH_LOCALS
            pg8::StaticOrder S; S.init(NT / 256, DM / 256, G, bx, 0);
            LAS float* fac = (LAS float*)(lds + TAB_OFF);
            { pg8::Unit u; const float* SS = (const float*)(ws + WS_SS);
              for (int i = 0; i < 2 && S.next(i, u); ++i) if (t_ < 256) { const float4* ss4 = (const float4*)(SS + (size_t)(u.pm * 256 + t_) * 16); const float4 s0 = ss4[0], s1 = ss4[1], s2 = ss4[2], s3 = ss4[3];
                  const float ra = rsqrtf((s0.x + s0.y + s0.z + s0.w) * (1.f / 256.f) + EPS), rb = rsqrtf((s1.x + s1.y + s1.z + s1.w + s2.x + s2.y) * (1.f / 384.f) + EPS), rc = rsqrtf((s2.z + s2.w + s3.x + s3.y + s3.z + s3.w) * (1.f / 384.f) + EPS);
                  LAS float* f = fac + (i * 256 + t_) * 4; f[0] = ra / rb; f[1] = rb / rc; f[2] = rc; f[3] = 0.f; } }
            __syncthreads();
            pg8::Gemm g{(bf16*)(ws + WS_XN), (bf16*)(ws + WS_WOUT), DM, DM, DM, nullptr};
            pg8::EpiResid E{(bf16*)(ws + WS_HB), fac};
            pg8::gemm_phase<pg8::EpiResid, pg8::StaticOrder, true>(lds, g, S, E);
            SEAM(pb + PL_OUT);
        }
        if (IN(pb + PL_ROUTER)) { PH_LOCALS REPEAT(PL_ROUTER) ph_router(a, l, lds, gw, ngw, lane); SEAM(pb + PL_ROUTER); }
        if (IN(pb + PL_TOPK)) { PH_LOCALS ph_topk(ws, lds, bx, G); __syncthreads(); REPEAT(100) ph_prep(a, l, 0, lds, gw, ngw, wave, lane); SEAM(pb + PL_TOPK); }
        if (IN(pb + PL_MOE1)) { PH_LOCALS
            pg8::StaticOrder S; S.init(NSLOTS / 256, 8, G, bx, 16);
            LAS int* gidx = (LAS int*)(lds + TAB_OFF);
            LAS float* rst = (LAS float*)(lds + TAB_OFF + 8192);
            { pg8::Unit u; const int* IDX = (const int*)(ws + WS_IDX); const float* R2 = (const float*)(ws + WS_RSTD2);
              for (int i = 0; i < 8 && S.next(i, u); ++i) if (t_ < 256) { const int tok = IDX[u.pm * 256 + t_]; gidx[i * 256 + t_] = tok; rst[i * 256 + t_] = R2[tok]; } }
            __syncthreads();
            REPEAT(PL_MOE1) {
            pg8::Gemm g{(bf16*)(ws + WS_HB), (bf16*)(ws + WS_WGU), DM, DM, DM, gidx};
            pg8::EpiSwiglu E{(bf16*)(ws + WS_HID), rst};
            pg8::gemm_phase<pg8::EpiSwiglu, pg8::StaticOrder, true, true>(lds, g, S, E); }
            SEAM(pb + PL_MOE1);
        }
        if (IN(pb + PL_MOE2)) { PH_LOCALS
            pg8::StaticOrder S; S.init(NSLOTS / 256, 4, G, bx, 16); S.rev = 1;
            LAS float* gtab = (LAS float*)(lds + TAB_OFF);
            { pg8::Unit u; const float* GATE = (const float*)(ws + WS_GATE);
              for (int i = 0; i < 4 && S.next(i, u); ++i) if (t_ < 256) gtab[i * 256 + t_] = GATE[u.pm * 256 + t_]; }
            __syncthreads();
            REPEAT(PL_MOE2) {
            pg8::Gemm g{(bf16*)(ws + WS_HID), (bf16*)(ws + WS_WD), DM, DM, DM, nullptr};
            pg8::EpiGate E{(bf16*)(ws + WS_PROJ), gtab};
            pg8::gemm_phase<pg8::EpiGate, pg8::StaticOrder, true>(lds, g, S, E); }
            SEAM(pb + PL_MOE2);
        }
        if (IN(pb + PL_COMBINE)) { PH_LOCALS
            ph_combine(a, l, gw, ngw, lane);
            if (l + 1 < DEPTH) { __syncthreads(); ph_prep(a, l + 1, 1, lds, gw, ngw, wave, lane); }
            SEAM(pb + PL_COMBINE);
        }
}
__global__ void __launch_bounds__(NWAVES * 64, 2) mega(MegaArgs a) {
    extern __shared__ __attribute__((aligned(16))) unsigned char lds_raw[];
    LAS unsigned char* lds = (LAS unsigned char*)lds_raw;
    constexpr int G = 256;
    constexpr int ngw = G * NWAVES;
    for (int u = threadIdx.x; u < (LDS_BYTES - RING_BYTES) / 4; u += NWAVES * 64) ((LAS unsigned*)(lds + RING_BYTES))[u] = 0u;
    __syncthreads();
    XcdBarrier bar = xcd_barrier_post((unsigned*)(a.ws + WS_CTL) + CW_BAR, (volatile LAS unsigned*)(lds + MISC_OFF) + 8);
    const int lo = a.ph_lo, hi = a.ph_hi;
    if (IN(0)) { PH_LOCALS ph_prep(a, 0, 1, lds, gw, ngw, wave, lane); ph_norm_x(a, gw, ngw, lane); SEAM(0); }
    layer_phases<0>(a, lds, bar, lo, hi);
    layer_phases<1>(a, lds, bar, lo, hi);
    static_assert(DEPTH == 2, "two layers are written out");
}


#ifndef MK_PER_PHASE
#define MK_PER_PHASE 0
#endif
extern "C" void kernel_launch(void* const* d_in, const int* in_sizes, int n_in, void* d_out, int out_size, void* d_ws, size_t ws_size, hipStream_t stream) {
    if (n_in != 17 || out_size != NT * DM || ws_size < WS_END) { fprintf(stderr, "kernel_launch: unexpected shapes (n_in %d out %d ws %zu)\n", n_in, out_size, ws_size); return; }
    static int grid = 0;
    if (grid == 0) { int dev = 0, cus = 0; (void)hipGetDevice(&dev); (void)hipDeviceGetAttribute(&cus, hipDeviceAttributeMultiprocessorCount, dev);
        if (hipFuncSetAttribute((const void*)mega, hipFuncAttributeMaxDynamicSharedMemorySize, LDS_BYTES) != hipSuccess) fprintf(stderr, "hipFuncSetAttribute failed\n");
        if (cus != 256) fprintf(stderr, "kernel_launch: built for a 256-CU device (got %d CUs)\n", cus);
        grid = 256; }
    (void)hipMemsetAsync((char*)d_ws + WS_CTL, 0, 1 * MiB, stream);
    MegaArgs ma{};
    ma.x = (const float*)d_in[0]; ma.attn_norm = (const float*)d_in[1]; ma.w_in = (const float*)d_in[2]; ma.na_rpb = (const float*)d_in[3]; ma.q_norm = (const float*)d_in[4]; ma.w_uq = (const float*)d_in[5];
    ma.kv_norm = (const float*)d_in[6]; ma.w_ukv = (const float*)d_in[7]; ma.swa_sink = (const float*)d_in[8]; ma.group_norm = (const float*)d_in[9]; ma.w_out = (const float*)d_in[10]; ma.ffn_norm = (const float*)d_in[11];
    ma.w_router = (const float*)d_in[12]; ma.w_gate = (const float*)d_in[13]; ma.w_up = (const float*)d_in[14]; ma.w_down = (const float*)d_in[15]; ma.final_norm = (const float*)d_in[16];
    ma.out = (float*)d_out; ma.ws = (unsigned char*)d_ws;
#if MK_PER_PHASE
    for (int p = 0; p < N_PHASES; ++p) { ma.ph_lo = p; ma.ph_hi = p + 1; hipLaunchKernelGGL(mega, dim3(grid), dim3(NWAVES * 64), LDS_BYTES, stream, ma); }
#else
    ma.ph_lo = 0; ma.ph_hi = N_PHASES; hipLaunchKernelGGL(mega, dim3(grid), dim3(NWAVES * 64), LDS_BYTES, stream, ma);
#endif
}
```

```cpp
#include <hip/hip_runtime.h>
#include <cstdint>
#include <cstdio>

typedef unsigned short bf16;
constexpr int NB = 8, NS = 4096, DM = 1024, NT = NB * NS, NP = 2048, NE = 16, CAP = 512, DEPTH = 2;
constexpr int NSLOTS = NE * NB * CAP;
constexpr float LOG2E = 1.4426950408889634f;
constexpr float QS64 = 0.125f * LOG2E;
constexpr float QS96 = 0.10206207261596577f * LOG2E;
constexpr float EPS = 1e-6f;
constexpr int C_AQ = 0, C_AK = 256, C_AV = 512, C_CQ = 768, C_CKV = 1024, C_KR = 1152, C_SQ = 1184, C_SK = 1568, C_SV = 1696, C_END = 1824;

constexpr size_t MiB = 1u << 20;
constexpr size_t WS_CTL = 0;
constexpr size_t WS_COS64 = 1 * MiB, WS_SIN64 = WS_COS64 + 512 * 1024, WS_COS32 = 2 * MiB, WS_SIN32 = WS_COS32 + 256 * 1024;
constexpr size_t WS_WIN = 4 * MiB, WS_WUQ = 8 * MiB, WS_WUKV = 8 * MiB + 512 * 1024, WS_WOUT = 9 * MiB, WS_WGU = 12 * MiB, WS_WD = 76 * MiB;
constexpr size_t WS_CQSS = 108 * MiB, WS_CKVSS = WS_CQSS + 512 * 1024, WS_SS = 109 * MiB, WS_AFF = 111 * MiB, WS_INV = 113 * MiB, WS_IDX = 115 * MiB, WS_GATE = WS_IDX + 256 * 1024;
constexpr size_t WS_XN = 120 * MiB;
constexpr size_t WS_HB8 = WS_XN;
constexpr size_t WS_PROJ = 184 * MiB;
constexpr size_t WS_QB = 312 * MiB;
constexpr size_t WS_KV = 348 * MiB;
constexpr size_t WS_HID = 312 * MiB;
constexpr size_t WS_HB = 440 * MiB;
constexpr size_t WS_RSTD1 = 504 * MiB, WS_RSTD2 = WS_RSTD1 + 256 * 1024;
constexpr size_t WS_END = 505 * MiB;

__device__ __forceinline__ unsigned f2bf(float f) { unsigned u = __builtin_bit_cast(unsigned, f); return (u + 0x7fffu + ((u >> 16) & 1u)) >> 16; }
__device__ __forceinline__ float bf2f(unsigned short b) { return __builtin_bit_cast(float, (unsigned)b << 16); }
__device__ __forceinline__ float wave_sum(float v) {
#pragma unroll
    for (int o = 1; o < 64; o <<= 1) v += __shfl_xor(v, o);
    return v;
}

constexpr float W8_SCALE = 64.f, H8_SCALE = 8.f, Y8_SCALE = 64.f;
__device__ __forceinline__ float clamp8(float v) { return __builtin_amdgcn_fmed3f(v, -448.f, 448.f); }
__device__ __forceinline__ unsigned pk_fp8x4(float a, float b, float c, float d) { int w = 0; w = __builtin_amdgcn_cvt_pk_fp8_f32(clamp8(a), clamp8(b), w, false); w = __builtin_amdgcn_cvt_pk_fp8_f32(clamp8(c), clamp8(d), w, true); return (unsigned)w; }
enum { PK_WIN = 0, PK_WUQ = 1, PK_WUKV = 2, PK_WOUT = 3, PK_WGU = 4, PK_WD = 5 };
__device__ __forceinline__ int prep_map(int kind, int n, float& sc, int& which) {
    sc = 1.f; which = 0;
    switch (kind) {
    case PK_WIN:
        if (n < 256) { sc = QS64; return n; }
        if (n < C_KR) return n;
        if (n < C_SQ) { const int p = n - C_KR, g = p >> 3, e = p & 7; return C_KR + 4 * g + (e & 3) + 16 * (e >> 2); }
        if (n < C_SK) { const int p = n - C_SQ, h = p >> 6, pp = p & 63, g = pp >> 3, e = pp & 7; sc = QS64; return C_SQ + h * 64 + 4 * g + (e & 3) + 32 * (e >> 2); }
        if (n < C_SV) { const int p = n - C_SK, h = p >> 6, pp = p & 63, g = pp >> 3, e = pp & 7; return C_SK + h * 64 + 4 * g + (e & 3) + 32 * (e >> 2); }
        if (n < C_END) return n;
        return -1;
    case PK_WUQ:
        if (n < 576) { const int h = n / 96, d = n % 96; sc = QS96; if (d < 64) return n; const int p = d - 64, g = p >> 3, e = p & 7; return h * 96 + 64 + 4 * g + (e & 3) + 16 * (e >> 2); }
        return -1;
    case PK_WUKV:
        if (n < 384) { const int h = n >> 6, d = n & 63; return h * 128 + d; }
        { const int m = n - 384, h = m >> 6, d = m & 63; return h * 128 + 64 + d; }
    case PK_WGU: { const int pn = n >> 8, wc = (n >> 6) & 3, half = (n >> 5) & 1, j = n & 31; which = half; sc = W8_SCALE; return 128 * pn + 32 * wc + j; }
    case PK_WD: sc = W8_SCALE; return n;
    default: return n;
    }
}
#define LAS __attribute__((address_space(3)))
#define GAS __attribute__((address_space(1)))
namespace pg8 {
typedef short bf16x8 __attribute__((ext_vector_type(8)));
typedef float f32x4 __attribute__((ext_vector_type(4)));
typedef unsigned u32x4 __attribute__((ext_vector_type(4)));
constexpr int BM = 256, BK = 64, HALF = 128, HTB = HALF * BK * 2, STAGE_BYTES = 8 * HTB, NXCD = 8, WGM = 8;
__host__ __device__ __forceinline__ int lds_byte(int r, int c) { const int st = (r >> 4) * 2 + (c >> 5), rr = r & 15, cc = c & 31, ob = rr * 64 + cc * 2; return st * 1024 + (ob ^ (((ob >> 9) & 1) << 5)); }
__host__ __device__ __forceinline__ void stage_rc(int b, int& R, int& C) { const int st = b / 1024, sb = b % 1024, swz = sb ^ (((sb >> 9) & 1) << 5); R = (st >> 1) * 16 + swz / 64; C = (st & 1) * 32 + (swz % 64) / 2; }
__host__ __device__ __forceinline__ int perm32(int rho) { const int n = rho >> 4, i = rho & 15; return 8 * (i >> 2) + 4 * n + (i & 3); }
__host__ __device__ __forceinline__ int perm64(int rho) { const int n = rho >> 4, i = rho & 15; return 16 * (i >> 2) + 4 * n + (i & 3); }
struct Unit { int pm, pn, pb; };
struct Gemm { const bf16* A; const bf16* Bt; int K, lda, ldb; const LAS int* gidx; };
struct StaticOrder {
    int nM, nN, nwg, G, c, gm, rev = 0;
    __device__ __forceinline__ void init(int nM_, int nN_, int G_, int c_, int gm_) { nM = nM_; nN = nN_; nwg = nM * nN; G = G_; c = c_; gm = gm_; }
    __device__ __forceinline__ bool next(int i, Unit& u) const {
        const long L = (long)i * G + c; if (L >= nwg) return false;
        int wgid = (int)L; { const int q = nwg / NXCD, r = nwg % NXCD, xcd = wgid % NXCD, off = wgid / NXCD; wgid = (xcd < r ? xcd * (q + 1) : r * (q + 1) + (xcd - r) * q) + off; }
        const int nig = WGM * nN, gid = wgid / nig, fm = gid * WGM, gsz = (nM - fm) < WGM ? (nM - fm) : WGM;
        u.pm = fm + ((wgid % nig) % gsz); if (rev) u.pm = nM - 1 - u.pm; u.pn = (wgid % nig) / gsz; u.pb = gm ? (u.pm / gm) * nN + u.pn : u.pn; return true;
    }
};
__device__ __forceinline__ unsigned cvt_pk_bf16(float lo, float hi) { unsigned r; asm volatile("v_cvt_pk_bf16_f32 %0, %1, %2" : "=v"(r) : "v"(lo), "v"(hi)); return r; }

typedef int i32x8 __attribute__((ext_vector_type(8)));
typedef short s16x16 __attribute__((ext_vector_type(16)));
__device__ __forceinline__ i32x8 cat8(bf16x8 a, bf16x8 b) { return __builtin_bit_cast(i32x8, __builtin_shufflevector(a, b, 0, 1, 2, 3, 4, 5, 6, 7, 8, 9, 10, 11, 12, 13, 14, 15)); }
__device__ __forceinline__ void mfma8(f32x4& acc, i32x8 a, i32x8 b) { asm volatile("v_mfma_f32_16x16x128_f8f6f4 %0, %1, %2, %0" : "+v"(acc) : "v"(a), "v"(b)); }
template <class Epi, class Sched, bool ALIGN_EPI, bool GATHER = false, bool FP8 = false>
__device__ __forceinline__ void gemm_phase(LAS unsigned char* lds, const Gemm g, const Sched& S, const Epi& E, int tid_in) {
    int tid = tid_in; asm volatile("" : "+v"(tid));
    const int wid = __builtin_amdgcn_readfirstlane(tid >> 6), lane = tid & 63, wr = wid >> 2, wc = wid & 3, fr = lane & 15, fq = lane >> 4;
    const int K = g.K, nt = K / BK;
    unsigned vC[2][2], vNs[2][2], voffB[2]; int RA[2], CA[2];
    const size_t kstep = (size_t)(BK * 2);
    const size_t hstepA = (size_t)HALF * g.lda * 2, hstepB = (size_t)(Epi::PERM64 ? 8 : 32) * g.ldb * 2, tstepA = GATHER ? 0 : 2 * hstepA, tstepB = (size_t)BM * g.ldb * 2;
#pragma unroll
    for (int i = 0; i < 2; ++i) { int R, C; stage_rc(tid * 16 + i * 8192, R, C); const int Rb = 64 * (R >> 5) + (Epi::PERM64 ? perm64(R & 31) : (Epi::PERM ? perm32(R & 31) : (R & 31))); RA[i] = R; CA[i] = C;
        voffB[i] = (unsigned)(Rb * g.ldb + C) * 2u;
#pragma unroll
        for (int h = 0; h < 2; ++h) { vC[h][i] = GATHER ? ((unsigned)g.gidx[h * HALF + R] * (unsigned)(g.lda * 2) + (unsigned)C * 2u) : ((unsigned)(R * g.lda + C) * 2u + (unsigned)(h * hstepA)); vNs[h][i] = vC[h][i]; } }
    unsigned (&vN)[2][2] = GATHER ? vNs : vC;
    const unsigned ldsw = (unsigned)wid * 1024u;
    const int aoff = lds_byte(wr * 64 + fr, fq * 8), boff = lds_byte(wc * 32 + fr, fq * 8);
#define PG8_SA(b, h) (((b) * 2 + (h)) * HTB)
#define PG8_SB(b, h) ((4 + (b) * 2 + (h)) * HTB)
#define PG8_STAGE(bufoff, gbase, voff) do { _Pragma("unroll") for (int _i = 0; _i < 2; ++_i) \
        __builtin_amdgcn_global_load_lds((const unsigned*)((const char*)(gbase) + (voff)[_i]), (LAS unsigned*)(lds + (bufoff) + ldsw + _i * 8192), 16, 0, 0); } while (0)
#define PG8_STAGEA(bufoff, gbase, V, h) do { _Pragma("unroll") for (int _i = 0; _i < 2; ++_i) \
        __builtin_amdgcn_global_load_lds((const unsigned*)((const char*)(gbase) + (V)[h][_i]), (LAS unsigned*)(lds + (bufoff) + ldsw + _i * 8192), 16, 0, 0); } while (0)
#define PG8_STAGEAL(bufoff, gbase, h) do { _Pragma("unroll") for (int _i = 0; _i < 2; ++_i) { const unsigned _v = (GATHER && last) ? vN[h][_i] : vC[h][_i]; \
        __builtin_amdgcn_global_load_lds((const unsigned*)((const char*)(gbase) + _v), (LAS unsigned*)(lds + (bufoff) + ldsw + _i * 8192), 16, 0, 0); } } while (0)
#define PG8_LDA(dst, b, h) do { _Pragma("unroll") for (int m = 0; m < 4; ++m) _Pragma("unroll") for (int k = 0; k < 2; ++k) dst[m][k] = *(const LAS bf16x8*)(lds + PG8_SA(b, h) + aoff + m * 2048 + k * 1024); } while (0)
#define PG8_LDB(dst, b, h) do { _Pragma("unroll") for (int n = 0; n < 2; ++n) _Pragma("unroll") for (int k = 0; k < 2; ++k) dst[n][k] = *(const LAS bf16x8*)(lds + PG8_SB(b, h) + boff + n * 2048 + k * 1024); } while (0)
#define PG8_MMA(ai, bj, At, Bt) do { __builtin_amdgcn_s_setprio(1); _Pragma("unroll") for (int m = 0; m < 4; ++m) _Pragma("unroll") for (int n = 0; n < 2; ++n) { \
        if constexpr (FP8) mfma8(acc[ai][bj][m][n], cat8(Bt[n][0], Bt[n][1]), cat8(At[m][0], At[m][1])); \
        else { _Pragma("unroll") for (int k = 0; k < 2; ++k) acc[ai][bj][m][n] = __builtin_amdgcn_mfma_f32_16x16x32_bf16(Bt[n][k], At[m][k], acc[ai][bj][m][n], 0, 0, 0); } } __builtin_amdgcn_s_setprio(0); } while (0)
#define PG8_WAIT_V(n) asm volatile("s_waitcnt vmcnt(" #n ")" ::: "memory")
#define PG8_WAIT_L(n) asm volatile("s_waitcnt lgkmcnt(" #n ")" ::: "memory")
#define PG8_BAR __builtin_amdgcn_s_barrier()
#define PG8_SCHED __builtin_amdgcn_sched_barrier(0)
    Unit cur, nxt; int ui = 0;
    if (!S.next(0, cur)) return;
    f32x4 acc[2][2][4][2];
#pragma unroll
    for (int a = 0; a < 2; ++a)
#pragma unroll
        for (int b = 0; b < 2; ++b)
#pragma unroll
            for (int m = 0; m < 4; ++m)
#pragma unroll
                for (int n = 0; n < 2; ++n) acc[a][b][m][n] = (f32x4){0.f, 0.f, 0.f, 0.f};
    bf16x8 At[4][2], B0[2][2], B1[2][2];
    const char* cA = (const char*)g.A + (size_t)cur.pm * tstepA; const char* cB = (const char*)g.Bt + (size_t)cur.pb * tstepB;
    PG8_STAGE(PG8_SB(0, 0), cB, voffB); PG8_STAGE(PG8_SB(0, 1), cB + hstepB, voffB); PG8_STAGEA(PG8_SA(0, 0), cA, vC, 0); PG8_STAGEA(PG8_SA(0, 1), cA, vC, 1);
    if (wr == 1) PG8_BAR;
    PG8_WAIT_V(2); PG8_BAR;
    PG8_STAGE(PG8_SB(1, 0), cB + kstep, voffB); PG8_STAGEA(PG8_SA(1, 0), cA + kstep, vC, 0); PG8_STAGE(PG8_SB(1, 1), cB + hstepB + kstep, voffB);
    PG8_WAIT_V(6); PG8_BAR;
    for (;;) {
        const bool has_next = S.next(ui + 1, nxt);
        if (GATHER && has_next) {
#pragma unroll
            for (int i = 0; i < 2; ++i)
#pragma unroll
                for (int h = 0; h < 2; ++h) vNs[h][i] = (unsigned)g.gidx[(ui + 1) * BM + h * HALF + RA[i]] * (unsigned)(g.lda * 2) + (unsigned)CA[i] * 2u; }
        const char* nA = has_next ? (const char*)g.A + (size_t)nxt.pm * tstepA : cA; const char* nB = has_next ? (const char*)g.Bt + (size_t)nxt.pb * tstepB : cB;
#pragma unroll 1
        for (int t = 0; t < nt; t += 2) {
            const bool last = (t == nt - 2);
            const char* a1 = cA + (size_t)(t + 1) * kstep;
            const char* a2 = last ? nA : cA + (size_t)(t + 2) * kstep; const char* b2 = last ? nB : cB + (size_t)(t + 2) * kstep;
            const char* a3 = a2 + kstep; const char* b3 = b2 + kstep;
            PG8_LDB(B0, 0, 0); PG8_LDB(B1, 0, 1); PG8_SCHED; PG8_LDA(At, 0, 0); PG8_STAGEA(PG8_SA(1, 1), a1, vC, 1);
            PG8_WAIT_V(8); PG8_WAIT_L(0); PG8_BAR; PG8_MMA(0, 0, At, B0); PG8_MMA(0, 1, At, B1); PG8_BAR; PG8_SCHED;
            PG8_LDA(At, 0, 1); PG8_STAGE(PG8_SB(0, 0), b2, voffB); PG8_STAGE(PG8_SB(0, 1), b2 + hstepB, voffB); PG8_STAGEAL(PG8_SA(0, 0), a2, 0);
            PG8_WAIT_V(8); PG8_WAIT_L(0); PG8_BAR; PG8_MMA(1, 0, At, B0); PG8_MMA(1, 1, At, B1); PG8_BAR; PG8_SCHED;
            PG8_LDB(B0, 1, 0); PG8_LDB(B1, 1, 1); PG8_SCHED; PG8_LDA(At, 1, 0); PG8_STAGEAL(PG8_SA(0, 1), a2, 1);
            PG8_WAIT_V(8); PG8_WAIT_L(0); PG8_BAR; PG8_MMA(0, 0, At, B0); PG8_MMA(0, 1, At, B1); PG8_BAR; PG8_SCHED;
            PG8_LDA(At, 1, 1); PG8_STAGE(PG8_SB(1, 0), b3, voffB); PG8_STAGE(PG8_SB(1, 1), b3 + hstepB, voffB); PG8_STAGEAL(PG8_SA(1, 0), a3, 0);
            PG8_WAIT_V(8); PG8_WAIT_L(0); PG8_BAR; PG8_MMA(1, 0, At, B0); PG8_MMA(1, 1, At, B1); PG8_BAR; PG8_SCHED;
            if constexpr (Epi::KHOOK) { if (t == 2 || t == 8) { asm volatile("" ::: "memory"); E.khook(acc, ui, t == 2 ? 0 : 1, wr, fr); asm volatile("" ::: "memory"); } }
        }
        if constexpr (FP8) asm volatile("s_nop 15\n\ts_nop 15" ::: "memory");
        if constexpr (ALIGN_EPI) { if (wr == 0) PG8_BAR; }
        { int t2 = tid_in; asm volatile("" : "+v"(t2)); E(acc, cur, wr, wc, t2 & 15, (t2 >> 4) & 3, ui); }
        if (!has_next) break;
#pragma unroll
        for (int a = 0; a < 2; ++a)
#pragma unroll
            for (int b = 0; b < 2; ++b)
#pragma unroll
                for (int m = 0; m < 4; ++m)
#pragma unroll
                    for (int n = 0; n < 2; ++n) acc[a][b][m][n] = (f32x4){0.f, 0.f, 0.f, 0.f};
        cur = nxt; cA = nA; cB = nB; ++ui;
        if (GATHER) {
#pragma unroll
            for (int i = 0; i < 2; ++i)
#pragma unroll
                for (int h = 0; h < 2; ++h) vC[h][i] = vNs[h][i]; }
        if constexpr (ALIGN_EPI) { if (wr == 1) PG8_BAR; }
    }
    PG8_WAIT_V(0);
    if constexpr (!ALIGN_EPI) { if (wr == 0) PG8_BAR; }
    PG8_BAR;
#undef PG8_SA
#undef PG8_SB
#undef PG8_STAGE
#undef PG8_STAGEA
#undef PG8_STAGEAL
#undef PG8_LDA
#undef PG8_LDB
#undef PG8_MMA
#undef PG8_WAIT_V
#undef PG8_WAIT_L
#undef PG8_BAR
#undef PG8_SCHED
}

typedef const f32x4 (&AccRef)[2][2][4][2];
template <int DIM> __device__ __forceinline__ void rope_cs(int pos, int j0, f32x4& c, f32x4& s) {
    constexpr float KEXP = 13.287712379549449f * 2.f / DIM;
#pragma unroll
    for (int e = 0; e < 4; ++e) { const float inv = __builtin_amdgcn_exp2f(-(float)(j0 + e) * KEXP), ang = (float)pos * inv, rev = ang * 0.15915494309189535f, fr = __builtin_amdgcn_fractf(rev);
        c[e] = __builtin_amdgcn_cosf(fr); s[e] = __builtin_amdgcn_sinf(fr); }
}
__device__ __forceinline__ void st_bf16x8(bf16* p, f32x4 v0, f32x4 v1) { u32x4 w; w.x = cvt_pk_bf16(v0[0], v0[1]); w.y = cvt_pk_bf16(v0[2], v0[3]); w.z = cvt_pk_bf16(v1[0], v1[1]); w.w = cvt_pk_bf16(v1[2], v1[3]); *(u32x4*)p = w; }
struct EpiProj {
    static constexpr bool PERM = true, PERM64 = false, KHOOK = false;
    bf16* P; float *cqss, *ckvss; const LAS float* rs;
    __device__ __forceinline__ void operator()(AccRef acc, const Unit& u, int wr, int wc, int fr, int fq, int ui) const {
#pragma unroll
        for (int ai = 0; ai < 2; ++ai)
#pragma unroll
            for (int m = 0; m < 4; ++m) { const int row = u.pm * BM + ai * HALF + wr * 64 + m * 16 + fr; const int pos = row & (NS - 1); float ssq = 0.f; const float rsv = rs[ui * BM + ai * HALF + wr * 64 + m * 16 + fr];
#pragma unroll
                for (int bj = 0; bj < 2; ++bj) { const int cw = u.pn * BM + wc * 64 + bj * 32, col0 = cw + 8 * fq; f32x4 v0 = acc[ai][bj][m][0] * rsv, v1 = acc[ai][bj][m][1] * rsv;
                    if (cw >= C_SQ && cw < C_SV) { const int g = ((col0 - C_SQ) & 63) >> 3; f32x4 c, s; rope_cs<64>(pos, 4 * g, c, s);
                        const f32x4 o0 = v0 * c - v1 * s, o1 = v1 * c + v0 * s; v0 = o0; v1 = o1; }
                    else if (cw == C_KR) { f32x4 c, s; rope_cs<32>(pos, 4 * fq, c, s);
                        const f32x4 o0 = v0 * c - v1 * s, o1 = v1 * c + v0 * s; v0 = o0; v1 = o1; }
                    if (cw >= C_CQ && cw < C_KR) ssq += (v0[0] * v0[0] + v0[1] * v0[1]) + (v0[2] * v0[2] + v0[3] * v0[3]) + (v1[0] * v1[0] + v1[1] * v1[1]) + (v1[2] * v1[2] + v1[3] * v1[3]);
                    st_bf16x8(P + (size_t)row * NP + col0, v0, v1); }
                if (u.pn == 3 || u.pn == 4) { ssq += __shfl_xor(ssq, 16); ssq += __shfl_xor(ssq, 32); if (fq == 0) (u.pn == 3 ? cqss : ckvss)[(size_t)row * 4 + wc] = ssq; }
            }
    }
};
template <bool QMODE, int ldc, int ncols> struct EpiMla {
    static constexpr bool PERM = true, PERM64 = false, KHOOK = false;
    bf16* O; const LAS float* rs;
    __device__ __forceinline__ void operator()(AccRef acc, const Unit& u, int wr, int wc, int fr, int fq, int ui) const {
#pragma unroll
        for (int ai = 0; ai < 2; ++ai)
#pragma unroll
            for (int m = 0; m < 4; ++m) { const int row = u.pm * BM + ai * HALF + wr * 64 + m * 16 + fr; const int pos = row & (NS - 1);
                const float rsv = rs[ui * BM + ai * HALF + wr * 64 + m * 16 + fr];
#pragma unroll
                for (int bj = 0; bj < 2; ++bj) { const int cw = u.pn * BM + wc * 64 + bj * 32, col0 = cw + 8 * fq; if (cw >= ncols) continue;
                    f32x4 v0 = acc[ai][bj][m][0] * rsv, v1 = acc[ai][bj][m][1] * rsv;
                    if (QMODE && (cw % 96) == 64) { f32x4 c, s; rope_cs<32>(pos, 4 * fq, c, s);
                        const f32x4 o0 = v0 * c - v1 * s, o1 = v1 * c + v0 * s; v0 = o0; v1 = o1; }
                    st_bf16x8(O + (size_t)row * ldc + col0, v0, v1); }
                asm volatile("" ::: "memory"); }
    }
};
struct EpiResid {
    static constexpr bool PERM = true, PERM64 = false, KHOOK = true;
    bf16* HB; const LAS float* fac;
    __device__ __forceinline__ void khook(f32x4 (&acc)[2][2][4][2], int ui, int which, int wr, int fr) const {
#pragma unroll
        for (int ai = 0; ai < 2; ++ai)
#pragma unroll
            for (int m = 0; m < 4; ++m) { const float f = fac[(ui * BM + ai * HALF + wr * 64 + m * 16 + fr) * 4 + which];
#pragma unroll
                for (int bj = 0; bj < 2; ++bj)
#pragma unroll
                    for (int n = 0; n < 2; ++n) acc[ai][bj][m][n] *= f; }
    }
    __device__ __forceinline__ void operator()(AccRef acc, const Unit& u, int wr, int wc, int fr, int fq, int ui) const {
#pragma unroll
        for (int ai = 0; ai < 2; ++ai)
            { u32x4 wv[4][2];
#pragma unroll
              for (int m = 0; m < 4; ++m)
#pragma unroll
                  for (int bj = 0; bj < 2; ++bj) wv[m][bj] = *(const u32x4*)(HB + (size_t)(u.pm * BM + ai * HALF + wr * 64 + m * 16 + fr) * DM + u.pn * BM + wc * 64 + 8 * fq + bj * 32);
#pragma unroll
            for (int m = 0; m < 4; ++m) { const int rl = ai * HALF + wr * 64 + m * 16 + fr; const float f = fac[(ui * BM + rl) * 4 + 2]; bf16* p = HB + (size_t)(u.pm * BM + rl) * DM + u.pn * BM + wc * 64 + 8 * fq;
#pragma unroll
                for (int bj = 0; bj < 2; ++bj) { const u32x4 w = wv[m][bj]; f32x4 h0, h1;
                    h0[0] = __builtin_bit_cast(float, w[0] << 16); h0[1] = __builtin_bit_cast(float, w[0] & 0xffff0000u); h0[2] = __builtin_bit_cast(float, w[1] << 16); h0[3] = __builtin_bit_cast(float, w[1] & 0xffff0000u);
                    h1[0] = __builtin_bit_cast(float, w[2] << 16); h1[1] = __builtin_bit_cast(float, w[2] & 0xffff0000u); h1[2] = __builtin_bit_cast(float, w[3] << 16); h1[3] = __builtin_bit_cast(float, w[3] & 0xffff0000u);
                    st_bf16x8(p + bj * 32, h0 + acc[ai][bj][m][0] * f, h1 + acc[ai][bj][m][1] * f); } } }
    }
};
struct EpiSwiglu {
    static constexpr bool PERM = true, PERM64 = false, KHOOK = false;
    unsigned char* Hd; const LAS float* rs;
    __device__ __forceinline__ void operator()(AccRef acc, const Unit& u, int wr, int wc, int fr, int fq, int ui) const {
#pragma unroll
        for (int ai = 0; ai < 2; ++ai)
#pragma unroll
            for (int m = 0; m < 4; ++m) { const size_t row = (size_t)(u.pm * BM + ai * HALF + wr * 64 + m * 16 + fr); f32x4 o[2]; const float rsv = rs[ui * BM + ai * HALF + wr * 64 + m * 16 + fr];
                const float k1 = -rsv * LOG2E, k2 = rsv * rsv * H8_SCALE;
#pragma unroll
                for (int n = 0; n < 2; ++n) { const f32x4 ag = acc[ai][0][m][n], au = acc[ai][1][m][n]; const f32x4 arg = ag * k1; f32x4 den;
#pragma unroll
                    for (int e = 0; e < 4; ++e) den[e] = __builtin_amdgcn_exp2f(arg[e]);
                    den = den + 1.f; f32x4 sg;
#pragma unroll
                    for (int e = 0; e < 4; ++e) sg[e] = __builtin_amdgcn_rcpf(den[e]);
                    o[n] = ((ag * au) * k2) * sg; }
                *(uint2*)(Hd + row * DM + u.pn * HALF + wc * 32 + 8 * fq) = make_uint2(pk_fp8x4(o[0][0], o[0][1], o[0][2], o[0][3]), pk_fp8x4(o[1][0], o[1][1], o[1][2], o[1][3])); }
    }
};
struct EpiGate {
    static constexpr bool PERM = true, PERM64 = true, KHOOK = false; static constexpr int NST = 8;
    unsigned char* Y; const LAS float* gate;
    __device__ __forceinline__ void operator()(AccRef acc, const Unit& u, int wr, int wc, int fr, int fq, int ui) const {
#pragma unroll
        for (int ai = 0; ai < 2; ++ai)
#pragma unroll
            for (int m = 0; m < 4; ++m) { const size_t row = (size_t)(u.pm * BM + ai * HALF + wr * 64 + m * 16 + fr); const float gt = gate[ui * BM + ai * HALF + wr * 64 + m * 16 + fr];
                const f32x4 a0 = acc[ai][0][m][0] * gt, a1 = acc[ai][0][m][1] * gt, b0 = acc[ai][1][m][0] * gt, b1 = acc[ai][1][m][1] * gt; u32x4 w;
                w.x = pk_fp8x4(a0[0], a0[1], a0[2], a0[3]); w.y = pk_fp8x4(a1[0], a1[1], a1[2], a1[3]); w.z = pk_fp8x4(b0[0], b0[1], b0[2], b0[3]); w.w = pk_fp8x4(b1[0], b1[1], b1[2], b1[3]);
                *(u32x4*)(Y + row * DM + u.pn * BM + wc * 64 + 16 * fq) = w; }
    }
};
}


namespace att {
typedef short bf16x8 __attribute__((ext_vector_type(8)));
typedef short s16x4 __attribute__((ext_vector_type(4)));
typedef float f32x16 __attribute__((ext_vector_type(16)));
typedef float f32x4 __attribute__((ext_vector_type(4)));
typedef unsigned u32x4 __attribute__((ext_vector_type(4)));
typedef float f32x2_t __attribute__((ext_vector_type(2))); typedef __bf16 bf16x2_t __attribute__((ext_vector_type(2)));
typedef short v4i16_t __attribute__((ext_vector_type(4)));
constexpr int KSLOT = 12288, VSLOT = 8192, NSL = 3;
constexpr int L_K = 0, L_V = NSL * KSLOT, L_WS = L_V + NSL * VSLOT, L_OST = L_WS + 8 * 256, L_BIAS = L_OST + 8 * 4096, L_END = L_BIAS + 2048;
constexpr float THR = 8.f;
constexpr int ATT_PROBE = 0;
constexpr bool LSUM_MFMA = true;
__device__ __forceinline__ int crow(int r, int hi) { return (r & 3) + 8 * (r >> 2) + 4 * hi; }
__device__ __forceinline__ unsigned cvtpk(float lo, float hi) { f32x2_t v = {lo, hi}; bf16x2_t b = __builtin_convertvector(v, bf16x2_t); return __builtin_bit_cast(unsigned, b); }
__device__ __forceinline__ s16x4 vtr(const LAS unsigned char* p) { return __builtin_bit_cast(s16x4, __builtin_amdgcn_ds_read_tr16_b64_v4i16((LAS v4i16_t*)p)); }
__device__ __forceinline__ void glds(const bf16* src, unsigned lds_dst) { unsigned keep;
    asm volatile("s_mov_b32 %0, m0\n\ts_mov_b32 m0, %2\n\ts_nop 0\n\tglobal_load_lds_dwordx4 %1, off\n\ts_mov_b32 m0, %0" : "=&s"(keep) : "v"(src), "s"(lds_dst) : "memory"); }
struct AttnP { const bf16 *PROJ, *QB, *KV; bf16* O; float* SS; const float* rpb; const float* sink; };
#define ATT_WAIT_BAR() do { if (PROBE != 3) asm volatile("s_waitcnt vmcnt(0) lgkmcnt(0)\n\ts_barrier" ::: "memory"); } while (0)

template <int TYPE, int PROBE = 0> __device__ __forceinline__ void attn_unit(const AttnP& P, int b, int h, int qb, LAS unsigned char* lds, int tid_in) {
    constexpr int ND0 = (TYPE == 1) ? 6 : 4;
    int tid = tid_in; asm volatile("" : "+v"(tid));
    const int lane = tid & 63, r32 = lane & 31, hi = lane >> 5, wid = __builtin_amdgcn_readfirstlane(tid >> 6);
    const bool ordA = wid < 4;
    const int q0 = qb * 256, qw0 = q0 + wid * 32; const size_t tokb = (size_t)b * NS;
    int ntile, kbase, ta, tb;
    if (TYPE == 1) { ntile = NS / 64; kbase = 0; ta = 0; tb = ntile - 1; }
    else if (TYPE == 2) { kbase = max(q0 - 128, 0); const int ke = min(q0 + 384, NS); ntile = (ke - kbase) >> 6; ta = max(qw0 - 128 - kbase, 0) >> 6; tb = min(ntile - 1, (qw0 + 159 - kbase) >> 6); }
    else { const int r0 = qb * 4; kbase = min(max(r0 - 4, 0), 56); ntile = min(max(r0 - 1, 0), 56) + 7 - kbase + 1; const int r = r0 + (wid >> 1); ta = min(max(r - 4, 0), 56) - kbase; tb = ta + 7; }
    const int kvh = (TYPE == 2) ? h / 3 : h;
    const bf16 *ksrc, *ksrc2 = nullptr, *vsrc; size_t kpitch, vpitch;
    { const size_t key0 = tokb + (TYPE == 0 ? (size_t)kbase * 64 : (size_t)kbase); const int vrow = 16 * (wid & 3) + (lane >> 2), vcol = (wid >> 2) * 32 + (lane & 3) * 8;
      if (TYPE == 0) { ksrc = P.PROJ + (key0 + lane) * NP + C_AK + h * 64 + wid * 8; vsrc = P.PROJ + (key0 + vrow) * NP + C_AV + h * 64 + vcol; kpitch = vpitch = NP; }
      else if (TYPE == 1) { ksrc = P.KV + (key0 + lane) * 768 + h * 64 + wid * 8; ksrc2 = P.PROJ + (key0 + lane) * NP + C_KR + (wid & 3) * 8; vsrc = P.KV + (key0 + vrow) * 768 + 384 + h * 64 + vcol; kpitch = vpitch = 768; }
      else { ksrc = P.PROJ + (key0 + lane) * NP + C_SK + kvh * 64 + wid * 8; vsrc = P.PROJ + (key0 + vrow) * NP + C_SV + kvh * 64 + vcol; kpitch = vpitch = NP; } }
    const unsigned kdst = (unsigned)(uintptr_t)(lds + L_K) + wid * 1024, vdst = (unsigned)(uintptr_t)(lds + L_V) + wid * 1024;
#define ATT_DMA(t, slot) do { if (PROBE == 2 || PROBE == 3) break; glds(ksrc + (size_t)(t) * 64 * kpitch, (unsigned)__builtin_amdgcn_readfirstlane(kdst + (slot) * KSLOT)); if (TYPE == 1 && wid < 4) glds(ksrc2 + (size_t)(t) * 64 * NP, (unsigned)__builtin_amdgcn_readfirstlane(kdst + (slot) * KSLOT + 8192)); \
        glds(vsrc + (size_t)(t) * 64 * vpitch, (unsigned)__builtin_amdgcn_readfirstlane(vdst + (slot) * VSLOT)); } while (0)
    LAS float* biasL = (LAS float*)(lds + L_BIAS);
    if (TYPE == 0) { for (int i = tid; i < 15 * 31; i += 512) biasL[i] = P.rpb[h * 465 + i] * LOG2E; }
    bf16x8 qr[ND0];
    { const bf16* qp = (TYPE == 1) ? P.QB + (tokb + qw0 + r32) * 576 + h * 96 : P.PROJ + (tokb + qw0 + r32) * NP + (TYPE == 0 ? C_AQ : C_SQ) + h * 64;
#pragma unroll
      for (int d0 = 0; d0 < ND0; ++d0) qr[d0] = *(const bf16x8*)(qp + d0 * 16 + hi * 8); }
    LAS float* wsf = (LAS float*)(lds + L_WS) + wid * 64;
    float m = (TYPE == 2) ? P.sink[h] * LOG2E : 0.f;
    f32x16 negm; { const float nm = -m;
#pragma unroll
      for (int r = 0; r < 16; ++r) negm[r] = nm; }
    f32x16 o[2]; o[0] = f32x16{}; o[1] = f32x16{};
    f32x16 lacc;
    { const float l0 = (TYPE == 2) ? 1.f : 0.f;
#pragma unroll
      for (int r = 0; r < 16; ++r) lacc[r] = l0; }
    float lsum = (TYPE == 2 && hi == 0) ? 1.f : 0.f;
    const bf16x8 ones = (bf16x8){0x3F80, 0x3F80, 0x3F80, 0x3F80, 0x3F80, 0x3F80, 0x3F80, 0x3F80};
    f32x16 sA0, sA1, sB0, sB1;
#define ATT_QK(X0, X1, tt, sl) do { const LAS unsigned char* Kp = lds + L_K + (sl) * KSLOT + hi * 1024 + r32 * 16; X0 = negm; X1 = negm; \
        bf16x8 ka0 = *(const LAS bf16x8*)(Kp), ka1 = *(const LAS bf16x8*)(Kp + 512); \
        _Pragma("unroll") for (int d0 = 0; d0 < ND0; ++d0) { bf16x8 kb0 = ka0, kb1 = ka1; \
            if (d0 + 1 < ND0) { kb0 = *(const LAS bf16x8*)(Kp + (d0 + 1) * 2048); kb1 = *(const LAS bf16x8*)(Kp + (d0 + 1) * 2048 + 512); }     \
            X0 = __builtin_amdgcn_mfma_f32_32x32x16_bf16(ka0, qr[d0], X0, 0, 0, 0); X1 = __builtin_amdgcn_mfma_f32_32x32x16_bf16(ka1, qr[d0], X1, 0, 0, 0); ka0 = kb0; ka1 = kb1; } \
        __builtin_amdgcn_sched_group_barrier(0x100, 2, 0); __builtin_amdgcn_sched_group_barrier(0x100, 2, 0);        \
        _Pragma("unroll") for (int d0 = 0; d0 + 2 < ND0; ++d0) { __builtin_amdgcn_sched_group_barrier(0x8, 2, 0); __builtin_amdgcn_sched_group_barrier(0x100, 2, 0); } \
        __builtin_amdgcn_sched_group_barrier(0x8, 2, 0); __builtin_amdgcn_sched_group_barrier(0x8, 2, 0); \
        if (TYPE == 2) { const int dq = qw0 + r32 - (kbase + (tt) * 64) - 4 * hi; \
            _Pragma("unroll") for (int r = 0; r < 16; ++r) { const int d0_ = dq - ((r & 3) + 8 * (r >> 2)), d1_ = d0_ - 32; \
                if (d0_ > 128 || d0_ < -128) X0[r] = -INFINITY; if (d1_ > 128 || d1_ < -128) X1[r] = -INFINITY; } } \
        if (TYPE == 0) { const int c = (wid & 1) * 32 + r32, cs = min(max(c - 8, 0), 48); const int rq = qb * 4 + (wid >> 1), kr = kbase + (tt); const LAS float* brow = biasL + (kr - rq + 7) * 31 + 15 - c; \
            _Pragma("unroll") for (int rr = 0; rr < 16; ++rr) { const int kc0 = crow(rr, hi), kc1 = kc0 + 32; \
                const bool v0 = kc0 >= cs && kc0 < cs + 16, v1 = kc1 >= cs && kc1 < cs + 16; \
                X0[rr] = v0 ? X0[rr] + brow[v0 ? kc0 : c] : -INFINITY; X1[rr] = v1 ? X1[rr] + brow[v1 ? kc1 : c] : -INFINITY; } } \
        asm volatile("s_nop 15\n\ts_nop 7" : "+v"(X0), "+v"(X1)); } while (0)
#define ATT_MAX3(a, b, c) ({ float r_; asm("v_max3_f32 %0, %1, %2, %3" : "=v"(r_) : "v"(a), "v"(b), "v"(c)); r_; })
#define ATT_STEP(ORDA, C0, C1, N0, N1, t) do { \
        if ((t) + 1 < ntile) ATT_WAIT_BAR(); \
        if ((t) + 2 < ntile) ATT_DMA((t) + 2, sl_nn); \
        const bool act = ((t) >= ta && (t) <= tb), nact = ((t) + 1 >= ta && (t) + 1 <= tb); \
        if (ORDA && nact) ATT_QK(N0, N1, (t) + 1, sl_nxt); \
        if (act) { \
            float ma = 0.f, mb = 0.f; if (PROBE != 4) { ma = ATT_MAX3(C0[0], C0[1], C1[0]); mb = ATT_MAX3(C0[2], C0[3], C1[1]); ma = ATT_MAX3(ma, C1[2], C1[3]); \
            _Pragma("unroll") for (int r = 4; r < 16; r += 4) { ma = ATT_MAX3(ma, C0[r], C0[r + 1]); mb = ATT_MAX3(mb, C0[r + 2], C0[r + 3]); ma = ATT_MAX3(ma, C1[r], C1[r + 1]); mb = ATT_MAX3(mb, C1[r + 2], C1[r + 3]); } } \
            float rm = fmaxf(ma, mb); \
            { auto rr = __builtin_amdgcn_permlane32_swap(__float_as_uint(rm), __float_as_uint(rm), false, false); rm = fmaxf(__uint_as_float(rr[0]), __uint_as_float(rr[1])); } \
            const bool first = (TYPE != 2) && ((t) == ta); \
            if (first || __any(rm > THR)) { const float dl = first ? rm : fmaxf(rm, 0.f), f = first ? 1.f : __builtin_amdgcn_exp2f(-dl); m += dl; lsum *= f; \
                _Pragma("unroll") for (int r = 0; r < 16; ++r) { C0[r] -= dl; C1[r] -= dl; negm[r] = -m; } \
                if (ORDA && nact) { _Pragma("unroll") for (int r = 0; r < 16; ++r) { N0[r] -= dl; N1[r] -= dl; } } \
                if (hi == 0) wsf[r32] = f; \
                _Pragma("unroll") for (int g = 0; g < 4; ++g) { const f32x4 fv = *(const LAS f32x4*)(wsf + 8 * g + 4 * hi); \
                    _Pragma("unroll") for (int e = 0; e < 4; ++e) { o[0][4 * g + e] *= fv[e]; o[1][4 * g + e] *= fv[e]; lacc[4 * g + e] *= fv[e]; } } } \
            const LAS unsigned char* Vp = lds + L_V + sl_cur * VSLOT + ((lane >> 4) & 1) * 32 + (lane & 3) * 8 + (4 * hi + ((lane & 15) >> 2)) * 64; \
            s16x4 va[4], vb[4]; \
            va[0] = vtr(Vp); va[1] = vtr(Vp + 512); va[2] = vtr(Vp + 4096); va[3] = vtr(Vp + 4096 + 512);        \
            if (PROBE != 4) { _Pragma("unroll") for (int r = 0; r < 16; ++r) { C0[r] = __builtin_amdgcn_exp2f(C0[r]); C1[r] = __builtin_amdgcn_exp2f(C1[r]); } } \
            if (!LSUM_MFMA) { float sa = 0.f, sb = 0.f; _Pragma("unroll") for (int r = 0; r < 16; ++r) { sa += C0[r]; sb += C1[r]; } lsum += sa + sb; } \
            u32x4 pw[4]; \
            _Pragma("unroll") for (int e = 0; e < 4; ++e) { pw[0][e] = cvtpk(C0[2 * e], C0[2 * e + 1]); pw[1][e] = cvtpk(C0[8 + 2 * e], C0[9 + 2 * e]); pw[2][e] = cvtpk(C1[2 * e], C1[2 * e + 1]); pw[3][e] = cvtpk(C1[8 + 2 * e], C1[9 + 2 * e]); } \
            _Pragma("unroll") for (int ks = 0; ks < 4; ++ks) { const bf16x8 pa = __builtin_bit_cast(bf16x8, pw[ks]); \
                if (ks + 1 < 4) { vb[0] = vtr(Vp + (ks + 1) * 1024); vb[1] = vtr(Vp + (ks + 1) * 1024 + 512); vb[2] = vtr(Vp + 4096 + (ks + 1) * 1024); vb[3] = vtr(Vp + 4096 + (ks + 1) * 1024 + 512); }     \
                o[0] = __builtin_amdgcn_mfma_f32_32x32x16_bf16(pa, ((bf16x8){va[0][0], va[0][1], va[0][2], va[0][3], va[1][0], va[1][1], va[1][2], va[1][3]}), o[0], 0, 0, 0); \
                o[1] = __builtin_amdgcn_mfma_f32_32x32x16_bf16(pa, ((bf16x8){va[2][0], va[2][1], va[2][2], va[2][3], va[3][0], va[3][1], va[3][2], va[3][3]}), o[1], 0, 0, 0); \
                if (LSUM_MFMA) lacc = __builtin_amdgcn_mfma_f32_32x32x16_bf16(pa, ones, lacc, 0, 0, 0); \
                _Pragma("unroll") for (int q_ = 0; q_ < 4; ++q_) va[q_] = vb[q_]; } \
            __builtin_amdgcn_sched_group_barrier(0x100, 4, 1); \
            _Pragma("unroll") for (int ks = 0; ks < 3; ++ks) { __builtin_amdgcn_sched_group_barrier(0x100, 4, 1); __builtin_amdgcn_sched_group_barrier(0x8, LSUM_MFMA ? 3 : 2, 1); } \
            __builtin_amdgcn_sched_group_barrier(0x8, LSUM_MFMA ? 3 : 2, 1); \
        } \
        if (!(ORDA) && nact) ATT_QK(N0, N1, (t) + 1, sl_nxt); \
        { const int tmp = sl_cur; sl_cur = sl_nxt; sl_nxt = sl_nn; sl_nn = tmp; } } while (0)
    ATT_DMA(0, 0);
    if (ntile > 1) ATT_DMA(1, 1);
    if (PROBE == 2 || PROBE == 3) {} else if (ntile > 1) { if (TYPE == 1 && wid < 4) asm volatile("s_waitcnt vmcnt(3)" ::: "memory"); else asm volatile("s_waitcnt vmcnt(2)" ::: "memory"); } else asm volatile("s_waitcnt vmcnt(0)" ::: "memory");
    asm volatile("s_waitcnt lgkmcnt(0)\n\ts_barrier" ::: "memory");
    if (ta == 0) ATT_QK(sA0, sA1, 0, 0);
    int sl_cur = 0, sl_nxt = 1, sl_nn = 2;
    if (ordA) {
        for (int t = 0; t < ntile; t += 2) { ATT_STEP(true, sA0, sA1, sB0, sB1, t); if (t + 1 < ntile) ATT_STEP(true, sB0, sB1, sA0, sA1, t + 1); }
    } else {
        for (int t = 0; t < ntile; t += 2) { ATT_STEP(false, sA0, sA1, sB0, sB1, t); if (t + 1 < ntile) ATT_STEP(false, sB0, sB1, sA0, sA1, t + 1); }
    }
    LAS bf16* stg = (LAS bf16*)(lds + L_OST) + wid * 2048;
    if (!LSUM_MFMA) { { auto rr = __builtin_amdgcn_permlane32_swap(__float_as_uint(lsum), __float_as_uint(lsum), false, false); lsum = __uint_as_float(rr[0]) + __uint_as_float(rr[1]); }
        if (hi == 0) wsf[32 + r32] = lsum;
#pragma unroll
        for (int g = 0; g < 4; ++g) { const f32x4 lv = *(const LAS f32x4*)(wsf + 32 + 8 * g + 4 * hi);
#pragma unroll
            for (int e = 0; e < 4; ++e) lacc[4 * g + e] = lv[e]; } }
#pragma unroll
    for (int r = 0; r < 16; ++r) { const float iv = __builtin_amdgcn_rcpf(lacc[r]); const int orow = crow(r, hi);
        stg[orow * 64 + r32] = (bf16)(cvtpk(o[0][r] * iv, 0.f) & 0xffff); stg[orow * 64 + 32 + r32] = (bf16)(cvtpk(o[1][r] * iv, 0.f) & 0xffff); }
    const int ocol = (TYPE == 0 ? 0 : (TYPE == 1 ? 256 : 640)) + h * 64, sidx = (TYPE == 0 ? 0 : (TYPE == 1 ? 4 : 10)) + h;
#pragma unroll
    for (int i = 0; i < 4; ++i) { const int row = i * 8 + (lane >> 3), ch = lane & 7; const u32x4 v = *(const LAS u32x4*)(stg + row * 64 + ch * 8);
        const size_t tokn = tokb + qw0 + row; if (PROBE == 0) *(u32x4*)(P.O + tokn * DM + ocol + ch * 8) = v; else asm volatile("" :: "v"(v));
        float sq = 0.f;
#pragma unroll
        for (int e = 0; e < 4; ++e) { const float a = __builtin_bit_cast(float, v[e] << 16), c2 = __builtin_bit_cast(float, v[e] & 0xffff0000u); sq += a * a + c2 * c2; }
        sq += __shfl_xor(sq, 1); sq += __shfl_xor(sq, 2); sq += __shfl_xor(sq, 4);
        if (ch == 0 && PROBE == 0) P.SS[tokn * 16 + sidx] = sq; }
    ATT_WAIT_BAR();
#undef ATT_DMA
#undef ATT_QK
#undef ATT_STEP
#undef ATT_MAX3
}
__device__ __forceinline__ void attn_phase(const AttnP& P, LAS unsigned char* lds, int vcu, int tid) {
    const int x = vcu >> 5, cx = vcu & 31;
    for (int i = 0; i < 3; ++i) { const int j = cx * 3 + i, bh = 6 * x + (j >> 4), qb = j & 15; attn_unit<1>(P, bh / 6, bh % 6, qb, lds, tid); }
    if (ATT_PROBE) for (int i = 0; i < 3; ++i) { const int j = cx * 3 + i, bh = 6 * x + (j >> 4), qb = j & 15; attn_unit<1, ATT_PROBE>(P, bh / 6, bh % 6, qb, lds, tid); }
    for (int i = 0; i < 3; ++i) { const int j = cx * 3 + i, bh = 6 * x + (j >> 4), qb = j & 15; attn_unit<2>(P, bh / 6, bh % 6, qb, lds, tid); }
    for (int i = 0; i < 2; ++i) { const int j = cx * 2 + i, bh = 4 * x + (j >> 4), qb = j & 15; attn_unit<0>(P, bh >> 2, bh & 3, qb, lds, tid); }
}
}


constexpr int NWAVES = 8, LDS_BYTES = 155648, RING_BYTES = 131072, MISC_OFF = RING_BYTES + 320, TAB_OFF = RING_BYTES + 512;
#define XB_TMO      128
#define XB_XCNT(j)  (256  + 64 * (j))
#define XB_XSUB(j)  (1280 + 64 * (j))
#define XB_XGEN(j)  (2304 + 64 * (j))
#define XB_TOP      3328
#define XB_TOPGEN   3392
#define XCD_BAR_WORDS 3456
#define XB_SPIN_CAP (1u << 18)
constexpr int CW_BAR = 4096;
__device__ __forceinline__ unsigned xb_ld(unsigned* p)              { return __hip_atomic_load(p, __ATOMIC_RELAXED, __HIP_MEMORY_SCOPE_AGENT); }
__device__ __forceinline__ unsigned xb_add(unsigned* p, unsigned v) { return __hip_atomic_fetch_add(p, v, __ATOMIC_RELAXED, __HIP_MEMORY_SCOPE_AGENT); }
__device__ __forceinline__ unsigned xb_xcc_id() { return (unsigned)__builtin_amdgcn_s_getreg((3 << 11) | 20) & 0xFu; }
#define XB_SPIN(cond, bar) do { unsigned _sp = 0; while (cond) { __builtin_amdgcn_s_sleep(1); \
    if ((++_sp & 255u) == 0u) { if (xb_ld(&(bar)[XB_TMO])) break; if (_sp > XB_SPIN_CAP) { atomicAdd(&(bar)[XB_TMO], 1u); break; } } } } while (0)
struct XcdBarrier { unsigned* bar; unsigned x; volatile LAS unsigned* st; };
__device__ __forceinline__ XcdBarrier xcd_barrier_post(unsigned* bar, volatile LAS unsigned* st) {
    XcdBarrier b; b.bar = bar; b.x = xb_xcc_id(); b.st = st;
    if (threadIdx.x == 0) (void)xb_add(&bar[XB_XCNT(b.x)], 1u);
    return b;
}
__device__ __forceinline__ void xcd_barrier_complete(unsigned* bar, unsigned x, unsigned& nloc, unsigned& nx) {
    const unsigned G = gridDim.x * gridDim.y * gridDim.z;
    unsigned sum, cnt, mine, sp = 0u;
    for (;;) {
        sum = 0u; cnt = 0u; mine = 0u;
#pragma unroll
        for (unsigned j = 0; j < 16; ++j) { const unsigned c = xb_ld(&bar[XB_XCNT(j)]); sum += c; cnt += (c > 0u) ? 1u : 0u; mine = (j == x) ? c : mine; }
        if (sum == G) break;
        __builtin_amdgcn_s_sleep(1);
        if ((++sp & 255u) == 0u) { if (xb_ld(&bar[XB_TMO])) break; if (sp > XB_SPIN_CAP) { atomicAdd(&bar[XB_TMO], 1u); break; } }
    }
    nloc = mine > 0u ? mine : 1u; nx = cnt > 0u ? cnt : 1u;
}
__device__ __forceinline__ void xcd_barrier(const XcdBarrier& b, bool leader) {
    asm volatile("s_waitcnt vmcnt(0)" ::: "memory");
    __syncthreads();
    if (leader) {
        unsigned long long zb = 0; asm volatile("" : "+s"(zb)); unsigned* bar = b.bar + zb;
        __builtin_amdgcn_s_waitcnt(0);
        unsigned nloc = b.st[0], nx = b.st[1];
        if (nloc == 0u) { xcd_barrier_complete(bar, b.x, nloc, nx); b.st[0] = nloc; b.st[1] = nx; }
        const unsigned old = xb_add(&bar[XB_XSUB(b.x)], 1u);
        const unsigned gen = old / nloc;
        if (old + 1u == (gen + 1u) * nloc) {
            __builtin_amdgcn_fence(__ATOMIC_RELEASE, "agent");
            asm volatile("s_waitcnt vmcnt(0)" ::: "memory");
            const unsigned og = xb_add(&bar[XB_TOP], 1u);
            const unsigned tg = og / nx;
            if (og + 1u == (tg + 1u) * nx) xb_add(&bar[XB_TOPGEN], 1u);
            else XB_SPIN(xb_ld(&bar[XB_TOPGEN]) == tg, bar);
            __builtin_amdgcn_fence(__ATOMIC_ACQUIRE, "agent");
            xb_add(&bar[XB_XGEN(b.x)], 1u);
            asm volatile("s_waitcnt vmcnt(0)" ::: "memory");
        } else {
            XB_SPIN(xb_ld(&bar[XB_XGEN(b.x)]) == gen, bar);
            __builtin_amdgcn_fence(__ATOMIC_ACQUIRE, "agent");
            asm volatile("s_waitcnt vmcnt(0)" ::: "memory");
        }
    }
    __syncthreads();
}

struct MegaArgs {
    const float *x, *attn_norm, *w_in, *na_rpb, *q_norm, *w_uq, *kv_norm, *w_ukv, *swa_sink, *group_norm, *w_out, *ffn_norm, *w_router, *w_gate, *w_up, *w_down, *final_norm;
    float* out; unsigned char* ws;
    int ph_lo, ph_hi;
};

__device__ __forceinline__ void prep_item(int kind, const float* W, const float* W2, const float* kgain, bf16* Wt, int K, int Nsrc, int nblk, int item, LAS float* scr, int lane) {
    const int kb = item / nblk, nb = item % nblk, k0 = 64 * kb, n0 = 32 * nb, r = lane >> 3, q = lane & 7;
    float sc; int which; const int src4 = prep_map(kind, n0 + 4 * q, sc, which); const float* Wb = which ? W2 : W;
    float4 v[8];
#pragma unroll
    for (int i = 0; i < 8; ++i) v[i] = (src4 >= 0) ? *(const float4*)(Wb + (size_t)(k0 + 8 * i + r) * Nsrc + src4) : make_float4(0.f, 0.f, 0.f, 0.f);
#pragma unroll
    for (int i = 0; i < 8; ++i) { const float g = (kgain ? kgain[k0 + 8 * i + r] : 1.f) * sc; LAS float* d = scr + (8 * i + r) * 33 + 4 * q; d[0] = v[i].x * g; d[1] = v[i].y * g; d[2] = v[i].z * g; d[3] = v[i].w * g; }
    asm volatile("s_waitcnt lgkmcnt(0)" ::: "memory");
    const int c = lane & 7;
#pragma unroll
    for (int j = 0; j < 4; ++j) { const int n = (lane >> 3) + 8 * j; const LAS float* s = scr + (8 * c) * 33 + n;
        if (kind == PK_WGU || kind == PK_WD) { *(uint2*)((unsigned char*)Wt + (size_t)(n0 + n) * K + k0 + 8 * c) = make_uint2(pk_fp8x4(s[0], s[33], s[2 * 33], s[3 * 33]), pk_fp8x4(s[4 * 33], s[5 * 33], s[6 * 33], s[7 * 33])); continue; }
        uint4 o; o.x = f2bf(s[0]) | (f2bf(s[33]) << 16); o.y = f2bf(s[2 * 33]) | (f2bf(s[3 * 33]) << 16); o.z = f2bf(s[4 * 33]) | (f2bf(s[5 * 33]) << 16); o.w = f2bf(s[6 * 33]) | (f2bf(s[7 * 33]) << 16);
        *(uint4*)(Wt + (size_t)(n0 + n) * K + k0 + 8 * c) = o; }
    asm volatile("s_waitcnt lgkmcnt(0)" ::: "memory");
}
__device__ __forceinline__ void ph_prep(const MegaArgs& a, int l, int part, LAS unsigned char* lds, int gw, int ngw, int wave, int lane, int sub = 0, int nsub = 1) {
    unsigned char* ws = a.ws; LAS float* scr = (LAS float*)(lds + wave * 8448);
    constexpr int I_WIN = 16 * 64, I_WUQ = 4 * 24, I_WUKV = 2 * 24, I_WOUT = 16 * 32, I_WGU1 = 16 * 64, I_WGU = NE * I_WGU1, I_WD1 = 16 * 32, I_WD = NE * I_WD1;
    constexpr int NITEMS = I_WIN + I_WUQ + I_WUKV + I_WOUT + I_WGU + I_WD;
    const int p0 = (part == 0 || part == 2) ? 0 : (part == 3 ? I_WGU : I_WGU + I_WD), p1 = part == 2 ? I_WGU : ((part == 0 || part == 3) ? I_WGU + I_WD : NITEMS);
    const int it0 = p0 + (int)((long)(p1 - p0) * sub / nsub), it1 = p0 + (int)((long)(p1 - p0) * (sub + 1) / nsub);
    for (int it = it0 + gw; it < it1; it += ngw) { int r = it;
        if (r < I_WGU) { const int e = r / I_WGU1; prep_item(PK_WGU, a.w_gate + ((size_t)l * NE + e) * DM * DM, a.w_up + ((size_t)l * NE + e) * DM * DM, a.ffn_norm + l * DM, (bf16*)(ws + WS_WGU + (size_t)e * 2048 * DM), DM, DM, 64, r % I_WGU1, scr, lane); continue; } r -= I_WGU;
        if (r < I_WD) { const int e = r / I_WD1; prep_item(PK_WD, a.w_down + ((size_t)l * NE + e) * DM * DM, nullptr, nullptr, (bf16*)(ws + WS_WD + (size_t)e * DM * DM), DM, DM, 32, r % I_WD1, scr, lane); continue; } r -= I_WD;
        if (r < I_WIN) { prep_item(PK_WIN, a.w_in + (size_t)l * DM * C_END, nullptr, a.attn_norm + l * DM, (bf16*)(ws + WS_WIN), DM, C_END, 64, r, scr, lane); continue; } r -= I_WIN;
        if (r < I_WOUT) { prep_item(PK_WOUT, a.w_out + (size_t)l * DM * DM, nullptr, a.group_norm + l * DM, (bf16*)(ws + WS_WOUT), DM, DM, 32, r, scr, lane); continue; } r -= I_WOUT;
        if (r < I_WUQ) { prep_item(PK_WUQ, a.w_uq + (size_t)l * 256 * 576, nullptr, a.q_norm + l * 256, (bf16*)(ws + WS_WUQ), 256, 576, 24, r, scr, lane); continue; } r -= I_WUQ;
        prep_item(PK_WUKV, a.w_ukv + (size_t)l * 128 * 768, nullptr, a.kv_norm + l * 128, (bf16*)(ws + WS_WUKV), 128, 768, 24, r, scr, lane);
    }
}
__device__ __forceinline__ void row_store_bf16(const float4 (&v)[4], bf16* orow, float* rstd_out, int lane) {
    float s = 0.f;
#pragma unroll
    for (int j = 0; j < 4; ++j) s += v[j].x * v[j].x + v[j].y * v[j].y + v[j].z * v[j].z + v[j].w * v[j].w;
    const float rstd = rsqrtf(wave_sum(s) * (1.f / DM) + EPS);
    uint2* o = (uint2*)orow + lane;
#pragma unroll
    for (int j = 0; j < 4; ++j) o[64 * j] = make_uint2(f2bf(v[j].x) | (f2bf(v[j].y) << 16), f2bf(v[j].z) | (f2bf(v[j].w) << 16));
    if (lane == 0) *rstd_out = rstd;
}
__device__ __forceinline__ void ph_norm_x(const MegaArgs& a, int gw, int ngw, int lane) {
    bf16* HB = (bf16*)(a.ws + WS_HB); float* R1 = (float*)(a.ws + WS_RSTD1);
    for (int row = gw * 4; row < NT; row += ngw * 4) {
        float4 v[4][4];
#pragma unroll
        for (int r = 0; r < 4; ++r) { const float4* hr = (const float4*)(a.x + (size_t)(row + r) * DM) + lane;
#pragma unroll
            for (int j = 0; j < 4; ++j) v[r][j] = hr[64 * j]; }
#pragma unroll
        for (int r = 0; r < 4; ++r) row_store_bf16(v[r], HB + (size_t)(row + r) * DM, R1 + row + r, lane);
    }
}
__device__ __forceinline__ void ld_row_bf16(const bf16* row, float4 (&v)[4], int lane) {
    const uint2* p = (const uint2*)row + lane;
#pragma unroll
    for (int j = 0; j < 4; ++j) { const uint2 w = p[64 * j]; v[j] = make_float4(bf2f(w.x & 0xffff), bf2f(w.x >> 16), bf2f(w.y & 0xffff), bf2f(w.y >> 16)); }
}
__device__ __forceinline__ void ph_router(const MegaArgs& a, int l, LAS unsigned char* lds, int gw, int ngw, int lane, int tid) {
    LAS float* wl = (LAS float*)lds; const float* wr = a.w_router + (size_t)l * DM * NE; const float* g = a.ffn_norm + l * DM;
    const int rot = (gw / NWAVES) & 7;
    for (int h2 = 0; h2 < 2; ++h2) { float4 wv[4]; float gv[4];
#pragma unroll
      for (int it = 0; it < 4; ++it) { const int i4 = tid + (((h2 * 4 + it) + rot) & 7) * NWAVES * 64; wv[it] = ((const float4*)wr)[i4]; gv[it] = g[i4 >> 2]; }
#pragma unroll
      for (int it = 0; it < 4; ++it) { const int i4 = tid + (((h2 * 4 + it) + rot) & 7) * NWAVES * 64, k = i4 >> 2, e0 = (i4 & 3) * 4; LAS float* d = wl + e0 * DM + k; d[0] = wv[it].x * gv[it]; d[DM] = wv[it].y * gv[it]; d[2 * DM] = wv[it].z * gv[it]; d[3 * DM] = wv[it].w * gv[it]; } }
    __syncthreads();
    const bf16* HB = (const bf16*)(a.ws + WS_HB); float* AFF = (float*)(a.ws + WS_AFF); float* R2 = (float*)(a.ws + WS_RSTD2); unsigned* HB8 = (unsigned*)(a.ws + WS_HB8);
    for (int row0 = gw * 4; row0 < NT; row0 += ngw * 4) {
        asm volatile("" ::: "memory");
        uint2 wn[4][4];
        { const uint2* p = (const uint2*)(HB + (size_t)row0 * DM) + lane;
#pragma unroll
          for (int r = 0; r < 4; ++r)
#pragma unroll
              for (int j = 0; j < 4; ++j) wn[r][j] = p[r * (DM / 4) + 64 * j]; }
        float acc[4][16]; float ssq[4];
#pragma unroll
        for (int r = 0; r < 4; ++r) { ssq[r] = 0.f;
#pragma unroll
            for (int e = 0; e < 16; ++e) acc[r][e] = 0.f; }
#pragma unroll
        for (int j = 0; j < 4; ++j) { float4 hv[4];
#pragma unroll
            for (int r = 0; r < 4; ++r) { hv[r] = make_float4(bf2f(wn[r][j].x & 0xffff), bf2f(wn[r][j].x >> 16), bf2f(wn[r][j].y & 0xffff), bf2f(wn[r][j].y >> 16)); ssq[r] += hv[r].x * hv[r].x + hv[r].y * hv[r].y + hv[r].z * hv[r].z + hv[r].w * hv[r].w;
                HB8[(size_t)(row0 + r) * (DM / 4) + lane + 64 * j] = pk_fp8x4(hv[r].x, hv[r].y, hv[r].z, hv[r].w); }
#pragma unroll
            for (int e = 0; e < 16; ++e) { if ((e & 3) == 0) asm volatile("" ::: "memory");
                const pg8::f32x4 w = *(const LAS pg8::f32x4*)(wl + e * DM + 4 * lane + 256 * j);
#pragma unroll
                for (int r = 0; r < 4; ++r) acc[r][e] += hv[r].x * w[0] + hv[r].y * w[1] + hv[r].z * w[2] + hv[r].w * w[3]; } }
        float v32[32];
        { const bool up = (lane & 32) != 0;
#pragma unroll
          for (int i = 0; i < 32; ++i) { const float lo = acc[i >> 4][i & 15], hi = acc[2 + (i >> 4)][i & 15]; const float keep = up ? hi : lo, send = up ? lo : hi; v32[i] = keep + __shfl_xor(send, 32); } }
#define RT_STEP(off, n) { const bool up = (lane & (off)) != 0; _Pragma("unroll") for (int i = 0; i < (n) / 2; ++i) { const float lo = v32[i], hi = v32[i + (n) / 2]; const float keep = up ? hi : lo, send = up ? lo : hi; v32[i] = keep + __shfl_xor(send, (off)); } }
        RT_STEP(16, 32) RT_STEP(8, 16) RT_STEP(4, 8) RT_STEP(2, 4) RT_STEP(1, 2)
#undef RT_STEP
        float rs[4];
#pragma unroll
        for (int r = 0; r < 4; ++r) rs[r] = rsqrtf(wave_sum(ssq[r]) * (1.f / DM) + EPS);
        const int myr = lane >> 4, mye = lane & 15; const float rstd = myr == 0 ? rs[0] : (myr == 1 ? rs[1] : (myr == 2 ? rs[2] : rs[3]));
        const float lg = v32[0] * rstd; float mx = lg;
#pragma unroll
        for (int o = 1; o < 16; o <<= 1) mx = fmaxf(mx, __shfl_xor(mx, o));
        const float ex = __expf(lg - mx); float den = ex;
#pragma unroll
        for (int o = 1; o < 16; o <<= 1) den += __shfl_xor(den, o);
        const float af = ex / den; const float a1 = __shfl(af, mye + 16), a2 = __shfl(af, mye + 32), a3 = __shfl(af, mye + 48);
        const int row = row0 + myr, b0 = row0 / NS, s0 = row0 % NS;
        if (myr == 0) *(float4*)(AFF + ((size_t)b0 * NE + mye) * NS + s0) = make_float4(af, a1, a2, a3);
        if (mye == 0) R2[row] = rstd;
    }
    __syncthreads();
}
__device__ __forceinline__ void ph_topk(unsigned char* ws, LAS unsigned char* lds, int bx, int G, int tid) {
    LAS unsigned* hist = (LAS unsigned*)lds;
    LAS unsigned* sh = hist + 256;
    LAS unsigned* wcnt = hist + 512;
    const int lane = tid & 63, wave = tid >> 6;
    const float* AFF = (const float*)(ws + WS_AFF); int* INV = (int*)(ws + WS_INV); int* IDX = (int*)(ws + WS_IDX); float* GATE = (float*)(ws + WS_GATE);
    for (int be = bx; be < NB * NE; be += G) {
        const int b = be / NE, e = be % NE; const float* src = AFF + (size_t)be * NS;
        unsigned u[8];
#pragma unroll
        for (int i = 0; i < 8; ++i) u[i] = __float_as_uint(src[tid * 8 + i]);
        unsigned prefix = 0u, krem = CAP;
#pragma unroll 1
        for (int pass = 0; pass < 4; ++pass) { const int shift = 24 - 8 * pass; const unsigned pmask = pass == 0 ? 0u : (0xffffffffu << (shift + 8));
            if (tid < 256) hist[tid] = 0u;
            __syncthreads();
#pragma unroll
            for (int i = 0; i < 8; ++i) if ((u[i] & pmask) == prefix) __hip_atomic_fetch_add(&hist[(u[i] >> shift) & 255u], 1u, __ATOMIC_RELAXED, __HIP_MEMORY_SCOPE_WORKGROUP);
            __syncthreads();
            if (wave == 0) {
                unsigned c4[4]; unsigned tot = 0u;
#pragma unroll
                for (int i = 0; i < 4; ++i) { c4[i] = hist[255 - (lane * 4 + i)]; tot += c4[i]; }
                unsigned inc = tot;
#pragma unroll
                for (int o = 1; o < 64; o <<= 1) { const unsigned t = __shfl_up(inc, o); if (lane >= o) inc += t; }
                const unsigned before = inc - tot;
                if (before < krem && inc >= krem) { unsigned acc = before;
#pragma unroll
                    for (int i = 0; i < 4; ++i) { if (acc < krem && acc + c4[i] >= krem) { sh[0] = prefix | ((unsigned)(255 - (lane * 4 + i)) << shift); sh[1] = krem - acc; } acc += c4[i]; } }
            }
            __syncthreads();
            prefix = sh[0]; krem = sh[1];
            __syncthreads();
        }
        unsigned ngt = 0u, neq = 0u;
#pragma unroll
        for (int i = 0; i < 8; ++i) { ngt += (u[i] > prefix) ? 1u : 0u; neq += (u[i] == prefix) ? 1u : 0u; }
        unsigned ig = ngt, iq = neq;
#pragma unroll
        for (int o = 1; o < 64; o <<= 1) { const unsigned tg = __shfl_up(ig, o), tq = __shfl_up(iq, o); if (lane >= o) { ig += tg; iq += tq; } }
        if (lane == 63) { wcnt[wave * 2] = ig; wcnt[wave * 2 + 1] = iq; }
        __syncthreads();
        unsigned bg = 0u, bq = 0u;
        for (int w = 0; w < wave; ++w) { bg += wcnt[w * 2]; bq += wcnt[w * 2 + 1]; }
        unsigned pg = bg + ig - ngt, pq = bq + iq - neq;
#pragma unroll
        for (int i = 0; i < 8; ++i) { const int idx = tid * 8 + i; int slot = -1;
            if (u[i] > prefix) { slot = (int)(pg + min(pq, krem)); ++pg; }
            else if (u[i] == prefix) { if (pq < krem) slot = (int)(pg + pq); ++pq; }
            INV[(size_t)be * NS + idx] = slot;
            if (slot >= 0) { IDX[e * (NB * CAP) + b * CAP + slot] = b * NS + idx; GATE[(size_t)e * (NB * CAP) + b * CAP + slot] = __uint_as_float(u[i]); } }
        __syncthreads();
    }
}
__device__ __forceinline__ void ph_combine(const MegaArgs& a, int l, int gw, int ngw, int lane) {
    const unsigned char* Y = a.ws + WS_PROJ; const int* INV = (const int*)(a.ws + WS_INV); bf16* HB = (bf16*)(a.ws + WS_HB); float* R1 = (float*)(a.ws + WS_RSTD1); const bool last = (l == DEPTH - 1);
    uint2 wn[4]; int slot_n = -1;
    if (gw < NT) { const uint2* p = (const uint2*)(HB + (size_t)gw * DM) + lane;
#pragma unroll
        for (int j = 0; j < 4; ++j) wn[j] = p[64 * j];
        if (lane < NE) slot_n = INV[((size_t)(gw / NS) * NE + lane) * NS + (gw % NS)]; }
    for (int row = gw; row < NT; row += ngw) { const int b = row / NS;
        float4 v[4];
#pragma unroll
        for (int j = 0; j < 4; ++j) v[j] = make_float4(bf2f(wn[j].x & 0xffff), bf2f(wn[j].x >> 16), bf2f(wn[j].y & 0xffff), bf2f(wn[j].y >> 16));
        const int slot_l = slot_n; const int nrow = row + ngw;
        if (nrow < NT) { const uint2* p = (const uint2*)(HB + (size_t)nrow * DM) + lane;
#pragma unroll
            for (int j = 0; j < 4; ++j) wn[j] = p[64 * j];
            slot_n = -1; if (lane < NE) slot_n = INV[((size_t)(nrow / NS) * NE + lane) * NS + (nrow % NS)]; }
        unsigned long long msk = __ballot(slot_l >= 0);
        while (msk) { const int e = __builtin_ctzll(msk); msk &= msk - 1; const int slot = __shfl(slot_l, e);
            const unsigned* y = (const unsigned*)(Y + ((size_t)e * (NB * CAP) + b * CAP + slot) * DM) + lane;
            unsigned w[4]; unsigned w2[4]; int e2 = -1;
#pragma unroll
            for (int j = 0; j < 4; ++j) w[j] = y[64 * j];
            if (msk) { e2 = __builtin_ctzll(msk); msk &= msk - 1; const int slot2 = __shfl(slot_l, e2); const unsigned* y2 = (const unsigned*)(Y + ((size_t)e2 * (NB * CAP) + b * CAP + slot2) * DM) + lane;
#pragma unroll
                for (int j = 0; j < 4; ++j) w2[j] = y2[64 * j]; }
#pragma unroll
            for (int j = 0; j < 4; ++j) { const att::f32x2_t lo = __builtin_amdgcn_cvt_pk_f32_fp8((int)w[j], false), hi = __builtin_amdgcn_cvt_pk_f32_fp8((int)w[j], true); v[j].x += lo[0] * (1.f / Y8_SCALE); v[j].y += lo[1] * (1.f / Y8_SCALE); v[j].z += hi[0] * (1.f / Y8_SCALE); v[j].w += hi[1] * (1.f / Y8_SCALE); }
            if (e2 >= 0) {
#pragma unroll
                for (int j = 0; j < 4; ++j) { const att::f32x2_t lo = __builtin_amdgcn_cvt_pk_f32_fp8((int)w2[j], false), hi = __builtin_amdgcn_cvt_pk_f32_fp8((int)w2[j], true); v[j].x += lo[0] * (1.f / Y8_SCALE); v[j].y += lo[1] * (1.f / Y8_SCALE); v[j].z += hi[0] * (1.f / Y8_SCALE); v[j].w += hi[1] * (1.f / Y8_SCALE); } } }
        if (last) { float ssum = 0.f;
#pragma unroll
            for (int j = 0; j < 4; ++j) ssum += v[j].x * v[j].x + v[j].y * v[j].y + v[j].z * v[j].z + v[j].w * v[j].w;
            const float rstd = rsqrtf(wave_sum(ssum) * (1.f / DM) + EPS); float4* orow = (float4*)(a.out + (size_t)row * DM) + lane;
#pragma unroll
            for (int j = 0; j < 4; ++j) { const float4 gg = ((const float4*)a.final_norm)[lane + 64 * j]; orow[64 * j] = make_float4(v[j].x * rstd * gg.x, v[j].y * rstd * gg.y, v[j].z * rstd * gg.z, v[j].w * rstd * gg.w); } }
        else row_store_bf16(v, HB + (size_t)row * DM, R1 + row, lane);
    }
}

enum { PL_PROJ = 0, PL_MLAUP, PL_ATTN, PL_OUT, PL_ROUTER, PL_TOPK, PL_MOE1, PL_MOE2, PL_COMBINE, PL_COUNT };
constexpr int N_PHASES = 1 + DEPTH * PL_COUNT;
constexpr int TIME_PH = -1;
constexpr int REP_PH = -1;
#define REPEAT(ph) for (int rep_ = 0; rep_ < (REP_PH == (ph) ? 2 : 1); ++rep_)
#define IN(k) (lo <= (k) && (k) < hi)
#define SEAM(k) do { if (IN((k) + 1)) xcd_barrier(bar, t_ == 0); if (TIME_PH >= 0) { const unsigned long long now_ = __builtin_amdgcn_s_memrealtime(); \
        if (((k) == 0 ? 9 : ((k) - 1) % PL_COUNT) == TIME_PH) { const unsigned long long d_ = now_ - tph; while (__builtin_amdgcn_s_memrealtime() - now_ < d_) __builtin_amdgcn_s_sleep(16); } \
        tph = __builtin_amdgcn_s_memrealtime(); } } while (0)
#define PH_LOCALS unsigned long long z_ = 0; asm volatile("" : "+s"(z_)); unsigned char* ws = a.ws + z_;     \
    int t_ = wave_s * 64 + (int)__builtin_amdgcn_mbcnt_hi(~0u, __builtin_amdgcn_mbcnt_lo(~0u, 0u)); asm volatile("" : "+v"(t_));     \
    int bx = blockIdx.x; asm volatile("" : "+s"(bx)); \
    const int vcu = (bx % 8) * (G / 8) + bx / 8; const int lane = t_ & 63, wave = __builtin_amdgcn_readfirstlane(t_ >> 6), gw = vcu * NWAVES + wave; (void)lane; (void)gw; (void)ws; (void)vcu;
template <int l> __device__ __forceinline__ void layer_phases(const MegaArgs& a, LAS unsigned char* lds, const XcdBarrier& bar, const int lo, const int hi, unsigned long long& tph, const int wave_s) {
    constexpr int G = 256, ngw = G * NWAVES, pb = 1 + l * PL_COUNT;
        if (IN(pb + PL_PROJ)) { PH_LOCALS
            const bool early = ((bx >> 3) & 1) != 0;
            if (early) { ph_prep(a, l, 2, lds, gw, ngw, wave, lane, 0, 2); __syncthreads(); }
            pg8::StaticOrder S; S.init(NT / 256, NP / 256, G, bx, 0);
            LAS float* rst = (LAS float*)(lds + TAB_OFF);
            { pg8::Unit u; const float* R1 = (const float*)(ws + WS_RSTD1);
              for (int i = 0; i < 4 && S.next(i, u); ++i) if (t_ < 256) rst[i * 256 + t_] = R1[u.pm * 256 + t_]; }
            __syncthreads();
            REPEAT(PL_PROJ) {
            pg8::Gemm g{(bf16*)(ws + WS_HB), (bf16*)(ws + WS_WIN), DM, DM, DM, nullptr};
            pg8::EpiProj E{(bf16*)(ws + WS_PROJ), (float*)(ws + WS_CQSS), (float*)(ws + WS_CKVSS), rst};
            pg8::gemm_phase<pg8::EpiProj, pg8::StaticOrder, true>(lds, g, S, E, t_); }
            if (!early) { __syncthreads(); ph_prep(a, l, 2, lds, gw, ngw, wave, lane, 0, 2); }
            SEAM(pb + PL_PROJ);
        }
        if (IN(pb + PL_MLAUP)) { PH_LOCALS const bool early = ((bx >> 3) & 1) != 0;
            if (early) { ph_prep(a, l, 2, lds, gw, ngw, wave, lane, 1, 2); __syncthreads(); }
            REPEAT(PL_MLAUP) {
            LAS float* rst = (LAS float*)(lds + TAB_OFF);
            { pg8::StaticOrder S; S.init(NT / 256, 3, G, bx, 0); pg8::Unit u; const float* SSQ = (const float*)(ws + WS_CQSS);
              for (int i = 0; i < 2 && S.next(i, u); ++i) if (t_ < 256) { const float4 p = *(const float4*)(SSQ + (size_t)(u.pm * 256 + t_) * 4); rst[i * 256 + t_] = rsqrtf((p.x + p.y + p.z + p.w) * (1.f / 256.f) + EPS); }
              __syncthreads();
              pg8::Gemm g{(bf16*)(ws + WS_PROJ) + C_CQ, (bf16*)(ws + WS_WUQ), 256, NP, 256, nullptr};
              typedef pg8::EpiMla<true, 576, 576> EQ; EQ E{(bf16*)(ws + WS_QB), rst};
              pg8::gemm_phase<EQ, pg8::StaticOrder, true>(lds, g, S, E, t_); }
            __syncthreads();
            { pg8::StaticOrder S; S.init(NT / 256, 3, G, bx, 0); pg8::Unit u; const float* SSQ = (const float*)(ws + WS_CKVSS);
              for (int i = 0; i < 2 && S.next(i, u); ++i) if (t_ < 256) { const float4 p = *(const float4*)(SSQ + (size_t)(u.pm * 256 + t_) * 4); rst[i * 256 + t_] = rsqrtf((p.x + p.y + p.z + p.w) * (1.f / 128.f) + EPS); }
              __syncthreads();
              pg8::Gemm g{(bf16*)(ws + WS_PROJ) + C_CKV, (bf16*)(ws + WS_WUKV), 128, NP, 128, nullptr};
              typedef pg8::EpiMla<false, 768, 768> EK; EK E{(bf16*)(ws + WS_KV), rst};
              pg8::gemm_phase<EK, pg8::StaticOrder, true>(lds, g, S, E, t_); } }
            if (!early) { __syncthreads(); ph_prep(a, l, 2, lds, gw, ngw, wave, lane, 1, 2); }
            SEAM(pb + PL_MLAUP);
        }
        if (IN(pb + PL_ATTN)) { PH_LOCALS
            REPEAT(PL_ATTN) { const att::AttnP P{(bf16*)(ws + WS_PROJ), (bf16*)(ws + WS_QB), (bf16*)(ws + WS_KV), (bf16*)(ws + WS_XN), (float*)(ws + WS_SS), a.na_rpb + (size_t)l * 4 * 15 * 31, a.swa_sink + l * 6}; att::attn_phase(P, lds, vcu, t_); }
            SEAM(pb + PL_ATTN);
        }
        if (IN(pb + PL_OUT)) { PH_LOCALS
            const bool early = ((bx >> 3) & 1) != 0;
            if (early) { ph_prep(a, l, 3, lds, gw, ngw, wave, lane, 0, 2); __syncthreads(); }
            pg8::StaticOrder S; S.init(NT / 256, DM / 256, G, bx, 0);
            LAS float* fac = (LAS float*)(lds + TAB_OFF);
            { pg8::Unit u; const float* SS = (const float*)(ws + WS_SS);
              for (int i = 0; i < 2 && S.next(i, u); ++i) if (t_ < 256) { const float4* ss4 = (const float4*)(SS + (size_t)(u.pm * 256 + t_) * 16); const float4 s0 = ss4[0], s1 = ss4[1], s2 = ss4[2], s3 = ss4[3];
                  const float ra = rsqrtf((s0.x + s0.y + s0.z + s0.w) * (1.f / 256.f) + EPS), rb = rsqrtf((s1.x + s1.y + s1.z + s1.w + s2.x + s2.y) * (1.f / 384.f) + EPS), rc = rsqrtf((s2.z + s2.w + s3.x + s3.y + s3.z + s3.w) * (1.f / 384.f) + EPS);
                  LAS float* f = fac + (i * 256 + t_) * 4; f[0] = ra / rb; f[1] = rb / rc; f[2] = rc; f[3] = 0.f; } }
            __syncthreads();
            pg8::Gemm g{(bf16*)(ws + WS_XN), (bf16*)(ws + WS_WOUT), DM, DM, DM, nullptr};
            pg8::EpiResid E{(bf16*)(ws + WS_HB), fac};
            pg8::gemm_phase<pg8::EpiResid, pg8::StaticOrder, true>(lds, g, S, E, t_);
            if (!early) { __syncthreads(); ph_prep(a, l, 3, lds, gw, ngw, wave, lane, 0, 2); }
            SEAM(pb + PL_OUT);
        }
        if (IN(pb + PL_ROUTER)) { PH_LOCALS REPEAT(PL_ROUTER) ph_router(a, l, lds, gw, ngw, lane, t_); SEAM(pb + PL_ROUTER); }
        if (IN(pb + PL_TOPK)) { PH_LOCALS ph_topk(ws, lds, bx, G, t_); SEAM(pb + PL_TOPK); }
        if (IN(pb + PL_MOE1)) { PH_LOCALS
            const bool early = ((bx >> 3) & 1) != 0;
            if (early) { ph_prep(a, l, 3, lds, gw, ngw, wave, lane, 1, 2); __syncthreads(); }
            pg8::StaticOrder S; S.init(NSLOTS / 256, 8, G, bx, 16);
            LAS int* gidx = (LAS int*)(lds + TAB_OFF);
            LAS float* rst = (LAS float*)(lds + TAB_OFF + 8192);
            { pg8::Unit u; const int* IDX = (const int*)(ws + WS_IDX); const float* R2 = (const float*)(ws + WS_RSTD2);
              for (int i = 0; i < 8 && S.next(i, u); ++i) if (t_ < 256) { const int tok = IDX[u.pm * 256 + t_]; gidx[i * 256 + t_] = tok; rst[i * 256 + t_] = R2[tok] * (1.f / W8_SCALE); } }
            __syncthreads();
            REPEAT(PL_MOE1) {
            pg8::Gemm g{(bf16*)(ws + WS_HB8), (bf16*)(ws + WS_WGU), DM / 2, DM / 2, DM / 2, gidx};
            pg8::EpiSwiglu E{ws + WS_HID, rst};
            pg8::gemm_phase<pg8::EpiSwiglu, pg8::StaticOrder, true, true, true>(lds, g, S, E, t_); }
            if (!early) { __syncthreads(); ph_prep(a, l, 3, lds, gw, ngw, wave, lane, 1, 2); }
            SEAM(pb + PL_MOE1);
        }
        if (IN(pb + PL_MOE2)) { PH_LOCALS
            const bool early = ((bx >> 3) & 1) != 0;
            if (l + 1 < DEPTH && early) { ph_prep(a, l + 1, 1, lds, gw, ngw, wave, lane); __syncthreads(); }
            pg8::StaticOrder S; S.init(NSLOTS / 256, 4, G, bx, 16); S.rev = 1;
            LAS float* gtab = (LAS float*)(lds + TAB_OFF);
            { pg8::Unit u; const float* GATE = (const float*)(ws + WS_GATE);
              for (int i = 0; i < 4 && S.next(i, u); ++i) if (t_ < 256) gtab[i * 256 + t_] = GATE[u.pm * 256 + t_] * (Y8_SCALE / (W8_SCALE * H8_SCALE)); }
            __syncthreads();
            REPEAT(PL_MOE2) {
            pg8::Gemm g{(bf16*)(ws + WS_HID), (bf16*)(ws + WS_WD), DM / 2, DM / 2, DM / 2, nullptr};
            pg8::EpiGate E{ws + WS_PROJ, gtab};
            pg8::gemm_phase<pg8::EpiGate, pg8::StaticOrder, true, false, true>(lds, g, S, E, t_); }
            if (l + 1 < DEPTH && !early) { __syncthreads(); ph_prep(a, l + 1, 1, lds, gw, ngw, wave, lane); }
            SEAM(pb + PL_MOE2);
        }
        if (IN(pb + PL_COMBINE)) { PH_LOCALS
            ph_combine(a, l, gw, ngw, lane);
            SEAM(pb + PL_COMBINE);
        }
}
__global__ void __launch_bounds__(NWAVES * 64, 2) mega(MegaArgs a) {
    extern __shared__ __attribute__((aligned(16))) unsigned char lds_raw[];
    LAS unsigned char* lds = (LAS unsigned char*)lds_raw;
    constexpr int G = 256;
    constexpr int ngw = G * NWAVES;
    const int wave_s = __builtin_amdgcn_readfirstlane(threadIdx.x >> 6);
    for (int u = threadIdx.x; u < (LDS_BYTES - RING_BYTES) / 4; u += NWAVES * 64) ((LAS unsigned*)(lds + RING_BYTES))[u] = 0u;
    __syncthreads();
    XcdBarrier bar = xcd_barrier_post((unsigned*)(a.ws + WS_CTL) + CW_BAR, (volatile LAS unsigned*)(lds + MISC_OFF) + 8);
    const int lo = a.ph_lo, hi = a.ph_hi;
    unsigned long long tph = (TIME_PH >= 0) ? __builtin_amdgcn_s_memrealtime() : 0ull;
    if (IN(0)) { PH_LOCALS ph_prep(a, 0, 1, lds, gw, ngw, wave, lane); ph_norm_x(a, gw, ngw, lane); SEAM(0); }
    layer_phases<0>(a, lds, bar, lo, hi, tph, wave_s);
    layer_phases<1>(a, lds, bar, lo, hi, tph, wave_s);
    static_assert(DEPTH == 2, "two layers are written out");
}


#ifndef MK_PER_PHASE
#define MK_PER_PHASE 0
#endif
extern "C" void kernel_launch(void* const* d_in, const int* in_sizes, int n_in, void* d_out, int out_size, void* d_ws, size_t ws_size, hipStream_t stream) {
    if (n_in != 17 || out_size != NT * DM || ws_size < WS_END) { fprintf(stderr, "kernel_launch: unexpected shapes (n_in %d out %d ws %zu)\n", n_in, out_size, ws_size); return; }
    static int grid = 0;
    if (grid == 0) { int dev = 0, cus = 0; (void)hipGetDevice(&dev); (void)hipDeviceGetAttribute(&cus, hipDeviceAttributeMultiprocessorCount, dev);
        if (hipFuncSetAttribute((const void*)mega, hipFuncAttributeMaxDynamicSharedMemorySize, LDS_BYTES) != hipSuccess) fprintf(stderr, "hipFuncSetAttribute failed\n");
        if (cus != 256) fprintf(stderr, "kernel_launch: built for a 256-CU device (got %d CUs)\n", cus);
        grid = 256; }
    (void)hipMemsetAsync((char*)d_ws + WS_CTL, 0, 1 * MiB, stream);
    MegaArgs ma{};
    ma.x = (const float*)d_in[0]; ma.attn_norm = (const float*)d_in[1]; ma.w_in = (const float*)d_in[2]; ma.na_rpb = (const float*)d_in[3]; ma.q_norm = (const float*)d_in[4]; ma.w_uq = (const float*)d_in[5];
    ma.kv_norm = (const float*)d_in[6]; ma.w_ukv = (const float*)d_in[7]; ma.swa_sink = (const float*)d_in[8]; ma.group_norm = (const float*)d_in[9]; ma.w_out = (const float*)d_in[10]; ma.ffn_norm = (const float*)d_in[11];
    ma.w_router = (const float*)d_in[12]; ma.w_gate = (const float*)d_in[13]; ma.w_up = (const float*)d_in[14]; ma.w_down = (const float*)d_in[15]; ma.final_norm = (const float*)d_in[16];
    ma.out = (float*)d_out; ma.ws = (unsigned char*)d_ws;
#if MK_PER_PHASE
    for (int p = 0; p < N_PHASES; ++p) { ma.ph_lo = p; ma.ph_hi = p + 1; hipLaunchKernelGGL(mega, dim3(grid), dim3(NWAVES * 64), LDS_BYTES, stream, ma); }
#else
    ma.ph_lo = 0; ma.ph_hi = N_PHASES; hipLaunchKernelGGL(mega, dim3(grid), dim3(NWAVES * 64), LDS_BYTES, stream, ma);
#endif
}
```

```cpp
#include <hip/hip_runtime.h>
#include <cstdint>
#include <cstdio>

typedef unsigned short bf16;
constexpr int NB = 8, NS = 4096, DM = 1024, NT = NB * NS, NP = 2048, NE = 16, CAP = 512, DEPTH = 2;
constexpr int NSLOTS = NE * NB * CAP;
constexpr float LOG2E = 1.4426950408889634f;
constexpr float QS64 = 0.125f * LOG2E;
constexpr float QS96 = 0.10206207261596577f * LOG2E;
constexpr float EPS = 1e-6f;
constexpr int C_AQ = 0, C_AK = 256, C_AV = 512, C_CQ = 768, C_CKV = 1024, C_KR = 1152, C_SQ = 1184, C_SK = 1568, C_SV = 1696, C_END = 1824;

constexpr size_t MiB = 1u << 20;
constexpr size_t WS_CTL = 0;
constexpr size_t WS_COS64 = 1 * MiB, WS_SIN64 = WS_COS64 + 512 * 1024, WS_COS32 = 2 * MiB, WS_SIN32 = WS_COS32 + 256 * 1024;
constexpr size_t WS_WIN = 4 * MiB, WS_WUQ = 8 * MiB, WS_WUKV = 8 * MiB + 512 * 1024, WS_WOUT = 9 * MiB, WS_WGU = 12 * MiB, WS_WD = 76 * MiB;
constexpr size_t WS_CQSS = 108 * MiB, WS_CKVSS = WS_CQSS + 512 * 1024, WS_SS = 109 * MiB, WS_AFF = 111 * MiB, WS_INV = 113 * MiB, WS_IDX = 115 * MiB, WS_GATE = WS_IDX + 256 * 1024;
constexpr size_t WS_XN = 120 * MiB;
constexpr size_t WS_HB8 = WS_XN;
constexpr size_t WS_PROJ = 184 * MiB;
constexpr size_t WS_QB = 312 * MiB;
constexpr size_t WS_KV = 348 * MiB;
constexpr size_t WS_HID = 312 * MiB;
constexpr size_t WS_HB = 440 * MiB;
constexpr size_t WS_RSTD1 = 504 * MiB, WS_RSTD2 = WS_RSTD1 + 256 * 1024;
constexpr size_t WS_END = 505 * MiB;

__device__ __forceinline__ unsigned f2bf(float f) { unsigned u = __builtin_bit_cast(unsigned, f); return (u + 0x7fffu + ((u >> 16) & 1u)) >> 16; }
__device__ __forceinline__ float bf2f(unsigned short b) { return __builtin_bit_cast(float, (unsigned)b << 16); }
__device__ __forceinline__ float wave_sum(float v) {
#pragma unroll
    for (int o = 1; o < 64; o <<= 1) v += __shfl_xor(v, o);
    return v;
}

constexpr float W8_SCALE = 64.f, H8_SCALE = 8.f, Y8_SCALE = 64.f;
__device__ __forceinline__ float clamp8(float v) { return __builtin_amdgcn_fmed3f(v, -448.f, 448.f); }
__device__ __forceinline__ unsigned pk_fp8x4(float a, float b, float c, float d) { int w = 0; w = __builtin_amdgcn_cvt_pk_fp8_f32(clamp8(a), clamp8(b), w, false); w = __builtin_amdgcn_cvt_pk_fp8_f32(clamp8(c), clamp8(d), w, true); return (unsigned)w; }
enum { PK_WIN = 0, PK_WUQ = 1, PK_WUKV = 2, PK_WOUT = 3, PK_WGU = 4, PK_WD = 5 };
__device__ __forceinline__ int prep_map(int kind, int n, float& sc, int& which) {
    sc = 1.f; which = 0;
    switch (kind) {
    case PK_WIN:
        if (n < 256) { sc = QS64; return n; }
        if (n < C_KR) return n;
        if (n < C_SQ) { const int p = n - C_KR, g = p >> 3, e = p & 7; return C_KR + 4 * g + (e & 3) + 16 * (e >> 2); }
        if (n < C_SK) { const int p = n - C_SQ, h = p >> 6, pp = p & 63, g = pp >> 3, e = pp & 7; sc = QS64; return C_SQ + h * 64 + 4 * g + (e & 3) + 32 * (e >> 2); }
        if (n < C_SV) { const int p = n - C_SK, h = p >> 6, pp = p & 63, g = pp >> 3, e = pp & 7; return C_SK + h * 64 + 4 * g + (e & 3) + 32 * (e >> 2); }
        if (n < C_END) return n;
        return -1;
    case PK_WUQ:
        if (n < 576) { const int h = n / 96, d = n % 96; sc = QS96; if (d < 64) return n; const int p = d - 64, g = p >> 3, e = p & 7; return h * 96 + 64 + 4 * g + (e & 3) + 16 * (e >> 2); }
        return -1;
    case PK_WUKV:
        if (n < 384) { const int h = n >> 6, d = n & 63; return h * 128 + d; }
        { const int m = n - 384, h = m >> 6, d = m & 63; return h * 128 + 64 + d; }
    case PK_WGU: { const int pn = n >> 8, wc = (n >> 6) & 3, half = (n >> 5) & 1, j = n & 31; which = half; sc = W8_SCALE; return 128 * pn + 32 * wc + j; }
    case PK_WD: sc = W8_SCALE; return n;
    default: return n;
    }
}
#define LAS __attribute__((address_space(3)))
#define GAS __attribute__((address_space(1)))
namespace pg8 {
typedef short bf16x8 __attribute__((ext_vector_type(8)));
typedef float f32x4 __attribute__((ext_vector_type(4)));
typedef unsigned u32x4 __attribute__((ext_vector_type(4)));
constexpr int BM = 256, BK = 64, HALF = 128, HTB = HALF * BK * 2, STAGE_BYTES = 8 * HTB, NXCD = 8, WGM = 8;
__host__ __device__ __forceinline__ int lds_byte(int r, int c) { const int st = (r >> 4) * 2 + (c >> 5), rr = r & 15, cc = c & 31, ob = rr * 64 + cc * 2; return st * 1024 + (ob ^ (((ob >> 9) & 1) << 5)); }
__host__ __device__ __forceinline__ void stage_rc(int b, int& R, int& C) { const int st = b / 1024, sb = b % 1024, swz = sb ^ (((sb >> 9) & 1) << 5); R = (st >> 1) * 16 + swz / 64; C = (st & 1) * 32 + (swz % 64) / 2; }
__host__ __device__ __forceinline__ int perm32(int rho) { const int n = rho >> 4, i = rho & 15; return 8 * (i >> 2) + 4 * n + (i & 3); }
__host__ __device__ __forceinline__ int perm64(int rho) { const int n = rho >> 4, i = rho & 15; return 16 * (i >> 2) + 4 * n + (i & 3); }
struct Unit { int pm, pn, pb; };
struct Gemm { const bf16* A; const bf16* Bt; int K, lda, ldb; const LAS int* gidx; };
struct StaticOrder {
    int nM, nN, nwg, G, c, gm, rev = 0;
    __device__ __forceinline__ void init(int nM_, int nN_, int G_, int c_, int gm_) { nM = nM_; nN = nN_; nwg = nM * nN; G = G_; c = c_; gm = gm_; }
    __device__ __forceinline__ bool next(int i, Unit& u) const {
        const long L = (long)i * G + c; if (L >= nwg) return false;
        int wgid = (int)L; { const int q = nwg / NXCD, r = nwg % NXCD, xcd = wgid % NXCD, off = wgid / NXCD; wgid = (xcd < r ? xcd * (q + 1) : r * (q + 1) + (xcd - r) * q) + off; }
        const int nig = WGM * nN, gid = wgid / nig, fm = gid * WGM, gsz = (nM - fm) < WGM ? (nM - fm) : WGM;
        u.pm = fm + ((wgid % nig) % gsz); if (rev) u.pm = nM - 1 - u.pm; u.pn = (wgid % nig) / gsz; u.pb = gm ? (u.pm / gm) * nN + u.pn : u.pn; return true;
    }
};
__device__ __forceinline__ unsigned cvt_pk_bf16(float lo, float hi) { unsigned r; asm volatile("v_cvt_pk_bf16_f32 %0, %1, %2" : "=v"(r) : "v"(lo), "v"(hi)); return r; }

typedef int i32x8 __attribute__((ext_vector_type(8)));
typedef short s16x16 __attribute__((ext_vector_type(16)));
__device__ __forceinline__ i32x8 cat8(bf16x8 a, bf16x8 b) { return __builtin_bit_cast(i32x8, __builtin_shufflevector(a, b, 0, 1, 2, 3, 4, 5, 6, 7, 8, 9, 10, 11, 12, 13, 14, 15)); }
__device__ __forceinline__ void mfma8(f32x4& acc, i32x8 a, i32x8 b) { asm volatile("v_mfma_f32_16x16x128_f8f6f4 %0, %1, %2, %0" : "+v"(acc) : "v"(a), "v"(b)); }
struct NoPre { __device__ __forceinline__ void operator()() const {} };
template <class Epi, class Sched, bool ALIGN_EPI, bool GATHER = false, bool FP8 = false, class Pre = NoPre>
__device__ __forceinline__ void gemm_phase(LAS unsigned char* lds, const Gemm g, const Sched& S, const Epi& E, int tid_in, const Pre& pre = Pre()) {
    int tid = tid_in; asm volatile("" : "+v"(tid));
    const int wid = __builtin_amdgcn_readfirstlane(tid >> 6), lane = tid & 63, wr = wid >> 2, wc = wid & 3, fr = lane & 15, fq = lane >> 4;
    const int K = g.K, nt = K / BK;
    unsigned vC[2][2], vNs[2][2], voffB[2]; int RA[2], CA[2];
    const size_t kstep = (size_t)(BK * 2);
    const size_t hstepA = (size_t)HALF * g.lda * 2, hstepB = (size_t)(Epi::PERM64 ? 8 : 32) * g.ldb * 2, tstepA = GATHER ? 0 : 2 * hstepA, tstepB = (size_t)BM * g.ldb * 2;
#pragma unroll
    for (int i = 0; i < 2; ++i) { int R, C; stage_rc(tid * 16 + i * 8192, R, C); const int Rb = 64 * (R >> 5) + (Epi::PERM64 ? perm64(R & 31) : (Epi::PERM ? perm32(R & 31) : (R & 31))); RA[i] = R; CA[i] = C;
        voffB[i] = (unsigned)(Rb * g.ldb + C) * 2u;
#pragma unroll
        for (int h = 0; h < 2; ++h) { vC[h][i] = GATHER ? ((unsigned)g.gidx[h * HALF + R] * (unsigned)(g.lda * 2) + (unsigned)C * 2u) : ((unsigned)(R * g.lda + C) * 2u + (unsigned)(h * hstepA)); vNs[h][i] = vC[h][i]; } }
    unsigned (&vN)[2][2] = GATHER ? vNs : vC;
    const unsigned ldsw = (unsigned)wid * 1024u;
    const int aoff = lds_byte(wr * 64 + fr, fq * 8), boff = lds_byte(wc * 32 + fr, fq * 8);
#define PG8_SA(b, h) (((b) * 2 + (h)) * HTB)
#define PG8_SB(b, h) ((4 + (b) * 2 + (h)) * HTB)
#define PG8_STAGE(bufoff, gbase, voff) do { _Pragma("unroll") for (int _i = 0; _i < 2; ++_i) \
        __builtin_amdgcn_global_load_lds((const unsigned*)((const char*)(gbase) + (voff)[_i]), (LAS unsigned*)(lds + (bufoff) + ldsw + _i * 8192), 16, 0, 0); } while (0)
#define PG8_STAGEA(bufoff, gbase, V, h) do { _Pragma("unroll") for (int _i = 0; _i < 2; ++_i) \
        __builtin_amdgcn_global_load_lds((const unsigned*)((const char*)(gbase) + (V)[h][_i]), (LAS unsigned*)(lds + (bufoff) + ldsw + _i * 8192), 16, 0, 0); } while (0)
#define PG8_STAGEAL(bufoff, gbase, h) do { _Pragma("unroll") for (int _i = 0; _i < 2; ++_i) { const unsigned _v = (GATHER && last) ? vN[h][_i] : vC[h][_i]; \
        __builtin_amdgcn_global_load_lds((const unsigned*)((const char*)(gbase) + _v), (LAS unsigned*)(lds + (bufoff) + ldsw + _i * 8192), 16, 0, 0); } } while (0)
#define PG8_LDA(dst, b, h) do { _Pragma("unroll") for (int m = 0; m < 4; ++m) _Pragma("unroll") for (int k = 0; k < 2; ++k) dst[m][k] = *(const LAS bf16x8*)(lds + PG8_SA(b, h) + aoff + m * 2048 + k * 1024); } while (0)
#define PG8_LDB(dst, b, h) do { _Pragma("unroll") for (int n = 0; n < 2; ++n) _Pragma("unroll") for (int k = 0; k < 2; ++k) dst[n][k] = *(const LAS bf16x8*)(lds + PG8_SB(b, h) + boff + n * 2048 + k * 1024); } while (0)
#define PG8_MMA(ai, bj, At, Bt) do { __builtin_amdgcn_s_setprio(1); _Pragma("unroll") for (int m = 0; m < 4; ++m) _Pragma("unroll") for (int n = 0; n < 2; ++n) { \
        if constexpr (FP8) mfma8(acc[ai][bj][m][n], cat8(Bt[n][0], Bt[n][1]), cat8(At[m][0], At[m][1])); \
        else { _Pragma("unroll") for (int k = 0; k < 2; ++k) acc[ai][bj][m][n] = __builtin_amdgcn_mfma_f32_16x16x32_bf16(Bt[n][k], At[m][k], acc[ai][bj][m][n], 0, 0, 0); } } __builtin_amdgcn_s_setprio(0); } while (0)
#define PG8_WAIT_V(n) asm volatile("s_waitcnt vmcnt(" #n ")" ::: "memory")
#define PG8_WAIT_L(n) asm volatile("s_waitcnt lgkmcnt(" #n ")" ::: "memory")
#define PG8_BAR __builtin_amdgcn_s_barrier()
#define PG8_SCHED __builtin_amdgcn_sched_barrier(0)
    Unit cur, nxt; int ui = 0;
    if (!S.next(0, cur)) return;
    f32x4 acc[2][2][4][2];
#pragma unroll
    for (int a = 0; a < 2; ++a)
#pragma unroll
        for (int b = 0; b < 2; ++b)
#pragma unroll
            for (int m = 0; m < 4; ++m)
#pragma unroll
                for (int n = 0; n < 2; ++n) acc[a][b][m][n] = (f32x4){0.f, 0.f, 0.f, 0.f};
    bf16x8 At[4][2], B0[2][2], B1[2][2];
    const char* cA = (const char*)g.A + (size_t)cur.pm * tstepA; const char* cB = (const char*)g.Bt + (size_t)cur.pb * tstepB;
    PG8_STAGE(PG8_SB(0, 0), cB, voffB); PG8_STAGE(PG8_SB(0, 1), cB + hstepB, voffB); PG8_STAGEA(PG8_SA(0, 0), cA, vC, 0); PG8_STAGEA(PG8_SA(0, 1), cA, vC, 1);
    pre();
    if (wr == 1) PG8_BAR;
    PG8_WAIT_V(2); PG8_BAR;
    PG8_STAGE(PG8_SB(1, 0), cB + kstep, voffB); PG8_STAGEA(PG8_SA(1, 0), cA + kstep, vC, 0); PG8_STAGE(PG8_SB(1, 1), cB + hstepB + kstep, voffB);
    PG8_WAIT_V(6); PG8_BAR;
    for (;;) {
        const bool has_next = S.next(ui + 1, nxt);
        if (GATHER && has_next) {
#pragma unroll
            for (int i = 0; i < 2; ++i)
#pragma unroll
                for (int h = 0; h < 2; ++h) vNs[h][i] = (unsigned)g.gidx[(ui + 1) * BM + h * HALF + RA[i]] * (unsigned)(g.lda * 2) + (unsigned)CA[i] * 2u; }
        const char* nA = has_next ? (const char*)g.A + (size_t)nxt.pm * tstepA : cA; const char* nB = has_next ? (const char*)g.Bt + (size_t)nxt.pb * tstepB : cB;
#pragma unroll 1
        for (int t = 0; t < nt; t += 2) {
            const bool last = (t == nt - 2);
            const char* a1 = cA + (size_t)(t + 1) * kstep;
            const char* a2 = last ? nA : cA + (size_t)(t + 2) * kstep; const char* b2 = last ? nB : cB + (size_t)(t + 2) * kstep;
            const char* a3 = a2 + kstep; const char* b3 = b2 + kstep;
            PG8_LDB(B0, 0, 0); PG8_LDB(B1, 0, 1); PG8_SCHED; PG8_LDA(At, 0, 0); PG8_STAGEA(PG8_SA(1, 1), a1, vC, 1);
            PG8_WAIT_V(8); PG8_WAIT_L(0); PG8_BAR; PG8_MMA(0, 0, At, B0); PG8_MMA(0, 1, At, B1); PG8_BAR; PG8_SCHED;
            PG8_LDA(At, 0, 1); PG8_STAGE(PG8_SB(0, 0), b2, voffB); PG8_STAGE(PG8_SB(0, 1), b2 + hstepB, voffB); PG8_STAGEAL(PG8_SA(0, 0), a2, 0);
            PG8_WAIT_V(8); PG8_WAIT_L(0); PG8_BAR; PG8_MMA(1, 0, At, B0); PG8_MMA(1, 1, At, B1); PG8_BAR; PG8_SCHED;
            PG8_LDB(B0, 1, 0); PG8_LDB(B1, 1, 1); PG8_SCHED; PG8_LDA(At, 1, 0); PG8_STAGEAL(PG8_SA(0, 1), a2, 1);
            PG8_WAIT_V(8); PG8_WAIT_L(0); PG8_BAR; PG8_MMA(0, 0, At, B0); PG8_MMA(0, 1, At, B1); PG8_BAR; PG8_SCHED;
            PG8_LDA(At, 1, 1); PG8_STAGE(PG8_SB(1, 0), b3, voffB); PG8_STAGE(PG8_SB(1, 1), b3 + hstepB, voffB); PG8_STAGEAL(PG8_SA(1, 0), a3, 0);
            PG8_WAIT_V(8); PG8_WAIT_L(0); PG8_BAR; PG8_MMA(1, 0, At, B0); PG8_MMA(1, 1, At, B1); PG8_BAR; PG8_SCHED;
            if constexpr (Epi::KHOOK) { if (t == 2 || t == 8) { asm volatile("" ::: "memory"); E.khook(acc, ui, t == 2 ? 0 : 1, wr, fr); asm volatile("" ::: "memory"); } }
        }
        if constexpr (FP8) asm volatile("s_nop 15\n\ts_nop 15" ::: "memory");
        if constexpr (ALIGN_EPI) { if (wr == 0) PG8_BAR; }
        { int t2 = tid_in; asm volatile("" : "+v"(t2)); E(acc, cur, wr, wc, t2 & 15, (t2 >> 4) & 3, ui); }
        if (!has_next) break;
#pragma unroll
        for (int a = 0; a < 2; ++a)
#pragma unroll
            for (int b = 0; b < 2; ++b)
#pragma unroll
                for (int m = 0; m < 4; ++m)
#pragma unroll
                    for (int n = 0; n < 2; ++n) acc[a][b][m][n] = (f32x4){0.f, 0.f, 0.f, 0.f};
        cur = nxt; cA = nA; cB = nB; ++ui;
        if (GATHER) {
#pragma unroll
            for (int i = 0; i < 2; ++i)
#pragma unroll
                for (int h = 0; h < 2; ++h) vC[h][i] = vNs[h][i]; }
        if constexpr (ALIGN_EPI) { if (wr == 1) PG8_BAR; }
    }
    PG8_WAIT_V(0);
    if constexpr (!ALIGN_EPI) { if (wr == 0) PG8_BAR; }
    PG8_BAR;
#undef PG8_SA
#undef PG8_SB
#undef PG8_STAGE
#undef PG8_STAGEA
#undef PG8_STAGEAL
#undef PG8_LDA
#undef PG8_LDB
#undef PG8_MMA
#undef PG8_WAIT_V
#undef PG8_WAIT_L
#undef PG8_BAR
#undef PG8_SCHED
}

typedef const f32x4 (&AccRef)[2][2][4][2];
template <int DIM> __device__ __forceinline__ void rope_cs(int pos, int j0, f32x4& c, f32x4& s) {
    constexpr float KEXP = 13.287712379549449f * 2.f / DIM;
#pragma unroll
    for (int e = 0; e < 4; ++e) { const float inv = __builtin_amdgcn_exp2f(-(float)(j0 + e) * KEXP), ang = (float)pos * inv, rev = ang * 0.15915494309189535f, fr = __builtin_amdgcn_fractf(rev);
        c[e] = __builtin_amdgcn_cosf(fr); s[e] = __builtin_amdgcn_sinf(fr); }
}
__device__ __forceinline__ void st_bf16x8(bf16* p, f32x4 v0, f32x4 v1) { u32x4 w; w.x = cvt_pk_bf16(v0[0], v0[1]); w.y = cvt_pk_bf16(v0[2], v0[3]); w.z = cvt_pk_bf16(v1[0], v1[1]); w.w = cvt_pk_bf16(v1[2], v1[3]); *(u32x4*)p = w; }
struct EpiProj {
    static constexpr bool PERM = true, PERM64 = false, KHOOK = false;
    bf16* P; float *cqss, *ckvss; const LAS float* rs;
    __device__ __forceinline__ void operator()(AccRef acc, const Unit& u, int wr, int wc, int fr, int fq, int ui) const {
#pragma unroll
        for (int ai = 0; ai < 2; ++ai)
#pragma unroll
            for (int m = 0; m < 4; ++m) { const int row = u.pm * BM + ai * HALF + wr * 64 + m * 16 + fr; const int pos = row & (NS - 1); float ssq = 0.f; const float rsv = rs[ui * BM + ai * HALF + wr * 64 + m * 16 + fr];
#pragma unroll
                for (int bj = 0; bj < 2; ++bj) { const int cw = u.pn * BM + wc * 64 + bj * 32, col0 = cw + 8 * fq; f32x4 v0 = acc[ai][bj][m][0] * rsv, v1 = acc[ai][bj][m][1] * rsv;
                    if (cw >= C_SQ && cw < C_SV) { const int g = ((col0 - C_SQ) & 63) >> 3; f32x4 c, s; rope_cs<64>(pos, 4 * g, c, s);
                        const f32x4 o0 = v0 * c - v1 * s, o1 = v1 * c + v0 * s; v0 = o0; v1 = o1; }
                    else if (cw == C_KR) { f32x4 c, s; rope_cs<32>(pos, 4 * fq, c, s);
                        const f32x4 o0 = v0 * c - v1 * s, o1 = v1 * c + v0 * s; v0 = o0; v1 = o1; }
                    if (cw >= C_CQ && cw < C_KR) ssq += (v0[0] * v0[0] + v0[1] * v0[1]) + (v0[2] * v0[2] + v0[3] * v0[3]) + (v1[0] * v1[0] + v1[1] * v1[1]) + (v1[2] * v1[2] + v1[3] * v1[3]);
                    st_bf16x8(P + (size_t)row * NP + col0, v0, v1); }
                if (u.pn == 3 || u.pn == 4) { ssq += __shfl_xor(ssq, 16); ssq += __shfl_xor(ssq, 32); if (fq == 0) (u.pn == 3 ? cqss : ckvss)[(size_t)row * 4 + wc] = ssq; }
            }
    }
};
template <bool QMODE, int ldc, int ncols> struct EpiMla {
    static constexpr bool PERM = true, PERM64 = false, KHOOK = false;
    bf16* O; const LAS float* rs;
    __device__ __forceinline__ void operator()(AccRef acc, const Unit& u, int wr, int wc, int fr, int fq, int ui) const {
#pragma unroll
        for (int ai = 0; ai < 2; ++ai)
#pragma unroll
            for (int m = 0; m < 4; ++m) { const int row = u.pm * BM + ai * HALF + wr * 64 + m * 16 + fr; const int pos = row & (NS - 1);
                const float rsv = rs[ui * BM + ai * HALF + wr * 64 + m * 16 + fr];
#pragma unroll
                for (int bj = 0; bj < 2; ++bj) { const int cw = u.pn * BM + wc * 64 + bj * 32, col0 = cw + 8 * fq; if (cw >= ncols) continue;
                    f32x4 v0 = acc[ai][bj][m][0] * rsv, v1 = acc[ai][bj][m][1] * rsv;
                    if (QMODE && (cw % 96) == 64) { f32x4 c, s; rope_cs<32>(pos, 4 * fq, c, s);
                        const f32x4 o0 = v0 * c - v1 * s, o1 = v1 * c + v0 * s; v0 = o0; v1 = o1; }
                    st_bf16x8(O + (size_t)row * ldc + col0, v0, v1); }
                asm volatile("" ::: "memory"); }
    }
};
struct EpiResid {
    static constexpr bool PERM = true, PERM64 = false, KHOOK = true;
    bf16* HB; const LAS float* fac;
    __device__ __forceinline__ void khook(f32x4 (&acc)[2][2][4][2], int ui, int which, int wr, int fr) const {
#pragma unroll
        for (int ai = 0; ai < 2; ++ai)
#pragma unroll
            for (int m = 0; m < 4; ++m) { const float f = fac[(ui * BM + ai * HALF + wr * 64 + m * 16 + fr) * 4 + which];
#pragma unroll
                for (int bj = 0; bj < 2; ++bj)
#pragma unroll
                    for (int n = 0; n < 2; ++n) acc[ai][bj][m][n] *= f; }
    }
    __device__ __forceinline__ void operator()(AccRef acc, const Unit& u, int wr, int wc, int fr, int fq, int ui) const {
        u32x4 wva[2][4][2];
#pragma unroll
        for (int ai = 0; ai < 2; ++ai)
#pragma unroll
              for (int m = 0; m < 4; ++m)
#pragma unroll
                  for (int bj = 0; bj < 2; ++bj) wva[ai][m][bj] = *(const u32x4*)(HB + (size_t)(u.pm * BM + ai * HALF + wr * 64 + m * 16 + fr) * DM + u.pn * BM + wc * 64 + 8 * fq + bj * 32);
#pragma unroll
        for (int ai = 0; ai < 2; ++ai)
            { const u32x4 (&wv)[4][2] = wva[ai];
#pragma unroll
            for (int m = 0; m < 4; ++m) { const int rl = ai * HALF + wr * 64 + m * 16 + fr; const float f = fac[(ui * BM + rl) * 4 + 2]; bf16* p = HB + (size_t)(u.pm * BM + rl) * DM + u.pn * BM + wc * 64 + 8 * fq;
#pragma unroll
                for (int bj = 0; bj < 2; ++bj) { const u32x4 w = wv[m][bj]; f32x4 h0, h1;
                    h0[0] = __builtin_bit_cast(float, w[0] << 16); h0[1] = __builtin_bit_cast(float, w[0] & 0xffff0000u); h0[2] = __builtin_bit_cast(float, w[1] << 16); h0[3] = __builtin_bit_cast(float, w[1] & 0xffff0000u);
                    h1[0] = __builtin_bit_cast(float, w[2] << 16); h1[1] = __builtin_bit_cast(float, w[2] & 0xffff0000u); h1[2] = __builtin_bit_cast(float, w[3] << 16); h1[3] = __builtin_bit_cast(float, w[3] & 0xffff0000u);
                    st_bf16x8(p + bj * 32, h0 + acc[ai][bj][m][0] * f, h1 + acc[ai][bj][m][1] * f); } } }
    }
};
struct EpiSwiglu {
    static constexpr bool PERM = true, PERM64 = false, KHOOK = false;
    unsigned char* Hd; const LAS float* rs;
    __device__ __forceinline__ void operator()(AccRef acc, const Unit& u, int wr, int wc, int fr, int fq, int ui) const {
#pragma unroll
        for (int ai = 0; ai < 2; ++ai)
#pragma unroll
            for (int m = 0; m < 4; ++m) { const size_t row = (size_t)(u.pm * BM + ai * HALF + wr * 64 + m * 16 + fr); f32x4 o[2]; const float rsv = rs[ui * BM + ai * HALF + wr * 64 + m * 16 + fr];
                const float k1 = -rsv * LOG2E, ik2 = __builtin_amdgcn_rcpf(rsv * rsv * H8_SCALE); const f32x4 ik2v = {ik2, ik2, ik2, ik2};
#pragma unroll
                for (int n = 0; n < 2; ++n) { const f32x4 ag = acc[ai][0][m][n], au = acc[ai][1][m][n]; const f32x4 arg = ag * k1; f32x4 den;
#pragma unroll
                    for (int e = 0; e < 4; ++e) den[e] = __builtin_amdgcn_exp2f(arg[e]);
                    den = __builtin_elementwise_fma(den, ik2v, ik2v); f32x4 sg;
#pragma unroll
                    for (int e = 0; e < 4; ++e) sg[e] = __builtin_amdgcn_rcpf(den[e]);
                    o[n] = (ag * au) * sg; }
                *(uint2*)(Hd + row * DM + u.pn * HALF + wc * 32 + 8 * fq) = make_uint2(pk_fp8x4(o[0][0], o[0][1], o[0][2], o[0][3]), pk_fp8x4(o[1][0], o[1][1], o[1][2], o[1][3])); }
    }
};
struct EpiGate {
    static constexpr bool PERM = true, PERM64 = true, KHOOK = false; static constexpr int NST = 8;
    unsigned char* Y; const LAS float* gate;
    __device__ __forceinline__ void operator()(AccRef acc, const Unit& u, int wr, int wc, int fr, int fq, int ui) const {
#pragma unroll
        for (int ai = 0; ai < 2; ++ai)
#pragma unroll
            for (int m = 0; m < 4; ++m) { const size_t row = (size_t)(u.pm * BM + ai * HALF + wr * 64 + m * 16 + fr); const float gt = gate[ui * BM + ai * HALF + wr * 64 + m * 16 + fr];
                const f32x4 a0 = acc[ai][0][m][0] * gt, a1 = acc[ai][0][m][1] * gt, b0 = acc[ai][1][m][0] * gt, b1 = acc[ai][1][m][1] * gt; u32x4 w;
                w.x = pk_fp8x4(a0[0], a0[1], a0[2], a0[3]); w.y = pk_fp8x4(a1[0], a1[1], a1[2], a1[3]); w.z = pk_fp8x4(b0[0], b0[1], b0[2], b0[3]); w.w = pk_fp8x4(b1[0], b1[1], b1[2], b1[3]);
                *(u32x4*)(Y + row * DM + u.pn * BM + wc * 64 + 16 * fq) = w; }
    }
};
}


namespace att {
typedef short bf16x8 __attribute__((ext_vector_type(8)));
typedef short s16x4 __attribute__((ext_vector_type(4)));
typedef float f32x16 __attribute__((ext_vector_type(16)));
typedef float f32x4 __attribute__((ext_vector_type(4)));
typedef unsigned u32x4 __attribute__((ext_vector_type(4)));
typedef float f32x2_t __attribute__((ext_vector_type(2))); typedef __bf16 bf16x2_t __attribute__((ext_vector_type(2)));
typedef short v4i16_t __attribute__((ext_vector_type(4)));
constexpr int KSLOT = 12288, VSLOT = 8192, NSL = 3;
constexpr int L_K = 0, L_V = NSL * KSLOT, L_WS = L_V + NSL * VSLOT, L_OST = L_WS + 8 * 256, L_BIAS = L_OST + 8 * 4096, L_END = L_BIAS + 2048;
constexpr float THR = 8.f;
constexpr int ATT_PROBE = 0;
constexpr bool LSUM_MFMA = true;
__device__ __forceinline__ int crow(int r, int hi) { return (r & 3) + 8 * (r >> 2) + 4 * hi; }
__device__ __forceinline__ unsigned cvtpk(float lo, float hi) { f32x2_t v = {lo, hi}; bf16x2_t b = __builtin_convertvector(v, bf16x2_t); return __builtin_bit_cast(unsigned, b); }
__device__ __forceinline__ s16x4 vtr(const LAS unsigned char* p) { return __builtin_bit_cast(s16x4, __builtin_amdgcn_ds_read_tr16_b64_v4i16((LAS v4i16_t*)p)); }
__device__ __forceinline__ void glds(const bf16* src, unsigned lds_dst) { unsigned keep;
    asm volatile("s_mov_b32 %0, m0\n\ts_mov_b32 m0, %2\n\ts_nop 0\n\tglobal_load_lds_dwordx4 %1, off\n\ts_mov_b32 m0, %0" : "=&s"(keep) : "v"(src), "s"(lds_dst) : "memory"); }
struct AttnP { const bf16 *PROJ, *QB, *KV; bf16* O; float* SS; const float* rpb; const float* sink; const bf16* WUQ; const float* CQSS; };
#define ATT_WAIT_BAR() do { if (PROBE != 3) asm volatile("s_waitcnt vmcnt(0) lgkmcnt(0)\n\ts_barrier" ::: "memory"); } while (0)

template <int TYPE, int PROBE = 0> __device__ __forceinline__ void attn_unit(const AttnP& P, int b, int h, int qb, LAS unsigned char* lds, int tid_in) {
    constexpr int ND0 = (TYPE == 1) ? 6 : 4;
    int tid = tid_in; asm volatile("" : "+v"(tid));
    const int lane = tid & 63, r32 = lane & 31, hi = lane >> 5, wid = __builtin_amdgcn_readfirstlane(tid >> 6);
    const bool ordA = wid < 4;
    const int q0 = qb * 256, qw0 = q0 + wid * 32; const size_t tokb = (size_t)b * NS;
    int ntile, kbase, ta, tb;
    if (TYPE == 1) { ntile = NS / 64; kbase = 0; ta = 0; tb = ntile - 1; }
    else if (TYPE == 2) { kbase = max(q0 - 128, 0); const int ke = min(q0 + 384, NS); ntile = (ke - kbase) >> 6; ta = max(qw0 - 128 - kbase, 0) >> 6; tb = min(ntile - 1, (qw0 + 159 - kbase) >> 6); }
    else { const int r0 = qb * 4; kbase = min(max(r0 - 4, 0), 56); ntile = min(max(r0 - 1, 0), 56) + 7 - kbase + 1; const int r = r0 + (wid >> 1); ta = min(max(r - 4, 0), 56) - kbase; tb = ta + 7; }
    const int kvh = (TYPE == 2) ? h / 3 : h;
    const bf16 *ksrc, *ksrc2 = nullptr, *vsrc; size_t kpitch, vpitch;
    { const size_t key0 = tokb + (TYPE == 0 ? (size_t)kbase * 64 : (size_t)kbase); const int vrow = 16 * (wid & 3) + (lane >> 2), vcol = (wid >> 2) * 32 + (lane & 3) * 8;
      if (TYPE == 0) { ksrc = P.PROJ + (key0 + lane) * NP + C_AK + h * 64 + wid * 8; vsrc = P.PROJ + (key0 + vrow) * NP + C_AV + h * 64 + vcol; kpitch = vpitch = NP; }
      else if (TYPE == 1) { ksrc = P.KV + (key0 + lane) * 768 + h * 64 + wid * 8; ksrc2 = P.PROJ + (key0 + lane) * NP + C_KR + (wid & 3) * 8; vsrc = P.KV + (key0 + vrow) * 768 + 384 + h * 64 + vcol; kpitch = vpitch = 768; }
      else { ksrc = P.PROJ + (key0 + lane) * NP + C_SK + kvh * 64 + wid * 8; vsrc = P.PROJ + (key0 + vrow) * NP + C_SV + kvh * 64 + vcol; kpitch = vpitch = NP; } }
    const unsigned kdst = (unsigned)(uintptr_t)(lds + L_K) + wid * 1024, vdst = (unsigned)(uintptr_t)(lds + L_V) + wid * 1024;
#define ATT_DMA(t, slot) do { if (PROBE == 2 || PROBE == 3) break; glds(ksrc + (size_t)(t) * 64 * kpitch, (unsigned)__builtin_amdgcn_readfirstlane(kdst + (slot) * KSLOT)); if (TYPE == 1 && wid < 4) glds(ksrc2 + (size_t)(t) * 64 * NP, (unsigned)__builtin_amdgcn_readfirstlane(kdst + (slot) * KSLOT + 8192)); \
        glds(vsrc + (size_t)(t) * 64 * vpitch, (unsigned)__builtin_amdgcn_readfirstlane(vdst + (slot) * VSLOT)); } while (0)
    LAS float* biasL = (LAS float*)(lds + L_BIAS);
    if (TYPE == 0) { for (int i = tid; i < 15 * 31; i += 512) biasL[i] = P.rpb[h * 465 + i] * LOG2E; }
    bf16x8 qr[ND0];
    bf16x8 cqf[(TYPE == 1) ? 16 : 1]; float4 cqs = make_float4(0.f, 0.f, 0.f, 0.f);
    if (TYPE == 1) {
#pragma unroll
        for (int k6 = 0; k6 < 6; ++k6) { const int f = wid * 6 + k6, tile = f >> 4, ks = f & 15, dpos = 32 * tile + 16 * (r32 >> 4) + 8 * ((r32 >> 2) & 1) + 4 * ((r32 >> 3) & 1) + (r32 & 3);
            glds(P.WUQ + (size_t)(h * 96 + dpos) * 256 + 16 * ks + 8 * hi, (unsigned)__builtin_amdgcn_readfirstlane((unsigned)(uintptr_t)(lds + L_OST) + f * 1024)); }
        const bf16* cq = P.PROJ + (tokb + qw0 + r32) * NP + C_CQ + hi * 8;
#pragma unroll
        for (int ks = 0; ks < 16; ++ks) cqf[ks] = *(const bf16x8*)(cq + 16 * ks);
        cqs = *(const float4*)(P.CQSS + (tokb + qw0 + r32) * 4);
    } else { const bf16* qp = P.PROJ + (tokb + qw0 + r32) * NP + (TYPE == 0 ? C_AQ : C_SQ) + h * 64;
#pragma unroll
      for (int d0 = 0; d0 < ND0; ++d0) qr[d0] = *(const bf16x8*)(qp + d0 * 16 + hi * 8); }
    LAS float* wsf = (LAS float*)(lds + L_WS) + wid * 64;
    float m = (TYPE == 2) ? P.sink[h] * LOG2E : 0.f;
    f32x16 negm; { const float nm = -m;
#pragma unroll
      for (int r = 0; r < 16; ++r) negm[r] = nm; }
    f32x16 o[2]; o[0] = f32x16{}; o[1] = f32x16{};
    f32x16 lacc;
    { const float l0 = (TYPE == 2) ? 1.f : 0.f;
#pragma unroll
      for (int r = 0; r < 16; ++r) lacc[r] = l0; }
    float lsum = (TYPE == 2 && hi == 0) ? 1.f : 0.f;
    const bf16x8 ones = (bf16x8){0x3F80, 0x3F80, 0x3F80, 0x3F80, 0x3F80, 0x3F80, 0x3F80, 0x3F80};
    f32x16 sA0, sA1, sB0, sB1;
#define ATT_QK(X0, X1, tt, sl) do { const LAS unsigned char* Kp = lds + L_K + (sl) * KSLOT + hi * 1024 + r32 * 16; X0 = negm; X1 = negm; \
        bf16x8 ka0 = *(const LAS bf16x8*)(Kp), ka1 = *(const LAS bf16x8*)(Kp + 512); \
        _Pragma("unroll") for (int d0 = 0; d0 < ND0; ++d0) { bf16x8 kb0 = ka0, kb1 = ka1; \
            if (d0 + 1 < ND0) { kb0 = *(const LAS bf16x8*)(Kp + (d0 + 1) * 2048); kb1 = *(const LAS bf16x8*)(Kp + (d0 + 1) * 2048 + 512); }     \
            X0 = __builtin_amdgcn_mfma_f32_32x32x16_bf16(ka0, qr[d0], X0, 0, 0, 0); X1 = __builtin_amdgcn_mfma_f32_32x32x16_bf16(ka1, qr[d0], X1, 0, 0, 0); ka0 = kb0; ka1 = kb1; } \
        __builtin_amdgcn_sched_group_barrier(0x100, 2, 0); __builtin_amdgcn_sched_group_barrier(0x100, 2, 0);        \
        _Pragma("unroll") for (int d0 = 0; d0 + 2 < ND0; ++d0) { __builtin_amdgcn_sched_group_barrier(0x8, 2, 0); __builtin_amdgcn_sched_group_barrier(0x100, 2, 0); } \
        __builtin_amdgcn_sched_group_barrier(0x8, 2, 0); __builtin_amdgcn_sched_group_barrier(0x8, 2, 0); \
        if (TYPE == 2) { const int dq = qw0 + r32 - (kbase + (tt) * 64) - 4 * hi; \
            _Pragma("unroll") for (int r = 0; r < 16; ++r) { const int d0_ = dq - ((r & 3) + 8 * (r >> 2)), d1_ = d0_ - 32; \
                if (d0_ > 128 || d0_ < -128) X0[r] = -INFINITY; if (d1_ > 128 || d1_ < -128) X1[r] = -INFINITY; } } \
        if (TYPE == 0) { const int c = (wid & 1) * 32 + r32, cs = min(max(c - 8, 0), 48); const int rq = qb * 4 + (wid >> 1), kr = kbase + (tt); const LAS float* brow = biasL + (kr - rq + 7) * 31 + 15 - c; \
            _Pragma("unroll") for (int rr = 0; rr < 16; ++rr) { const int kc0 = crow(rr, hi), kc1 = kc0 + 32; \
                const bool v0 = kc0 >= cs && kc0 < cs + 16, v1 = kc1 >= cs && kc1 < cs + 16; \
                X0[rr] = v0 ? X0[rr] + brow[v0 ? kc0 : c] : -INFINITY; X1[rr] = v1 ? X1[rr] + brow[v1 ? kc1 : c] : -INFINITY; } } \
        asm volatile("s_nop 15\n\ts_nop 7" : "+v"(X0), "+v"(X1)); } while (0)
#define ATT_MAX3(a, b, c) ({ float r_; asm("v_max3_f32 %0, %1, %2, %3" : "=v"(r_) : "v"(a), "v"(b), "v"(c)); r_; })
#define ATT_STEP(ORDA, C0, C1, N0, N1, t) do { \
        if ((t) + 1 < ntile) ATT_WAIT_BAR(); \
        if ((t) + 2 < ntile) ATT_DMA((t) + 2, sl_nn); \
        const bool act = ((t) >= ta && (t) <= tb), nact = ((t) + 1 >= ta && (t) + 1 <= tb); \
        if (ORDA && nact) ATT_QK(N0, N1, (t) + 1, sl_nxt); \
        if (act) { \
            float ma = 0.f, mb = 0.f; if (PROBE != 4) { ma = ATT_MAX3(C0[0], C0[1], C1[0]); mb = ATT_MAX3(C0[2], C0[3], C1[1]); ma = ATT_MAX3(ma, C1[2], C1[3]); \
            _Pragma("unroll") for (int r = 4; r < 16; r += 4) { ma = ATT_MAX3(ma, C0[r], C0[r + 1]); mb = ATT_MAX3(mb, C0[r + 2], C0[r + 3]); ma = ATT_MAX3(ma, C1[r], C1[r + 1]); mb = ATT_MAX3(mb, C1[r + 2], C1[r + 3]); } } \
            float rm = fmaxf(ma, mb); \
            { auto rr = __builtin_amdgcn_permlane32_swap(__float_as_uint(rm), __float_as_uint(rm), false, false); rm = fmaxf(__uint_as_float(rr[0]), __uint_as_float(rr[1])); } \
            const bool first = (TYPE != 2) && ((t) == ta); \
            if (first || __any(rm > THR)) { const float dl = first ? rm : fmaxf(rm, 0.f), f = first ? 1.f : __builtin_amdgcn_exp2f(-dl); m += dl; lsum *= f; \
                _Pragma("unroll") for (int r = 0; r < 16; ++r) { C0[r] -= dl; C1[r] -= dl; negm[r] = -m; } \
                if (ORDA && nact) { _Pragma("unroll") for (int r = 0; r < 16; ++r) { N0[r] -= dl; N1[r] -= dl; } } \
                if (hi == 0) wsf[r32] = f; \
                _Pragma("unroll") for (int g = 0; g < 4; ++g) { const f32x4 fv = *(const LAS f32x4*)(wsf + 8 * g + 4 * hi); \
                    _Pragma("unroll") for (int e = 0; e < 4; ++e) { o[0][4 * g + e] *= fv[e]; o[1][4 * g + e] *= fv[e]; lacc[4 * g + e] *= fv[e]; } } } \
            const LAS unsigned char* Vp = lds + L_V + sl_cur * VSLOT + ((lane >> 4) & 1) * 32 + (lane & 3) * 8 + (4 * hi + ((lane & 15) >> 2)) * 64; \
            s16x4 va[4], vb[4]; \
            va[0] = vtr(Vp); va[1] = vtr(Vp + 512); va[2] = vtr(Vp + 4096); va[3] = vtr(Vp + 4096 + 512);        \
            if (PROBE != 4) { _Pragma("unroll") for (int r = 0; r < 16; ++r) { C0[r] = __builtin_amdgcn_exp2f(C0[r]); C1[r] = __builtin_amdgcn_exp2f(C1[r]); } } \
            if (!LSUM_MFMA) { float sa = 0.f, sb = 0.f; _Pragma("unroll") for (int r = 0; r < 16; ++r) { sa += C0[r]; sb += C1[r]; } lsum += sa + sb; } \
            u32x4 pw[4]; \
            _Pragma("unroll") for (int e = 0; e < 4; ++e) { pw[0][e] = cvtpk(C0[2 * e], C0[2 * e + 1]); pw[1][e] = cvtpk(C0[8 + 2 * e], C0[9 + 2 * e]); pw[2][e] = cvtpk(C1[2 * e], C1[2 * e + 1]); pw[3][e] = cvtpk(C1[8 + 2 * e], C1[9 + 2 * e]); } \
            _Pragma("unroll") for (int ks = 0; ks < 4; ++ks) { const bf16x8 pa = __builtin_bit_cast(bf16x8, pw[ks]); \
                if (ks + 1 < 4) { vb[0] = vtr(Vp + (ks + 1) * 1024); vb[1] = vtr(Vp + (ks + 1) * 1024 + 512); vb[2] = vtr(Vp + 4096 + (ks + 1) * 1024); vb[3] = vtr(Vp + 4096 + (ks + 1) * 1024 + 512); }     \
                o[0] = __builtin_amdgcn_mfma_f32_32x32x16_bf16(pa, ((bf16x8){va[0][0], va[0][1], va[0][2], va[0][3], va[1][0], va[1][1], va[1][2], va[1][3]}), o[0], 0, 0, 0); \
                o[1] = __builtin_amdgcn_mfma_f32_32x32x16_bf16(pa, ((bf16x8){va[2][0], va[2][1], va[2][2], va[2][3], va[3][0], va[3][1], va[3][2], va[3][3]}), o[1], 0, 0, 0); \
                if (LSUM_MFMA) lacc = __builtin_amdgcn_mfma_f32_32x32x16_bf16(pa, ones, lacc, 0, 0, 0); \
                _Pragma("unroll") for (int q_ = 0; q_ < 4; ++q_) va[q_] = vb[q_]; } \
            __builtin_amdgcn_sched_group_barrier(0x100, 4, 1); \
            _Pragma("unroll") for (int ks = 0; ks < 3; ++ks) { __builtin_amdgcn_sched_group_barrier(0x100, 4, 1); __builtin_amdgcn_sched_group_barrier(0x8, LSUM_MFMA ? 3 : 2, 1); } \
            __builtin_amdgcn_sched_group_barrier(0x8, LSUM_MFMA ? 3 : 2, 1); \
        } \
        if (!(ORDA) && nact) ATT_QK(N0, N1, (t) + 1, sl_nxt); \
        { const int tmp = sl_cur; sl_cur = sl_nxt; sl_nxt = sl_nn; sl_nn = tmp; } } while (0)
    ATT_DMA(0, 0);
    if (ntile > 1) ATT_DMA(1, 1);
    if (PROBE == 2 || PROBE == 3) {} else if (ntile > 1) { if (TYPE == 1 && wid < 4) asm volatile("s_waitcnt vmcnt(3)" ::: "memory"); else asm volatile("s_waitcnt vmcnt(2)" ::: "memory"); } else asm volatile("s_waitcnt vmcnt(0)" ::: "memory");
    asm volatile("s_waitcnt lgkmcnt(0)\n\ts_barrier" ::: "memory");
    if (TYPE == 1) { f32x16 qa[3];
#pragma unroll
        for (int tile = 0; tile < 3; ++tile) { qa[tile] = f32x16{};
#pragma unroll
            for (int ks = 0; ks < 16; ++ks) qa[tile] = __builtin_amdgcn_mfma_f32_32x32x16_bf16(*(const LAS bf16x8*)(lds + L_OST + (tile * 16 + ks) * 1024 + lane * 16), cqf[ks], qa[tile], 0, 0, 0); }
        const float rq = rsqrtf((cqs.x + cqs.y + cqs.z + cqs.w) * (1.f / 256.f) + EPS); const int pos = (qw0 + r32) & (NS - 1);
#pragma unroll
        for (int tile = 0; tile < 3; ++tile)
#pragma unroll
            for (int r = 0; r < 16; ++r) qa[tile][r] *= rq;
#pragma unroll
        for (int t = 0; t < 2; ++t) { f32x4 c, sn; pg8::rope_cs<32>(pos, 4 * (2 * t + hi), c, sn);
#pragma unroll
            for (int e = 0; e < 4; ++e) { const float v0 = qa[2][8 * t + e], v1 = qa[2][8 * t + 4 + e]; qa[2][8 * t + e] = v0 * c[e] - v1 * sn[e]; qa[2][8 * t + 4 + e] = v1 * c[e] + v0 * sn[e]; } }
#pragma unroll
        for (int d0 = 0; d0 < 6; ++d0) { const int tile = d0 >> 1, t8 = (d0 & 1) * 8; u32x4 w;
            w.x = cvtpk(qa[tile][t8 + 0], qa[tile][t8 + 1]); w.y = cvtpk(qa[tile][t8 + 2], qa[tile][t8 + 3]); w.z = cvtpk(qa[tile][t8 + 4], qa[tile][t8 + 5]); w.w = cvtpk(qa[tile][t8 + 6], qa[tile][t8 + 7]);
            qr[d0] = __builtin_bit_cast(bf16x8, w); } }
    if (ta == 0) ATT_QK(sA0, sA1, 0, 0);
    int sl_cur = 0, sl_nxt = 1, sl_nn = 2;
    if (ordA) {
        for (int t = 0; t < ntile; t += 2) { ATT_STEP(true, sA0, sA1, sB0, sB1, t); if (t + 1 < ntile) ATT_STEP(true, sB0, sB1, sA0, sA1, t + 1); }
    } else {
        for (int t = 0; t < ntile; t += 2) { ATT_STEP(false, sA0, sA1, sB0, sB1, t); if (t + 1 < ntile) ATT_STEP(false, sB0, sB1, sA0, sA1, t + 1); }
    }
    LAS bf16* stg = (LAS bf16*)(lds + L_OST) + wid * 2048;
    if (!LSUM_MFMA) { { auto rr = __builtin_amdgcn_permlane32_swap(__float_as_uint(lsum), __float_as_uint(lsum), false, false); lsum = __uint_as_float(rr[0]) + __uint_as_float(rr[1]); }
        if (hi == 0) wsf[32 + r32] = lsum;
#pragma unroll
        for (int g = 0; g < 4; ++g) { const f32x4 lv = *(const LAS f32x4*)(wsf + 32 + 8 * g + 4 * hi);
#pragma unroll
            for (int e = 0; e < 4; ++e) lacc[4 * g + e] = lv[e]; } }
#pragma unroll
    for (int r = 0; r < 16; ++r) { const float iv = __builtin_amdgcn_rcpf(lacc[r]); const int orow = crow(r, hi);
        stg[orow * 64 + r32] = (bf16)(cvtpk(o[0][r] * iv, 0.f) & 0xffff); stg[orow * 64 + 32 + r32] = (bf16)(cvtpk(o[1][r] * iv, 0.f) & 0xffff); }
    const int ocol = (TYPE == 0 ? 0 : (TYPE == 1 ? 256 : 640)) + h * 64, sidx = (TYPE == 0 ? 0 : (TYPE == 1 ? 4 : 10)) + h;
#pragma unroll
    for (int i = 0; i < 4; ++i) { const int row = i * 8 + (lane >> 3), ch = lane & 7; const u32x4 v = *(const LAS u32x4*)(stg + row * 64 + ch * 8);
        const size_t tokn = tokb + qw0 + row; if (PROBE == 0) *(u32x4*)(P.O + tokn * DM + ocol + ch * 8) = v; else asm volatile("" :: "v"(v));
        float sq = 0.f;
#pragma unroll
        for (int e = 0; e < 4; ++e) { const float a = __builtin_bit_cast(float, v[e] << 16), c2 = __builtin_bit_cast(float, v[e] & 0xffff0000u); sq += a * a + c2 * c2; }
        sq += __shfl_xor(sq, 1); sq += __shfl_xor(sq, 2); sq += __shfl_xor(sq, 4);
        if (ch == 0 && PROBE == 0) P.SS[tokn * 16 + sidx] = sq; }
    ATT_WAIT_BAR();
#undef ATT_DMA
#undef ATT_QK
#undef ATT_STEP
#undef ATT_MAX3
}
__device__ __forceinline__ void attn_phase(const AttnP& P, LAS unsigned char* lds, int vcu, int tid) {
    const int x = vcu >> 5, cx = vcu & 31;
    for (int i = 0; i < 3; ++i) { const int j = cx * 3 + i, bh = 6 * x + (j >> 4), qb = j & 15; attn_unit<1>(P, bh / 6, bh % 6, qb, lds, tid); }
    if (ATT_PROBE) for (int i = 0; i < 3; ++i) { const int j = cx * 3 + i, bh = 6 * x + (j >> 4), qb = j & 15; attn_unit<1, ATT_PROBE>(P, bh / 6, bh % 6, qb, lds, tid); }
    for (int i = 0; i < 3; ++i) { const int j = cx * 3 + i, bh = 6 * x + (j >> 4), qb = j & 15; attn_unit<2>(P, bh / 6, bh % 6, qb, lds, tid); }
    for (int i = 0; i < 2; ++i) { const int j = cx * 2 + i, bh = 4 * x + (j >> 4), qb = j & 15; attn_unit<0>(P, bh >> 2, bh & 3, qb, lds, tid); }
}
}


constexpr int NWAVES = 8, LDS_BYTES = 155648, RING_BYTES = 131072, MISC_OFF = RING_BYTES + 320, TAB_OFF = RING_BYTES + 512;
#define XB_TMO      128
#define XB_XCNT(j)  (256  + 64 * (j))
#define XB_XSUB(j)  (1280 + 64 * (j))
#define XB_XGEN(j)  (2304 + 64 * (j))
#define XB_TOP      3328
#define XB_TOPGEN   3392
#define XCD_BAR_WORDS 3456
#define XB_SPIN_CAP (1u << 18)
constexpr int CW_BAR = 4096;
__device__ __forceinline__ unsigned xb_ld(unsigned* p)              { return __hip_atomic_load(p, __ATOMIC_RELAXED, __HIP_MEMORY_SCOPE_AGENT); }
__device__ __forceinline__ unsigned xb_add(unsigned* p, unsigned v) { return __hip_atomic_fetch_add(p, v, __ATOMIC_RELAXED, __HIP_MEMORY_SCOPE_AGENT); }
__device__ __forceinline__ unsigned xb_xcc_id() { return (unsigned)__builtin_amdgcn_s_getreg((3 << 11) | 20) & 0xFu; }
#define XB_SPIN(cond, bar) do { unsigned _sp = 0; while (cond) { __builtin_amdgcn_s_sleep(1); \
    if ((++_sp & 255u) == 0u) { if (xb_ld(&(bar)[XB_TMO])) break; if (_sp > XB_SPIN_CAP) { atomicAdd(&(bar)[XB_TMO], 1u); break; } } } } while (0)
struct XcdBarrier { unsigned* bar; unsigned x; volatile LAS unsigned* st; };
__device__ __forceinline__ XcdBarrier xcd_barrier_post(unsigned* bar, volatile LAS unsigned* st) {
    XcdBarrier b; b.bar = bar; b.x = xb_xcc_id(); b.st = st;
    if (threadIdx.x == 0) (void)xb_add(&bar[XB_XCNT(b.x)], 1u);
    return b;
}
__device__ __forceinline__ void xcd_barrier_complete(unsigned* bar, unsigned x, unsigned& nloc, unsigned& nx) {
    const unsigned G = gridDim.x * gridDim.y * gridDim.z;
    unsigned sum, cnt, mine, sp = 0u;
    for (;;) {
        sum = 0u; cnt = 0u; mine = 0u;
#pragma unroll
        for (unsigned j = 0; j < 16; ++j) { const unsigned c = xb_ld(&bar[XB_XCNT(j)]); sum += c; cnt += (c > 0u) ? 1u : 0u; mine = (j == x) ? c : mine; }
        if (sum == G) break;
        __builtin_amdgcn_s_sleep(1);
        if ((++sp & 255u) == 0u) { if (xb_ld(&bar[XB_TMO])) break; if (sp > XB_SPIN_CAP) { atomicAdd(&bar[XB_TMO], 1u); break; } }
    }
    nloc = mine > 0u ? mine : 1u; nx = cnt > 0u ? cnt : 1u;
}
__device__ __forceinline__ void xcd_barrier(const XcdBarrier& b, bool leader) {
    asm volatile("s_waitcnt vmcnt(0)" ::: "memory");
    __syncthreads();
    if (leader) {
        unsigned long long zb = 0; asm volatile("" : "+s"(zb)); unsigned* bar = b.bar + zb;
        __builtin_amdgcn_s_waitcnt(0);
        unsigned nloc = b.st[0], nx = b.st[1];
        if (nloc == 0u) { xcd_barrier_complete(bar, b.x, nloc, nx); b.st[0] = nloc; b.st[1] = nx; }
        const unsigned old = xb_add(&bar[XB_XSUB(b.x)], 1u);
        const unsigned gen = old / nloc;
        if (old + 1u == (gen + 1u) * nloc) {
            __builtin_amdgcn_fence(__ATOMIC_RELEASE, "agent");
            asm volatile("s_waitcnt vmcnt(0)" ::: "memory");
            const unsigned og = xb_add(&bar[XB_TOP], 1u);
            const unsigned tg = og / nx;
            if (og + 1u == (tg + 1u) * nx) xb_add(&bar[XB_TOPGEN], 1u);
            else XB_SPIN(xb_ld(&bar[XB_TOPGEN]) == tg, bar);
            __builtin_amdgcn_fence(__ATOMIC_ACQUIRE, "agent");
            xb_add(&bar[XB_XGEN(b.x)], 1u);
            asm volatile("s_waitcnt vmcnt(0)" ::: "memory");
        } else {
            XB_SPIN(xb_ld(&bar[XB_XGEN(b.x)]) == gen, bar);
            __builtin_amdgcn_fence(__ATOMIC_ACQUIRE, "agent");
            asm volatile("s_waitcnt vmcnt(0)" ::: "memory");
        }
    }
    __syncthreads();
}

struct MegaArgs {
    const float *x, *attn_norm, *w_in, *na_rpb, *q_norm, *w_uq, *kv_norm, *w_ukv, *swa_sink, *group_norm, *w_out, *ffn_norm, *w_router, *w_gate, *w_up, *w_down, *final_norm;
    float* out; unsigned char* ws;
    int ph_lo, ph_hi;
};

__device__ __forceinline__ void prep_item(int kind, const float* W, const float* W2, const float* kgain, bf16* Wt, int K, int Nsrc, int nblk, int item, LAS float* scr, int lane) {
    const int kb = item / nblk, nb = item % nblk, k0 = 64 * kb, n0 = 32 * nb, r = lane >> 3, q = lane & 7;
    float sc; int which; const int src4 = prep_map(kind, n0 + 4 * q, sc, which); const float* Wb = which ? W2 : W;
    float4 v[8];
#pragma unroll
    for (int i = 0; i < 8; ++i) v[i] = (src4 >= 0) ? *(const float4*)(Wb + (size_t)(k0 + 8 * i + r) * Nsrc + src4) : make_float4(0.f, 0.f, 0.f, 0.f);
#pragma unroll
    for (int i = 0; i < 8; ++i) { const float g = (kgain ? kgain[k0 + 8 * i + r] : 1.f) * sc; LAS float* d = scr + (8 * i + r) * 33 + 4 * q; d[0] = v[i].x * g; d[1] = v[i].y * g; d[2] = v[i].z * g; d[3] = v[i].w * g; }
    asm volatile("s_waitcnt lgkmcnt(0)" ::: "memory");
    const int c = lane & 7;
#pragma unroll
    for (int j = 0; j < 4; ++j) { const int n = (lane >> 3) + 8 * j; const LAS float* s = scr + (8 * c) * 33 + n;
        if (kind == PK_WGU || kind == PK_WD) { *(uint2*)((unsigned char*)Wt + (size_t)(n0 + n) * K + k0 + 8 * c) = make_uint2(pk_fp8x4(s[0], s[33], s[2 * 33], s[3 * 33]), pk_fp8x4(s[4 * 33], s[5 * 33], s[6 * 33], s[7 * 33])); continue; }
        uint4 o; o.x = f2bf(s[0]) | (f2bf(s[33]) << 16); o.y = f2bf(s[2 * 33]) | (f2bf(s[3 * 33]) << 16); o.z = f2bf(s[4 * 33]) | (f2bf(s[5 * 33]) << 16); o.w = f2bf(s[6 * 33]) | (f2bf(s[7 * 33]) << 16);
        *(uint4*)(Wt + (size_t)(n0 + n) * K + k0 + 8 * c) = o; }
    asm volatile("s_waitcnt lgkmcnt(0)" ::: "memory");
}
__device__ __forceinline__ void ph_prep(const MegaArgs& a, int l, int part, LAS unsigned char* lds, int gw, int ngw, int wave, int lane, int sub = 0, int nsub = 1) {
    unsigned char* ws = a.ws; LAS float* scr = (LAS float*)(lds + wave * 8448);
    constexpr int I_WIN = 16 * 64, I_WUQ = 4 * 24, I_WUKV = 2 * 24, I_WOUT = 16 * 32, I_WGU1 = 16 * 64, I_WGU = NE * I_WGU1, I_WD1 = 16 * 32, I_WD = NE * I_WD1;
    constexpr int NITEMS = I_WIN + I_WUQ + I_WUKV + I_WOUT + I_WGU + I_WD;
    const int p0 = (part == 0 || part == 2) ? 0 : (part == 3 ? I_WGU : I_WGU + I_WD), p1 = part == 2 ? I_WGU : ((part == 0 || part == 3) ? I_WGU + I_WD : NITEMS);
    const int it0 = p0 + (int)((long)(p1 - p0) * sub / nsub), it1 = p0 + (int)((long)(p1 - p0) * (sub + 1) / nsub);
    for (int it = it0 + gw; it < it1; it += ngw) { int r = it;
        if (r < I_WGU) { const int e = r / I_WGU1; prep_item(PK_WGU, a.w_gate + ((size_t)l * NE + e) * DM * DM, a.w_up + ((size_t)l * NE + e) * DM * DM, a.ffn_norm + l * DM, (bf16*)(ws + WS_WGU + (size_t)e * 2048 * DM), DM, DM, 64, r % I_WGU1, scr, lane); continue; } r -= I_WGU;
        if (r < I_WD) { const int e = r / I_WD1; prep_item(PK_WD, a.w_down + ((size_t)l * NE + e) * DM * DM, nullptr, nullptr, (bf16*)(ws + WS_WD + (size_t)e * DM * DM), DM, DM, 32, r % I_WD1, scr, lane); continue; } r -= I_WD;
        if (r < I_WIN) { prep_item(PK_WIN, a.w_in + (size_t)l * DM * C_END, nullptr, a.attn_norm + l * DM, (bf16*)(ws + WS_WIN), DM, C_END, 64, r, scr, lane); continue; } r -= I_WIN;
        if (r < I_WOUT) { prep_item(PK_WOUT, a.w_out + (size_t)l * DM * DM, nullptr, a.group_norm + l * DM, (bf16*)(ws + WS_WOUT), DM, DM, 32, r, scr, lane); continue; } r -= I_WOUT;
        if (r < I_WUQ) { prep_item(PK_WUQ, a.w_uq + (size_t)l * 256 * 576, nullptr, a.q_norm + l * 256, (bf16*)(ws + WS_WUQ), 256, 576, 24, r, scr, lane); continue; } r -= I_WUQ;
        prep_item(PK_WUKV, a.w_ukv + (size_t)l * 128 * 768, nullptr, a.kv_norm + l * 128, (bf16*)(ws + WS_WUKV), 128, 768, 24, r, scr, lane);
    }
}
__device__ __forceinline__ void row_store_bf16(const float4 (&v)[4], bf16* orow, float* rstd_out, int lane) {
    float s = 0.f;
#pragma unroll
    for (int j = 0; j < 4; ++j) s += v[j].x * v[j].x + v[j].y * v[j].y + v[j].z * v[j].z + v[j].w * v[j].w;
    const float rstd = rsqrtf(wave_sum(s) * (1.f / DM) + EPS);
    uint2* o = (uint2*)orow + lane;
#pragma unroll
    for (int j = 0; j < 4; ++j) o[64 * j] = make_uint2(f2bf(v[j].x) | (f2bf(v[j].y) << 16), f2bf(v[j].z) | (f2bf(v[j].w) << 16));
    if (lane == 0) *rstd_out = rstd;
}
__device__ __forceinline__ void ph_norm_x(const MegaArgs& a, int gw, int ngw, int lane) {
    bf16* HB = (bf16*)(a.ws + WS_HB); float* R1 = (float*)(a.ws + WS_RSTD1);
    for (int row = gw * 4; row < NT; row += ngw * 4) {
        float4 v[4][4];
#pragma unroll
        for (int r = 0; r < 4; ++r) { const float4* hr = (const float4*)(a.x + (size_t)(row + r) * DM) + lane;
#pragma unroll
            for (int j = 0; j < 4; ++j) v[r][j] = hr[64 * j]; }
#pragma unroll
        for (int r = 0; r < 4; ++r) row_store_bf16(v[r], HB + (size_t)(row + r) * DM, R1 + row + r, lane);
    }
}
__device__ __forceinline__ void ld_row_bf16(const bf16* row, float4 (&v)[4], int lane) {
    const uint2* p = (const uint2*)row + lane;
#pragma unroll
    for (int j = 0; j < 4; ++j) { const uint2 w = p[64 * j]; v[j] = make_float4(bf2f(w.x & 0xffff), bf2f(w.x >> 16), bf2f(w.y & 0xffff), bf2f(w.y >> 16)); }
}
__device__ __forceinline__ void ph_router(const MegaArgs& a, int l, LAS unsigned char* lds, int gw, int ngw, int lane, int tid) {
    static_assert(NT == 256 * NWAVES * 16, "one 16-row step per wave");
    LAS unsigned short* wl = (LAS unsigned short*)lds;
    const float* wr = a.w_router + (size_t)l * DM * NE; const float* g = a.ffn_norm + l * DM;
    const int rot = (gw / NWAVES) & 7;
    for (int h2 = 0; h2 < 2; ++h2) { float4 wv[4]; float gv[4];
#pragma unroll
      for (int it = 0; it < 4; ++it) { const int i4 = tid + (((h2 * 4 + it) + rot) & 7) * NWAVES * 64; wv[it] = ((const float4*)wr)[i4]; gv[it] = g[i4 >> 2]; }
#pragma unroll
      for (int it = 0; it < 4; ++it) { const int i4 = tid + (((h2 * 4 + it) + rot) & 7) * NWAVES * 64, k = i4 >> 2, e0 = (i4 & 3) * 4;
          const int pos = (((k >> 6) * 2 + ((k >> 3) & 1)) * 4 + ((k >> 4) & 3)) * 128 + (k & 7);
          const float w4[4] = {wv[it].x * gv[it], wv[it].y * gv[it], wv[it].z * gv[it], wv[it].w * gv[it]};
#pragma unroll
          for (int e = 0; e < 4; ++e) { const unsigned hi = f2bf(w4[e]); const float r1 = w4[e] - bf2f((unsigned short)hi); const unsigned mid = f2bf(r1); const float r2 = r1 - bf2f((unsigned short)mid); const unsigned lo = f2bf(r2);
              LAS unsigned short* d = wl + pos + (e0 + e) * 8; d[0] = (unsigned short)hi; d[16384] = (unsigned short)mid; d[32768] = (unsigned short)lo; } } }
    __syncthreads();
    const bf16* HB = (const bf16*)(a.ws + WS_HB); float* AFF = (float*)(a.ws + WS_AFF); float* R2 = (float*)(a.ws + WS_RSTD2); unsigned char* HB8 = a.ws + WS_HB8;
    const int row0 = gw * 16, ri = lane & 15, kq = lane >> 4;
    const pg8::u32x4* hp = (const pg8::u32x4*)(HB + (size_t)(row0 + ri) * DM + 16 * kq);
    pg8::u32x4* h8 = (pg8::u32x4*)(HB8 + (size_t)(row0 + ri) * DM + 16 * kq);
    pg8::f32x4 acc = {0.f, 0.f, 0.f, 0.f}; float ssq = 0.f;
#pragma unroll
    for (int hb = 0; hb < 2; ++hb) { pg8::u32x4 hv[8][2];
#pragma unroll
        for (int s8 = 0; s8 < 8; ++s8) { hv[s8][0] = hp[(hb * 8 + s8) * 8]; hv[s8][1] = hp[(hb * 8 + s8) * 8 + 1]; }
#pragma unroll
        for (int s8 = 0; s8 < 8; ++s8) { const int sl = hb * 8 + s8; float f[16];
#pragma unroll
            for (int t = 0; t < 2; ++t) {
#pragma unroll
                for (int q = 0; q < 4; ++q) { const unsigned w = hv[s8][t][q]; f[t * 8 + 2 * q] = __builtin_bit_cast(float, w << 16); f[t * 8 + 2 * q + 1] = __builtin_bit_cast(float, w & 0xffff0000u); }
                const pg8::bf16x8 af = __builtin_bit_cast(pg8::bf16x8, hv[s8][t]);
#pragma unroll
                for (int p = 0; p < 3; ++p) { const pg8::bf16x8 bfr = *(const LAS pg8::bf16x8*)(wl + p * 16384 + (sl * 2 + t) * 512 + lane * 8);
                    acc = __builtin_amdgcn_mfma_f32_16x16x32_bf16(af, bfr, acc, 0, 0, 0); } }
#pragma unroll
            for (int q = 0; q < 16; ++q) ssq += f[q] * f[q];
            pg8::u32x4 o8; o8.x = pk_fp8x4(f[0], f[1], f[2], f[3]); o8.y = pk_fp8x4(f[4], f[5], f[6], f[7]); o8.z = pk_fp8x4(f[8], f[9], f[10], f[11]); o8.w = pk_fp8x4(f[12], f[13], f[14], f[15]);
            h8[sl * 4] = o8; } }
    ssq += __shfl_xor(ssq, 16); ssq += __shfl_xor(ssq, 32);
    const float rstd = rsqrtf(ssq * (1.f / DM) + EPS);
    if (kq == 0) R2[row0 + ri] = rstd;
    const int me = lane & 15, rg = lane >> 4; float af4[4];
#pragma unroll
    for (int r = 0; r < 4; ++r) { const float rs = __shfl(rstd, 4 * rg + r); const float lg = acc[r] * rs; float mx = lg;
#pragma unroll
        for (int o = 1; o < 16; o <<= 1) mx = fmaxf(mx, __shfl_xor(mx, o));
        const float ex = __expf(lg - mx); float den = ex;
#pragma unroll
        for (int o = 1; o < 16; o <<= 1) den += __shfl_xor(den, o);
        af4[r] = ex / den; }
    { const int b0 = row0 / NS, s0 = row0 % NS; *(float4*)(AFF + ((size_t)b0 * NE + me) * NS + s0 + 4 * rg) = make_float4(af4[0], af4[1], af4[2], af4[3]); }
    __syncthreads();
}
__device__ __forceinline__ void ph_topk(unsigned char* ws, LAS unsigned char* lds, int bx, int G, int tid) {
    LAS unsigned* hist = (LAS unsigned*)lds;
    LAS unsigned* sh = hist + 256;
    LAS unsigned* wcnt = hist + 512;
    const int lane = tid & 63, wave = tid >> 6;
    const float* AFF = (const float*)(ws + WS_AFF); int* INV = (int*)(ws + WS_INV); int* IDX = (int*)(ws + WS_IDX); float* GATE = (float*)(ws + WS_GATE);
    for (int be = bx; be < NB * NE; be += G) {
        const int b = be / NE, e = be % NE; const float* src = AFF + (size_t)be * NS;
        unsigned u[8];
#pragma unroll
        for (int i = 0; i < 8; ++i) u[i] = __float_as_uint(src[tid * 8 + i]);
        unsigned prefix = 0u, krem = CAP;
#pragma unroll 1
        for (int pass = 0; pass < 4; ++pass) { const int shift = 24 - 8 * pass; const unsigned pmask = pass == 0 ? 0u : (0xffffffffu << (shift + 8));
            if (tid < 256) hist[tid] = 0u;
            __syncthreads();
#pragma unroll
            for (int i = 0; i < 8; ++i) if ((u[i] & pmask) == prefix) __hip_atomic_fetch_add(&hist[(u[i] >> shift) & 255u], 1u, __ATOMIC_RELAXED, __HIP_MEMORY_SCOPE_WORKGROUP);
            __syncthreads();
            if (wave == 0) {
                unsigned c4[4]; unsigned tot = 0u;
#pragma unroll
                for (int i = 0; i < 4; ++i) { c4[i] = hist[255 - (lane * 4 + i)]; tot += c4[i]; }
                unsigned inc = tot;
#pragma unroll
                for (int o = 1; o < 64; o <<= 1) { const unsigned t = __shfl_up(inc, o); if (lane >= o) inc += t; }
                const unsigned before = inc - tot;
                if (before < krem && inc >= krem) { unsigned acc = before;
#pragma unroll
                    for (int i = 0; i < 4; ++i) { if (acc < krem && acc + c4[i] >= krem) { sh[0] = prefix | ((unsigned)(255 - (lane * 4 + i)) << shift); sh[1] = krem - acc; } acc += c4[i]; } }
            }
            __syncthreads();
            prefix = sh[0]; krem = sh[1];
            __syncthreads();
        }
        unsigned ngt = 0u, neq = 0u;
#pragma unroll
        for (int i = 0; i < 8; ++i) { ngt += (u[i] > prefix) ? 1u : 0u; neq += (u[i] == prefix) ? 1u : 0u; }
        unsigned ig = ngt, iq = neq;
#pragma unroll
        for (int o = 1; o < 64; o <<= 1) { const unsigned tg = __shfl_up(ig, o), tq = __shfl_up(iq, o); if (lane >= o) { ig += tg; iq += tq; } }
        if (lane == 63) { wcnt[wave * 2] = ig; wcnt[wave * 2 + 1] = iq; }
        __syncthreads();
        unsigned bg = 0u, bq = 0u;
        for (int w = 0; w < wave; ++w) { bg += wcnt[w * 2]; bq += wcnt[w * 2 + 1]; }
        unsigned pg = bg + ig - ngt, pq = bq + iq - neq;
#pragma unroll
        for (int i = 0; i < 8; ++i) { const int idx = tid * 8 + i; int slot = -1;
            if (u[i] > prefix) { slot = (int)(pg + min(pq, krem)); ++pg; }
            else if (u[i] == prefix) { if (pq < krem) slot = (int)(pg + pq); ++pq; }
            INV[(size_t)be * NS + idx] = slot;
            if (slot >= 0) { IDX[e * (NB * CAP) + b * CAP + slot] = b * NS + idx; GATE[(size_t)e * (NB * CAP) + b * CAP + slot] = __uint_as_float(u[i]); } }
        __syncthreads();
    }
}
__device__ __forceinline__ void ph_combine(const MegaArgs& a, int l, int gw, int ngw, int lane) {
    const unsigned char* Y = a.ws + WS_PROJ; const int* INV = (const int*)(a.ws + WS_INV); bf16* HB = (bf16*)(a.ws + WS_HB); float* R1 = (float*)(a.ws + WS_RSTD1); const bool last = (l == DEPTH - 1);
    uint2 wn[4]; int slot_n = -1;
    if (gw < NT) { const uint2* p = (const uint2*)(HB + (size_t)gw * DM) + lane;
#pragma unroll
        for (int j = 0; j < 4; ++j) wn[j] = p[64 * j];
        if (lane < NE) slot_n = INV[((size_t)(gw / NS) * NE + lane) * NS + (gw % NS)]; }
    for (int row = gw; row < NT; row += ngw) { const int b = row / NS;
        float4 v[4];
#pragma unroll
        for (int j = 0; j < 4; ++j) v[j] = make_float4(bf2f(wn[j].x & 0xffff), bf2f(wn[j].x >> 16), bf2f(wn[j].y & 0xffff), bf2f(wn[j].y >> 16));
        const int slot_l = slot_n; const int nrow = row + ngw;
        if (nrow < NT) { const uint2* p = (const uint2*)(HB + (size_t)nrow * DM) + lane;
#pragma unroll
            for (int j = 0; j < 4; ++j) wn[j] = p[64 * j];
            slot_n = -1; if (lane < NE) slot_n = INV[((size_t)(nrow / NS) * NE + lane) * NS + (nrow % NS)]; }
        unsigned long long msk = __ballot(slot_l >= 0);
        while (msk) { const int e = __builtin_ctzll(msk); msk &= msk - 1; const int slot = __shfl(slot_l, e);
            const unsigned* y = (const unsigned*)(Y + ((size_t)e * (NB * CAP) + b * CAP + slot) * DM) + lane;
            unsigned w[4]; unsigned w2[4]; int e2 = -1;
#pragma unroll
            for (int j = 0; j < 4; ++j) w[j] = y[64 * j];
            if (msk) { e2 = __builtin_ctzll(msk); msk &= msk - 1; const int slot2 = __shfl(slot_l, e2); const unsigned* y2 = (const unsigned*)(Y + ((size_t)e2 * (NB * CAP) + b * CAP + slot2) * DM) + lane;
#pragma unroll
                for (int j = 0; j < 4; ++j) w2[j] = y2[64 * j]; }
#pragma unroll
            for (int j = 0; j < 4; ++j) { const att::f32x2_t lo = __builtin_amdgcn_cvt_pk_f32_fp8((int)w[j], false), hi = __builtin_amdgcn_cvt_pk_f32_fp8((int)w[j], true); v[j].x += lo[0] * (1.f / Y8_SCALE); v[j].y += lo[1] * (1.f / Y8_SCALE); v[j].z += hi[0] * (1.f / Y8_SCALE); v[j].w += hi[1] * (1.f / Y8_SCALE); }
            if (e2 >= 0) {
#pragma unroll
                for (int j = 0; j < 4; ++j) { const att::f32x2_t lo = __builtin_amdgcn_cvt_pk_f32_fp8((int)w2[j], false), hi = __builtin_amdgcn_cvt_pk_f32_fp8((int)w2[j], true); v[j].x += lo[0] * (1.f / Y8_SCALE); v[j].y += lo[1] * (1.f / Y8_SCALE); v[j].z += hi[0] * (1.f / Y8_SCALE); v[j].w += hi[1] * (1.f / Y8_SCALE); } } }
        if (last) { float ssum = 0.f;
#pragma unroll
            for (int j = 0; j < 4; ++j) ssum += v[j].x * v[j].x + v[j].y * v[j].y + v[j].z * v[j].z + v[j].w * v[j].w;
            const float rstd = rsqrtf(wave_sum(ssum) * (1.f / DM) + EPS); float4* orow = (float4*)(a.out + (size_t)row * DM) + lane;
#pragma unroll
            for (int j = 0; j < 4; ++j) { const float4 gg = ((const float4*)a.final_norm)[lane + 64 * j]; orow[64 * j] = make_float4(v[j].x * rstd * gg.x, v[j].y * rstd * gg.y, v[j].z * rstd * gg.z, v[j].w * rstd * gg.w); } }
        else row_store_bf16(v, HB + (size_t)row * DM, R1 + row, lane);
    }
}

enum { PL_PROJ = 0, PL_MLAUP, PL_ATTN, PL_OUT, PL_ROUTER, PL_TOPK, PL_MOE1, PL_MOE2, PL_COMBINE, PL_COUNT };
constexpr int N_PHASES = 1 + DEPTH * PL_COUNT;
constexpr int TIME_PH = -1;
constexpr int REP_PH = -1;
#define REPEAT(ph) for (int rep_ = 0; rep_ < (REP_PH == (ph) ? 2 : 1); ++rep_)
#define IN(k) (lo <= (k) && (k) < hi)
#define SEAM(k) do { if (IN((k) + 1)) xcd_barrier(bar, t_ == 0); if (TIME_PH >= 0) { const unsigned long long now_ = __builtin_amdgcn_s_memrealtime(); \
        if (((k) == 0 ? 9 : ((k) - 1) % PL_COUNT) == TIME_PH) { const unsigned long long d_ = now_ - tph; while (__builtin_amdgcn_s_memrealtime() - now_ < d_) __builtin_amdgcn_s_sleep(16); } \
        tph = __builtin_amdgcn_s_memrealtime(); } } while (0)
#define PH_LOCALS unsigned long long z_ = 0; asm volatile("" : "+s"(z_)); unsigned char* ws = a.ws + z_;     \
    int t_ = wave_s * 64 + (int)__builtin_amdgcn_mbcnt_hi(~0u, __builtin_amdgcn_mbcnt_lo(~0u, 0u)); asm volatile("" : "+v"(t_));     \
    int bx = blockIdx.x; asm volatile("" : "+s"(bx)); \
    const int vcu = (bx % 8) * (G / 8) + bx / 8; const int lane = t_ & 63, wave = __builtin_amdgcn_readfirstlane(t_ >> 6), gw = vcu * NWAVES + wave; (void)lane; (void)gw; (void)ws; (void)vcu;
template <int l> __device__ __forceinline__ void layer_phases(const MegaArgs& a, LAS unsigned char* lds, const XcdBarrier& bar, const int lo, const int hi, unsigned long long& tph, const int wave_s) {
    constexpr int G = 256, ngw = G * NWAVES, pb = 1 + l * PL_COUNT;
        if (IN(pb + PL_PROJ)) { PH_LOCALS
            const bool early = ((bx >> 3) & 1) != 0;
            if (early) { ph_prep(a, l, 2, lds, gw, ngw, wave, lane, 0, 2); __syncthreads(); }
            pg8::StaticOrder S; S.init(NT / 256, NP / 256, G, bx, 0);
            LAS float* rst = (LAS float*)(lds + TAB_OFF);
            auto pre = [&]() { const float* R1 = (const float*)(ws + WS_RSTD1); if (t_ < 256) { float v[4]; bool ok[4];
#pragma unroll
              for (int i = 0; i < 4; ++i) { pg8::Unit u; ok[i] = S.next(i, u); v[i] = R1[(ok[i] ? u.pm : 0) * 256 + t_]; }
#pragma unroll
              for (int i = 0; i < 4; ++i) if (ok[i]) rst[i * 256 + t_] = v[i]; } };
            REPEAT(PL_PROJ) {
            pg8::Gemm g{(bf16*)(ws + WS_HB), (bf16*)(ws + WS_WIN), DM, DM, DM, nullptr};
            pg8::EpiProj E{(bf16*)(ws + WS_PROJ), (float*)(ws + WS_CQSS), (float*)(ws + WS_CKVSS), rst};
            pg8::gemm_phase<pg8::EpiProj, pg8::StaticOrder, true, false, false>(lds, g, S, E, t_, pre); }
            if (!early) { __syncthreads(); ph_prep(a, l, 2, lds, gw, ngw, wave, lane, 0, 2); }
            SEAM(pb + PL_PROJ);
        }
        if (IN(pb + PL_MLAUP)) { PH_LOCALS const bool early = ((bx >> 3) & 1) != 0;
            if (early) { ph_prep(a, l, 2, lds, gw, ngw, wave, lane, 1, 2); __syncthreads(); }
            REPEAT(PL_MLAUP) {
            LAS float* rst = (LAS float*)(lds + TAB_OFF);
            { pg8::StaticOrder S; S.init(NT / 256, 3, G, bx, 0); const float* SSQ = (const float*)(ws + WS_CKVSS);
              auto pre = [&]() { if (t_ < 256) { float4 p[2]; bool ok[2];
#pragma unroll
                for (int i = 0; i < 2; ++i) { pg8::Unit u; ok[i] = S.next(i, u); p[i] = *(const float4*)(SSQ + (size_t)((ok[i] ? u.pm : 0) * 256 + t_) * 4); }
#pragma unroll
                for (int i = 0; i < 2; ++i) if (ok[i]) rst[i * 256 + t_] = rsqrtf((p[i].x + p[i].y + p[i].z + p[i].w) * (1.f / 128.f) + EPS); } };
              pg8::Gemm g{(bf16*)(ws + WS_PROJ) + C_CKV, (bf16*)(ws + WS_WUKV), 128, NP, 128, nullptr};
              typedef pg8::EpiMla<false, 768, 768> EK; EK E{(bf16*)(ws + WS_KV), rst};
              pg8::gemm_phase<EK, pg8::StaticOrder, true, false, false>(lds, g, S, E, t_, pre); } }
            if (!early) { __syncthreads(); ph_prep(a, l, 2, lds, gw, ngw, wave, lane, 1, 2); }
            SEAM(pb + PL_MLAUP);
        }
        if (IN(pb + PL_ATTN)) { PH_LOCALS
            REPEAT(PL_ATTN) { const att::AttnP P{(bf16*)(ws + WS_PROJ), (bf16*)(ws + WS_QB), (bf16*)(ws + WS_KV), (bf16*)(ws + WS_XN), (float*)(ws + WS_SS), a.na_rpb + (size_t)l * 4 * 15 * 31, a.swa_sink + l * 6, (const bf16*)(ws + WS_WUQ), (const float*)(ws + WS_CQSS)}; att::attn_phase(P, lds, vcu, t_); }
            SEAM(pb + PL_ATTN);
        }
        if (IN(pb + PL_OUT)) { PH_LOCALS
            const bool early = ((bx >> 3) & 1) != 0;
            if (early) { ph_prep(a, l, 3, lds, gw, ngw, wave, lane, 0, 2); __syncthreads(); }
            pg8::StaticOrder S; S.init(NT / 256, DM / 256, G, bx, 0);
            LAS float* fac = (LAS float*)(lds + TAB_OFF);
            auto pre = [&]() { const float* SS = (const float*)(ws + WS_SS); if (t_ < 256) { float4 sv[2][4]; bool ok[2];
#pragma unroll
              for (int i = 0; i < 2; ++i) { pg8::Unit u; ok[i] = S.next(i, u); const float4* ss4 = (const float4*)(SS + (size_t)((ok[i] ? u.pm : 0) * 256 + t_) * 16); sv[i][0] = ss4[0]; sv[i][1] = ss4[1]; sv[i][2] = ss4[2]; sv[i][3] = ss4[3]; }
#pragma unroll
              for (int i = 0; i < 2; ++i) if (ok[i]) { const float4 s0 = sv[i][0], s1 = sv[i][1], s2 = sv[i][2], s3 = sv[i][3];
                  const float ra = rsqrtf((s0.x + s0.y + s0.z + s0.w) * (1.f / 256.f) + EPS), rb = rsqrtf((s1.x + s1.y + s1.z + s1.w + s2.x + s2.y) * (1.f / 384.f) + EPS), rc = rsqrtf((s2.z + s2.w + s3.x + s3.y + s3.z + s3.w) * (1.f / 384.f) + EPS);
                  LAS float* f = fac + (i * 256 + t_) * 4; f[0] = ra / rb; f[1] = rb / rc; f[2] = rc; f[3] = 0.f; } } };
            pg8::Gemm g{(bf16*)(ws + WS_XN), (bf16*)(ws + WS_WOUT), DM, DM, DM, nullptr};
            pg8::EpiResid E{(bf16*)(ws + WS_HB), fac};
            pg8::gemm_phase<pg8::EpiResid, pg8::StaticOrder, true, false, false>(lds, g, S, E, t_, pre);
            if (!early) { __syncthreads(); ph_prep(a, l, 3, lds, gw, ngw, wave, lane, 0, 2); }
            SEAM(pb + PL_OUT);
        }
        if (IN(pb + PL_ROUTER)) { PH_LOCALS REPEAT(PL_ROUTER) ph_router(a, l, lds, gw, ngw, lane, t_); SEAM(pb + PL_ROUTER); }
        if (IN(pb + PL_TOPK)) { PH_LOCALS ph_topk(ws, lds, bx, G, t_); SEAM(pb + PL_TOPK); }
        if (IN(pb + PL_MOE1)) { PH_LOCALS
            const bool early = ((bx >> 3) & 1) != 0;
            if (early) { ph_prep(a, l, 3, lds, gw, ngw, wave, lane, 1, 2); __syncthreads(); }
            pg8::StaticOrder S; S.init(NSLOTS / 256, 8, G, bx, 16);
            LAS int* gidx = (LAS int*)(lds + TAB_OFF);
            LAS float* rst = (LAS float*)(lds + TAB_OFF + 8192);
            int tok[8];
            if (t_ < 256) { const int* IDX = (const int*)(ws + WS_IDX);
#pragma unroll
              for (int i = 0; i < 8; ++i) { pg8::Unit u; const bool ok = S.next(i, u); const int tk = IDX[(ok ? u.pm : 0) * 256 + t_]; tok[i] = ok ? tk : -1; }
#pragma unroll
              for (int i = 0; i < 8; ++i) if (tok[i] >= 0) gidx[i * 256 + t_] = tok[i]; }
            __syncthreads();
            auto pre = [&]() { const float* R2 = (const float*)(ws + WS_RSTD2); if (t_ < 256) { float v[8];
#pragma unroll
              for (int i = 0; i < 8; ++i) v[i] = R2[tok[i] >= 0 ? tok[i] : 0];
#pragma unroll
              for (int i = 0; i < 8; ++i) if (tok[i] >= 0) rst[i * 256 + t_] = v[i] * (1.f / W8_SCALE); } };
            REPEAT(PL_MOE1) {
            pg8::Gemm g{(bf16*)(ws + WS_HB8), (bf16*)(ws + WS_WGU), DM / 2, DM / 2, DM / 2, gidx};
            pg8::EpiSwiglu E{ws + WS_HID, rst};
            pg8::gemm_phase<pg8::EpiSwiglu, pg8::StaticOrder, true, true, true>(lds, g, S, E, t_, pre); }
            if (!early) { __syncthreads(); ph_prep(a, l, 3, lds, gw, ngw, wave, lane, 1, 2); }
            SEAM(pb + PL_MOE1);
        }
        if (IN(pb + PL_MOE2)) { PH_LOCALS
            const bool early = ((bx >> 3) & 1) != 0;
            if (l + 1 < DEPTH && early) { ph_prep(a, l + 1, 1, lds, gw, ngw, wave, lane); __syncthreads(); }
            pg8::StaticOrder S; S.init(NSLOTS / 256, 4, G, bx, 16); S.rev = 1;
            LAS float* gtab = (LAS float*)(lds + TAB_OFF);
            auto pre = [&]() { const float* GATE = (const float*)(ws + WS_GATE); if (t_ < 256) { float v[4]; bool ok[4];
#pragma unroll
              for (int i = 0; i < 4; ++i) { pg8::Unit u; ok[i] = S.next(i, u); v[i] = GATE[(ok[i] ? u.pm : 0) * 256 + t_]; }
#pragma unroll
              for (int i = 0; i < 4; ++i) if (ok[i]) gtab[i * 256 + t_] = v[i] * (Y8_SCALE / (W8_SCALE * H8_SCALE)); } };
            REPEAT(PL_MOE2) {
            pg8::Gemm g{(bf16*)(ws + WS_HID), (bf16*)(ws + WS_WD), DM / 2, DM / 2, DM / 2, nullptr};
            pg8::EpiGate E{ws + WS_PROJ, gtab};
            pg8::gemm_phase<pg8::EpiGate, pg8::StaticOrder, true, false, true>(lds, g, S, E, t_, pre); }
            if (l + 1 < DEPTH && !early) { __syncthreads(); ph_prep(a, l + 1, 1, lds, gw, ngw, wave, lane); }
            SEAM(pb + PL_MOE2);
        }
        if (IN(pb + PL_COMBINE)) { PH_LOCALS
            ph_combine(a, l, gw, ngw, lane);
            SEAM(pb + PL_COMBINE);
        }
}
__global__ void __launch_bounds__(NWAVES * 64, 2) mega(MegaArgs a) {
    extern __shared__ __attribute__((aligned(16))) unsigned char lds_raw[];
    LAS unsigned char* lds = (LAS unsigned char*)lds_raw;
    constexpr int G = 256;
    constexpr int ngw = G * NWAVES;
    const int wave_s = __builtin_amdgcn_readfirstlane(threadIdx.x >> 6);
    for (int u = threadIdx.x; u < (LDS_BYTES - RING_BYTES) / 4; u += NWAVES * 64) ((LAS unsigned*)(lds + RING_BYTES))[u] = 0u;
    __syncthreads();
    XcdBarrier bar = xcd_barrier_post((unsigned*)(a.ws + WS_CTL) + CW_BAR, (volatile LAS unsigned*)(lds + MISC_OFF) + 8);
    const int lo = a.ph_lo, hi = a.ph_hi;
    unsigned long long tph = (TIME_PH >= 0) ? __builtin_amdgcn_s_memrealtime() : 0ull;
    if (IN(0)) { PH_LOCALS ph_prep(a, 0, 1, lds, gw, ngw, wave, lane); ph_norm_x(a, gw, ngw, lane); SEAM(0); }
    layer_phases<0>(a, lds, bar, lo, hi, tph, wave_s);
    layer_phases<1>(a, lds, bar, lo, hi, tph, wave_s);
    static_assert(DEPTH == 2, "two layers are written out");
}


#ifndef MK_PER_PHASE
#define MK_PER_PHASE 0
#endif
extern "C" void kernel_launch(void* const* d_in, const int* in_sizes, int n_in, void* d_out, int out_size, void* d_ws, size_t ws_size, hipStream_t stream) {
    if (n_in != 17 || out_size != NT * DM || ws_size < WS_END) { fprintf(stderr, "kernel_launch: unexpected shapes (n_in %d out %d ws %zu)\n", n_in, out_size, ws_size); return; }
    static int grid = 0;
    if (grid == 0) { int dev = 0, cus = 0; (void)hipGetDevice(&dev); (void)hipDeviceGetAttribute(&cus, hipDeviceAttributeMultiprocessorCount, dev);
        if (hipFuncSetAttribute((const void*)mega, hipFuncAttributeMaxDynamicSharedMemorySize, LDS_BYTES) != hipSuccess) fprintf(stderr, "hipFuncSetAttribute failed\n");
        if (cus != 256) fprintf(stderr, "kernel_launch: built for a 256-CU device (got %d CUs)\n", cus);
        grid = 256; }
    (void)hipMemsetAsync((char*)d_ws + WS_CTL, 0, 64 * 1024, stream);
    MegaArgs ma{};
    ma.x = (const float*)d_in[0]; ma.attn_norm = (const float*)d_in[1]; ma.w_in = (const float*)d_in[2]; ma.na_rpb = (const float*)d_in[3]; ma.q_norm = (const float*)d_in[4]; ma.w_uq = (const float*)d_in[5];
    ma.kv_norm = (const float*)d_in[6]; ma.w_ukv = (const float*)d_in[7]; ma.swa_sink = (const float*)d_in[8]; ma.group_norm = (const float*)d_in[9]; ma.w_out = (const float*)d_in[10]; ma.ffn_norm = (const float*)d_in[11];
    ma.w_router = (const float*)d_in[12]; ma.w_gate = (const float*)d_in[13]; ma.w_up = (const float*)d_in[14]; ma.w_down = (const float*)d_in[15]; ma.final_norm = (const float*)d_in[16];
    ma.out = (float*)d_out; ma.ws = (unsigned char*)d_ws;
#if MK_PER_PHASE
    for (int p = 0; p < N_PHASES; ++p) { ma.ph_lo = p; ma.ph_hi = p + 1; hipLaunchKernelGGL(mega, dim3(grid), dim3(NWAVES * 64), LDS_BYTES, stream, ma); }
#else
    ma.ph_lo = 0; ma.ph_hi = N_PHASES; hipLaunchKernelGGL(mega, dim3(grid), dim3(NWAVES * 64), LDS_BYTES, stream, ma);
#endif
}
```
